# Optimizing an MI355X kernel written in HIP

```python
import math
import jax, jax.numpy as jnp
from jax import lax
import numpy as np

D_MODEL = 1024
BATCH = 4
SEQ = 4096
DEPTH = 2

D_MIX = D_MODEL
D_A = 3 * D_MIX // 8
D_B = 3 * D_MIX // 8
D_C = D_MIX - D_A - D_B
HEAD_DIM = 64
N_Q_HEADS = D_B // HEAD_DIM
N_KV_HEADS = 2
GROUP = N_Q_HEADS // N_KV_HEADS
D_KV = N_KV_HEADS * HEAD_DIM
D_IN = 2 * D_A + D_B + 2 * D_KV + 3 * D_C
LRU_BW = 64
LRU_BLOCKS = D_A // LRU_BW
C_LRU = 8.0
CONV_A = 4
WINDOW = 128
BLOCK = 128
ROPE_THETA = 500000.0
ROT_DIM = HEAD_DIM // 4
CONV_C = 3
HY_EMB = 33
HY_BANDS = (HY_EMB - 1) // 2
HY_WIDTH = 64
HY_TARGET = 1e-2
HY_MAX_DECAY = math.log(HY_TARGET) / 0.3
HY_MIN_DECAY = math.log(HY_TARGET) / 1.5
D_FF = 4 * D_MODEL
EPS = 1e-6
NEG = -1e30

kernel_name = "hybrid_rglru_swa_hyena_encoder"

F32 = jnp.float32


def rmsnorm(x, g):
    xf = x.astype(F32)
    y = xf * lax.rsqrt(jnp.mean(xf * xf, axis=-1, keepdims=True) + EPS) * g.astype(F32)
    return y.astype(x.dtype)


def depthwise_conv(x, w, b, pad_left, pad_right):
    L = x.shape[1]
    xp = jnp.pad(x, ((0, 0), (pad_left, pad_right), (0, 0)))
    y = xp[:, 0:L] * w[0]
    for k in range(1, w.shape[0]):
        y = y + xp[:, k:k + L] * w[k]
    return y + b


def rope_tables(L):
    pos = jnp.arange(L, dtype=F32)
    inv_freq = ROPE_THETA ** (-jnp.arange(0, ROT_DIM, 2, dtype=F32) / ROT_DIM)
    ang = pos[:, None] * inv_freq[None, :]
    return jnp.cos(ang), jnp.sin(ang)


def rope_partial(t, cos, sin):
    half = ROT_DIM // 2
    tf = t.astype(F32)
    t1, t2, rest = tf[..., :half], tf[..., half:ROT_DIM], tf[..., ROT_DIM:]
    c = cos[None, :, None, :]
    s = sin[None, :, None, :]
    return jnp.concatenate([t1 * c - t2 * s, t2 * c + t1 * s, rest], axis=-1).astype(t.dtype)


def linear_scan(a, b, reverse):
    def combine(c1, c2):
        a1, b1 = c1
        a2, b2 = c2
        return a1 * a2, a2 * b1 + b2
    _, h = lax.associative_scan(combine, (a, b), axis=1, reverse=reverse)
    return h


def rglru_mixer(u, gate, conv_w, conv_b, wa, ba, wx, bx, lam):
    xc = depthwise_conv(u, conv_w, conv_b, 2, 1).astype(F32)
    Bn, L, _ = xc.shape
    xb = xc.reshape(Bn, L, LRU_BLOCKS, LRU_BW)
    r = jax.nn.sigmoid(jnp.einsum("blhi,nhij->nblhj", xb, wa.astype(F32)).reshape(2, Bn, L, D_A)
                       + ba.astype(F32)[:, None, None, :])
    i = jax.nn.sigmoid(jnp.einsum("blhi,nhij->nblhj", xb, wx.astype(F32)).reshape(2, Bn, L, D_A)
                       + bx.astype(F32)[:, None, None, :])
    log_a = -C_LRU * r * jax.nn.softplus(-lam.astype(F32))[:, None, None, :]
    a = jnp.exp(log_a)
    b = jnp.sqrt(-jnp.expm1(2.0 * log_a)) * (i * xc[None])
    h = linear_scan(a[0], b[0], reverse=False) + linear_scan(a[1], b[1], reverse=True)
    return (h * jax.nn.gelu(gate.astype(F32))).astype(u.dtype)


def window_attention(q, k, v, sink, cos, sin):
    Bn, L = q.shape[0], q.shape[1]
    nblk = L // BLOCK
    q = rope_partial(q.reshape(Bn, L, N_Q_HEADS, HEAD_DIM), cos, sin)
    k = rope_partial(k.reshape(Bn, L, N_KV_HEADS, HEAD_DIM), cos, sin)
    v = v.reshape(Bn, L, N_KV_HEADS, HEAD_DIM)
    qb = q.reshape(Bn, nblk, BLOCK, N_KV_HEADS, GROUP, HEAD_DIM)

    def band(t):
        tp = jnp.pad(t, ((0, 0), (BLOCK, BLOCK), (0, 0), (0, 0)))
        tp = tp.reshape(Bn, nblk + 2, BLOCK, N_KV_HEADS, HEAD_DIM)
        return jnp.concatenate([tp[:, :-2], tp[:, 1:-1], tp[:, 2:]], axis=2)

    kb, vb = band(k), band(v)
    s = jnp.einsum("bnqhgd,bnshd->bnhgqs", qb.astype(F32), kb.astype(F32)) * (HEAD_DIM ** -0.5)
    blk = jnp.arange(nblk)[:, None]
    qpos = blk * BLOCK + jnp.arange(BLOCK)[None, :]
    kpos = (blk - 1) * BLOCK + jnp.arange(3 * BLOCK)[None, :]
    diff = qpos[:, :, None] - kpos[:, None, :]
    valid = (jnp.abs(diff) <= WINDOW) & (kpos[:, None, :] >= 0) & (kpos[:, None, :] < L)
    s = jnp.where(valid[None, :, None, None], s, NEG)
    sk = sink.astype(F32).reshape(N_KV_HEADS, GROUP)[None, None, :, :, None, None]
    m = jnp.maximum(jnp.max(s, axis=-1, keepdims=True), sk)
    p = jnp.exp(s - m)
    denom = jnp.sum(p, axis=-1, keepdims=True) + jnp.exp(sk - m)
    o = jnp.einsum("bnhgqs,bnshd->bnqhgd", p / denom, vb.astype(F32))
    return o.reshape(Bn, L, D_B).astype(q.dtype)


def hyena_filters(L, w1, b1, freq, w2, b2, w3):
    t = jnp.linspace(0.0, 1.0, L, dtype=F32)[:, None]
    w = 2.0 * math.pi * jnp.arange(L, dtype=F32)[:, None] / L
    f = jnp.linspace(1e-4, HY_BANDS - 1, HY_BANDS, dtype=F32)[None, :]
    z = jnp.concatenate([t, jnp.cos(f * w), -jnp.sin(f * w)], axis=-1)
    fr = freq.astype(F32)
    hdn = jnp.sin(fr * (z @ w1.astype(F32) + b1.astype(F32)))
    hdn = jnp.sin(fr * (hdn @ w2.astype(F32) + b2.astype(F32)))
    filt = (hdn @ w3.astype(F32)).reshape(L, 2, D_C)
    deltas = jnp.abs(jnp.linspace(HY_MIN_DECAY, HY_MAX_DECAY, D_C, dtype=F32))
    decay = jnp.exp(-t * deltas[None, :])
    filt = filt * decay[:, None, :]
    return filt[:, 0], filt[:, 1]


def hyena_mixer(u, conv_w, conv_b, h_fwd, h_bwd, bias):
    uc = depthwise_conv(u, conv_w, conv_b, 1, 1).astype(F32)
    L = uc.shape[1]
    x0, x1, v = jnp.split(uc, 3, axis=-1)
    z = v * x1
    filt_circ = jnp.concatenate([h_fwd, jnp.zeros((1, D_C), F32), h_bwd[1:][::-1]], axis=0)
    zf = jnp.fft.rfft(z, n=2 * L, axis=1)
    hf = jnp.fft.rfft(filt_circ, n=2 * L, axis=0)
    y = jnp.fft.irfft(zf * hf[None], n=2 * L, axis=1)[:, :L] + z * bias.astype(F32)
    return (y * x0).astype(u.dtype)


def setup_inputs(seed: int = 0) -> dict:
    key = jax.random.key(seed)
    ks = jax.random.split(key, 32)

    def nrm(k, shape, scale):
        return jax.random.normal(k, shape, F32) * scale

    a0 = jax.random.uniform(ks[9], (DEPTH, 2, D_A), F32, 0.9, 0.999)
    return {
        "x": nrm(ks[0], (BATCH, SEQ, D_MODEL), 1.0),
        "norm_mix_g": 1.0 + nrm(ks[1], (DEPTH, D_MODEL), 0.02),
        "w_in": nrm(ks[2], (DEPTH, D_MODEL, D_IN), D_MODEL ** -0.5),
        "conv_a_w": nrm(ks[3], (DEPTH, CONV_A, D_A), CONV_A ** -0.5),
        "conv_a_b": nrm(ks[4], (DEPTH, D_A), 0.01),
        "lru_wa": nrm(ks[5], (DEPTH, 2, LRU_BLOCKS, LRU_BW, LRU_BW), LRU_BW ** -0.5),
        "lru_ba": nrm(ks[6], (DEPTH, 2, D_A), 0.01),
        "lru_wx": nrm(ks[7], (DEPTH, 2, LRU_BLOCKS, LRU_BW, LRU_BW), LRU_BW ** -0.5),
        "lru_bx": nrm(ks[8], (DEPTH, 2, D_A), 0.01),
        "lru_lambda": jnp.log(a0) - jnp.log1p(-a0),
        "attn_sink": nrm(ks[10], (DEPTH, N_Q_HEADS), 0.5),
        "hy_conv_w": nrm(ks[11], (DEPTH, CONV_C, 3 * D_C), CONV_C ** -0.5),
        "hy_conv_b": nrm(ks[12], (DEPTH, 3 * D_C), 0.01),
        "hy_w1": nrm(ks[13], (DEPTH, HY_EMB, HY_WIDTH), HY_EMB ** -0.5),
        "hy_b1": nrm(ks[14], (DEPTH, HY_WIDTH), 0.1),
        "hy_freq": 1.0 + nrm(ks[15], (DEPTH, HY_WIDTH), 0.05),
        "hy_w2": nrm(ks[16], (DEPTH, HY_WIDTH, HY_WIDTH), HY_WIDTH ** -0.5),
        "hy_b2": nrm(ks[17], (DEPTH, HY_WIDTH), 0.1),
        "hy_w3": nrm(ks[18], (DEPTH, HY_WIDTH, 2 * D_C), HY_WIDTH ** -0.5),
        "hy_bias": nrm(ks[19], (DEPTH, D_C), 0.1),
        "gnorm_a": 1.0 + nrm(ks[20], (DEPTH, D_A), 0.02),
        "gnorm_b": 1.0 + nrm(ks[21], (DEPTH, D_B), 0.02),
        "gnorm_c": 1.0 + nrm(ks[22], (DEPTH, D_C), 0.02),
        "w_out": nrm(ks[23], (DEPTH, D_MIX, D_MODEL), D_MIX ** -0.5),
        "norm_mlp_g": 1.0 + nrm(ks[24], (DEPTH, D_MODEL), 0.02),
        "w_up": nrm(ks[25], (DEPTH, D_MODEL, D_FF), D_MODEL ** -0.5),
        "w_down": nrm(ks[26], (DEPTH, D_FF, D_MODEL), D_FF ** -0.5),
        "final_norm_g": 1.0 + nrm(ks[27], (D_MODEL,), 0.02),
    }


def reference(x, norm_mix_g, w_in, conv_a_w, conv_a_b, lru_wa, lru_ba, lru_wx, lru_bx, lru_lambda,
              attn_sink, hy_conv_w, hy_conv_b, hy_w1, hy_b1, hy_freq, hy_w2, hy_b2, hy_w3, hy_bias,
              gnorm_a, gnorm_b, gnorm_c, w_out, norm_mlp_g, w_up, w_down, final_norm_g):
    L = x.shape[1]
    cos, sin = rope_tables(L)
    splits = [D_A, 2 * D_A, 2 * D_A + D_B, 2 * D_A + D_B + D_KV, 2 * D_A + D_B + 2 * D_KV]
    for i in range(DEPTH):
        h = rmsnorm(x, norm_mix_g[i])
        p = h @ w_in[i]
        a_x, a_g, q, k, v, c_u = jnp.split(p, splits, axis=-1)
        y_a = rglru_mixer(a_x, a_g, conv_a_w[i], conv_a_b[i], lru_wa[i], lru_ba[i],
                          lru_wx[i], lru_bx[i], lru_lambda[i])
        y_b = window_attention(q, k, v, attn_sink[i], cos, sin)
        h_fwd, h_bwd = hyena_filters(L, hy_w1[i], hy_b1[i], hy_freq[i], hy_w2[i], hy_b2[i], hy_w3[i])
        y_c = hyena_mixer(c_u, hy_conv_w[i], hy_conv_b[i], h_fwd, h_bwd, hy_bias[i])
        y = jnp.concatenate([rmsnorm(y_a, gnorm_a[i]), rmsnorm(y_b, gnorm_b[i]),
                             rmsnorm(y_c, gnorm_c[i])], axis=-1)
        x = x + (y @ w_out[i]).astype(x.dtype)
        h2 = rmsnorm(x, norm_mlp_g[i])
        x = x + (jnp.square(jax.nn.relu(h2 @ w_up[i])) @ w_down[i]).astype(x.dtype)
    return rmsnorm(x, final_norm_g)
```

```cpp
#include <hip/hip_runtime.h>
#include <stdint.h>
#include <math.h>

typedef unsigned short bf16_t;
typedef short bf16x8 __attribute__((ext_vector_type(8)));
typedef float f32x4 __attribute__((ext_vector_type(4)));

constexpr int NB = 4, SL = 4096, DM = 1024, MT = NB * SL, DEPTH = 2;
constexpr int DA = 384, DBB = 384, DC = 256, HD = 64, NQH = 6, NKVH = 2, DIN = 2176, DINP = 2304, DFF = 4096;
constexpr int P_AX = 0, P_AG = 384, P_Q = 768, P_K = 1152, P_V = 1280, P_CU = 1408;
constexpr int LRU_BLK = 6, LRU_BW = 64, WIN = 128, HY_EMB = 33, HY_W = 64;
constexpr float EPS = 1e-6f;

constexpr size_t MiB = 1u << 20;
constexpr size_t WS_WIN = 0;
constexpr size_t WS_WOUT = 9 * MiB;
constexpr size_t WS_WUP = 13 * MiB;
constexpr size_t WS_WDN = 29 * MiB;
constexpr size_t WS_ROPE = 45 * MiB;
constexpr size_t WS_SS = 45 * MiB + 512 * 1024;
constexpr size_t WS_HF = 46 * MiB;
constexpr size_t WS_XG = 62 * MiB;
constexpr size_t WS_BIG = 94 * MiB;
constexpr size_t WS_H = WS_BIG;
constexpr size_t WS_P = WS_BIG;
constexpr size_t WS_YN = WS_BIG + 72 * MiB;
constexpr size_t WS_SCR = WS_BIG + 104 * MiB;
constexpr size_t NV_A = WS_XG;
constexpr size_t NV_B = WS_SCR;
constexpr size_t NV_HS = WS_SCR + 24 * MiB;
constexpr size_t NV_Z = WS_SCR;
constexpr size_t NV_X0 = WS_SCR + 16 * MiB;
constexpr size_t NV_YC = WS_SCR + 32 * MiB;
constexpr size_t WS_END = WS_SCR + 48 * MiB;

__device__ __forceinline__ unsigned f2bf(float f) { unsigned u = __builtin_bit_cast(unsigned, f); return (u + 0x7fffu + ((u >> 16) & 1u)) >> 16; }
__device__ __forceinline__ float bf2f(bf16_t h) { return __builtin_bit_cast(float, (unsigned)h << 16); }
__device__ __forceinline__ float sigmoidf_(float x) { return 1.f / (1.f + expf(-x)); }
__device__ __forceinline__ float gelu_tanh(float x) { const float u = 0.7978845608028654f * (x + 0.044715f * x * x * x); return 0.5f * x * (1.f + tanhf(u)); }

__device__ __forceinline__ float block_sum(float v, float* red) {
    for (int o = 32; o > 0; o >>= 1) v += __shfl_xor(v, o);
    const int w = threadIdx.x >> 6, nw = blockDim.x >> 6;
    __syncthreads();
    if ((threadIdx.x & 63) == 0) red[w] = v;
    __syncthreads();
    float s = 0.f;
    for (int i = 0; i < nw; ++i) s += red[i];
    return s;
}

__global__ void k_wconv(const float* __restrict__ W, bf16_t* __restrict__ Wt, int K, int N, int Npad) {
    __shared__ float tile[32][33];
    const int k0 = blockIdx.x * 32, n0 = blockIdx.y * 32, tx = threadIdx.x & 31, ty = threadIdx.x >> 5;
    for (int i = ty; i < 32; i += 8) { const int n = n0 + tx; tile[i][tx] = (n < N) ? W[(size_t)(k0 + i) * N + n] : 0.f; }
    __syncthreads();
    for (int i = ty; i < 32; i += 8) { const int n = n0 + i; if (n < Npad) Wt[(size_t)n * K + k0 + tx] = (bf16_t)f2bf(tile[tx][i]); }
}

__global__ void k_rope(float* __restrict__ tab) {
    const int i = blockIdx.x * blockDim.x + threadIdx.x; if (i >= SL * 8) return;
    const int pos = i >> 3, j = i & 7;
    const double inv = pow(500000.0, -(double)j / 8.0), ang = (double)pos * inv;
    tab[pos * 16 + j] = (float)cos(ang); tab[pos * 16 + 8 + j] = (float)sin(ang);
}

__global__ void k_hy_filter(const float* __restrict__ w1, const float* __restrict__ b1, const float* __restrict__ freq, const float* __restrict__ w2,
                            const float* __restrict__ b2, const float* __restrict__ w3, float* __restrict__ HF) {
    __shared__ float z[HY_EMB], h1[HY_W], h2[HY_W];
    const int t = blockIdx.x, tid = threadIdx.x;
    const double PI2 = 6.283185307179586476925286766559;
    const float tt = (float)((double)t / (double)(SL - 1));
    if (tid < HY_EMB) {
        float v;
        if (tid == 0) v = tt;
        else { const int bi = (tid - 1) & 15; const double f = 1e-4 + (double)bi * ((15.0 - 1e-4) / 15.0); const double w = PI2 * (double)t / (double)SL;
               v = (tid <= 16) ? (float)cos(f * w) : (float)(-sin(f * w)); }
        z[tid] = v;
    }
    __syncthreads();
    if (tid < HY_W) { float a = b1[tid]; for (int i = 0; i < HY_EMB; ++i) a += z[i] * w1[i * HY_W + tid]; h1[tid] = sinf(freq[tid] * a); }
    __syncthreads();
    if (tid < HY_W) { float a = b2[tid]; for (int i = 0; i < HY_W; ++i) a += h1[i] * w2[i * HY_W + tid]; h2[tid] = sinf(freq[tid] * a); }
    __syncthreads();
    const double mind = log(1e-2) / 1.5, maxd = log(1e-2) / 0.3;
    for (int o = tid; o < 2 * DC; o += 256) {
        float a = 0.f; for (int i = 0; i < HY_W; ++i) a += h2[i] * w3[i * 2 * DC + o];
        const int c = o & 255, dir = o >> 8;
        const float delta = fabsf((float)(mind + (maxd - mind) * (double)c / 255.0));
        HF[((size_t)dir * SL + t) * DC + c] = a * expf(-tt * delta);
    }
}

__global__ void k_norm_xg(const float* __restrict__ x, const float* __restrict__ g, bf16_t* __restrict__ XG, float* __restrict__ SS) {
    const int row = blockIdx.x, tid = threadIdx.x;
    const f32x4 v = *(const f32x4*)(x + (size_t)row * DM + tid * 4), gg = *(const f32x4*)(g + tid * 4);
    float s = v[0] * v[0] + v[1] * v[1] + v[2] * v[2] + v[3] * v[3];
    for (int o = 32; o > 0; o >>= 1) s += __shfl_xor(s, o);
    if ((tid & 63) == 0) SS[row * 4 + (tid >> 6)] = s;
    unsigned lo = f2bf(v[0] * gg[0]) | (f2bf(v[1] * gg[1]) << 16), hi = f2bf(v[2] * gg[2]) | (f2bf(v[3] * gg[3]) << 16);
    *(uint2*)(XG + (size_t)row * DM + tid * 4) = make_uint2(lo, hi);
}

__device__ __forceinline__ float row_rstd(const float* SS, int row) { const f32x4 s = *(const f32x4*)(SS + row * 4); return 1.f / sqrtf((s[0] + s[1] + s[2] + s[3]) * (1.f / DM) + EPS); }
struct EpiWin { bf16_t* P; const float* SS;
    __device__ void operator()(int row, int col, f32x4 v) const { const float r = row_rstd(SS, row);
        *(uint2*)(P + (size_t)row * DINP + col) = make_uint2(f2bf(v[0] * r) | (f2bf(v[1] * r) << 16), f2bf(v[2] * r) | (f2bf(v[3] * r) << 16)); } };
struct EpiRes { const float* base; float* out;
    __device__ void operator()(int row, int col, f32x4 v) const { const f32x4 b = *(const f32x4*)(base + (size_t)row * DM + col); *(f32x4*)(out + (size_t)row * DM + col) = b + v; } };
struct EpiUp { bf16_t* H; const float* SS;
    __device__ void operator()(int row, int col, f32x4 v) const { const float r = row_rstd(SS, row);
        float a[4]; for (int i = 0; i < 4; ++i) { const float t = fmaxf(v[i] * r, 0.f); a[i] = t * t; }
        *(uint2*)(H + (size_t)row * DFF + col) = make_uint2(f2bf(a[0]) | (f2bf(a[1]) << 16), f2bf(a[2]) | (f2bf(a[3]) << 16)); } };

template <class Epi>
__global__ __launch_bounds__(256) void k_gemm_nt(const bf16_t* __restrict__ A, const bf16_t* __restrict__ Bt, int K, Epi epi) {
    const int lane = threadIdx.x & 63, wave = threadIdx.x >> 6, fr = lane & 15, fq = lane >> 4;
    const int m0 = blockIdx.y * 128 + wave * 32, n0 = blockIdx.x * 64;
    f32x4 acc[2][4];
    for (int i = 0; i < 2; ++i) for (int j = 0; j < 4; ++j) acc[i][j] = (f32x4){0.f, 0.f, 0.f, 0.f};
    const bf16_t* ap = A + (size_t)(m0 + fr) * K + fq * 8;
    const bf16_t* bp = Bt + (size_t)(n0 + fr) * K + fq * 8;
    for (int k0 = 0; k0 < K; k0 += 32) {
        bf16x8 a[2], b[4];
#pragma unroll
        for (int i = 0; i < 2; ++i) a[i] = *(const bf16x8*)(ap + (size_t)i * 16 * K + k0);
#pragma unroll
        for (int j = 0; j < 4; ++j) b[j] = *(const bf16x8*)(bp + (size_t)j * 16 * K + k0);
#pragma unroll
        for (int i = 0; i < 2; ++i)
#pragma unroll
            for (int j = 0; j < 4; ++j) acc[i][j] = __builtin_amdgcn_mfma_f32_16x16x32_bf16(b[j], a[i], acc[i][j], 0, 0, 0);
    }
#pragma unroll
    for (int i = 0; i < 2; ++i)
#pragma unroll
        for (int j = 0; j < 4; ++j) epi(m0 + 16 * i + fr, n0 + 16 * j + 4 * fq, acc[i][j]);
}

__global__ __launch_bounds__(384) void k_lru_ab(const bf16_t* __restrict__ P, const float* __restrict__ cw, const float* __restrict__ cb, const float* __restrict__ wa, const float* __restrict__ ba,
                                               const float* __restrict__ wx, const float* __restrict__ bx, const float* __restrict__ lam, float* __restrict__ Aout, float* __restrict__ Bout, int n) {
    __shared__ float xc[DA];
    const int m = blockIdx.x, t = m % SL, j = threadIdx.x;
    float v = cb[j];
#pragma unroll
    for (int k = 0; k < 4; ++k) { const int tt = t + k - 2; if (tt >= 0 && tt < SL) v += cw[k * DA + j] * bf2f(P[(size_t)(m + k - 2) * DINP + P_AX + j]); }
    xc[j] = v;
    __syncthreads();
    const int blk = j >> 6, jj = j & 63;
    {
        float ra = ba[n * DA + j], ia = bx[n * DA + j];
        const float* wap = wa + ((size_t)(n * LRU_BLK + blk) * 64) * 64 + jj; const float* wxp = wx + ((size_t)(n * LRU_BLK + blk) * 64) * 64 + jj;
        for (int i = 0; i < 64; ++i) { const float xi = xc[blk * 64 + i]; ra += xi * wap[i * 64]; ia += xi * wxp[i * 64]; }
        const float r = sigmoidf_(ra), ig = sigmoidf_(ia);
        const float l = lam[n * DA + j]; const float sp = (-l > 20.f) ? -l : log1pf(expf(-l));
        const float log_a = -8.f * r * sp;
        const float a = expf(log_a), bb = sqrtf(-expm1f(2.f * log_a)) * (ig * v);
        Aout[(size_t)m * DA + j] = a; Bout[(size_t)m * DA + j] = bb;
    }
}
__global__ void k_lru_scan(const float* __restrict__ A, const float* __restrict__ Bv, float* __restrict__ HS, int n) {
    const int id = blockIdx.x * blockDim.x + threadIdx.x; if (id >= NB * DA) return;
    const int ch = id % DA, b = id / DA;
    float h = 0.f;
    for (int s = 0; s < SL; ++s) { const int t = n ? (SL - 1 - s) : s; const size_t o = ((size_t)b * SL + t) * DA + ch; h = A[o] * h + Bv[o]; HS[o] = n ? (HS[o] + h) : h; }
}
__global__ __launch_bounds__(384) void k_lru_out(const bf16_t* __restrict__ P, const float* __restrict__ HS, const float* __restrict__ gn, bf16_t* __restrict__ YN) {
    __shared__ float red[8];
    const int m = blockIdx.x, j = threadIdx.x;
    const float h = HS[(size_t)m * DA + j];
    const float y = h * gelu_tanh(bf2f(P[(size_t)m * DINP + P_AG + j]));
    const float ss = block_sum(y * y, red);
    const float r = 1.f / sqrtf(ss * (1.f / DA) + EPS);
    YN[(size_t)m * DM + j] = (bf16_t)f2bf(y * r * gn[j]);
}

__global__ __launch_bounds__(384) void k_attn(const bf16_t* __restrict__ P, const float* __restrict__ rope, const float* __restrict__ sink, const float* __restrict__ gn, bf16_t* __restrict__ YN) {
    __shared__ float qs[NQH][HD], ps[NQH][320], red[8];
    const int m = blockIdx.x, t = m % SL, w = threadIdx.x >> 6, lane = threadIdx.x & 63, kvh = w / 3;
    const float* rt = rope + t * 16;
    const bf16_t* qp = P + (size_t)m * DINP + P_Q + w * HD;
    {   float q = bf2f(qp[lane]);
        if (lane < 8) q = q * rt[lane] - bf2f(qp[lane + 8]) * rt[8 + lane];
        else if (lane < 16) q = q * rt[lane - 8] + bf2f(qp[lane - 8]) * rt[lane];
        qs[w][lane] = q; }
    __syncthreads();
    float sv[5]; float mx = sink[w];
#pragma unroll
    for (int pss = 0; pss < 5; ++pss) {
        const int jrel = pss * 64 + lane, jt = t - WIN + jrel; float s = -1e30f;
        if (jrel <= 2 * WIN && jt >= 0 && jt < SL) {
            const bf16_t* kp = P + (size_t)(m - WIN + jrel) * DINP + P_K + kvh * HD; const float* rk = rope + jt * 16;
            float acc = 0.f;
            for (int d = 0; d < 8; ++d) { const float k1 = bf2f(kp[d]), k2 = bf2f(kp[d + 8]); acc += qs[w][d] * (k1 * rk[d] - k2 * rk[8 + d]) + qs[w][d + 8] * (k2 * rk[d] + k1 * rk[8 + d]); }
            for (int d = 16; d < HD; ++d) acc += qs[w][d] * bf2f(kp[d]);
            s = acc * 0.125f;
        }
        sv[pss] = s; mx = fmaxf(mx, s);
    }
    for (int o = 32; o > 0; o >>= 1) mx = fmaxf(mx, __shfl_xor(mx, o));
    float den = 0.f;
#pragma unroll
    for (int pss = 0; pss < 5; ++pss) { const float p = (sv[pss] > -1e29f) ? expf(sv[pss] - mx) : 0.f; ps[w][pss * 64 + lane] = p; den += p; }
    for (int o = 32; o > 0; o >>= 1) den += __shfl_xor(den, o);
    den += expf(sink[w] - mx);
    __syncthreads();
    float o = 0.f;
    for (int jrel = 0; jrel <= 2 * WIN; ++jrel) { const int jt = t - WIN + jrel; if (jt < 0 || jt >= SL) continue; o += ps[w][jrel] * bf2f(P[(size_t)(m - WIN + jrel) * DINP + P_V + kvh * HD + lane]); }
    o /= den;
    const float ss = block_sum(o * o, red);
    const float r = 1.f / sqrtf(ss * (1.f / DBB) + EPS);
    YN[(size_t)m * DM + DA + w * HD + lane] = (bf16_t)f2bf(o * r * gn[w * HD + lane]);
}

__global__ __launch_bounds__(256) void k_hy_prep(const bf16_t* __restrict__ P, const float* __restrict__ cw, const float* __restrict__ cb, float* __restrict__ Z, float* __restrict__ X0) {
    const int m = blockIdx.x, t = m % SL, c = threadIdx.x;
    float u[3];
#pragma unroll
    for (int part = 0; part < 3; ++part) { const int ch = part * DC + c; float v = cb[ch];
#pragma unroll
        for (int k = 0; k < 3; ++k) { const int tt = t + k - 1; if (tt >= 0 && tt < SL) v += cw[k * 3 * DC + ch] * bf2f(P[(size_t)(m + k - 1) * DINP + P_CU + ch]); }
        u[part] = v; }
    Z[(size_t)m * DC + c] = u[2] * u[1]; X0[(size_t)m * DC + c] = u[0];
}
__global__ __launch_bounds__(256) void k_hy_conv(const float* __restrict__ Z, const float* __restrict__ X0, const float* __restrict__ HF, const float* __restrict__ bias, float* __restrict__ YC) {
    const int m = blockIdx.x, b = m / SL, t = m % SL, c = threadIdx.x;
    const float* zb = Z + (size_t)b * SL * DC + c; const float* hf = HF + c; const float* hb = HF + (size_t)SL * DC + c;
    float y = 0.f;
    for (int s = 0; s <= t; ++s) y += hf[(size_t)(t - s) * DC] * zb[(size_t)s * DC];
    for (int s = t + 1; s < SL; ++s) y += hb[(size_t)(s - t) * DC] * zb[(size_t)s * DC];
    YC[(size_t)m * DC + c] = (y + zb[(size_t)t * DC] * bias[c]) * X0[(size_t)m * DC + c];
}
__global__ __launch_bounds__(256) void k_hy_norm(const float* __restrict__ YC, const float* __restrict__ gn, bf16_t* __restrict__ YN) {
    __shared__ float red[8];
    const int m = blockIdx.x, c = threadIdx.x; const float y = YC[(size_t)m * DC + c];
    const float ss = block_sum(y * y, red); const float r = 1.f / sqrtf(ss * (1.f / DC) + EPS);
    YN[(size_t)m * DM + DA + DBB + c] = (bf16_t)f2bf(y * r * gn[c]);
}

__global__ __launch_bounds__(256) void k_final_norm(const float* __restrict__ x, const float* __restrict__ g, float* __restrict__ out) {
    __shared__ float red[8];
    const int row = blockIdx.x, tid = threadIdx.x;
    const f32x4 v = *(const f32x4*)(x + (size_t)row * DM + tid * 4), gg = *(const f32x4*)(g + tid * 4);
    const float ss = block_sum(v[0] * v[0] + v[1] * v[1] + v[2] * v[2] + v[3] * v[3], red);
    const float r = 1.f / sqrtf(ss * (1.f / DM) + EPS);
    *(f32x4*)(out + (size_t)row * DM + tid * 4) = (f32x4){v[0] * r * gg[0], v[1] * r * gg[1], v[2] * r * gg[2], v[3] * r * gg[3]};
}

extern "C" void kernel_launch(void* const* d_in, const int* in_sizes, int n_in, void* d_out, int out_size, void* d_ws, size_t ws_size, hipStream_t stream) {
    if (n_in != 28 || ws_size < WS_END) return;
    unsigned char* ws = (unsigned char*)d_ws;
    auto F = [&](int i) { return (const float*)d_in[i]; };
    bf16_t* Win = (bf16_t*)(ws + WS_WIN); bf16_t* Wout = (bf16_t*)(ws + WS_WOUT); bf16_t* Wup = (bf16_t*)(ws + WS_WUP); bf16_t* Wdn = (bf16_t*)(ws + WS_WDN);
    float* rope = (float*)(ws + WS_ROPE); float* HF = (float*)(ws + WS_HF); float* SS = (float*)(ws + WS_SS);
    bf16_t* XG = (bf16_t*)(ws + WS_XG); bf16_t* P = (bf16_t*)(ws + WS_P); bf16_t* YN = (bf16_t*)(ws + WS_YN); bf16_t* H = (bf16_t*)(ws + WS_H);
    float* XR = (float*)d_out;
    float* nA = (float*)(ws + NV_A); float* nB = (float*)(ws + NV_B); float* nHS = (float*)(ws + NV_HS); float* nZ = (float*)(ws + NV_Z); float* nX0 = (float*)(ws + NV_X0); float* nYC = (float*)(ws + NV_YC);

    for (int l = 0; l < DEPTH; ++l) {
        k_wconv<<<dim3(DM / 32, DINP / 32), 256, 0, stream>>>(F(2) + (size_t)l * DM * DIN, Win + (size_t)l * DINP * DM, DM, DIN, DINP);
        k_wconv<<<dim3(DM / 32, DM / 32), 256, 0, stream>>>(F(23) + (size_t)l * DM * DM, Wout + (size_t)l * DM * DM, DM, DM, DM);
        k_wconv<<<dim3(DM / 32, DFF / 32), 256, 0, stream>>>(F(25) + (size_t)l * DM * DFF, Wup + (size_t)l * DFF * DM, DM, DFF, DFF);
        k_wconv<<<dim3(DFF / 32, DM / 32), 256, 0, stream>>>(F(26) + (size_t)l * DFF * DM, Wdn + (size_t)l * DM * DFF, DFF, DM, DM);
        k_hy_filter<<<SL, 256, 0, stream>>>(F(13) + (size_t)l * HY_EMB * HY_W, F(14) + l * HY_W, F(15) + l * HY_W, F(16) + (size_t)l * HY_W * HY_W, F(17) + l * HY_W,
                                            F(18) + (size_t)l * HY_W * 2 * DC, HF + (size_t)l * 2 * SL * DC);
    }
    k_rope<<<(SL * 8 + 255) / 256, 256, 0, stream>>>(rope);

    const float* xin = F(0);
    for (int l = 0; l < DEPTH; ++l) {
        k_norm_xg<<<MT, 256, 0, stream>>>(xin, F(1) + l * DM, XG, SS);
        k_gemm_nt<EpiWin><<<dim3(DINP / 64, MT / 128), 256, 0, stream>>>(XG, Win + (size_t)l * DINP * DM, DM, EpiWin{P, SS});
        for (int n = 0; n < 2; ++n) {
            k_lru_ab<<<MT, 384, 0, stream>>>(P, F(3) + l * 4 * DA, F(4) + l * DA, F(5) + (size_t)l * 2 * LRU_BLK * 64 * 64, F(6) + l * 2 * DA, F(7) + (size_t)l * 2 * LRU_BLK * 64 * 64, F(8) + l * 2 * DA,
                                            F(9) + l * 2 * DA, nA, nB, n);
            k_lru_scan<<<(NB * DA + 63) / 64, 64, 0, stream>>>(nA, nB, nHS, n);
        }
        k_lru_out<<<MT, 384, 0, stream>>>(P, nHS, F(20) + l * DA, YN);
        k_attn<<<MT, 384, 0, stream>>>(P, rope, F(10) + l * NQH, F(21) + l * DBB, YN);
        k_hy_prep<<<MT, 256, 0, stream>>>(P, F(11) + l * 3 * 3 * DC, F(12) + l * 3 * DC, nZ, nX0);
        k_hy_conv<<<MT, 256, 0, stream>>>(nZ, nX0, HF + (size_t)l * 2 * SL * DC, F(19) + l * DC, nYC);
        k_hy_norm<<<MT, 256, 0, stream>>>(nYC, F(22) + l * DC, YN);
        k_gemm_nt<EpiRes><<<dim3(DM / 64, MT / 128), 256, 0, stream>>>(YN, Wout + (size_t)l * DM * DM, DM, EpiRes{xin, XR});
        k_norm_xg<<<MT, 256, 0, stream>>>(XR, F(24) + l * DM, XG, SS);
        k_gemm_nt<EpiUp><<<dim3(DFF / 64, MT / 128), 256, 0, stream>>>(XG, Wup + (size_t)l * DFF * DM, DM, EpiUp{H, SS});
        k_gemm_nt<EpiRes><<<dim3(DM / 64, MT / 128), 256, 0, stream>>>(H, Wdn + (size_t)l * DM * DFF, DFF, EpiRes{XR, XR});
        xin = XR;
    }
    k_final_norm<<<MT, 256, 0, stream>>>(XR, F(27), (float*)d_out);
}
```

```cpp
#include <hip/hip_runtime.h>
#include <stdint.h>
#include <math.h>

typedef unsigned short bf16_t;
typedef short bf16x8 __attribute__((ext_vector_type(8)));
typedef float f32x4 __attribute__((ext_vector_type(4)));

constexpr int NB = 4, SL = 4096, DM = 1024, MT = NB * SL, DEPTH = 2;
constexpr int DA = 384, DBB = 384, DC = 256, HD = 64, NQH = 6, NKVH = 2, DIN = 2176, DINP = 2304, DFF = 4096;
constexpr int P_AX = 0, P_AG = 384, P_Q = 768, P_K = 1152, P_V = 1280, P_CU = 1408;
constexpr int LRU_BLK = 6, LRU_BW = 64, WIN = 128, HY_EMB = 33, HY_W = 64;
constexpr float EPS = 1e-6f;

constexpr size_t MiB = 1u << 20;
constexpr size_t WS_WIN = 0;
constexpr size_t WS_WOUT = 9 * MiB;
constexpr size_t WS_WUP = 13 * MiB;
constexpr size_t WS_WDN = 29 * MiB;
constexpr size_t WS_ROPE = 45 * MiB;
constexpr size_t WS_HF = 46 * MiB;
constexpr size_t WS_XG = 62 * MiB;
constexpr size_t WS_BIG = 94 * MiB;
constexpr size_t WS_H = WS_BIG;
constexpr size_t WS_P = WS_BIG;
constexpr size_t WS_YN = WS_BIG + 72 * MiB;
constexpr size_t WS_SCR = WS_BIG + 104 * MiB;
constexpr size_t WS_CTL = 254 * MiB;
constexpr size_t WS_SS = 255 * MiB;
constexpr size_t WS_END = 256 * MiB;
constexpr size_t NV_A = WS_XG;
constexpr size_t NV_B = WS_SCR;
constexpr size_t NV_HS = WS_SCR + 24 * MiB;
constexpr size_t NV_Z = WS_SCR;
constexpr size_t NV_X0 = WS_SCR + 16 * MiB;
constexpr size_t NV_YC = WS_SCR + 32 * MiB;

__device__ __forceinline__ unsigned f2bf(float f) { unsigned u = __builtin_bit_cast(unsigned, f); return (u + 0x7fffu + ((u >> 16) & 1u)) >> 16; }
__device__ __forceinline__ float bf2f(bf16_t h) { return __builtin_bit_cast(float, (unsigned)h << 16); }
__device__ __forceinline__ float sigmoidf_(float x) { return 1.f / (1.f + expf(-x)); }
__device__ __forceinline__ float gelu_tanh(float x) { const float u = 0.7978845608028654f * (x + 0.044715f * x * x * x); return 0.5f * x * (1.f + tanhf(u)); }

__device__ __forceinline__ float block_sum(float v, float* red) {
    for (int o = 32; o > 0; o >>= 1) v += __shfl_xor(v, o);
    const int w = threadIdx.x >> 6, nw = blockDim.x >> 6;
    __syncthreads();
    if ((threadIdx.x & 63) == 0) red[w] = v;
    __syncthreads();
    float s = 0.f;
    for (int i = 0; i < nw; ++i) s += red[i];
    return s;
}

__global__ void k_rope(float* __restrict__ tab) {
    const int i = blockIdx.x * blockDim.x + threadIdx.x; if (i >= SL * 8) return;
    const int pos = i >> 3, j = i & 7;
    const double inv = pow(500000.0, -(double)j / 8.0), ang = (double)pos * inv;
    tab[pos * 16 + j] = (float)cos(ang); tab[pos * 16 + 8 + j] = (float)sin(ang);
}

__global__ void k_hy_filter(const float* __restrict__ w1, const float* __restrict__ b1, const float* __restrict__ freq, const float* __restrict__ w2,
                            const float* __restrict__ b2, const float* __restrict__ w3, float* __restrict__ HF) {
    __shared__ float z[HY_EMB], h1[HY_W], h2[HY_W];
    const int t = blockIdx.x, tid = threadIdx.x;
    const double PI2 = 6.283185307179586476925286766559;
    const float tt = (float)((double)t / (double)(SL - 1));
    if (tid < HY_EMB) {
        float v;
        if (tid == 0) v = tt;
        else { const int bi = (tid - 1) & 15; const double f = 1e-4 + (double)bi * ((15.0 - 1e-4) / 15.0); const double w = PI2 * (double)t / (double)SL;
               v = (tid <= 16) ? (float)cos(f * w) : (float)(-sin(f * w)); }
        z[tid] = v;
    }
    __syncthreads();
    if (tid < HY_W) { float a = b1[tid]; for (int i = 0; i < HY_EMB; ++i) a += z[i] * w1[i * HY_W + tid]; h1[tid] = sinf(freq[tid] * a); }
    __syncthreads();
    if (tid < HY_W) { float a = b2[tid]; for (int i = 0; i < HY_W; ++i) a += h1[i] * w2[i * HY_W + tid]; h2[tid] = sinf(freq[tid] * a); }
    __syncthreads();
    const double mind = log(1e-2) / 1.5, maxd = log(1e-2) / 0.3;
    for (int o = tid; o < 2 * DC; o += 256) {
        float a = 0.f; for (int i = 0; i < HY_W; ++i) a += h2[i] * w3[i * 2 * DC + o];
        const int c = o & 255, dir = o >> 8;
        const float delta = fabsf((float)(mind + (maxd - mind) * (double)c / 255.0));
        HF[((size_t)dir * SL + t) * DC + c] = a * expf(-tt * delta);
    }
}

__global__ __launch_bounds__(384) void k_lru_ab(const bf16_t* __restrict__ P, const float* __restrict__ cw, const float* __restrict__ cb, const float* __restrict__ wa, const float* __restrict__ ba,
                                               const float* __restrict__ wx, const float* __restrict__ bx, const float* __restrict__ lam, float* __restrict__ Aout, float* __restrict__ Bout, int n) {
    __shared__ float xc[DA];
    const int m = blockIdx.x, t = m % SL, j = threadIdx.x;
    float v = cb[j];
#pragma unroll
    for (int k = 0; k < 4; ++k) { const int tt = t + k - 2; if (tt >= 0 && tt < SL) v += cw[k * DA + j] * bf2f(P[(size_t)(m + k - 2) * DINP + P_AX + j]); }
    xc[j] = v;
    __syncthreads();
    const int blk = j >> 6, jj = j & 63;
    {
        float ra = ba[n * DA + j], ia = bx[n * DA + j];
        const float* wap = wa + ((size_t)(n * LRU_BLK + blk) * 64) * 64 + jj; const float* wxp = wx + ((size_t)(n * LRU_BLK + blk) * 64) * 64 + jj;
        for (int i = 0; i < 64; ++i) { const float xi = xc[blk * 64 + i]; ra += xi * wap[i * 64]; ia += xi * wxp[i * 64]; }
        const float r = sigmoidf_(ra), ig = sigmoidf_(ia);
        const float l = lam[n * DA + j]; const float sp = (-l > 20.f) ? -l : log1pf(expf(-l));
        const float log_a = -8.f * r * sp;
        const float a = expf(log_a), bb = sqrtf(-expm1f(2.f * log_a)) * (ig * v);
        Aout[(size_t)m * DA + j] = a; Bout[(size_t)m * DA + j] = bb;
    }
}
__global__ void k_lru_scan(const float* __restrict__ A, const float* __restrict__ Bv, float* __restrict__ HS, int n) {
    const int id = blockIdx.x * blockDim.x + threadIdx.x; if (id >= NB * DA) return;
    const int ch = id % DA, b = id / DA;
    float h = 0.f;
    for (int s = 0; s < SL; ++s) { const int t = n ? (SL - 1 - s) : s; const size_t o = ((size_t)b * SL + t) * DA + ch; h = A[o] * h + Bv[o]; HS[o] = n ? (HS[o] + h) : h; }
}
__global__ __launch_bounds__(384) void k_lru_out(const bf16_t* __restrict__ P, const float* __restrict__ HS, const float* __restrict__ gn, bf16_t* __restrict__ YN) {
    __shared__ float red[8];
    const int m = blockIdx.x, j = threadIdx.x;
    const float h = HS[(size_t)m * DA + j];
    const float y = h * gelu_tanh(bf2f(P[(size_t)m * DINP + P_AG + j]));
    const float ss = block_sum(y * y, red);
    const float r = 1.f / sqrtf(ss * (1.f / DA) + EPS);
    YN[(size_t)m * DM + j] = (bf16_t)f2bf(y * r * gn[j]);
}

__global__ __launch_bounds__(384) void k_attn(const bf16_t* __restrict__ P, const float* __restrict__ rope, const float* __restrict__ sink, const float* __restrict__ gn, bf16_t* __restrict__ YN) {
    __shared__ float qs[NQH][HD], ps[NQH][320], red[8];
    const int m = blockIdx.x, t = m % SL, w = threadIdx.x >> 6, lane = threadIdx.x & 63, kvh = w / 3;
    const float* rt = rope + t * 16;
    const bf16_t* qp = P + (size_t)m * DINP + P_Q + w * HD;
    {   float q = bf2f(qp[lane]);
        if (lane < 8) q = q * rt[lane] - bf2f(qp[lane + 8]) * rt[8 + lane];
        else if (lane < 16) q = q * rt[lane - 8] + bf2f(qp[lane - 8]) * rt[lane];
        qs[w][lane] = q; }
    __syncthreads();
    float sv[5]; float mx = sink[w];
#pragma unroll
    for (int pss = 0; pss < 5; ++pss) {
        const int jrel = pss * 64 + lane, jt = t - WIN + jrel; float s = -1e30f;
        if (jrel <= 2 * WIN && jt >= 0 && jt < SL) {
            const bf16_t* kp = P + (size_t)(m - WIN + jrel) * DINP + P_K + kvh * HD; const float* rk = rope + jt * 16;
            float acc = 0.f;
            for (int d = 0; d < 8; ++d) { const float k1 = bf2f(kp[d]), k2 = bf2f(kp[d + 8]); acc += qs[w][d] * (k1 * rk[d] - k2 * rk[8 + d]) + qs[w][d + 8] * (k2 * rk[d] + k1 * rk[8 + d]); }
            for (int d = 16; d < HD; ++d) acc += qs[w][d] * bf2f(kp[d]);
            s = acc * 0.125f;
        }
        sv[pss] = s; mx = fmaxf(mx, s);
    }
    for (int o = 32; o > 0; o >>= 1) mx = fmaxf(mx, __shfl_xor(mx, o));
    float den = 0.f;
#pragma unroll
    for (int pss = 0; pss < 5; ++pss) { const float p = (sv[pss] > -1e29f) ? expf(sv[pss] - mx) : 0.f; ps[w][pss * 64 + lane] = p; den += p; }
    for (int o = 32; o > 0; o >>= 1) den += __shfl_xor(den, o);
    den += expf(sink[w] - mx);
    __syncthreads();
    float o = 0.f;
    for (int jrel = 0; jrel <= 2 * WIN; ++jrel) { const int jt = t - WIN + jrel; if (jt < 0 || jt >= SL) continue; o += ps[w][jrel] * bf2f(P[(size_t)(m - WIN + jrel) * DINP + P_V + kvh * HD + lane]); }
    o /= den;
    const float ss = block_sum(o * o, red);
    const float r = 1.f / sqrtf(ss * (1.f / DBB) + EPS);
    YN[(size_t)m * DM + DA + w * HD + lane] = (bf16_t)f2bf(o * r * gn[w * HD + lane]);
}

__global__ __launch_bounds__(384) void k_attn_norm(const bf16_t* __restrict__ AO, const float* __restrict__ gn, bf16_t* __restrict__ YN) {
    __shared__ float red[8];
    const int m = blockIdx.x, j = threadIdx.x; const float o = bf2f(AO[(size_t)m * DBB + j]);
    const float ss = block_sum(o * o, red); const float r = 1.f / sqrtf(ss * (1.f / DBB) + EPS);
    YN[(size_t)m * DM + DA + j] = (bf16_t)f2bf(o * r * gn[j]);
}
__global__ __launch_bounds__(256) void k_hy_prep(const bf16_t* __restrict__ P, const float* __restrict__ cw, const float* __restrict__ cb, float* __restrict__ Z, float* __restrict__ X0) {
    const int m = blockIdx.x, t = m % SL, c = threadIdx.x;
    float u[3];
#pragma unroll
    for (int part = 0; part < 3; ++part) { const int ch = part * DC + c; float v = cb[ch];
#pragma unroll
        for (int k = 0; k < 3; ++k) { const int tt = t + k - 1; if (tt >= 0 && tt < SL) v += cw[k * 3 * DC + ch] * bf2f(P[(size_t)(m + k - 1) * DINP + P_CU + ch]); }
        u[part] = v; }
    Z[(size_t)m * DC + c] = u[2] * u[1]; X0[(size_t)m * DC + c] = u[0];
}
__global__ __launch_bounds__(256) void k_hy_conv(const float* __restrict__ Z, const float* __restrict__ X0, const float* __restrict__ HF, const float* __restrict__ bias, float* __restrict__ YC) {
    const int m = blockIdx.x, b = m / SL, t = m % SL, c = threadIdx.x;
    const float* zb = Z + (size_t)b * SL * DC + c; const float* hf = HF + c; const float* hb = HF + (size_t)SL * DC + c;
    float y = 0.f;
    for (int s = 0; s <= t; ++s) y += hf[(size_t)(t - s) * DC] * zb[(size_t)s * DC];
    for (int s = t + 1; s < SL; ++s) y += hb[(size_t)(s - t) * DC] * zb[(size_t)s * DC];
    YC[(size_t)m * DC + c] = (y + zb[(size_t)t * DC] * bias[c]) * X0[(size_t)m * DC + c];
}
__global__ __launch_bounds__(256) void k_hy_norm(const bf16_t* __restrict__ YCT, const float* __restrict__ gn, bf16_t* __restrict__ YN) {
    __shared__ float red[8];
    const int m = blockIdx.x, c = threadIdx.x; const float y = bf2f(YCT[((size_t)(m / SL) * DC + c) * SL + (m % SL)]);
    const float ss = block_sum(y * y, red); const float r = 1.f / sqrtf(ss * (1.f / DC) + EPS);
    YN[(size_t)m * DM + DA + DBB + c] = (bf16_t)f2bf(y * r * gn[c]);
}

namespace pg8 {
#define PG8_LAS __attribute__((address_space(3)))
typedef unsigned short bf16_t;
typedef short bf16x8 __attribute__((ext_vector_type(8)));
typedef float f32x4 __attribute__((ext_vector_type(4)));
typedef unsigned u32x4 __attribute__((ext_vector_type(4)));
constexpr int BM = 256, BK = 64, HALF = 128, HTB = HALF * BK * 2  , STAGE_BYTES = 8 * HTB, NXCD = 8, WGM = 8;

__host__ __device__ __forceinline__ int lds_byte(int r, int c) { const int st = (r >> 4) * 2 + (c >> 5), rr = r & 15, cc = c & 31, ob = rr * 64 + cc * 2; return st * 1024 + (ob ^ (((ob >> 9) & 1) << 5)); }
__host__ __device__ __forceinline__ void stage_rc(int b, int& R, int& C) { const int st = b / 1024, sb = b % 1024, swz = sb ^ (((sb >> 9) & 1) << 5); R = (st >> 1) * 16 + swz / 64; C = (st & 1) * 32 + (swz % 64) / 2; }
__host__ __device__ __forceinline__ int perm32(int rho) { const int n = rho >> 4, i = rho & 15; return 8 * (i >> 2) + 4 * n + (i & 3); }

struct Unit { int pm, pn; };
struct Gemm { const bf16_t* A; const bf16_t* Bt; int M, N, K; };

struct StaticOrder {
    int nM, nN, nwg, G, c;
    __host__ __device__ void init(int M, int N, int G_, int c_) { nM = M / BM; nN = N / BM; nwg = nM * nN; G = G_; c = c_; }
    __host__ __device__ bool next(int i, Unit& u) const {
        const long L = (long)i * G + c; if (L >= nwg) return false;
        int wgid = (int)L; { const int q = nwg / NXCD, r = nwg % NXCD, xcd = wgid % NXCD, off = wgid / NXCD; wgid = (xcd < r ? xcd * (q + 1) : r * (q + 1) + (xcd - r) * q) + off; }
        const int nig = WGM * nN, gid = wgid / nig, fm = gid * WGM, gsz = (nM - fm) < WGM ? (nM - fm) : WGM;
        u.pm = fm + ((wgid % nig) % gsz); u.pn = (wgid % nig) / gsz; return true;
    }
    __device__ __forceinline__ void a_ready(const Unit&) const {}
    __device__ __forceinline__ void done(const Unit&) const {}
};

__device__ __forceinline__ unsigned cvt_pk_bf16(float lo, float hi) { unsigned r; asm volatile("v_cvt_pk_bf16_f32 %0, %1, %2" : "=v"(r) : "v"(lo), "v"(hi)); return r; }

constexpr int E_DM = 1024, E_DINP = 2304, E_DFF = 4096; constexpr float E_EPS = 1e-6f;
__device__ __forceinline__ float rstd16(const float* SS, int row) {
    const f32x4* p = (const f32x4*)(SS + (size_t)row * 16); const f32x4 a = (p[0] + p[1]) + (p[2] + p[3]);
    return 1.0f / sqrtf(((a[0] + a[1]) + (a[2] + a[3])) * (1.0f / E_DM) + E_EPS);
}
template <int ACT> struct EpiScaleBf16 {
    static constexpr bool PERM = true, AFTER_DRAIN = false;
    bf16_t* O; int ldc; const float* SS;
    __device__ __forceinline__ void operator()(const f32x4 (&acc)[2][2][4][2], const Unit& u, int wr, int wc, int fr, int fq) const {
        const int row0 = u.pm * BM + wr * 64 + fr, col0 = u.pn * BM + wc * 32 + 8 * fq;
#pragma unroll
        for (int ai = 0; ai < 2; ++ai)
#pragma unroll
            for (int m = 0; m < 4; ++m) { const int row = row0 + ai * HALF + m * 16; const float r = rstd16(SS, row); bf16_t* rowp = O + (size_t)row * ldc + col0;
#pragma unroll
                for (int bj = 0; bj < 2; ++bj) { f32x4 v0 = acc[ai][bj][m][0] * r, v1 = acc[ai][bj][m][1] * r;
                    if (ACT == 1) {
#pragma unroll
                        for (int i = 0; i < 4; ++i) { const float a = fmaxf(v0[i], 0.f), b = fmaxf(v1[i], 0.f); v0[i] = a * a; v1[i] = b * b; } }
                    u32x4 w; w.x = cvt_pk_bf16(v0[0], v0[1]); w.y = cvt_pk_bf16(v0[2], v0[3]); w.z = cvt_pk_bf16(v1[0], v1[1]); w.w = cvt_pk_bf16(v1[2], v1[3]);
                    *(u32x4*)(rowp + bj * HALF) = w; } }
    }
};
struct EpiRes {
    static constexpr bool PERM = false, AFTER_DRAIN = false;
    const float* base; float* out; bf16_t* XG; const float* g; float* SS;
    __device__ __forceinline__ void operator()(const f32x4 (&acc)[2][2][4][2], const Unit& u, int wr, int wc, int fr, int fq) const {
        typedef unsigned u32x2v __attribute__((ext_vector_type(2)));
        const int row0 = u.pm * BM + wr * 64 + fr, col0 = u.pn * BM + wc * 32 + 4 * fq;
        f32x4 gv[2][2];
#pragma unroll
        for (int bj = 0; bj < 2; ++bj)
#pragma unroll
            for (int n = 0; n < 2; ++n) gv[bj][n] = XG ? *(const f32x4*)(g + col0 + bj * HALF + n * 16) : (f32x4){0.f, 0.f, 0.f, 0.f};
#pragma unroll
        for (int ai = 0; ai < 2; ++ai)
#pragma unroll
            for (int m = 0; m < 4; ++m) { const int row = row0 + ai * HALF + m * 16; const size_t off = (size_t)row * E_DM + col0; float s = 0.f;
#pragma unroll
                for (int bj = 0; bj < 2; ++bj)
#pragma unroll
                    for (int n = 0; n < 2; ++n) { const f32x4 b = *(const f32x4*)(base + off + bj * HALF + n * 16); const f32x4 v = b + acc[ai][bj][m][n];
                        *(f32x4*)(out + off + bj * HALF + n * 16) = v; s += (v[0] * v[0] + v[1] * v[1]) + (v[2] * v[2] + v[3] * v[3]);
                        if (XG) { const f32x4 x = v * gv[bj][n]; u32x2v w; w.x = cvt_pk_bf16(x[0], x[1]); w.y = cvt_pk_bf16(x[2], x[3]); *(u32x2v*)(XG + off + bj * HALF + n * 16) = w; } }
                s += __shfl_xor(s, 16); s += __shfl_xor(s, 32);
                if (fq == 0) SS[(size_t)row * 16 + u.pn * 4 + wc] = s;
                if (m & 1) asm volatile("" ::: "memory"); }
    }
};

template <class Epi, class Sched, bool ALIGN_EPI = false, bool SP2 = false>
__device__ __forceinline__ void gemm_phase(PG8_LAS unsigned char* lds, const Gemm g, const Sched& S, const Epi& E) {
    const int tid = threadIdx.x, wid = __builtin_amdgcn_readfirstlane(tid >> 6), lane = tid & 63, wr = wid >> 2, wc = wid & 3, fr = lane & 15, fq = lane >> 4;
    const int K = g.K, nt = K / BK;
    unsigned voffA[2], voffB[2];
#pragma unroll
    for (int i = 0; i < 2; ++i) { int R, C; stage_rc(tid * 16 + i * 8192, R, C); const int Rb = Epi::PERM ? ((R & ~31) + perm32(R & 31)) : R;
        voffA[i] = (unsigned)(R * K + C) * 2u; voffB[i] = (unsigned)(Rb * K + C) * 2u; }
    const size_t kstep = (size_t)(BK * 2);
    const size_t hstep = (size_t)HALF * K * 2;
    const size_t tstep = 2 * hstep;
    const unsigned ldsw = (unsigned)wid * 1024u;
    const int aoff = lds_byte(wr * 64 + fr, fq * 8), boff = lds_byte(wc * 32 + fr, fq * 8);
#define PG8_SA(b, h) (((b) * 2 + (h)) * HTB)
#define PG8_SB(b, h) ((4 + (b) * 2 + (h)) * HTB)
#define PG8_STAGE(bufoff, gbase, voff) do { _Pragma("unroll") for (int _i = 0; _i < 2; ++_i) \
        __builtin_amdgcn_global_load_lds((const unsigned*)((const char*)(gbase) + (voff)[_i]), (PG8_LAS unsigned*)(lds + (bufoff) + ldsw + _i * 8192), 16, 0, 0); } while (0)
#define PG8_LDA(dst, b, h) do { _Pragma("unroll") for (int m = 0; m < 4; ++m) _Pragma("unroll") for (int k = 0; k < 2; ++k) dst[m][k] = *(const PG8_LAS bf16x8*)(lds + PG8_SA(b, h) + aoff + m * 2048 + k * 1024); } while (0)
#define PG8_LDB(dst, b, h) do { _Pragma("unroll") for (int n = 0; n < 2; ++n) _Pragma("unroll") for (int k = 0; k < 2; ++k) dst[n][k] = *(const PG8_LAS bf16x8*)(lds + PG8_SB(b, h) + boff + n * 2048 + k * 1024); } while (0)
#define PG8_MMA(ai, bj, At, Bt) do { __builtin_amdgcn_s_setprio(1); _Pragma("unroll") for (int m = 0; m < 4; ++m) _Pragma("unroll") for (int n = 0; n < 2; ++n) _Pragma("unroll") for (int k = 0; k < 2; ++k) \
        acc[ai][bj][m][n] = __builtin_amdgcn_mfma_f32_16x16x32_bf16(Bt[n][k], At[m][k], acc[ai][bj][m][n], 0, 0, 0); __builtin_amdgcn_s_setprio(0); } while (0)
#define PG8_WAIT_V(n) asm volatile("s_waitcnt vmcnt(" #n ")" ::: "memory")
#define PG8_WAIT_L(n) asm volatile("s_waitcnt lgkmcnt(" #n ")" ::: "memory")
#define PG8_BAR __builtin_amdgcn_s_barrier()
#define PG8_SCHED __builtin_amdgcn_sched_barrier(0)
    Unit cur, nxt; int ui = 0;
    if (!S.next(0, cur)) return;
    f32x4 acc[2][2][4][2];
#pragma unroll
    for (int a = 0; a < 2; ++a)
#pragma unroll
        for (int b = 0; b < 2; ++b)
#pragma unroll
            for (int m = 0; m < 4; ++m)
#pragma unroll
                for (int n = 0; n < 2; ++n) acc[a][b][m][n] = (f32x4){0.f, 0.f, 0.f, 0.f};
    bf16x8 At[4][2], B0[2][2], B1[2][2];
    const char* cA = (const char*)g.A + (size_t)cur.pm * tstep; const char* cB = (const char*)g.Bt + (size_t)cur.pn * tstep;
    S.a_ready(cur);
    if constexpr (SP2) {
        PG8_STAGE(PG8_SB(0, 0), cB, voffB); PG8_STAGE(PG8_SB(0, 1), cB + hstep, voffB); PG8_STAGE(PG8_SA(0, 0), cA, voffA); PG8_STAGE(PG8_SA(0, 1), cA + hstep, voffA);
        if (wr == 1) PG8_BAR;
        PG8_WAIT_V(2); PG8_BAR;
        PG8_STAGE(PG8_SB(1, 0), cB + kstep, voffB); PG8_STAGE(PG8_SA(1, 0), cA + kstep, voffA); PG8_STAGE(PG8_SB(1, 1), cB + hstep + kstep, voffB);
        PG8_WAIT_V(6); PG8_BAR;
    } else {
        PG8_STAGE(PG8_SB(0, 0), cB, voffB); PG8_STAGE(PG8_SA(0, 0), cA, voffA); PG8_STAGE(PG8_SB(0, 1), cB + hstep, voffB); PG8_STAGE(PG8_SA(0, 1), cA + hstep, voffA);
        if (wr == 1) PG8_BAR;
        PG8_WAIT_V(4); PG8_BAR;
        PG8_STAGE(PG8_SB(1, 0), cB + kstep, voffB); PG8_STAGE(PG8_SA(1, 0), cA + kstep, voffA); PG8_STAGE(PG8_SB(1, 1), cB + hstep + kstep, voffB);
        PG8_WAIT_V(6); PG8_BAR;
    }
    for (;;) {
        const bool has_next = S.next(ui + 1, nxt);
        const char* nA = has_next ? (const char*)g.A + (size_t)nxt.pm * tstep : cA; const char* nB = has_next ? (const char*)g.Bt + (size_t)nxt.pn * tstep : cB;
        for (int t = 0; t < nt; t += 2) {
            const bool last = (t == nt - 2);
            const char* a1 = cA + (size_t)(t + 1) * kstep;
            const char* a2 = last ? nA : cA + (size_t)(t + 2) * kstep; const char* b2 = last ? nB : cB + (size_t)(t + 2) * kstep;
            const char* a3 = a2 + kstep; const char* b3 = b2 + kstep;
            if (last && has_next) S.a_ready(nxt);
            if constexpr (SP2) {
            PG8_LDB(B0, 0, 0); PG8_LDB(B1, 0, 1); PG8_SCHED; PG8_LDA(At, 0, 0); PG8_STAGE(PG8_SA(1, 1), a1 + hstep, voffA);
            PG8_WAIT_V(8); PG8_WAIT_L(0); PG8_BAR; PG8_MMA(0, 0, At, B0); PG8_MMA(0, 1, At, B1); PG8_BAR; PG8_SCHED;
            PG8_LDA(At, 0, 1); PG8_STAGE(PG8_SB(0, 0), b2, voffB); PG8_STAGE(PG8_SB(0, 1), b2 + hstep, voffB); PG8_STAGE(PG8_SA(0, 0), a2, voffA);
            PG8_WAIT_V(8); PG8_WAIT_L(0); PG8_BAR; PG8_MMA(1, 0, At, B0); PG8_MMA(1, 1, At, B1); PG8_BAR; PG8_SCHED;
            PG8_LDB(B0, 1, 0); PG8_LDB(B1, 1, 1); PG8_SCHED; PG8_LDA(At, 1, 0); PG8_STAGE(PG8_SA(0, 1), a2 + hstep, voffA);
            PG8_WAIT_V(8); PG8_WAIT_L(0); PG8_BAR; PG8_MMA(0, 0, At, B0); PG8_MMA(0, 1, At, B1); PG8_BAR; PG8_SCHED;
            PG8_LDA(At, 1, 1); PG8_STAGE(PG8_SB(1, 0), b3, voffB); PG8_STAGE(PG8_SB(1, 1), b3 + hstep, voffB); PG8_STAGE(PG8_SA(1, 0), a3, voffA);
            PG8_WAIT_V(8); PG8_WAIT_L(0); PG8_BAR; PG8_MMA(1, 0, At, B0); PG8_MMA(1, 1, At, B1); PG8_BAR; PG8_SCHED;
            } else {
            PG8_LDB(B0, 0, 0); PG8_SCHED; PG8_LDA(At, 0, 0); PG8_STAGE(PG8_SA(1, 1), a1 + hstep, voffA);
            PG8_WAIT_L(8); PG8_BAR; PG8_WAIT_L(0); PG8_MMA(0, 0, At, B0); PG8_BAR; PG8_SCHED;
            PG8_LDB(B1, 0, 1); PG8_STAGE(PG8_SB(0, 0), b2, voffB);
            PG8_BAR; PG8_WAIT_L(0); PG8_MMA(0, 1, At, B1); PG8_BAR;
            PG8_LDA(At, 0, 1); PG8_STAGE(PG8_SA(0, 0), a2, voffA);
            PG8_BAR; PG8_WAIT_L(0); PG8_MMA(1, 0, At, B0); PG8_BAR; PG8_SCHED;
            PG8_STAGE(PG8_SB(0, 1), b2 + hstep, voffB);
            PG8_WAIT_V(6); PG8_BAR; PG8_MMA(1, 1, At, B1); PG8_BAR;
            PG8_LDB(B0, 1, 0); PG8_SCHED; PG8_LDA(At, 1, 0); PG8_STAGE(PG8_SA(0, 1), a2 + hstep, voffA);
            PG8_WAIT_L(8); PG8_BAR; PG8_WAIT_L(0); PG8_MMA(0, 0, At, B0); PG8_BAR; PG8_SCHED;
            PG8_LDB(B1, 1, 1); PG8_STAGE(PG8_SB(1, 0), b3, voffB);
            PG8_BAR; PG8_WAIT_L(0); PG8_MMA(0, 1, At, B1); PG8_BAR;
            PG8_LDA(At, 1, 1); PG8_STAGE(PG8_SA(1, 0), a3, voffA);
            PG8_BAR; PG8_WAIT_L(0); PG8_MMA(1, 0, At, B0); PG8_BAR; PG8_SCHED;
            PG8_STAGE(PG8_SB(1, 1), b3 + hstep, voffB);
            PG8_WAIT_V(6); PG8_BAR; PG8_MMA(1, 1, At, B1); PG8_BAR;
            }
        }
        if constexpr (ALIGN_EPI) { if (wr == 0) PG8_BAR; }
        if constexpr (!Epi::AFTER_DRAIN) { E(acc, cur, wr, wc, fr, fq); S.done(cur); }
        if (!has_next) break;
#pragma unroll
        for (int a = 0; a < 2; ++a)
#pragma unroll
            for (int b = 0; b < 2; ++b)
#pragma unroll
                for (int m = 0; m < 4; ++m)
#pragma unroll
                    for (int n = 0; n < 2; ++n) acc[a][b][m][n] = (f32x4){0.f, 0.f, 0.f, 0.f};
        cur = nxt; cA = nA; cB = nB; ++ui;
        if constexpr (ALIGN_EPI) { if (wr == 1) PG8_BAR; }
    }
    PG8_WAIT_V(0);
    if constexpr (!ALIGN_EPI) { if (wr == 0) PG8_BAR; }
    PG8_BAR;
    if constexpr (Epi::AFTER_DRAIN) { E.fused(acc, cur, wr, wc, fr, fq, lds, wid, lane); S.done(cur); }
#undef PG8_SA
#undef PG8_SB
#undef PG8_STAGE
#undef PG8_LDA
#undef PG8_LDB
#undef PG8_MMA
#undef PG8_WAIT_V
#undef PG8_WAIT_L
#undef PG8_BAR
#undef PG8_SCHED
}
}

constexpr int NWAVES = 8, NTHREADS = 512;
constexpr int LDS_BYTES = 163840;
constexpr int RING_OFF = 0, RING_BYTES = 131072;
constexpr int MISC_OFF = LDS_BYTES - 256;
constexpr int PH_PRO = 0, PH_PER_LAYER = 7, PH_FINAL = 1 + PH_PER_LAYER * DEPTH, NPH = PH_FINAL + 1;
constexpr int PL_WIN = 0, PL_MIX1 = 1, PL_FFT = 2, PL_FIN = 3, PL_WOUT = 4, PL_WUP = 5, PL_WDN = 6;
constexpr int CW_BAR = 4096, N_BAR_REG = 12;

#define GAS __attribute__((address_space(1)))
#define LAS __attribute__((address_space(3)))
typedef unsigned v4u __attribute__((ext_vector_type(4)));
typedef GAS unsigned gu32;
#define RLX_AGENT __ATOMIC_RELAXED, __HIP_MEMORY_SCOPE_AGENT
#define LDS_WAIT() asm volatile("s_waitcnt lgkmcnt(0)" ::: "memory")
#define VM_WAIT() asm volatile("s_waitcnt vmcnt(0)" ::: "memory")
__device__ __forceinline__ unsigned pk2(float lo, float hi) { return f2bf(lo) | (f2bf(hi) << 16); }

#define XB_TMO      128
#define XB_XCNT(j)  (256  + 64 * (j))
#define XB_XSUB(j)  (1280 + 64 * (j))
#define XB_XGEN(j)  (2304 + 64 * (j))
#define XB_TOP      3328
#define XB_TOPGEN   3392
#define XCD_BAR_WORDS 3456
#define XB_SPIN_CAP (1u << 18)

__device__ __forceinline__ unsigned xb_ld(unsigned* p)              { return __hip_atomic_load(p, __ATOMIC_RELAXED, __HIP_MEMORY_SCOPE_AGENT); }
__device__ __forceinline__ unsigned xb_add(unsigned* p, unsigned v) { return __hip_atomic_fetch_add(p, v, __ATOMIC_RELAXED, __HIP_MEMORY_SCOPE_AGENT); }
__device__ __forceinline__ unsigned xb_xcc_id() { return (unsigned)__builtin_amdgcn_s_getreg((3 << 11) | 20) & 0xFu; }
#define XB_SPIN(cond, bar) do { unsigned _sp = 0; while (cond) { __builtin_amdgcn_s_sleep(1); \
    if ((++_sp & 255u) == 0u) { if (xb_ld(&(bar)[XB_TMO])) break; if (_sp > XB_SPIN_CAP) { atomicAdd(&(bar)[XB_TMO], 1u); break; } } } } while (0)

struct XcdBarrier {
    unsigned* bar; unsigned x;
    volatile LAS unsigned* st;
};

__device__ __forceinline__ XcdBarrier xcd_barrier_post(unsigned* bar, volatile LAS unsigned* st) {
    XcdBarrier b; b.bar = bar; b.x = xb_xcc_id(); b.st = st;
    if (threadIdx.x == 0) (void)xb_add(&bar[XB_XCNT(b.x)], 1u);
    return b;
}
__device__ __forceinline__ void xcd_barrier_complete(unsigned* bar, unsigned x, unsigned& nloc, unsigned& nx) {
    const unsigned G = gridDim.x * gridDim.y * gridDim.z;
    unsigned sum, cnt, mine, sp = 0u;
    for (;;) {
        sum = 0u; cnt = 0u; mine = 0u;
#pragma unroll
        for (unsigned j = 0; j < 16; ++j) { const unsigned c = xb_ld(&bar[XB_XCNT(j)]); sum += c; cnt += (c > 0u) ? 1u : 0u; mine = (j == x) ? c : mine; }
        if (sum == G) break;
        __builtin_amdgcn_s_sleep(1);
        if ((++sp & 255u) == 0u) { if (xb_ld(&bar[XB_TMO])) break; if (sp > XB_SPIN_CAP) { atomicAdd(&bar[XB_TMO], 1u); break; } }
    }
    nloc = mine > 0u ? mine : 1u; nx = cnt > 0u ? cnt : 1u;
}

__device__ __forceinline__ void xcd_barrier(const XcdBarrier& b) {
    asm volatile("s_waitcnt vmcnt(0)" ::: "memory");
    __syncthreads();
    if (threadIdx.x == 0) {
        unsigned* bar = b.bar;
        __builtin_amdgcn_s_waitcnt(0);
        unsigned nloc = b.st[0], nx = b.st[1];
        if (nloc == 0u) { xcd_barrier_complete(bar, b.x, nloc, nx); b.st[0] = nloc; b.st[1] = nx; }
        const unsigned old = xb_add(&bar[XB_XSUB(b.x)], 1u);
        const unsigned gen = old / nloc;
        if (old + 1u == (gen + 1u) * nloc) {
            __builtin_amdgcn_fence(__ATOMIC_RELEASE, "agent");
            asm volatile("s_waitcnt vmcnt(0)" ::: "memory");
            const unsigned og = xb_add(&bar[XB_TOP], 1u);
            const unsigned tg = og / nx;
            if (og + 1u == (tg + 1u) * nx) xb_add(&bar[XB_TOPGEN], 1u);
            else XB_SPIN(xb_ld(&bar[XB_TOPGEN]) == tg, bar);
            __builtin_amdgcn_fence(__ATOMIC_ACQUIRE, "agent");
            xb_add(&bar[XB_XGEN(b.x)], 1u);
            asm volatile("s_waitcnt vmcnt(0)" ::: "memory");
        } else {
            XB_SPIN(xb_ld(&bar[XB_XGEN(b.x)]) == gen, bar);
            __builtin_amdgcn_fence(__ATOMIC_ACQUIRE, "agent");
            asm volatile("s_waitcnt vmcnt(0)" ::: "memory");
        }
    }
    __syncthreads();
}

constexpr size_t WS_ZT = WS_SCR, WS_X0T = WS_SCR + 8 * MiB, WS_YCT = WS_SCR + 16 * MiB;
constexpr size_t WS_TW = WS_ROPE + 256 * 1024;
namespace hy {
typedef float cf __attribute__((ext_vector_type(2)));
__device__ __forceinline__ cf cmul(cf a, cf b) { return {a.x * b.x - a.y * b.y, a.x * b.y + a.y * b.x}; }
__device__ __forceinline__ cf cmulc(cf a, cf b) { return {a.x * b.x + a.y * b.y, a.y * b.x - a.x * b.y}; }
__device__ __forceinline__ cf cadd(cf a, cf b) { return {a.x + b.x, a.y + b.y}; }
__device__ __forceinline__ cf csub(cf a, cf b) { return {a.x - b.x, a.y - b.y}; }
__device__ __forceinline__ int pidx(int i) { return i + (i >> 5); }
constexpr int FBUF = 8192 + 256;
template <bool INV> __device__ __forceinline__ cf tw16(cf d, int K) {
    float c, s;
    switch (K) {
        case 0: return d;
        case 4: return INV ? cf{-d.y, d.x} : cf{d.y, -d.x};
        case 1: c = 0.92387953251128674f; s = 0.38268343236508977f; break;
        case 2: c = 0.70710678118654752f; s = 0.70710678118654752f; break;
        case 3: c = 0.38268343236508977f; s = 0.92387953251128674f; break;
        case 5: c = -0.38268343236508977f; s = 0.92387953251128674f; break;
        case 6: c = -0.70710678118654752f; s = 0.70710678118654752f; break;
        default: c = -0.92387953251128674f; s = 0.38268343236508977f; break;
    }
    const cf w = {c, INV ? s : -s};
    return cmul(d, w);
}
template <int H, bool INV> __device__ __forceinline__ void stage16(cf (&v)[16]) {
#pragma unroll
    for (int blk = 0; blk < 16; blk += 2 * H)
#pragma unroll
        for (int j = 0; j < H; ++j) {
            if (!INV) { const cf a = v[blk + j], b = v[blk + j + H]; v[blk + j] = cadd(a, b); v[blk + j + H] = tw16<false>(csub(a, b), j * (8 / H)); }
            else { const cf A = v[blk + j], B = tw16<true>(v[blk + j + H], j * (8 / H)); v[blk + j] = cadd(A, B); v[blk + j + H] = csub(A, B); }
        }
}
template <bool INV> __device__ __forceinline__ void dft16(cf (&v)[16]) {
    if (!INV) { stage16<8, false>(v); stage16<4, false>(v); stage16<2, false>(v); stage16<1, false>(v); }
    else { stage16<1, true>(v); stage16<2, true>(v); stage16<4, true>(v); stage16<8, true>(v); }
}
__device__ __forceinline__ constexpr int br4(int r) { return ((r & 1) << 3) | ((r & 2) << 1) | ((r & 4) >> 1) | ((r & 8) >> 3); }
template <bool INV, int LSL> __device__ __forceinline__ void pass16(LAS cf* buf, int tid, const cf* __restrict__ TW) {
    constexpr int SH = LSL - 4, st = 1 << SH;
    const int sub = tid >> SH, n2 = tid & (st - 1), base = (sub << LSL) + n2;
    cf v[16];
#pragma unroll
    for (int r = 0; r < 16; ++r) v[r] = buf[pidx(base + r * st)];
    cf wp[16];
    wp[1] = TW[n2 << (13 - LSL)];
    asm volatile("" : "+v"(wp[1].x), "+v"(wp[1].y));
    wp[2] = cmul(wp[1], wp[1]); wp[4] = cmul(wp[2], wp[2]); wp[8] = cmul(wp[4], wp[4]);
    wp[3] = cmul(wp[2], wp[1]); wp[5] = cmul(wp[4], wp[1]); wp[6] = cmul(wp[4], wp[2]); wp[7] = cmul(wp[4], wp[3]);
    wp[9] = cmul(wp[8], wp[1]); wp[10] = cmul(wp[8], wp[2]); wp[11] = cmul(wp[8], wp[3]); wp[12] = cmul(wp[8], wp[4]);
    wp[13] = cmul(wp[8], wp[5]); wp[14] = cmul(wp[8], wp[6]); wp[15] = cmul(wp[8], wp[7]);
    if (!INV) {
        dft16<false>(v);
#pragma unroll
        for (int r = 1; r < 16; ++r) v[r] = cmul(v[r], wp[br4(r)]);
    } else {
#pragma unroll
        for (int r = 1; r < 16; ++r) v[r] = cmulc(v[r], wp[br4(r)]);
        dft16<true>(v);
    }
#pragma unroll
    for (int r = 0; r < 16; ++r) buf[pidx(base + r * st)] = v[r];
}
template <bool MUL> __device__ __forceinline__ void mid2(LAS cf* D, const LAS cf* Hs, int tid) {
#pragma unroll
    for (int e = 0; e < 8; ++e) { const int i = 16 * tid + 2 * e; const cf a = D[pidx(i)], b = D[pidx(i + 1)]; cf A = cadd(a, b), B = csub(a, b);
        if (MUL) { A = cmul(A, Hs[pidx(i)]); B = cmul(B, Hs[pidx(i + 1)]); D[pidx(i)] = cadd(A, B); D[pidx(i + 1)] = csub(A, B); }
        else { D[pidx(i)] = A; D[pidx(i + 1)] = B; } }
}
#define HY_SYNC() __syncthreads()
__device__ __forceinline__ void fft_unit(LAS unsigned char* lds, int c, int tid, const float* __restrict__ HFT_l, const cf* __restrict__ TW, const bf16_t* __restrict__ ZT, const bf16_t* __restrict__ X0T,
                                         bf16_t* __restrict__ YCT, float bias) {
    asm volatile("" : "+v"(tid));
    LAS cf* D = (LAS cf*)lds; LAS cf* Hs = D + FBUF;
    const float* hsrc = HFT_l + (size_t)c * 8192;
#pragma unroll
    for (int k = 0; k < 16; ++k) { const int i = k * 512 + tid; Hs[pidx(i)] = cf{hsrc[i], 0.f}; }
    HY_SYNC();
    pass16<false, 13>(Hs, tid, TW); HY_SYNC();
    pass16<false, 9>(Hs, tid, TW); HY_SYNC();
    pass16<false, 5>(Hs, tid, TW); HY_SYNC();
    mid2<false>(Hs, Hs, tid); HY_SYNC();
    for (int pr = 0; pr < 2; ++pr) {
        const size_t o0 = ((size_t)(2 * pr) * DC + c) * SL, o1 = ((size_t)(2 * pr + 1) * DC + c) * SL;
#pragma unroll
        for (int k = 0; k < 8; ++k) { const int i = k * 512 + tid; D[pidx(i)] = cf{bf2f(ZT[o0 + i]), bf2f(ZT[o1 + i])}; D[pidx(i + 4096)] = cf{0.f, 0.f}; }
        HY_SYNC();
        pass16<false, 13>(D, tid, TW); HY_SYNC();
        pass16<false, 9>(D, tid, TW); HY_SYNC();
        pass16<false, 5>(D, tid, TW); HY_SYNC();
        mid2<true>(D, Hs, tid); HY_SYNC();
        pass16<true, 5>(D, tid, TW); HY_SYNC();
        pass16<true, 9>(D, tid, TW); HY_SYNC();
        pass16<true, 13>(D, tid, TW); HY_SYNC();
#pragma unroll
        for (int k = 0; k < 8; ++k) { const int i = k * 512 + tid; const cf y = D[pidx(i)];
            const float z0 = bf2f(ZT[o0 + i]), z1 = bf2f(ZT[o1 + i]), a0 = bf2f(X0T[o0 + i]), a1 = bf2f(X0T[o1 + i]);
            YCT[o0 + i] = (bf16_t)f2bf((y.x * (1.f / 8192.f) + z0 * bias) * a0); YCT[o1 + i] = (bf16_t)f2bf((y.y * (1.f / 8192.f) + z1 * bias) * a1); }
        HY_SYNC();
    }
}
constexpr int HP_ROWB = 1540;
__device__ __forceinline__ void hyprep_unit(LAS unsigned char* lds, int unit, int tid, const bf16_t* __restrict__ P, const float* __restrict__ cw, const float* __restrict__ cb,
                                            bf16_t* __restrict__ ZT, bf16_t* __restrict__ X0T) {
    asm volatile("" : "+v"(tid));
    const int b = unit >> 6, t0 = (unit & 63) * 64; const size_t m0 = (size_t)b * SL + t0;
    for (int i = tid; i < 66 * 96; i += NTHREADS) { const int r = i / 96, ch8 = i % 96; const int t = t0 - 1 + r;
        uint4 v = make_uint4(0u, 0u, 0u, 0u);
        if (t >= 0 && t < SL) v = *(const uint4*)(P + (m0 + r - 1) * DINP + P_CU + ch8 * 8);
        LAS unsigned* d = (LAS unsigned*)(lds + r * HP_ROWB + ch8 * 16); d[0] = v.x; d[1] = v.y; d[2] = v.z; d[3] = v.w; }
    __syncthreads();
    const int tok = tid & 63, wv = tid >> 6;
    for (int j = 0; j < 32; ++j) { const int c = wv * 32 + j; float u[3];
#pragma unroll
        for (int part = 0; part < 3; ++part) { const int ch = part * DC + c; float a = cb[ch];
#pragma unroll
            for (int k = 0; k < 3; ++k) a += cw[k * 3 * DC + ch] * bf2f(*(const LAS bf16_t*)(lds + (tok + k) * HP_ROWB + ch * 2));
            u[part] = a; }
        const size_t o = ((size_t)b * DC + c) * SL + t0 + tok;
        ZT[o] = (bf16_t)f2bf(u[2] * u[1]); X0T[o] = (bf16_t)f2bf(u[0]); }
    __syncthreads();
}
__device__ __forceinline__ void filter_item(LAS float* scr  , int t, int lane, const float* __restrict__ w1, const float* __restrict__ b1, const float* __restrict__ freq,
                                            const float* __restrict__ w2, const float* __restrict__ b2, const float* __restrict__ w3, float* __restrict__ HFT_l) {
    const double PI2 = 6.283185307179586476925286766559;
    const float tt = (float)((double)t / (double)(SL - 1));
    if (lane < HY_EMB) { float v;
        if (lane == 0) v = tt;
        else { const int bi = (lane - 1) & 15; const double f = 1e-4 + (double)bi * ((15.0 - 1e-4) / 15.0); const double w = PI2 * (double)t / (double)SL; v = (lane <= 16) ? (float)cos(f * w) : (float)(-sin(f * w)); }
        scr[lane] = v; }
    LDS_WAIT(); asm volatile("" ::: "memory");
    { float a = b1[lane]; for (int i = 0; i < HY_EMB; ++i) a += scr[i] * w1[i * HY_W + lane]; scr[64 + lane] = sinf(freq[lane] * a); }
    LDS_WAIT(); asm volatile("" ::: "memory");
    { float a = b2[lane]; for (int i = 0; i < HY_W; ++i) a += scr[64 + i] * w2[i * HY_W + lane]; scr[128 + lane] = sinf(freq[lane] * a); }
    LDS_WAIT(); asm volatile("" ::: "memory");
    const double mind = log(1e-2) / 1.5, maxd = log(1e-2) / 0.3;
#pragma unroll
    for (int q = 0; q < 8; ++q) { const int o = q * 64 + lane; float a = 0.f;
        for (int i = 0; i < HY_W; ++i) a += scr[128 + i] * w3[i * 2 * DC + o];
        const int c = o & 255, dir = o >> 8; const float delta = fabsf((float)(mind + (maxd - mind) * (double)c / 255.0));
        const float val = a * expf(-tt * delta);
        if (dir == 0) HFT_l[(size_t)c * 8192 + t] = val; else if (t > 0) HFT_l[(size_t)c * 8192 + 8192 - t] = val;
        if (dir == 0 && t == 0) HFT_l[(size_t)c * 8192 + 4096] = 0.f; }
    LDS_WAIT(); asm volatile("" ::: "memory");
}
}

constexpr size_t WS_AO = 222 * MiB;
namespace at {
typedef short v4i16_t __attribute__((ext_vector_type(4)));
constexpr int KROW = 144, NKEY = 400, V_OFF = NKEY * KROW;
__device__ __forceinline__ float blo(unsigned u) { return __builtin_bit_cast(float, u << 16); }
__device__ __forceinline__ float bhi(unsigned u) { return __builtin_bit_cast(float, u & 0xffff0000u); }
__device__ __forceinline__ void rope16(uint4& A, uint4& B, const float* __restrict__ cs, float scale) {
    const f32x4 c0 = *(const f32x4*)cs, c1 = *(const f32x4*)(cs + 4), s0 = *(const f32x4*)(cs + 8), s1 = *(const f32x4*)(cs + 12);
    const float c[8] = {c0[0], c0[1], c0[2], c0[3], c1[0], c1[1], c1[2], c1[3]}, s[8] = {s0[0], s0[1], s0[2], s0[3], s1[0], s1[1], s1[2], s1[3]};
    unsigned a[4] = {A.x, A.y, A.z, A.w}, b[4] = {B.x, B.y, B.z, B.w};
#pragma unroll
    for (int d = 0; d < 4; ++d) {
        const float t1l = blo(a[d]), t1h = bhi(a[d]), t2l = blo(b[d]), t2h = bhi(b[d]);
        const float o1l = (t1l * c[2 * d] - t2l * s[2 * d]) * scale, o1h = (t1h * c[2 * d + 1] - t2h * s[2 * d + 1]) * scale;
        const float o2l = (t2l * c[2 * d] + t1l * s[2 * d]) * scale, o2h = (t2h * c[2 * d + 1] + t1h * s[2 * d + 1]) * scale;
        a[d] = f2bf(o1l) | (f2bf(o1h) << 16); b[d] = f2bf(o2l) | (f2bf(o2h) << 16);
    }
    A = make_uint4(a[0], a[1], a[2], a[3]); B = make_uint4(b[0], b[1], b[2], b[3]);
}
__device__ __forceinline__ unsigned scale2(unsigned u, float sc) { return f2bf(blo(u) * sc) | (f2bf(bhi(u) * sc) << 16); }
__device__ __forceinline__ void attn_unit(LAS unsigned char* lds, int unit, int tid, const bf16_t* __restrict__ P, const float* __restrict__ rope, const float* __restrict__ sink_l, bf16_t* __restrict__ AO) {
    asm volatile("" : "+v"(tid));
    const int b = unit >> 6, kvh = (unit >> 5) & 1, q0 = (unit & 31) * 128, W0 = q0 - 128;
    const size_t m0 = (size_t)b * SL;
    const int lane = tid & 63, wave = __builtin_amdgcn_readfirstlane(tid >> 6), i = lane & 15, g = lane >> 4;
    __syncthreads();
    for (int it = tid; it < 2 * NKEY * 4; it += NTHREADS) {
        const int isV = it >= NKEY * 4, j = it - isV * NKEY * 4, kk = j >> 2, ch = j & 3, pos = W0 + kk;
        uint4 a = make_uint4(0u, 0u, 0u, 0u), bq = a;
        if (pos >= 0 && pos < SL) {
            const bf16_t* src = P + (m0 + pos) * DINP + (isV ? P_V : P_K) + kvh * HD + ch * 16;
            a = *(const uint4*)src; bq = *(const uint4*)(src + 8);
            if (!isV && ch == 0) rope16(a, bq, rope + pos * 16, 1.0f);
        }
        LAS unsigned char* dst = lds + (isV ? V_OFF : 0) + kk * KROW + ch * 32;
        *(LAS v4u*)dst = (v4u){a.x, a.y, a.z, a.w}; *(LAS v4u*)(dst + 16) = (v4u){bq.x, bq.y, bq.z, bq.w};
    }
    __syncthreads();
    const bool edge = (q0 == 0) || (q0 == SL - 128);
#pragma unroll 1
    for (int gi = 0; gi < 3; ++gi) {
        const int grp = wave * 3 + gi, hl = grp >> 3, qsub = grp & 7, head = kvh * 3 + hl;
        const int tok = q0 + 16 * qsub + i;
        bf16x8 qf[2];
        {   const bf16_t* qp = P + (m0 + tok) * DINP + P_Q + head * HD + g * 8;
            uint4 own = *(const uint4*)qp, hi2 = *(const uint4*)(qp + 32);
            uint4 oth; oth.x = __shfl_xor(own.x, 16); oth.y = __shfl_xor(own.y, 16); oth.z = __shfl_xor(own.z, 16); oth.w = __shfl_xor(own.w, 16);
            uint4 t1 = (g == 0) ? own : oth, t2 = (g == 0) ? oth : own;
            rope16(t1, t2, rope + tok * 16, 0.125f);
            uint4 r0;
            if (g == 0) r0 = t1; else if (g == 1) r0 = t2; else r0 = make_uint4(scale2(own.x, 0.125f), scale2(own.y, 0.125f), scale2(own.z, 0.125f), scale2(own.w, 0.125f));
            hi2 = make_uint4(scale2(hi2.x, 0.125f), scale2(hi2.y, 0.125f), scale2(hi2.z, 0.125f), scale2(hi2.w, 0.125f));
            qf[0] = __builtin_bit_cast(bf16x8, r0); qf[1] = __builtin_bit_cast(bf16x8, hi2); }
        f32x4 st[17];
        const LAS unsigned char* kb = lds + (16 * qsub + i) * KROW + g * 16;
#pragma unroll
        for (int tt = 0; tt < 17; ++tt) {
            const bf16x8 k0 = *(const LAS bf16x8*)(kb + tt * 16 * KROW), k1 = *(const LAS bf16x8*)(kb + tt * 16 * KROW + 64);
            f32x4 acc = __builtin_amdgcn_mfma_f32_16x16x32_bf16(k0, qf[0], (f32x4){0.f, 0.f, 0.f, 0.f}, 0, 0, 0);
            st[tt] = __builtin_amdgcn_mfma_f32_16x16x32_bf16(k1, qf[1], acc, 0, 0, 0);
        }
        const float NEGF = -1e30f;
#pragma unroll
        for (int r = 0; r < 4; ++r) { if (4 * g + r < i) st[0][r] = NEGF; if (4 * g + r > i) st[16][r] = NEGF; }
        if (edge) {
#pragma unroll
            for (int tt = 0; tt < 17; ++tt)
#pragma unroll
                for (int r = 0; r < 4; ++r) { const int pos = W0 + 16 * (qsub + tt) + 4 * g + r; if (pos < 0 || pos >= SL) st[tt][r] = NEGF; }
        }
        const float sk = sink_l[head];
        float mx = sk;
#pragma unroll
        for (int tt = 0; tt < 17; ++tt) mx = fmaxf(fmaxf(mx, fmaxf(st[tt][0], st[tt][1])), fmaxf(st[tt][2], st[tt][3]));
        mx = fmaxf(mx, __shfl_xor(mx, 16)); mx = fmaxf(mx, __shfl_xor(mx, 32));
        const float L2E = 1.4426950408889634f, mb = mx * L2E;
        float lsum = 0.f;
        bf16x8 pf[9];
#pragma unroll
        for (int s = 0; s < 9; ++s) {
            float p[8];
#pragma unroll
            for (int r = 0; r < 4; ++r) { p[r] = __builtin_amdgcn_exp2f(st[2 * s][r] * L2E - mb); p[4 + r] = (2 * s + 1 < 17) ? __builtin_amdgcn_exp2f(st[(2 * s + 1 < 17) ? 2 * s + 1 : 16][r] * L2E - mb) : 0.f; }
#pragma unroll
            for (int r = 0; r < 8; ++r) lsum += p[r];
            uint4 w; w.x = f2bf(p[0]) | (f2bf(p[1]) << 16); w.y = f2bf(p[2]) | (f2bf(p[3]) << 16); w.z = f2bf(p[4]) | (f2bf(p[5]) << 16); w.w = f2bf(p[6]) | (f2bf(p[7]) << 16);
            pf[s] = __builtin_bit_cast(bf16x8, w);
        }
        lsum += __shfl_xor(lsum, 16); lsum += __shfl_xor(lsum, 32);
        lsum += __builtin_amdgcn_exp2f(sk * L2E - mb);
        const float rl = 1.0f / lsum;
        const LAS unsigned char* vb = lds + V_OFF + (16 * qsub + 4 * g + (i >> 2)) * KROW + (i & 3) * 8;
        bf16_t* op = AO + (m0 + tok) * DBB + head * HD + 4 * g;
#pragma unroll
        for (int dt = 0; dt < 4; ++dt) {
            f32x4 o = (f32x4){0.f, 0.f, 0.f, 0.f};
#pragma unroll
            for (int s = 0; s < 9; ++s) {
                const v4i16_t lo = __builtin_amdgcn_ds_read_tr16_b64_v4i16((LAS v4i16_t*)(vb + (32 * s) * KROW + dt * 32));
                const v4i16_t hi = __builtin_amdgcn_ds_read_tr16_b64_v4i16((LAS v4i16_t*)(vb + (32 * s + 16) * KROW + dt * 32));
                const bf16x8 vf = (bf16x8){lo[0], lo[1], lo[2], lo[3], hi[0], hi[1], hi[2], hi[3]};
                o = __builtin_amdgcn_mfma_f32_16x16x32_bf16(vf, pf[s], o, 0, 0, 0);
            }
            uint2 w; w.x = f2bf(o[0] * rl) | (f2bf(o[1] * rl) << 16); w.y = f2bf(o[2] * rl) | (f2bf(o[3] * rl) << 16);
            *(uint2*)(op + dt * 16) = w;
        }
    }
}
}

constexpr size_t WS_AGG = 234 * MiB;
constexpr size_t WS_LW = WS_ROPE + 512 * 1024;
namespace lru {
constexpr int AXROW = 784, XCROW = 784, XC_OFF = 67 * AXROW, CARRY_OFF = XC_OFF + 64 * XCROW, SSQ_OFF = CARRY_OFF + 2 * DA * 4, RSTD_OFF = SSQ_OFF + 64 * 24 * 4;
__device__ __forceinline__ float fsig(float x) { return __builtin_amdgcn_rcpf(1.0f + __builtin_amdgcn_exp2f(-1.4426950408889634f * x)); }
__device__ __forceinline__ float fgelu(float x) { const float u = 0.7978845608028654f * (x + 0.044715f * x * x * x); const float e = __builtin_amdgcn_exp2f(2.8853900817779268f * u);
    const float th = 1.0f - 2.0f * __builtin_amdgcn_rcpf(1.0f + e); return 0.5f * x * (1.0f + th); }
template <bool FIN>
__device__ __forceinline__ void lru_unit(LAS unsigned char* lds, int unit, int tid, const bf16_t* __restrict__ P, const float* __restrict__ cw, const float* __restrict__ cb, const bf16_t* __restrict__ LW_l,
                                         const float* __restrict__ ba, const float* __restrict__ bx, const float* __restrict__ lam, float* __restrict__ AGG, const float* __restrict__ gn, bf16_t* __restrict__ YN) {
    asm volatile("" : "+v"(tid));
    const int b = unit >> 6, kc = unit & 63, t0 = kc * 64; const size_t m0 = (size_t)b * SL + t0;
    const int lane = tid & 63, wave = __builtin_amdgcn_readfirstlane(tid >> 6), li = lane & 15, g = lane >> 4;
    LAS unsigned char* AX = lds; LAS unsigned char* XC = lds + XC_OFF; LAS float* CARRY = (LAS float*)(lds + CARRY_OFF); LAS float* SSQ = (LAS float*)(lds + SSQ_OFF); LAS float* RSTD = (LAS float*)(lds + RSTD_OFF);
    __syncthreads();
    for (int it = tid; it < 67 * 48; it += NTHREADS) { const int r = it / 48, c8 = it % 48, t = t0 - 2 + r;
        uint4 v = make_uint4(0u, 0u, 0u, 0u);
        if (t >= 0 && t < SL) v = *(const uint4*)(P + (m0 + r - 2) * DINP + P_AX + c8 * 8);
        *(LAS v4u*)(AX + r * AXROW + c8 * 16) = (v4u){v.x, v.y, v.z, v.w}; }
    if (FIN) { if (tid < DA) { const int ch = tid; const float* ag = AGG + (size_t)b * 64 * 4 * DA + ch;
        float hf = 0.f; for (int j = 0; j < kc; ++j) hf = ag[(size_t)j * 4 * DA] * hf + ag[(size_t)j * 4 * DA + DA];
        float hb = 0.f; for (int j = 63; j > kc; --j) hb = ag[(size_t)j * 4 * DA + 2 * DA] * hb + ag[(size_t)j * 4 * DA + 3 * DA];
        CARRY[ch] = hf; CARRY[DA + ch] = hb; } }
    __syncthreads();
    if (tid < 384) { const int c8 = tid % 48, tg = tid / 48, ch0 = c8 * 8;
        float w[4][8], bb[8];
#pragma unroll
        for (int e = 0; e < 8; ++e) { bb[e] = cb[ch0 + e];
#pragma unroll
            for (int k = 0; k < 4; ++k) w[k][e] = cw[k * DA + ch0 + e]; }
        for (int q = 0; q < 8; ++q) { const int tok = tg * 8 + q; float acc[8];
#pragma unroll
            for (int e = 0; e < 8; ++e) acc[e] = bb[e];
#pragma unroll
            for (int k = 0; k < 4; ++k) { const v4u v = *(const LAS v4u*)(AX + (tok + k) * AXROW + c8 * 16);
#pragma unroll
                for (int d = 0; d < 4; ++d) { acc[2 * d] += w[k][2 * d] * at::blo(v[d]); acc[2 * d + 1] += w[k][2 * d + 1] * at::bhi(v[d]); } }
            *(LAS v4u*)(XC + tok * XCROW + c8 * 16) = (v4u){pk2(acc[0], acc[1]), pk2(acc[2], acc[3]), pk2(acc[4], acc[5]), pk2(acc[6], acc[7])}; }
    }
    __syncthreads();
    float yk[3][4][4];
#pragma unroll
    for (int rd = 0; rd < 3; ++rd) {
        asm volatile("" ::: "memory"); __builtin_amdgcn_sched_barrier(0);
        const int h = 2 * rd + (wave >> 2), ct = wave & 3, ch = 64 * h + 16 * ct + li;
        f32x4 acc[4][4];
        {   bf16x8 af[4][2], bfr[4][2];
#pragma unroll
            for (int mt = 0; mt < 4; ++mt)
#pragma unroll
                for (int ks = 0; ks < 2; ++ks) af[mt][ks] = *(const LAS bf16x8*)(XC + (16 * mt + li) * XCROW + (64 * h + 32 * ks + 8 * g) * 2);
#pragma unroll
            for (int mat = 0; mat < 4; ++mat)
#pragma unroll
                for (int ks = 0; ks < 2; ++ks) bfr[mat][ks] = *(const bf16x8*)(LW_l + ((size_t)((h * 4 + mat) * 64 + 16 * ct + li)) * 64 + 32 * ks + 8 * g);
#pragma unroll
            for (int mat = 0; mat < 4; ++mat)
#pragma unroll
                for (int mt = 0; mt < 4; ++mt) { f32x4 c = __builtin_amdgcn_mfma_f32_16x16x32_bf16(af[mt][0], bfr[mat][0], (f32x4){0.f, 0.f, 0.f, 0.f}, 0, 0, 0);
                    acc[mat][mt] = __builtin_amdgcn_mfma_f32_16x16x32_bf16(af[mt][1], bfr[mat][1], c, 0, 0, 0); } }
        {   const float cw0 = cw[ch], cw1 = cw[DA + ch], cw2 = cw[2 * DA + ch], cw3 = cw[3 * DA + ch], cbv = cb[ch];
            float ban[2] = {ba[ch], ba[DA + ch]}, bxn[2] = {bx[ch], bx[DA + ch]}, spn[2];
#pragma unroll
            for (int n = 0; n < 2; ++n) { const float l = lam[n * DA + ch]; spn[n] = (-l > 20.f) ? -l : log1pf(expf(-l)); }
#pragma unroll
            for (int mt = 0; mt < 4; ++mt)
#pragma unroll
                for (int r = 0; r < 4; ++r) { const int tok = 16 * mt + 4 * g + r; const LAS unsigned char* ap = AX + tok * AXROW + ch * 2;
                    const float xcv = cbv + cw0 * bf2f(*(const LAS bf16_t*)ap) + cw1 * bf2f(*(const LAS bf16_t*)(ap + AXROW)) + cw2 * bf2f(*(const LAS bf16_t*)(ap + 2 * AXROW)) + cw3 * bf2f(*(const LAS bf16_t*)(ap + 3 * AXROW));
#pragma unroll
                    for (int n = 0; n < 2; ++n) { const float rg = fsig(acc[2 * n][mt][r] + ban[n]), ig = fsig(acc[2 * n + 1][mt][r] + bxn[n]);
                        const float la = -8.0f * rg * spn[n]; acc[2 * n][mt][r] = expf(la); acc[2 * n + 1][mt][r] = sqrtf(-expm1f(2.0f * la)) * (ig * xcv); } } }
        f32x4 hs[4];
        {   float hin = FIN ? CARRY[ch] : 0.f, atot = 1.f;
#pragma unroll
            for (int mt = 0; mt < 4; ++mt) { const f32x4 a = acc[0][mt], bb = acc[1][mt];
                float Ai = (a[0] * a[1]) * (a[2] * a[3]), Bi = ((bb[0] * a[1] + bb[1]) * a[2] + bb[2]) * a[3] + bb[3];
                { const float A1 = __shfl_up(Ai, 16), B1 = __shfl_up(Bi, 16); if (g >= 1) { Bi = B1 * Ai + Bi; Ai = A1 * Ai; } }
                { const float A2 = __shfl_up(Ai, 32), B2 = __shfl_up(Bi, 32); if (g >= 2) { Bi = B2 * Ai + Bi; Ai = A2 * Ai; } }
                float Ae = __shfl_up(Ai, 16), Be = __shfl_up(Bi, 16); if (g == 0) { Ae = 1.f; Be = 0.f; }
                float hh = Ae * hin + Be;
#pragma unroll
                for (int r = 0; r < 4; ++r) { hh = a[r] * hh + bb[r]; hs[mt][r] = hh; }
                const float At = __shfl(Ai, li + 48), Bt = __shfl(Bi, li + 48); hin = At * hin + Bt; atot *= At; }
            if (!FIN && g == 0) { float* ag = AGG + ((size_t)(b * 64 + kc) * 4) * DA + ch; ag[0] = atot; ag[DA] = hin; } }
        {   float hin = FIN ? CARRY[DA + ch] : 0.f, atot = 1.f;
#pragma unroll
            for (int mt = 3; mt >= 0; --mt) { const f32x4 a = acc[2][mt], bb = acc[3][mt];
                float Ai = (a[0] * a[1]) * (a[2] * a[3]), Bi = ((bb[3] * a[2] + bb[2]) * a[1] + bb[1]) * a[0] + bb[0];
                { const float A1 = __shfl_down(Ai, 16), B1 = __shfl_down(Bi, 16); if (g <= 2) { Bi = B1 * Ai + Bi; Ai = A1 * Ai; } }
                { const float A2 = __shfl_down(Ai, 32), B2 = __shfl_down(Bi, 32); if (g <= 1) { Bi = B2 * Ai + Bi; Ai = A2 * Ai; } }
                float Ae = __shfl_down(Ai, 16), Be = __shfl_down(Bi, 16); if (g == 3) { Ae = 1.f; Be = 0.f; }
                float hh = Ae * hin + Be;
#pragma unroll
                for (int r = 3; r >= 0; --r) { hh = a[r] * hh + bb[r]; hs[mt][r] += hh; }
                const float At = __shfl(Ai, li), Bt = __shfl(Bi, li); hin = At * hin + Bt; atot *= At; }
            if (!FIN && g == 0) { float* ag = AGG + ((size_t)(b * 64 + kc) * 4) * DA + ch; ag[2 * DA] = atot; ag[3 * DA] = hin; } }
        if (FIN) {
#pragma unroll
            for (int mt = 0; mt < 4; ++mt)
#pragma unroll
                for (int r = 0; r < 4; ++r) { const int tok = 16 * mt + 4 * g + r; const float y = hs[mt][r] * fgelu(bf2f(P[(m0 + tok) * DINP + P_AG + ch])); yk[rd][mt][r] = y;
                    float s = y * y; s += __shfl_xor(s, 1); s += __shfl_xor(s, 2); s += __shfl_xor(s, 4); s += __shfl_xor(s, 8);
                    if (li == 0) SSQ[tok * 24 + rd * 8 + wave] = s; }
        }
    }
    if (FIN) {
        __syncthreads();
        if (tid < 64) { float s = 0.f;
#pragma unroll
            for (int q = 0; q < 24; ++q) s += SSQ[tid * 24 + q];
            RSTD[tid] = 1.0f / sqrtf(s * (1.0f / DA) + EPS); }
        __syncthreads();
#pragma unroll
        for (int rd = 0; rd < 3; ++rd) { const int h = 2 * rd + (wave >> 2), ct = wave & 3, ch = 64 * h + 16 * ct + li; const float gv = gn[ch];
#pragma unroll
            for (int mt = 0; mt < 4; ++mt)
#pragma unroll
                for (int r = 0; r < 4; ++r) { const int tok = 16 * mt + 4 * g + r; YN[(m0 + tok) * DM + ch] = (bf16_t)f2bf(yk[rd][mt][r] * RSTD[tok] * gv); } }
    }
}
}

namespace fin {
constexpr int TROW = 528;
__device__ __forceinline__ float wsum(float v) {
#pragma unroll
    for (int o = 1; o < 64; o <<= 1) v += __shfl_xor(v, o);
    return v;
}
__device__ __forceinline__ void norm_bc_unit(LAS unsigned char* lds, int unit, int tid, const bf16_t* __restrict__ AO, const bf16_t* __restrict__ YCT, const float* __restrict__ gnb, const float* __restrict__ gnc, bf16_t* __restrict__ YN) {
    asm volatile("" : "+v"(tid));
    const int b = unit >> 6, t0 = (unit & 63) * 64; const size_t m0 = (size_t)b * SL + t0;
    const int lane = tid & 63, wave = __builtin_amdgcn_readfirstlane(tid >> 6);
    __syncthreads();
    {   const int c = tid >> 1, hf = tid & 1; const bf16_t* src = YCT + ((size_t)b * DC + c) * SL + t0 + hf * 32;
#pragma unroll
        for (int q = 0; q < 4; ++q) { const uint4 v = *(const uint4*)(src + q * 8); const unsigned w[4] = {v.x, v.y, v.z, v.w};
#pragma unroll
            for (int d = 0; d < 4; ++d) { const int tok = hf * 32 + q * 8 + 2 * d;
                *(LAS bf16_t*)(lds + tok * TROW + c * 2) = (bf16_t)(w[d] & 0xffffu); *(LAS bf16_t*)(lds + (tok + 1) * TROW + c * 2) = (bf16_t)(w[d] >> 16); } } }
    for (int q = 0; q < 8; ++q) { const int tok = wave * 8 + q; const unsigned* src = (const unsigned*)(AO + (m0 + tok) * DBB);
        float v[6]; float s = 0.f;
#pragma unroll
        for (int j = 0; j < 3; ++j) { const unsigned w = src[lane + 64 * j]; v[2 * j] = at::blo(w); v[2 * j + 1] = at::bhi(w); s += v[2 * j] * v[2 * j] + v[2 * j + 1] * v[2 * j + 1]; }
        const float r = 1.0f / sqrtf(wsum(s) * (1.0f / DBB) + EPS);
        unsigned* dst = (unsigned*)(YN + (m0 + tok) * DM + DA);
#pragma unroll
        for (int j = 0; j < 3; ++j) { const int c0 = 2 * (lane + 64 * j); dst[lane + 64 * j] = pk2(v[2 * j] * r * gnb[c0], v[2 * j + 1] * r * gnb[c0 + 1]); } }
    __syncthreads();
    for (int q = 0; q < 8; ++q) { const int tok = wave * 8 + q; typedef unsigned u32x2v __attribute__((ext_vector_type(2))); const u32x2v w = *(const LAS u32x2v*)(lds + tok * TROW + lane * 8);
        const float v0 = at::blo(w.x), v1 = at::bhi(w.x), v2 = at::blo(w.y), v3 = at::bhi(w.y);
        const float r = 1.0f / sqrtf(wsum(v0 * v0 + v1 * v1 + v2 * v2 + v3 * v3) * (1.0f / DC) + EPS);
        const f32x4 gg = *(const f32x4*)(gnc + lane * 4);
        uint2 o; o.x = pk2(v0 * r * gg[0], v1 * r * gg[1]); o.y = pk2(v2 * r * gg[2], v3 * r * gg[3]);
        *(uint2*)(YN + (m0 + tok) * DM + DA + DBB + lane * 4) = o; }
}
}

struct Frame {
    LAS unsigned char* lds;
    volatile LAS unsigned* MISC;
    int tid, lane, wave, vcu, G;
};
__device__ __forceinline__ void p0_transpose_item(const float* W, int K, int N, bf16_t* WT, LAS float* scr, int item, int lane) {
    const int nblk = N / 32, kb = item / nblk, nb = item % nblk, k0 = 64 * kb, n0 = 32 * nb;
#pragma unroll 8
    for (int i = 0; i < 32; ++i) { const int kk = 2 * i + (lane >> 5); scr[kk * 33 + (lane & 31)] = W[(size_t)(k0 + kk) * N + n0 + (lane & 31)]; }
    LDS_WAIT(); asm volatile("" ::: "memory");
    const int c = lane & 7;
#pragma unroll
    for (int j = 0; j < 4; ++j) { const int n = (lane >> 3) + 8 * j; const LAS float* s = scr + (8 * c) * 33 + n;
        v4u o; o.x = pk2(s[0 * 33], s[1 * 33]); o.y = pk2(s[2 * 33], s[3 * 33]); o.z = pk2(s[4 * 33], s[5 * 33]); o.w = pk2(s[6 * 33], s[7 * 33]);
        *(GAS v4u*)(WT + (size_t)(n0 + n) * K + k0 + 8 * c) = o; }
    LDS_WAIT(); asm volatile("" ::: "memory");
}
__device__ __forceinline__ void xg_row(const float* xrow, const float* g, bf16_t* orow, float* ssrow, int lane) {
    const GAS f32x4* xr = (const GAS f32x4*)xrow + lane; const GAS f32x4* gr = (const GAS f32x4*)g + lane;
    f32x4 v[4]; float s = 0.f;
#pragma unroll
    for (int j = 0; j < 4; ++j) { v[j] = xr[64 * j]; s += (v[j][0] * v[j][0] + v[j][1] * v[j][1]) + (v[j][2] * v[j][2] + v[j][3] * v[j][3]); }
    s += __shfl_xor(s, 1); s += __shfl_xor(s, 2);
    if ((lane & 3) == 0) ssrow[lane >> 2] = s;
    GAS unsigned long long* o8 = (GAS unsigned long long*)orow + lane;
#pragma unroll
    for (int j = 0; j < 4; ++j) { const f32x4 gg = gr[64 * j]; o8[64 * j] = (unsigned long long)pk2(v[j][0] * gg[0], v[j][1] * gg[1]) | ((unsigned long long)pk2(v[j][2] * gg[2], v[j][3] * gg[3]) << 32); }
}
__device__ __forceinline__ void final_row(const float* xrow, const float* g, const float* SS, int row, float* orow, int lane) {
    const GAS f32x4* xr = (const GAS f32x4*)xrow + lane; const GAS f32x4* gr = (const GAS f32x4*)g + lane; GAS f32x4* o = (GAS f32x4*)orow + lane;
    const float r = pg8::rstd16(SS, row);
#pragma unroll
    for (int j = 0; j < 4; ++j) { const f32x4 v = xr[64 * j], gg = gr[64 * j]; o[64 * j] = v * gg * r; }
}

template <int I> __device__ __forceinline__ const float* in_ptr() {
    unsigned long long v;
    asm volatile("s_load_dwordx2 %0, %1, %2\n\ts_waitcnt lgkmcnt(0)" : "=s"(v) : "s"(__builtin_amdgcn_kernarg_segment_ptr()), "n"(I * 8) : "memory");
    return (const float*)v;
}
#define INP(i) in_ptr<i>()
struct Args { const float* in[28]; float* out; unsigned char* ws; int ph_lo, ph_hi, li, pad; };

__global__ void __launch_bounds__(NTHREADS, 2) mega(Args args) {
    extern __shared__ __attribute__((aligned(16))) unsigned char lds[];
    Frame F;
    F.lds = (LAS unsigned char*)lds; F.MISC = (volatile LAS unsigned*)(F.lds + MISC_OFF);
    F.tid = threadIdx.x; F.lane = F.tid & 63; F.wave = __builtin_amdgcn_readfirstlane(F.tid >> 6);
    F.G = gridDim.x; { const int bx = blockIdx.x; F.vcu = (F.G % 8 == 0) ? (bx % 8) * (F.G / 8) + bx / 8 : bx; }
    unsigned char* ws = args.ws;
    gu32* ctl = (gu32*)(ws + WS_CTL);
    for (int u = F.tid; u < (LDS_BYTES - MISC_OFF) / 4; u += NTHREADS) ((LAS unsigned*)(F.lds + MISC_OFF))[u] = 0u;
    __syncthreads();
    const int lo = args.ph_lo, hi = args.ph_hi;
    XcdBarrier bar; bar.bar = (unsigned*)(ctl + CW_BAR) + args.li * XCD_BAR_WORDS; bar.x = 0; bar.st = nullptr;
    if (hi - lo > 1) bar = xcd_barrier_post((unsigned*)(ctl + CW_BAR) + args.li * XCD_BAR_WORDS, F.MISC + 8);

    bf16_t* Win_t = (bf16_t*)(ws + WS_WIN); bf16_t* Wout_t = (bf16_t*)(ws + WS_WOUT); bf16_t* Wup_t = (bf16_t*)(ws + WS_WUP); bf16_t* Wdn_t = (bf16_t*)(ws + WS_WDN);
    bf16_t* XG = (bf16_t*)(ws + WS_XG); bf16_t* P = (bf16_t*)(ws + WS_P); bf16_t* YN = (bf16_t*)(ws + WS_YN); bf16_t* HB = (bf16_t*)(ws + WS_H);
    float* SS = (float*)(ws + WS_SS); float* XR = args.out;
    const int gw = F.vcu * NWAVES + F.wave, NGW = F.G * NWAVES;

#define IN(k) (lo <= (k) && (k) < hi)
#define SEAM(k) do { if (IN(k) && IN((k) + 1)) xcd_barrier(bar); } while (0)
    if (IN(PH_PRO)) {
        LAS float* scr = (LAS float*)(F.lds + RING_OFF + F.wave * 16384);
        constexpr int I_IN = (DM / 64) * (DIN / 32), I_OUT = (DM / 64) * (DM / 32), I_UP = (DM / 64) * (DFF / 32), I_DN = (DFF / 64) * (DM / 32), I_L = I_IN + I_OUT + I_UP + I_DN;
        for (int it = gw; it < DEPTH * I_L; it += NGW) {
            const int l = it / I_L; int r = it % I_L;
            if (r < I_IN) { p0_transpose_item(INP(2) + (size_t)l * DM * DIN, DM, DIN, Win_t + (size_t)l * DINP * DM, scr, r, F.lane); continue; } r -= I_IN;
            if (r < I_OUT) { p0_transpose_item(INP(23) + (size_t)l * DM * DM, DM, DM, Wout_t + (size_t)l * DM * DM, scr, r, F.lane); continue; } r -= I_OUT;
            if (r < I_UP) { p0_transpose_item(INP(25) + (size_t)l * DM * DFF, DM, DFF, Wup_t + (size_t)l * DFF * DM, scr, r, F.lane); continue; } r -= I_UP;
            p0_transpose_item(INP(26) + (size_t)l * DFF * DM, DFF, DM, Wdn_t + (size_t)l * DM * DFF, scr, r, F.lane);
        }
        for (int i = blockIdx.x * NTHREADS + F.tid; i < DEPTH * 16384; i += F.G * NTHREADS) { const int l = i >> 14, r = i & 16383;
            *(GAS v4u*)((GAS unsigned char*)(Win_t + (size_t)l * DINP * DM + (size_t)DIN * DM) + (size_t)r * 16) = (v4u){0u, 0u, 0u, 0u}; }
        {
            float* TWf = (float*)(ws + WS_TW); float* rope = (float*)(ws + WS_ROPE);
            for (int i = blockIdx.x * NTHREADS + F.tid; i < 8192; i += F.G * NTHREADS) { const double a = 6.283185307179586476925286766559 * (double)i / 8192.0; TWf[2 * i] = (float)cos(a); TWf[2 * i + 1] = (float)(-sin(a)); }
            for (int i = blockIdx.x * NTHREADS + F.tid; i < SL * 8; i += F.G * NTHREADS) { const int pos = i >> 3, j = i & 7; const double ang = (double)pos * pow(500000.0, -(double)j / 8.0);
                rope[pos * 16 + j] = (float)cos(ang); rope[pos * 16 + 8 + j] = (float)sin(ang); }
        }
        {
            bf16_t* LW = (bf16_t*)(ws + WS_LW); const float* wa = INP(5); const float* wx = INP(7);
            for (int o = blockIdx.x * NTHREADS + F.tid; o < DEPTH * LRU_BLK * 4 * 64 * 64; o += F.G * NTHREADS) {
                const int i = o & 63, j = (o >> 6) & 63, mat = (o >> 12) & 3, lh = o >> 14, h = lh % LRU_BLK, l = lh / LRU_BLK, n = mat >> 1;
                const float* src = (mat & 1) ? wx : wa;
                LW[o] = (bf16_t)f2bf(src[((((size_t)l * 2 + n) * LRU_BLK + h) * 64 + i) * 64 + j]); }
        }
        {
            LAS float* fscr = (LAS float*)(F.lds + RING_OFF + F.wave * 16384);
            const float* w1 = INP(13); const float* b1 = INP(14); const float* fq = INP(15); const float* w2 = INP(16); const float* b2 = INP(17); const float* w3 = INP(18);
            for (int it = gw; it < DEPTH * SL; it += NGW) { const int l = it / SL, t = it % SL;
                hy::filter_item(fscr, t, F.lane, w1 + (size_t)l * HY_EMB * HY_W, b1 + l * HY_W, fq + l * HY_W, w2 + (size_t)l * HY_W * HY_W, b2 + l * HY_W, w3 + (size_t)l * HY_W * 2 * DC,
                                (float*)(ws + WS_HF) + (size_t)l * DC * 8192); }
        }
        { const float* x0 = INP(0); const float* g0 = INP(1);
          for (int m = gw; m < MT; m += NGW) xg_row(x0 + (size_t)m * DM, g0, XG + (size_t)m * DM, SS + (size_t)m * 16, F.lane); }
    }
    SEAM(PH_PRO);
#define LAYER(l) do { constexpr int pb = 1 + PH_PER_LAYER * (l); \
    if (IN(pb + PL_WIN)) { \
        pg8::Gemm g{XG, Win_t + (size_t)(l) * DINP * DM, MT, DINP, DM}; pg8::StaticOrder S; S.init(MT, DINP, F.G, (int)blockIdx.x); \
        pg8::EpiScaleBf16<0> E{P, DINP, SS}; \
        pg8::gemm_phase<pg8::EpiScaleBf16<0>, pg8::StaticOrder, true, true>(F.lds + RING_OFF, g, S, E); } \
    SEAM(pb + PL_WIN); \
    if (IN(pb + PL_MIX1)) { const float* cw = INP(11) + (l) * 9 * DC; const float* cb = INP(12) + (l) * 3 * DC; \
        for (int u = F.vcu; u < 256; u += F.G) hy::hyprep_unit(F.lds, u, F.tid, P, cw, cb, (bf16_t*)(ws + WS_ZT), (bf16_t*)(ws + WS_X0T)); \
        { const float* cwa = INP(3) + (l) * 4 * DA; const float* cba = INP(4) + (l) * DA; const float* ba = INP(6) + (l) * 2 * DA; const float* bx = INP(8) + (l) * 2 * DA; const float* lam = INP(9) + (l) * 2 * DA; \
          for (int u = F.vcu; u < 256; u += F.G) lru::lru_unit<false>(F.lds, u, F.tid, P, cwa, cba, (const bf16_t*)(ws + WS_LW) + (size_t)(l) * LRU_BLK * 4 * 4096, ba, bx, lam, (float*)(ws + WS_AGG), nullptr, YN); } \
        { const float* sk = INP(10) + (l) * NQH; \
          for (int u = F.vcu; u < 256; u += F.G) at::attn_unit(F.lds, u, F.tid, P, (const float*)(ws + WS_ROPE), sk, (bf16_t*)(ws + WS_AO)); } } \
    SEAM(pb + PL_MIX1); \
    if (IN(pb + PL_FFT)) { const float* hb = INP(19) + (l) * DC; \
        for (int u = F.vcu; u < DC; u += F.G) hy::fft_unit(F.lds, u, F.tid, (const float*)(ws + WS_HF) + (size_t)(l) * DC * 8192, (const hy::cf*)(ws + WS_TW), (const bf16_t*)(ws + WS_ZT), (const bf16_t*)(ws + WS_X0T), \
                                                           (bf16_t*)(ws + WS_YCT), hb[u]); } \
    SEAM(pb + PL_FFT); \
    if (IN(pb + PL_FIN)) { \
        { const float* cwa = INP(3) + (l) * 4 * DA; const float* cba = INP(4) + (l) * DA; const float* ba = INP(6) + (l) * 2 * DA; const float* bx = INP(8) + (l) * 2 * DA; const float* lam = INP(9) + (l) * 2 * DA; const float* gna = INP(20) + (l) * DA; \
          for (int u = F.vcu; u < 256; u += F.G) lru::lru_unit<true>(F.lds, u, F.tid, P, cwa, cba, (const bf16_t*)(ws + WS_LW) + (size_t)(l) * LRU_BLK * 4 * 4096, ba, bx, lam, (float*)(ws + WS_AGG), gna, YN); } \
        { const float* gnb = INP(21) + (l) * DBB; const float* gnc = INP(22) + (l) * DC; \
          for (int u = F.vcu; u < 256; u += F.G) fin::norm_bc_unit(F.lds, u, F.tid, (const bf16_t*)(ws + WS_AO), (const bf16_t*)(ws + WS_YCT), gnb, gnc, YN); } } \
    SEAM(pb + PL_FIN); \
    if (IN(pb + PL_WOUT)) { \
        pg8::Gemm g{YN, Wout_t + (size_t)(l) * DM * DM, MT, DM, DM}; pg8::StaticOrder S; S.init(MT, DM, F.G, (int)blockIdx.x); \
        pg8::EpiRes E{(l) == 0 ? INP(0) : (const float*)XR, XR, XG, INP(24) + (l) * DM, SS}; \
        pg8::gemm_phase<pg8::EpiRes, pg8::StaticOrder, true, true>(F.lds + RING_OFF, g, S, E); } \
    SEAM(pb + PL_WOUT); \
    if (IN(pb + PL_WUP)) { \
        pg8::Gemm g{XG, Wup_t + (size_t)(l) * DFF * DM, MT, DFF, DM}; pg8::StaticOrder S; S.init(MT, DFF, F.G, (int)blockIdx.x); \
        pg8::EpiScaleBf16<1> E{HB, DFF, SS}; \
        pg8::gemm_phase<pg8::EpiScaleBf16<1>, pg8::StaticOrder, true, true>(F.lds + RING_OFF, g, S, E); } \
    SEAM(pb + PL_WUP); \
    if (IN(pb + PL_WDN)) { \
        pg8::Gemm g{HB, Wdn_t + (size_t)(l) * DM * DFF, MT, DM, DFF}; pg8::StaticOrder S; S.init(MT, DM, F.G, (int)blockIdx.x); \
        pg8::EpiRes E{XR, XR, ((l) + 1 < DEPTH) ? XG : (bf16_t*)nullptr, INP(1) + (((l) + 1 < DEPTH) ? ((l) + 1) * DM : 0), SS}; \
        pg8::gemm_phase<pg8::EpiRes, pg8::StaticOrder, true, true>(F.lds + RING_OFF, g, S, E); } \
    SEAM(pb + PL_WDN); } while (0)
    LAYER(0);
    LAYER(1);
    if (IN(PH_FINAL)) { const float* gf = INP(27);
        for (int m = gw; m < MT; m += NGW) final_row(XR + (size_t)m * DM, gf, SS, m, XR + (size_t)m * DM, F.lane); }
#undef IN
#undef SEAM
#undef LAYER
}

static int g_grid = 0, g_li = 0;
static void launch_mega(Args a, int lo, int hi, hipStream_t stream) {
    a.ph_lo = lo; a.ph_hi = hi; a.li = (hi - lo > 1) ? g_li++ : 0;
    void* kargs[] = {&a};
    hipLaunchCooperativeKernel((const void*)mega, dim3(g_grid), dim3(NTHREADS), kargs, LDS_BYTES, stream);
}
extern "C" void kernel_launch(void* const* d_in, const int* in_sizes, int n_in, void* d_out, int out_size, void* d_ws, size_t ws_size, hipStream_t stream) {
    if (n_in != 28 || ws_size < WS_END) return;
    if (g_grid == 0) {
        int dev = 0, cus = 0, per_cu = 0;
        hipGetDevice(&dev); hipDeviceGetAttribute(&cus, hipDeviceAttributeMultiprocessorCount, dev);
        hipFuncSetAttribute((const void*)mega, hipFuncAttributeMaxDynamicSharedMemorySize, LDS_BYTES);
        hipOccupancyMaxActiveBlocksPerMultiprocessor(&per_cu, (const void*)mega, NTHREADS, LDS_BYTES);
        (void)hipGetLastError();
        if (per_cu < 1) per_cu = 1;
        if (per_cu > 1) per_cu = 1;
        g_grid = cus * per_cu;
    }
    g_li = 0;
    unsigned char* ws = (unsigned char*)d_ws;
    auto F = [&](int i) { return (const float*)d_in[i]; };
    hipMemsetAsync(ws + WS_CTL, 0, 1 * MiB, stream);
    Args a{};
    for (int i = 0; i < 28; ++i) a.in[i] = (const float*)d_in[i];
    a.out = (float*)d_out; a.ws = ws;
    float* rope = (float*)(ws + WS_ROPE); float* HF = (float*)(ws + WS_HF);
    bf16_t* P = (bf16_t*)(ws + WS_P); bf16_t* YN = (bf16_t*)(ws + WS_YN);
    float* nA = (float*)(ws + NV_A); float* nB = (float*)(ws + NV_B); float* nHS = (float*)(ws + NV_HS); float* nZ = (float*)(ws + NV_Z); float* nX0 = (float*)(ws + NV_X0); float* nYC = (float*)(ws + NV_YC);

    launch_mega(a, 0, NPH, stream);
}
```

```cpp
#include <hip/hip_runtime.h>
#include <stdint.h>
#include <math.h>

typedef unsigned short bf16_t;
typedef short bf16x8 __attribute__((ext_vector_type(8)));
typedef float f32x4 __attribute__((ext_vector_type(4)));

constexpr int NB = 4, SL = 4096, DM = 1024, MT = NB * SL, DEPTH = 2;
constexpr int DA = 384, DBB = 384, DC = 256, HD = 64, NQH = 6, NKVH = 2, DIN = 2176, DINP = 2304, DFF = 4096;
constexpr int P_AX = 0, P_AG = 384, P_Q = 768, P_K = 1152, P_V = 1280, P_CU = 1408;
constexpr int LRU_BLK = 6, LRU_BW = 64, WIN = 128, HY_EMB = 33, HY_W = 64;
constexpr float EPS = 1e-6f;

constexpr size_t MiB = 1u << 20;
constexpr size_t WS_WIN = 0;
constexpr size_t WS_WOUT = 9 * MiB;
constexpr size_t WS_WUP = 13 * MiB;
constexpr size_t WS_WDN = 29 * MiB;
constexpr size_t WS_ROPE = 45 * MiB;
constexpr size_t WS_HF = 46 * MiB;
constexpr size_t WS_XG = 62 * MiB;
constexpr size_t WS_BIG = 94 * MiB;
constexpr size_t WS_H = WS_BIG;
constexpr size_t WS_P = WS_BIG;
constexpr size_t WS_YN = WS_BIG + 72 * MiB;
constexpr size_t WS_SCR = WS_BIG + 104 * MiB;
constexpr size_t WS_CTL = 254 * MiB;
constexpr size_t WS_SS = 255 * MiB;
constexpr size_t WS_END = 256 * MiB;
constexpr size_t NV_A = WS_XG;
constexpr size_t NV_B = WS_SCR;
constexpr size_t NV_HS = WS_SCR + 24 * MiB;
constexpr size_t NV_Z = WS_SCR;
constexpr size_t NV_X0 = WS_SCR + 16 * MiB;
constexpr size_t NV_YC = WS_SCR + 32 * MiB;

__device__ __forceinline__ unsigned f2bf(float f) { unsigned u = __builtin_bit_cast(unsigned, f); return (u + 0x7fffu + ((u >> 16) & 1u)) >> 16; }
__device__ __forceinline__ float bf2f(bf16_t h) { return __builtin_bit_cast(float, (unsigned)h << 16); }
__device__ __forceinline__ float sigmoidf_(float x) { return 1.f / (1.f + expf(-x)); }
__device__ __forceinline__ float gelu_tanh(float x) { const float u = 0.7978845608028654f * (x + 0.044715f * x * x * x); return 0.5f * x * (1.f + tanhf(u)); }

__device__ __forceinline__ float block_sum(float v, float* red) {
    for (int o = 32; o > 0; o >>= 1) v += __shfl_xor(v, o);
    const int w = threadIdx.x >> 6, nw = blockDim.x >> 6;
    __syncthreads();
    if ((threadIdx.x & 63) == 0) red[w] = v;
    __syncthreads();
    float s = 0.f;
    for (int i = 0; i < nw; ++i) s += red[i];
    return s;
}

__global__ void k_rope(float* __restrict__ tab) {
    const int i = blockIdx.x * blockDim.x + threadIdx.x; if (i >= SL * 8) return;
    const int pos = i >> 3, j = i & 7;
    const double inv = pow(500000.0, -(double)j / 8.0), ang = (double)pos * inv;
    tab[pos * 16 + j] = (float)cos(ang); tab[pos * 16 + 8 + j] = (float)sin(ang);
}

__global__ void k_hy_filter(const float* __restrict__ w1, const float* __restrict__ b1, const float* __restrict__ freq, const float* __restrict__ w2,
                            const float* __restrict__ b2, const float* __restrict__ w3, float* __restrict__ HF) {
    __shared__ float z[HY_EMB], h1[HY_W], h2[HY_W];
    const int t = blockIdx.x, tid = threadIdx.x;
    const double PI2 = 6.283185307179586476925286766559;
    const float tt = (float)((double)t / (double)(SL - 1));
    if (tid < HY_EMB) {
        float v;
        if (tid == 0) v = tt;
        else { const int bi = (tid - 1) & 15; const double f = 1e-4 + (double)bi * ((15.0 - 1e-4) / 15.0); const double w = PI2 * (double)t / (double)SL;
               v = (tid <= 16) ? (float)cos(f * w) : (float)(-sin(f * w)); }
        z[tid] = v;
    }
    __syncthreads();
    if (tid < HY_W) { float a = b1[tid]; for (int i = 0; i < HY_EMB; ++i) a += z[i] * w1[i * HY_W + tid]; h1[tid] = sinf(freq[tid] * a); }
    __syncthreads();
    if (tid < HY_W) { float a = b2[tid]; for (int i = 0; i < HY_W; ++i) a += h1[i] * w2[i * HY_W + tid]; h2[tid] = sinf(freq[tid] * a); }
    __syncthreads();
    const double mind = log(1e-2) / 1.5, maxd = log(1e-2) / 0.3;
    for (int o = tid; o < 2 * DC; o += 256) {
        float a = 0.f; for (int i = 0; i < HY_W; ++i) a += h2[i] * w3[i * 2 * DC + o];
        const int c = o & 255, dir = o >> 8;
        const float delta = fabsf((float)(mind + (maxd - mind) * (double)c / 255.0));
        HF[((size_t)dir * SL + t) * DC + c] = a * expf(-tt * delta);
    }
}

__global__ __launch_bounds__(384) void k_lru_ab(const bf16_t* __restrict__ P, const float* __restrict__ cw, const float* __restrict__ cb, const float* __restrict__ wa, const float* __restrict__ ba,
                                               const float* __restrict__ wx, const float* __restrict__ bx, const float* __restrict__ lam, float* __restrict__ Aout, float* __restrict__ Bout, int n) {
    __shared__ float xc[DA];
    const int m = blockIdx.x, t = m % SL, j = threadIdx.x;
    float v = cb[j];
#pragma unroll
    for (int k = 0; k < 4; ++k) { const int tt = t + k - 2; if (tt >= 0 && tt < SL) v += cw[k * DA + j] * bf2f(P[(size_t)(m + k - 2) * DINP + P_AX + j]); }
    xc[j] = v;
    __syncthreads();
    const int blk = j >> 6, jj = j & 63;
    {
        float ra = ba[n * DA + j], ia = bx[n * DA + j];
        const float* wap = wa + ((size_t)(n * LRU_BLK + blk) * 64) * 64 + jj; const float* wxp = wx + ((size_t)(n * LRU_BLK + blk) * 64) * 64 + jj;
        for (int i = 0; i < 64; ++i) { const float xi = xc[blk * 64 + i]; ra += xi * wap[i * 64]; ia += xi * wxp[i * 64]; }
        const float r = sigmoidf_(ra), ig = sigmoidf_(ia);
        const float l = lam[n * DA + j]; const float sp = (-l > 20.f) ? -l : log1pf(expf(-l));
        const float log_a = -8.f * r * sp;
        const float a = expf(log_a), bb = sqrtf(-expm1f(2.f * log_a)) * (ig * v);
        Aout[(size_t)m * DA + j] = a; Bout[(size_t)m * DA + j] = bb;
    }
}
__global__ void k_lru_scan(const float* __restrict__ A, const float* __restrict__ Bv, float* __restrict__ HS, int n) {
    const int id = blockIdx.x * blockDim.x + threadIdx.x; if (id >= NB * DA) return;
    const int ch = id % DA, b = id / DA;
    float h = 0.f;
    for (int s = 0; s < SL; ++s) { const int t = n ? (SL - 1 - s) : s; const size_t o = ((size_t)b * SL + t) * DA + ch; h = A[o] * h + Bv[o]; HS[o] = n ? (HS[o] + h) : h; }
}
__global__ __launch_bounds__(384) void k_lru_out(const bf16_t* __restrict__ P, const float* __restrict__ HS, const float* __restrict__ gn, bf16_t* __restrict__ YN) {
    __shared__ float red[8];
    const int m = blockIdx.x, j = threadIdx.x;
    const float h = HS[(size_t)m * DA + j];
    const float y = h * gelu_tanh(bf2f(P[(size_t)m * DINP + P_AG + j]));
    const float ss = block_sum(y * y, red);
    const float r = 1.f / sqrtf(ss * (1.f / DA) + EPS);
    YN[(size_t)m * DM + j] = (bf16_t)f2bf(y * r * gn[j]);
}

__global__ __launch_bounds__(384) void k_attn(const bf16_t* __restrict__ P, const float* __restrict__ rope, const float* __restrict__ sink, const float* __restrict__ gn, bf16_t* __restrict__ YN) {
    __shared__ float qs[NQH][HD], ps[NQH][320], red[8];
    const int m = blockIdx.x, t = m % SL, w = threadIdx.x >> 6, lane = threadIdx.x & 63, kvh = w / 3;
    const float* rt = rope + t * 16;
    const bf16_t* qp = P + (size_t)m * DINP + P_Q + w * HD;
    {   float q = bf2f(qp[lane]);
        if (lane < 8) q = q * rt[lane] - bf2f(qp[lane + 8]) * rt[8 + lane];
        else if (lane < 16) q = q * rt[lane - 8] + bf2f(qp[lane - 8]) * rt[lane];
        qs[w][lane] = q; }
    __syncthreads();
    float sv[5]; float mx = sink[w];
#pragma unroll
    for (int pss = 0; pss < 5; ++pss) {
        const int jrel = pss * 64 + lane, jt = t - WIN + jrel; float s = -1e30f;
        if (jrel <= 2 * WIN && jt >= 0 && jt < SL) {
            const bf16_t* kp = P + (size_t)(m - WIN + jrel) * DINP + P_K + kvh * HD; const float* rk = rope + jt * 16;
            float acc = 0.f;
            for (int d = 0; d < 8; ++d) { const float k1 = bf2f(kp[d]), k2 = bf2f(kp[d + 8]); acc += qs[w][d] * (k1 * rk[d] - k2 * rk[8 + d]) + qs[w][d + 8] * (k2 * rk[d] + k1 * rk[8 + d]); }
            for (int d = 16; d < HD; ++d) acc += qs[w][d] * bf2f(kp[d]);
            s = acc * 0.125f;
        }
        sv[pss] = s; mx = fmaxf(mx, s);
    }
    for (int o = 32; o > 0; o >>= 1) mx = fmaxf(mx, __shfl_xor(mx, o));
    float den = 0.f;
#pragma unroll
    for (int pss = 0; pss < 5; ++pss) { const float p = (sv[pss] > -1e29f) ? expf(sv[pss] - mx) : 0.f; ps[w][pss * 64 + lane] = p; den += p; }
    for (int o = 32; o > 0; o >>= 1) den += __shfl_xor(den, o);
    den += expf(sink[w] - mx);
    __syncthreads();
    float o = 0.f;
    for (int jrel = 0; jrel <= 2 * WIN; ++jrel) { const int jt = t - WIN + jrel; if (jt < 0 || jt >= SL) continue; o += ps[w][jrel] * bf2f(P[(size_t)(m - WIN + jrel) * DINP + P_V + kvh * HD + lane]); }
    o /= den;
    const float ss = block_sum(o * o, red);
    const float r = 1.f / sqrtf(ss * (1.f / DBB) + EPS);
    YN[(size_t)m * DM + DA + w * HD + lane] = (bf16_t)f2bf(o * r * gn[w * HD + lane]);
}

__global__ __launch_bounds__(384) void k_attn_norm(const bf16_t* __restrict__ AO, const float* __restrict__ gn, bf16_t* __restrict__ YN) {
    __shared__ float red[8];
    const int m = blockIdx.x, j = threadIdx.x; const float o = bf2f(AO[(size_t)m * DBB + j]);
    const float ss = block_sum(o * o, red); const float r = 1.f / sqrtf(ss * (1.f / DBB) + EPS);
    YN[(size_t)m * DM + DA + j] = (bf16_t)f2bf(o * r * gn[j]);
}
__global__ __launch_bounds__(256) void k_hy_prep(const bf16_t* __restrict__ P, const float* __restrict__ cw, const float* __restrict__ cb, float* __restrict__ Z, float* __restrict__ X0) {
    const int m = blockIdx.x, t = m % SL, c = threadIdx.x;
    float u[3];
#pragma unroll
    for (int part = 0; part < 3; ++part) { const int ch = part * DC + c; float v = cb[ch];
#pragma unroll
        for (int k = 0; k < 3; ++k) { const int tt = t + k - 1; if (tt >= 0 && tt < SL) v += cw[k * 3 * DC + ch] * bf2f(P[(size_t)(m + k - 1) * DINP + P_CU + ch]); }
        u[part] = v; }
    Z[(size_t)m * DC + c] = u[2] * u[1]; X0[(size_t)m * DC + c] = u[0];
}
__global__ __launch_bounds__(256) void k_hy_conv(const float* __restrict__ Z, const float* __restrict__ X0, const float* __restrict__ HF, const float* __restrict__ bias, float* __restrict__ YC) {
    const int m = blockIdx.x, b = m / SL, t = m % SL, c = threadIdx.x;
    const float* zb = Z + (size_t)b * SL * DC + c; const float* hf = HF + c; const float* hb = HF + (size_t)SL * DC + c;
    float y = 0.f;
    for (int s = 0; s <= t; ++s) y += hf[(size_t)(t - s) * DC] * zb[(size_t)s * DC];
    for (int s = t + 1; s < SL; ++s) y += hb[(size_t)(s - t) * DC] * zb[(size_t)s * DC];
    YC[(size_t)m * DC + c] = (y + zb[(size_t)t * DC] * bias[c]) * X0[(size_t)m * DC + c];
}
__global__ __launch_bounds__(256) void k_hy_norm(const bf16_t* __restrict__ YCT, const float* __restrict__ gn, bf16_t* __restrict__ YN) {
    __shared__ float red[8];
    const int m = blockIdx.x, c = threadIdx.x; const float y = bf2f(YCT[((size_t)(m / SL) * DC + c) * SL + (m % SL)]);
    const float ss = block_sum(y * y, red); const float r = 1.f / sqrtf(ss * (1.f / DC) + EPS);
    YN[(size_t)m * DM + DA + DBB + c] = (bf16_t)f2bf(y * r * gn[c]);
}

namespace pg8 {
#define PG8_LAS __attribute__((address_space(3)))
typedef unsigned short bf16_t;
typedef short bf16x8 __attribute__((ext_vector_type(8)));
typedef float f32x4 __attribute__((ext_vector_type(4)));
typedef unsigned u32x4 __attribute__((ext_vector_type(4)));
constexpr int BM = 256, BK = 64, HALF = 128, HTB = HALF * BK * 2  , STAGE_BYTES = 8 * HTB, NXCD = 8, WGM = 8;

__host__ __device__ __forceinline__ int lds_byte(int r, int c) { const int st = (r >> 4) * 2 + (c >> 5), rr = r & 15, cc = c & 31, ob = rr * 64 + cc * 2; return st * 1024 + (ob ^ (((ob >> 9) & 1) << 5)); }
__host__ __device__ __forceinline__ void stage_rc(int b, int& R, int& C) { const int st = b / 1024, sb = b % 1024, swz = sb ^ (((sb >> 9) & 1) << 5); R = (st >> 1) * 16 + swz / 64; C = (st & 1) * 32 + (swz % 64) / 2; }
__host__ __device__ __forceinline__ int perm32(int rho) { const int n = rho >> 4, i = rho & 15; return 8 * (i >> 2) + 4 * n + (i & 3); }

struct Unit { int pm, pn; };
struct Gemm { const bf16_t* A; const bf16_t* Bt; int M, N, K; };

struct StaticOrder {
    int nM, nN, nwg, G, c;
    __host__ __device__ void init(int M, int N, int G_, int c_) { nM = M / BM; nN = N / BM; nwg = nM * nN; G = G_; c = c_; }
    __host__ __device__ bool next(int i, Unit& u) const {
        const long L = (long)i * G + c; if (L >= nwg) return false;
        int wgid = (int)L; { const int q = nwg / NXCD, r = nwg % NXCD, xcd = wgid % NXCD, off = wgid / NXCD; wgid = (xcd < r ? xcd * (q + 1) : r * (q + 1) + (xcd - r) * q) + off; }
        const int nig = WGM * nN, gid = wgid / nig, fm = gid * WGM, gsz = (nM - fm) < WGM ? (nM - fm) : WGM;
        u.pm = fm + ((wgid % nig) % gsz); u.pn = (wgid % nig) / gsz; return true;
    }
    __device__ __forceinline__ void a_ready(const Unit&) const {}
    __device__ __forceinline__ void done(const Unit&) const {}
};

__device__ __forceinline__ unsigned cvt_pk_bf16(float lo, float hi) { unsigned r; asm volatile("v_cvt_pk_bf16_f32 %0, %1, %2" : "=v"(r) : "v"(lo), "v"(hi)); return r; }

constexpr int E_DM = 1024, E_DINP = 2304, E_DFF = 4096; constexpr float E_EPS = 1e-6f;
__device__ __forceinline__ float rstd16(const float* SS, int row) {
    const f32x4* p = (const f32x4*)(SS + (size_t)row * 16); const f32x4 a = (p[0] + p[1]) + (p[2] + p[3]);
    return 1.0f / sqrtf(((a[0] + a[1]) + (a[2] + a[3])) * (1.0f / E_DM) + E_EPS);
}
template <int ACT> struct EpiScaleBf16 {
    static constexpr bool PERM = true, AFTER_DRAIN = false;
    bf16_t* O; int ldc; const float* SS;
    __device__ __forceinline__ void operator()(const f32x4 (&acc)[2][2][4][2], const Unit& u, int wr, int wc, int fr, int fq) const {
        const int row0 = u.pm * BM + wr * 64 + fr, col0 = u.pn * BM + wc * 32 + 8 * fq;
#pragma unroll
        for (int ai = 0; ai < 2; ++ai)
#pragma unroll
            for (int m = 0; m < 4; ++m) { const int row = row0 + ai * HALF + m * 16; const float r = rstd16(SS, row); bf16_t* rowp = O + (size_t)row * ldc + col0;
#pragma unroll
                for (int bj = 0; bj < 2; ++bj) { f32x4 v0 = acc[ai][bj][m][0] * r, v1 = acc[ai][bj][m][1] * r;
                    if (ACT == 1) {
#pragma unroll
                        for (int i = 0; i < 4; ++i) { const float a = fmaxf(v0[i], 0.f), b = fmaxf(v1[i], 0.f); v0[i] = a * a; v1[i] = b * b; } }
                    u32x4 w; w.x = cvt_pk_bf16(v0[0], v0[1]); w.y = cvt_pk_bf16(v0[2], v0[3]); w.z = cvt_pk_bf16(v1[0], v1[1]); w.w = cvt_pk_bf16(v1[2], v1[3]);
                    *(u32x4*)(rowp + bj * HALF) = w; } }
    }
};
struct EpiRes {
    static constexpr bool PERM = false, AFTER_DRAIN = false;
    const float* base; float* out; bf16_t* XG; const float* g; float* SS;
    __device__ __forceinline__ void operator()(const f32x4 (&acc)[2][2][4][2], const Unit& u, int wr, int wc, int fr, int fq) const {
        typedef unsigned u32x2v __attribute__((ext_vector_type(2)));
        const int row0 = u.pm * BM + wr * 64 + fr, col0 = u.pn * BM + wc * 32 + 4 * fq;
        f32x4 gv[2][2];
#pragma unroll
        for (int bj = 0; bj < 2; ++bj)
#pragma unroll
            for (int n = 0; n < 2; ++n) gv[bj][n] = XG ? *(const f32x4*)(g + col0 + bj * HALF + n * 16) : (f32x4){0.f, 0.f, 0.f, 0.f};
#pragma unroll
        for (int ai = 0; ai < 2; ++ai)
#pragma unroll
            for (int m = 0; m < 4; ++m) { const int row = row0 + ai * HALF + m * 16; const size_t off = (size_t)row * E_DM + col0; float s = 0.f;
#pragma unroll
                for (int bj = 0; bj < 2; ++bj)
#pragma unroll
                    for (int n = 0; n < 2; ++n) { const f32x4 b = *(const f32x4*)(base + off + bj * HALF + n * 16); const f32x4 v = b + acc[ai][bj][m][n];
                        *(f32x4*)(out + off + bj * HALF + n * 16) = v; s += (v[0] * v[0] + v[1] * v[1]) + (v[2] * v[2] + v[3] * v[3]);
                        if (XG) { const f32x4 x = v * gv[bj][n]; u32x2v w; w.x = cvt_pk_bf16(x[0], x[1]); w.y = cvt_pk_bf16(x[2], x[3]); *(u32x2v*)(XG + off + bj * HALF + n * 16) = w; } }
                s += __shfl_xor(s, 16); s += __shfl_xor(s, 32);
                if (fq == 0) SS[(size_t)row * 16 + u.pn * 4 + wc] = s;
                if (m & 1) asm volatile("" ::: "memory"); }
    }
};

template <class Epi, class Sched, bool ALIGN_EPI = false, bool SP2 = false>
__device__ __forceinline__ void gemm_phase(PG8_LAS unsigned char* lds, const Gemm g, const Sched& S, const Epi& E) {
    const int tid = threadIdx.x, wid = __builtin_amdgcn_readfirstlane(tid >> 6), lane = tid & 63, wr = wid >> 2, wc = wid & 3, fr = lane & 15, fq = lane >> 4;
    const int K = g.K, nt = K / BK;
    unsigned voffA[2], voffB[2];
#pragma unroll
    for (int i = 0; i < 2; ++i) { int R, C; stage_rc(tid * 16 + i * 8192, R, C); const int Rb = Epi::PERM ? ((R & ~31) + perm32(R & 31)) : R;
        voffA[i] = (unsigned)(R * K + C) * 2u; voffB[i] = (unsigned)(Rb * K + C) * 2u; }
    const size_t kstep = (size_t)(BK * 2);
    const size_t hstep = (size_t)HALF * K * 2;
    const size_t tstep = 2 * hstep;
    const unsigned ldsw = (unsigned)wid * 1024u;
    const int aoff = lds_byte(wr * 64 + fr, fq * 8), boff = lds_byte(wc * 32 + fr, fq * 8);
#define PG8_SA(b, h) (((b) * 2 + (h)) * HTB)
#define PG8_SB(b, h) ((4 + (b) * 2 + (h)) * HTB)
#define PG8_STAGE(bufoff, gbase, voff) do { _Pragma("unroll") for (int _i = 0; _i < 2; ++_i) \
        __builtin_amdgcn_global_load_lds((const unsigned*)((const char*)(gbase) + (voff)[_i]), (PG8_LAS unsigned*)(lds + (bufoff) + ldsw + _i * 8192), 16, 0, 0); } while (0)
#define PG8_LDA(dst, b, h) do { _Pragma("unroll") for (int m = 0; m < 4; ++m) _Pragma("unroll") for (int k = 0; k < 2; ++k) dst[m][k] = *(const PG8_LAS bf16x8*)(lds + PG8_SA(b, h) + aoff + m * 2048 + k * 1024); } while (0)
#define PG8_LDB(dst, b, h) do { _Pragma("unroll") for (int n = 0; n < 2; ++n) _Pragma("unroll") for (int k = 0; k < 2; ++k) dst[n][k] = *(const PG8_LAS bf16x8*)(lds + PG8_SB(b, h) + boff + n * 2048 + k * 1024); } while (0)
#define PG8_MMA(ai, bj, At, Bt) do { __builtin_amdgcn_s_setprio(1); _Pragma("unroll") for (int m = 0; m < 4; ++m) _Pragma("unroll") for (int n = 0; n < 2; ++n) _Pragma("unroll") for (int k = 0; k < 2; ++k) \
        acc[ai][bj][m][n] = __builtin_amdgcn_mfma_f32_16x16x32_bf16(Bt[n][k], At[m][k], acc[ai][bj][m][n], 0, 0, 0); __builtin_amdgcn_s_setprio(0); } while (0)
#define PG8_WAIT_V(n) asm volatile("s_waitcnt vmcnt(" #n ")" ::: "memory")
#define PG8_WAIT_L(n) asm volatile("s_waitcnt lgkmcnt(" #n ")" ::: "memory")
#define PG8_BAR __builtin_amdgcn_s_barrier()
#define PG8_SCHED __builtin_amdgcn_sched_barrier(0)
    Unit cur, nxt; int ui = 0;
    if (!S.next(0, cur)) return;
    f32x4 acc[2][2][4][2];
#pragma unroll
    for (int a = 0; a < 2; ++a)
#pragma unroll
        for (int b = 0; b < 2; ++b)
#pragma unroll
            for (int m = 0; m < 4; ++m)
#pragma unroll
                for (int n = 0; n < 2; ++n) acc[a][b][m][n] = (f32x4){0.f, 0.f, 0.f, 0.f};
    bf16x8 At[4][2], B0[2][2], B1[2][2];
    const char* cA = (const char*)g.A + (size_t)cur.pm * tstep; const char* cB = (const char*)g.Bt + (size_t)cur.pn * tstep;
    S.a_ready(cur);
    if constexpr (SP2) {
        PG8_STAGE(PG8_SB(0, 0), cB, voffB); PG8_STAGE(PG8_SB(0, 1), cB + hstep, voffB); PG8_STAGE(PG8_SA(0, 0), cA, voffA); PG8_STAGE(PG8_SA(0, 1), cA + hstep, voffA);
        if (wr == 1) PG8_BAR;
        PG8_WAIT_V(2); PG8_BAR;
        PG8_STAGE(PG8_SB(1, 0), cB + kstep, voffB); PG8_STAGE(PG8_SA(1, 0), cA + kstep, voffA); PG8_STAGE(PG8_SB(1, 1), cB + hstep + kstep, voffB);
        PG8_WAIT_V(6); PG8_BAR;
    } else {
        PG8_STAGE(PG8_SB(0, 0), cB, voffB); PG8_STAGE(PG8_SA(0, 0), cA, voffA); PG8_STAGE(PG8_SB(0, 1), cB + hstep, voffB); PG8_STAGE(PG8_SA(0, 1), cA + hstep, voffA);
        if (wr == 1) PG8_BAR;
        PG8_WAIT_V(4); PG8_BAR;
        PG8_STAGE(PG8_SB(1, 0), cB + kstep, voffB); PG8_STAGE(PG8_SA(1, 0), cA + kstep, voffA); PG8_STAGE(PG8_SB(1, 1), cB + hstep + kstep, voffB);
        PG8_WAIT_V(6); PG8_BAR;
    }
    for (;;) {
        const bool has_next = S.next(ui + 1, nxt);
        const char* nA = has_next ? (const char*)g.A + (size_t)nxt.pm * tstep : cA; const char* nB = has_next ? (const char*)g.Bt + (size_t)nxt.pn * tstep : cB;
        for (int t = 0; t < nt; t += 2) {
            const bool last = (t == nt - 2);
            const char* a1 = cA + (size_t)(t + 1) * kstep;
            const char* a2 = last ? nA : cA + (size_t)(t + 2) * kstep; const char* b2 = last ? nB : cB + (size_t)(t + 2) * kstep;
            const char* a3 = a2 + kstep; const char* b3 = b2 + kstep;
            if (last && has_next) S.a_ready(nxt);
            if constexpr (SP2) {
            PG8_LDB(B0, 0, 0); PG8_LDB(B1, 0, 1); PG8_SCHED; PG8_LDA(At, 0, 0); PG8_STAGE(PG8_SA(1, 1), a1 + hstep, voffA);
            PG8_WAIT_V(8); PG8_WAIT_L(0); PG8_BAR; PG8_MMA(0, 0, At, B0); PG8_MMA(0, 1, At, B1); PG8_BAR; PG8_SCHED;
            PG8_LDA(At, 0, 1); PG8_STAGE(PG8_SB(0, 0), b2, voffB); PG8_STAGE(PG8_SB(0, 1), b2 + hstep, voffB); PG8_STAGE(PG8_SA(0, 0), a2, voffA);
            PG8_WAIT_V(8); PG8_WAIT_L(0); PG8_BAR; PG8_MMA(1, 0, At, B0); PG8_MMA(1, 1, At, B1); PG8_BAR; PG8_SCHED;
            PG8_LDB(B0, 1, 0); PG8_LDB(B1, 1, 1); PG8_SCHED; PG8_LDA(At, 1, 0); PG8_STAGE(PG8_SA(0, 1), a2 + hstep, voffA);
            PG8_WAIT_V(8); PG8_WAIT_L(0); PG8_BAR; PG8_MMA(0, 0, At, B0); PG8_MMA(0, 1, At, B1); PG8_BAR; PG8_SCHED;
            PG8_LDA(At, 1, 1); PG8_STAGE(PG8_SB(1, 0), b3, voffB); PG8_STAGE(PG8_SB(1, 1), b3 + hstep, voffB); PG8_STAGE(PG8_SA(1, 0), a3, voffA);
            PG8_WAIT_V(8); PG8_WAIT_L(0); PG8_BAR; PG8_MMA(1, 0, At, B0); PG8_MMA(1, 1, At, B1); PG8_BAR; PG8_SCHED;
            } else {
            PG8_LDB(B0, 0, 0); PG8_SCHED; PG8_LDA(At, 0, 0); PG8_STAGE(PG8_SA(1, 1), a1 + hstep, voffA);
            PG8_WAIT_L(8); PG8_BAR; PG8_WAIT_L(0); PG8_MMA(0, 0, At, B0); PG8_BAR; PG8_SCHED;
            PG8_LDB(B1, 0, 1); PG8_STAGE(PG8_SB(0, 0), b2, voffB);
            PG8_BAR; PG8_WAIT_L(0); PG8_MMA(0, 1, At, B1); PG8_BAR;
            PG8_LDA(At, 0, 1); PG8_STAGE(PG8_SA(0, 0), a2, voffA);
            PG8_BAR; PG8_WAIT_L(0); PG8_MMA(1, 0, At, B0); PG8_BAR; PG8_SCHED;
            PG8_STAGE(PG8_SB(0, 1), b2 + hstep, voffB);
            PG8_WAIT_V(6); PG8_BAR; PG8_MMA(1, 1, At, B1); PG8_BAR;
            PG8_LDB(B0, 1, 0); PG8_SCHED; PG8_LDA(At, 1, 0); PG8_STAGE(PG8_SA(0, 1), a2 + hstep, voffA);
            PG8_WAIT_L(8); PG8_BAR; PG8_WAIT_L(0); PG8_MMA(0, 0, At, B0); PG8_BAR; PG8_SCHED;
            PG8_LDB(B1, 1, 1); PG8_STAGE(PG8_SB(1, 0), b3, voffB);
            PG8_BAR; PG8_WAIT_L(0); PG8_MMA(0, 1, At, B1); PG8_BAR;
            PG8_LDA(At, 1, 1); PG8_STAGE(PG8_SA(1, 0), a3, voffA);
            PG8_BAR; PG8_WAIT_L(0); PG8_MMA(1, 0, At, B0); PG8_BAR; PG8_SCHED;
            PG8_STAGE(PG8_SB(1, 1), b3 + hstep, voffB);
            PG8_WAIT_V(6); PG8_BAR; PG8_MMA(1, 1, At, B1); PG8_BAR;
            }
        }
        if constexpr (ALIGN_EPI) { if (wr == 0) PG8_BAR; }
        if constexpr (!Epi::AFTER_DRAIN) { E(acc, cur, wr, wc, fr, fq); S.done(cur); }
        if (!has_next) break;
#pragma unroll
        for (int a = 0; a < 2; ++a)
#pragma unroll
            for (int b = 0; b < 2; ++b)
#pragma unroll
                for (int m = 0; m < 4; ++m)
#pragma unroll
                    for (int n = 0; n < 2; ++n) acc[a][b][m][n] = (f32x4){0.f, 0.f, 0.f, 0.f};
        cur = nxt; cA = nA; cB = nB; ++ui;
        if constexpr (ALIGN_EPI) { if (wr == 1) PG8_BAR; }
    }
    PG8_WAIT_V(0);
    if constexpr (!ALIGN_EPI) { if (wr == 0) PG8_BAR; }
    PG8_BAR;
    if constexpr (Epi::AFTER_DRAIN) { E.fused(acc, cur, wr, wc, fr, fq, lds, wid, lane); S.done(cur); }
#undef PG8_SA
#undef PG8_SB
#undef PG8_STAGE
#undef PG8_LDA
#undef PG8_LDB
#undef PG8_MMA
#undef PG8_WAIT_V
#undef PG8_WAIT_L
#undef PG8_BAR
#undef PG8_SCHED
}
}

constexpr int NWAVES = 8, NTHREADS = 512;
constexpr int LDS_BYTES = 163840;
constexpr int RING_OFF = 0, RING_BYTES = 131072;
constexpr int MISC_OFF = LDS_BYTES - 256;
constexpr int PH_PRO = 0, PH_PER_LAYER = 7, PH_FINAL = 1 + PH_PER_LAYER * DEPTH, NPH = PH_FINAL + 1;
constexpr int PL_WIN = 0, PL_MIX1 = 1, PL_FFT = 2, PL_FIN = 3, PL_WOUT = 4, PL_WUP = 5, PL_WDN = 6;
constexpr int CW_BAR = 4096, N_BAR_REG = 12;

#define GAS __attribute__((address_space(1)))
#define LAS __attribute__((address_space(3)))
typedef unsigned v4u __attribute__((ext_vector_type(4)));
typedef GAS unsigned gu32;
#define RLX_AGENT __ATOMIC_RELAXED, __HIP_MEMORY_SCOPE_AGENT
#define LDS_WAIT() asm volatile("s_waitcnt lgkmcnt(0)" ::: "memory")
#define VM_WAIT() asm volatile("s_waitcnt vmcnt(0)" ::: "memory")
__device__ __forceinline__ unsigned pk2(float lo, float hi) { return f2bf(lo) | (f2bf(hi) << 16); }

#define XB_TMO      128
#define XB_XCNT(j)  (256  + 64 * (j))
#define XB_XSUB(j)  (1280 + 64 * (j))
#define XB_XGEN(j)  (2304 + 64 * (j))
#define XB_TOP      3328
#define XB_TOPGEN   3392
#define XCD_BAR_WORDS 3456
#define XB_SPIN_CAP (1u << 18)

__device__ __forceinline__ unsigned xb_ld(unsigned* p)              { return __hip_atomic_load(p, __ATOMIC_RELAXED, __HIP_MEMORY_SCOPE_AGENT); }
__device__ __forceinline__ unsigned xb_add(unsigned* p, unsigned v) { return __hip_atomic_fetch_add(p, v, __ATOMIC_RELAXED, __HIP_MEMORY_SCOPE_AGENT); }
__device__ __forceinline__ unsigned xb_xcc_id() { return (unsigned)__builtin_amdgcn_s_getreg((3 << 11) | 20) & 0xFu; }
#define XB_SPIN(cond, bar) do { unsigned _sp = 0; while (cond) { __builtin_amdgcn_s_sleep(1); \
    if ((++_sp & 255u) == 0u) { if (xb_ld(&(bar)[XB_TMO])) break; if (_sp > XB_SPIN_CAP) { atomicAdd(&(bar)[XB_TMO], 1u); break; } } } } while (0)

struct XcdBarrier {
    unsigned* bar; unsigned x;
    volatile LAS unsigned* st;
};

__device__ __forceinline__ XcdBarrier xcd_barrier_post(unsigned* bar, volatile LAS unsigned* st) {
    XcdBarrier b; b.bar = bar; b.x = xb_xcc_id(); b.st = st;
    if (threadIdx.x == 0) (void)xb_add(&bar[XB_XCNT(b.x)], 1u);
    return b;
}
__device__ __forceinline__ void xcd_barrier_complete(unsigned* bar, unsigned x, unsigned& nloc, unsigned& nx) {
    const unsigned G = gridDim.x * gridDim.y * gridDim.z;
    unsigned sum, cnt, mine, sp = 0u;
    for (;;) {
        sum = 0u; cnt = 0u; mine = 0u;
#pragma unroll
        for (unsigned j = 0; j < 16; ++j) { const unsigned c = xb_ld(&bar[XB_XCNT(j)]); sum += c; cnt += (c > 0u) ? 1u : 0u; mine = (j == x) ? c : mine; }
        if (sum == G) break;
        __builtin_amdgcn_s_sleep(1);
        if ((++sp & 255u) == 0u) { if (xb_ld(&bar[XB_TMO])) break; if (sp > XB_SPIN_CAP) { atomicAdd(&bar[XB_TMO], 1u); break; } }
    }
    nloc = mine > 0u ? mine : 1u; nx = cnt > 0u ? cnt : 1u;
}

__device__ __forceinline__ void xcd_barrier(const XcdBarrier& b) {
    asm volatile("s_waitcnt vmcnt(0)" ::: "memory");
    __syncthreads();
    if (threadIdx.x == 0) {
        unsigned* bar = b.bar;
        __builtin_amdgcn_s_waitcnt(0);
        unsigned nloc = b.st[0], nx = b.st[1];
        if (nloc == 0u) { xcd_barrier_complete(bar, b.x, nloc, nx); b.st[0] = nloc; b.st[1] = nx; }
        const unsigned old = xb_add(&bar[XB_XSUB(b.x)], 1u);
        const unsigned gen = old / nloc;
        if (old + 1u == (gen + 1u) * nloc) {
            __builtin_amdgcn_fence(__ATOMIC_RELEASE, "agent");
            asm volatile("s_waitcnt vmcnt(0)" ::: "memory");
            const unsigned og = xb_add(&bar[XB_TOP], 1u);
            const unsigned tg = og / nx;
            if (og + 1u == (tg + 1u) * nx) xb_add(&bar[XB_TOPGEN], 1u);
            else XB_SPIN(xb_ld(&bar[XB_TOPGEN]) == tg, bar);
            __builtin_amdgcn_fence(__ATOMIC_ACQUIRE, "agent");
            xb_add(&bar[XB_XGEN(b.x)], 1u);
            asm volatile("s_waitcnt vmcnt(0)" ::: "memory");
        } else {
            XB_SPIN(xb_ld(&bar[XB_XGEN(b.x)]) == gen, bar);
            __builtin_amdgcn_fence(__ATOMIC_ACQUIRE, "agent");
            asm volatile("s_waitcnt vmcnt(0)" ::: "memory");
        }
    }
    __syncthreads();
}

constexpr size_t WS_ZT = WS_SCR, WS_X0T = WS_SCR + 8 * MiB, WS_YCT = WS_SCR + 16 * MiB;
constexpr size_t WS_TW = WS_ROPE + 256 * 1024;
namespace hy {
typedef float cf __attribute__((ext_vector_type(2)));
__device__ __forceinline__ cf cmul(cf a, cf b) { return {a.x * b.x - a.y * b.y, a.x * b.y + a.y * b.x}; }
__device__ __forceinline__ cf cmulc(cf a, cf b) { return {a.x * b.x + a.y * b.y, a.y * b.x - a.x * b.y}; }
__device__ __forceinline__ cf cadd(cf a, cf b) { return {a.x + b.x, a.y + b.y}; }
__device__ __forceinline__ cf csub(cf a, cf b) { return {a.x - b.x, a.y - b.y}; }
__device__ __forceinline__ int pidx(int i) { return i + (i >> 5); }
constexpr int FBUF = 8192 + 256;
template <bool INV> __device__ __forceinline__ cf tw16(cf d, int K) {
    float c, s;
    switch (K) {
        case 0: return d;
        case 4: return INV ? cf{-d.y, d.x} : cf{d.y, -d.x};
        case 1: c = 0.92387953251128674f; s = 0.38268343236508977f; break;
        case 2: c = 0.70710678118654752f; s = 0.70710678118654752f; break;
        case 3: c = 0.38268343236508977f; s = 0.92387953251128674f; break;
        case 5: c = -0.38268343236508977f; s = 0.92387953251128674f; break;
        case 6: c = -0.70710678118654752f; s = 0.70710678118654752f; break;
        default: c = -0.92387953251128674f; s = 0.38268343236508977f; break;
    }
    const cf w = {c, INV ? s : -s};
    return cmul(d, w);
}
template <int H, bool INV> __device__ __forceinline__ void stage16(cf (&v)[16]) {
#pragma unroll
    for (int blk = 0; blk < 16; blk += 2 * H)
#pragma unroll
        for (int j = 0; j < H; ++j) {
            if (!INV) { const cf a = v[blk + j], b = v[blk + j + H]; v[blk + j] = cadd(a, b); v[blk + j + H] = tw16<false>(csub(a, b), j * (8 / H)); }
            else { const cf A = v[blk + j], B = tw16<true>(v[blk + j + H], j * (8 / H)); v[blk + j] = cadd(A, B); v[blk + j + H] = csub(A, B); }
        }
}
template <bool INV> __device__ __forceinline__ void dft16(cf (&v)[16]) {
    if (!INV) { stage16<8, false>(v); stage16<4, false>(v); stage16<2, false>(v); stage16<1, false>(v); }
    else { stage16<1, true>(v); stage16<2, true>(v); stage16<4, true>(v); stage16<8, true>(v); }
}
__device__ __forceinline__ constexpr int br4(int r) { return ((r & 1) << 3) | ((r & 2) << 1) | ((r & 4) >> 1) | ((r & 8) >> 3); }
template <bool INV, int LSL> __device__ __forceinline__ void pass16(LAS cf* buf, int tid, const cf* __restrict__ TW) {
    constexpr int SH = LSL - 4, st = 1 << SH;
    asm volatile("" : "+v"(tid));
    const int sub = tid >> SH, n2 = tid & (st - 1), base = (sub << LSL) + n2;
    cf v[16];
#pragma unroll
    for (int r = 0; r < 16; ++r) v[r] = buf[pidx(base + r * st)];
    cf wp[16];
    wp[1] = TW[n2 << (13 - LSL)];
    asm volatile("" : "+v"(wp[1].x), "+v"(wp[1].y));
    wp[2] = cmul(wp[1], wp[1]); wp[4] = cmul(wp[2], wp[2]); wp[8] = cmul(wp[4], wp[4]);
    wp[3] = cmul(wp[2], wp[1]); wp[5] = cmul(wp[4], wp[1]); wp[6] = cmul(wp[4], wp[2]); wp[7] = cmul(wp[4], wp[3]);
    wp[9] = cmul(wp[8], wp[1]); wp[10] = cmul(wp[8], wp[2]); wp[11] = cmul(wp[8], wp[3]); wp[12] = cmul(wp[8], wp[4]);
    wp[13] = cmul(wp[8], wp[5]); wp[14] = cmul(wp[8], wp[6]); wp[15] = cmul(wp[8], wp[7]);
    if (!INV) {
        dft16<false>(v);
#pragma unroll
        for (int r = 1; r < 16; ++r) v[r] = cmul(v[r], wp[br4(r)]);
    } else {
#pragma unroll
        for (int r = 1; r < 16; ++r) v[r] = cmulc(v[r], wp[br4(r)]);
        dft16<true>(v);
    }
#pragma unroll
    for (int r = 0; r < 16; ++r) buf[pidx(base + r * st)] = v[r];
}
template <bool MUL> __device__ __forceinline__ void mid2(LAS cf* D, const LAS cf* Hs, int tid) {
    asm volatile("" : "+v"(tid));
#pragma unroll
    for (int e = 0; e < 8; ++e) { const int i = 16 * tid + 2 * e; const cf a = D[pidx(i)], b = D[pidx(i + 1)]; cf A = cadd(a, b), B = csub(a, b);
        if (MUL) { A = cmul(A, Hs[pidx(i)]); B = cmul(B, Hs[pidx(i + 1)]); D[pidx(i)] = cadd(A, B); D[pidx(i + 1)] = csub(A, B); }
        else { D[pidx(i)] = A; D[pidx(i + 1)] = B; } }
}
#define HY_SYNC() __syncthreads()
__device__ __forceinline__ void fft_unit(LAS unsigned char* lds, int c, int tid, const float* __restrict__ HFT_l, const cf* __restrict__ TW, const bf16_t* __restrict__ ZT, const bf16_t* __restrict__ X0T,
                                         bf16_t* __restrict__ YCT, float bias) {
    asm volatile("" : "+v"(tid));
    LAS cf* D = (LAS cf*)lds; LAS cf* Hs = D + FBUF;
    const float* hsrc = HFT_l + (size_t)c * 8192;
#pragma unroll
    for (int k = 0; k < 16; ++k) { const int i = k * 512 + tid; Hs[pidx(i)] = cf{hsrc[i], 0.f}; }
    HY_SYNC();
    pass16<false, 13>(Hs, tid, TW); HY_SYNC();
    pass16<false, 9>(Hs, tid, TW); HY_SYNC();
    pass16<false, 5>(Hs, tid, TW); HY_SYNC();
    mid2<false>(Hs, Hs, tid); HY_SYNC();
    for (int pr = 0; pr < 2; ++pr) {
        const size_t o0 = ((size_t)(2 * pr) * DC + c) * SL, o1 = ((size_t)(2 * pr + 1) * DC + c) * SL;
#pragma unroll
        for (int k = 0; k < 8; ++k) { const int i = k * 512 + tid; D[pidx(i)] = cf{bf2f(ZT[o0 + i]), bf2f(ZT[o1 + i])}; D[pidx(i + 4096)] = cf{0.f, 0.f}; }
        HY_SYNC();
        pass16<false, 13>(D, tid, TW); HY_SYNC();
        pass16<false, 9>(D, tid, TW); HY_SYNC();
        pass16<false, 5>(D, tid, TW); HY_SYNC();
        mid2<true>(D, Hs, tid); HY_SYNC();
        pass16<true, 5>(D, tid, TW); HY_SYNC();
        pass16<true, 9>(D, tid, TW); HY_SYNC();
        pass16<true, 13>(D, tid, TW); HY_SYNC();
#pragma unroll
        for (int k = 0; k < 8; ++k) { const int i = k * 512 + tid; const cf y = D[pidx(i)];
            const float z0 = bf2f(ZT[o0 + i]), z1 = bf2f(ZT[o1 + i]), a0 = bf2f(X0T[o0 + i]), a1 = bf2f(X0T[o1 + i]);
            YCT[o0 + i] = (bf16_t)f2bf((y.x * (1.f / 8192.f) + z0 * bias) * a0); YCT[o1 + i] = (bf16_t)f2bf((y.y * (1.f / 8192.f) + z1 * bias) * a1); }
        HY_SYNC();
    }
}
constexpr int HP_ROWB = 1540;
__device__ __forceinline__ void hyprep_unit(LAS unsigned char* lds, int unit, int tid, const bf16_t* __restrict__ P, const float* __restrict__ cw, const float* __restrict__ cb,
                                            bf16_t* __restrict__ ZT, bf16_t* __restrict__ X0T) {
    asm volatile("" : "+v"(tid));
    const int b = unit >> 6, t0 = (unit & 63) * 64; const size_t m0 = (size_t)b * SL + t0;
    for (int i = tid; i < 66 * 96; i += NTHREADS) { const int r = i / 96, ch8 = i % 96; const int t = t0 - 1 + r;
        uint4 v = make_uint4(0u, 0u, 0u, 0u);
        if (t >= 0 && t < SL) v = *(const uint4*)(P + (m0 + r - 1) * DINP + P_CU + ch8 * 8);
        LAS unsigned* d = (LAS unsigned*)(lds + r * HP_ROWB + ch8 * 16); d[0] = v.x; d[1] = v.y; d[2] = v.z; d[3] = v.w; }
    __syncthreads();
    const int tok = tid & 63, wv = tid >> 6;
    for (int j = 0; j < 32; ++j) { const int c = wv * 32 + j; float u[3];
#pragma unroll
        for (int part = 0; part < 3; ++part) { const int ch = part * DC + c; float a = cb[ch];
#pragma unroll
            for (int k = 0; k < 3; ++k) a += cw[k * 3 * DC + ch] * bf2f(*(const LAS bf16_t*)(lds + (tok + k) * HP_ROWB + ch * 2));
            u[part] = a; }
        const size_t o = ((size_t)b * DC + c) * SL + t0 + tok;
        ZT[o] = (bf16_t)f2bf(u[2] * u[1]); X0T[o] = (bf16_t)f2bf(u[0]); }
    __syncthreads();
}
__device__ __forceinline__ void filter_unit(LAS unsigned char* lds, int tb, int tid, const float* __restrict__ w1, const float* __restrict__ b1, const float* __restrict__ freq,
                                            const float* __restrict__ w2, const float* __restrict__ b2, const float* __restrict__ w3, float* __restrict__ HFT_l) {
    asm volatile("" : "+v"(tid));
    LAS float* Z = (LAS float*)lds;
    LAS float* H1T = Z + 32 * 36;
    LAS float* H2T = H1T + 64 * 32;
    const int t0 = tb * 32;
    __syncthreads();
    {   const int pos = tid >> 4, f = tid & 15, t = t0 + pos;
        const double fb = 1e-4 + (double)f * ((15.0 - 1e-4) / 15.0), w = 6.283185307179586476925286766559 * (double)t / (double)SL;
        Z[pos * 36 + 1 + f] = (float)cos(fb * w); Z[pos * 36 + 17 + f] = (float)(-sin(fb * w));
        if (f == 0) Z[pos * 36] = (float)((double)t / (double)(SL - 1)); }
    __syncthreads();
    {   const int j = tid & 63; const float fj = freq[j], bj = b1[j];
#pragma unroll
        for (int q = 0; q < 4; ++q) { const int pos = (tid >> 6) + 8 * q; float a = bj;
            for (int i = 0; i < HY_EMB; ++i) a += Z[pos * 36 + i] * w1[i * HY_W + j];
            H1T[j * 32 + pos] = sinf(fj * a); } }
    __syncthreads();
    {   const int j = tid & 63; const float fj = freq[j], bj = b2[j];
#pragma unroll
        for (int q = 0; q < 4; ++q) { const int pos = (tid >> 6) + 8 * q; float a = bj;
            for (int i = 0; i < HY_W; ++i) a += H1T[i * 32 + pos] * w2[i * HY_W + j];
            H2T[j * 32 + pos] = sinf(fj * a); } }
    __syncthreads();
    {   const int o = tid, c = o & 255, dir = o >> 8;
        float acc[32];
#pragma unroll
        for (int p = 0; p < 32; ++p) acc[p] = 0.f;
        for (int i = 0; i < HY_W; ++i) { const float w = w3[i * 2 * DC + o];
#pragma unroll
            for (int p4 = 0; p4 < 8; ++p4) { const f32x4 h = *(const LAS f32x4*)(H2T + i * 32 + p4 * 4);
                acc[4 * p4] += h[0] * w; acc[4 * p4 + 1] += h[1] * w; acc[4 * p4 + 2] += h[2] * w; acc[4 * p4 + 3] += h[3] * w; } }
        const double mind = log(1e-2) / 1.5, maxd = log(1e-2) / 0.3;
        const float delta = fabsf((float)(mind + (maxd - mind) * (double)c / 255.0));
#pragma unroll
        for (int p = 0; p < 32; ++p) { const int t = t0 + p; const float tt = (float)((double)t / (double)(SL - 1)); acc[p] *= __builtin_amdgcn_exp2f(-1.4426950408889634f * tt * delta); }
        float* row = HFT_l + (size_t)c * 8192;
        if (dir == 0) {
#pragma unroll
            for (int p4 = 0; p4 < 8; ++p4) *(f32x4*)(row + t0 + 4 * p4) = (f32x4){acc[4 * p4], acc[4 * p4 + 1], acc[4 * p4 + 2], acc[4 * p4 + 3]};
            if (t0 == 0) row[4096] = 0.f;
        } else {
#pragma unroll
            for (int p = 0; p < 32; ++p) if (t0 + p > 0) row[8192 - t0 - p] = acc[p];
        } }
}
}

constexpr size_t WS_AO = 222 * MiB;
namespace at {
typedef short v4i16_t __attribute__((ext_vector_type(4)));
constexpr int KROW = 144, NKEY = 400, V_OFF = NKEY * KROW;
__device__ __forceinline__ float blo(unsigned u) { return __builtin_bit_cast(float, u << 16); }
__device__ __forceinline__ float bhi(unsigned u) { return __builtin_bit_cast(float, u & 0xffff0000u); }
__device__ __forceinline__ void rope16(uint4& A, uint4& B, const float* __restrict__ cs, float scale) {
    const f32x4 c0 = *(const f32x4*)cs, c1 = *(const f32x4*)(cs + 4), s0 = *(const f32x4*)(cs + 8), s1 = *(const f32x4*)(cs + 12);
    const float c[8] = {c0[0], c0[1], c0[2], c0[3], c1[0], c1[1], c1[2], c1[3]}, s[8] = {s0[0], s0[1], s0[2], s0[3], s1[0], s1[1], s1[2], s1[3]};
    unsigned a[4] = {A.x, A.y, A.z, A.w}, b[4] = {B.x, B.y, B.z, B.w};
#pragma unroll
    for (int d = 0; d < 4; ++d) {
        const float t1l = blo(a[d]), t1h = bhi(a[d]), t2l = blo(b[d]), t2h = bhi(b[d]);
        const float o1l = (t1l * c[2 * d] - t2l * s[2 * d]) * scale, o1h = (t1h * c[2 * d + 1] - t2h * s[2 * d + 1]) * scale;
        const float o2l = (t2l * c[2 * d] + t1l * s[2 * d]) * scale, o2h = (t2h * c[2 * d + 1] + t1h * s[2 * d + 1]) * scale;
        a[d] = f2bf(o1l) | (f2bf(o1h) << 16); b[d] = f2bf(o2l) | (f2bf(o2h) << 16);
    }
    A = make_uint4(a[0], a[1], a[2], a[3]); B = make_uint4(b[0], b[1], b[2], b[3]);
}
__device__ __forceinline__ unsigned scale2(unsigned u, float sc) { return f2bf(blo(u) * sc) | (f2bf(bhi(u) * sc) << 16); }
__device__ __forceinline__ void attn_unit(LAS unsigned char* lds, int unit, int tid, const bf16_t* __restrict__ P, const float* __restrict__ rope, const float* __restrict__ sink_l, bf16_t* __restrict__ AO) {
    asm volatile("" : "+v"(tid));
    const int b = unit >> 6, kvh = (unit >> 5) & 1, q0 = (unit & 31) * 128, W0 = q0 - 128;
    const size_t m0 = (size_t)b * SL;
    const int lane = tid & 63, wave = __builtin_amdgcn_readfirstlane(tid >> 6), i = lane & 15, g = lane >> 4;
    __syncthreads();
    for (int it = tid; it < 2 * NKEY * 4; it += NTHREADS) {
        const int isV = it >= NKEY * 4, j = it - isV * NKEY * 4, kk = j >> 2, ch = j & 3, pos = W0 + kk;
        uint4 a = make_uint4(0u, 0u, 0u, 0u), bq = a;
        if (pos >= 0 && pos < SL) {
            const bf16_t* src = P + (m0 + pos) * DINP + (isV ? P_V : P_K) + kvh * HD + ch * 16;
            a = *(const uint4*)src; bq = *(const uint4*)(src + 8);
            if (!isV && ch == 0) rope16(a, bq, rope + pos * 16, 1.0f);
        }
        LAS unsigned char* dst = lds + (isV ? V_OFF : 0) + kk * KROW + ch * 32;
        *(LAS v4u*)dst = (v4u){a.x, a.y, a.z, a.w}; *(LAS v4u*)(dst + 16) = (v4u){bq.x, bq.y, bq.z, bq.w};
    }
    __syncthreads();
    const bool edge = (q0 == 0) || (q0 == SL - 128);
#pragma unroll 1
    for (int gi = 0; gi < 3; ++gi) {
        const int grp = wave * 3 + gi, hl = grp >> 3, qsub = grp & 7, head = kvh * 3 + hl;
        const int tok = q0 + 16 * qsub + i;
        bf16x8 qf[2];
        {   const bf16_t* qp = P + (m0 + tok) * DINP + P_Q + head * HD + g * 8;
            uint4 own = *(const uint4*)qp, hi2 = *(const uint4*)(qp + 32);
            uint4 oth; oth.x = __shfl_xor(own.x, 16); oth.y = __shfl_xor(own.y, 16); oth.z = __shfl_xor(own.z, 16); oth.w = __shfl_xor(own.w, 16);
            uint4 t1 = (g == 0) ? own : oth, t2 = (g == 0) ? oth : own;
            rope16(t1, t2, rope + tok * 16, 0.125f);
            uint4 r0;
            if (g == 0) r0 = t1; else if (g == 1) r0 = t2; else r0 = make_uint4(scale2(own.x, 0.125f), scale2(own.y, 0.125f), scale2(own.z, 0.125f), scale2(own.w, 0.125f));
            hi2 = make_uint4(scale2(hi2.x, 0.125f), scale2(hi2.y, 0.125f), scale2(hi2.z, 0.125f), scale2(hi2.w, 0.125f));
            qf[0] = __builtin_bit_cast(bf16x8, r0); qf[1] = __builtin_bit_cast(bf16x8, hi2); }
        f32x4 st[17];
        const LAS unsigned char* kb = lds + (16 * qsub + i) * KROW + g * 16;
#pragma unroll
        for (int tt = 0; tt < 17; ++tt) {
            const bf16x8 k0 = *(const LAS bf16x8*)(kb + tt * 16 * KROW), k1 = *(const LAS bf16x8*)(kb + tt * 16 * KROW + 64);
            f32x4 acc = __builtin_amdgcn_mfma_f32_16x16x32_bf16(k0, qf[0], (f32x4){0.f, 0.f, 0.f, 0.f}, 0, 0, 0);
            st[tt] = __builtin_amdgcn_mfma_f32_16x16x32_bf16(k1, qf[1], acc, 0, 0, 0);
        }
        const float NEGF = -1e30f;
#pragma unroll
        for (int r = 0; r < 4; ++r) { if (4 * g + r < i) st[0][r] = NEGF; if (4 * g + r > i) st[16][r] = NEGF; }
        if (edge) {
#pragma unroll
            for (int tt = 0; tt < 17; ++tt)
#pragma unroll
                for (int r = 0; r < 4; ++r) { const int pos = W0 + 16 * (qsub + tt) + 4 * g + r; if (pos < 0 || pos >= SL) st[tt][r] = NEGF; }
        }
        const float sk = sink_l[head];
        float mx = sk;
#pragma unroll
        for (int tt = 0; tt < 17; ++tt) mx = fmaxf(fmaxf(mx, fmaxf(st[tt][0], st[tt][1])), fmaxf(st[tt][2], st[tt][3]));
        mx = fmaxf(mx, __shfl_xor(mx, 16)); mx = fmaxf(mx, __shfl_xor(mx, 32));
        const float L2E = 1.4426950408889634f, mb = mx * L2E;
        float lsum = 0.f;
        bf16x8 pf[9];
#pragma unroll
        for (int s = 0; s < 9; ++s) {
            float p[8];
#pragma unroll
            for (int r = 0; r < 4; ++r) { p[r] = __builtin_amdgcn_exp2f(st[2 * s][r] * L2E - mb); p[4 + r] = (2 * s + 1 < 17) ? __builtin_amdgcn_exp2f(st[(2 * s + 1 < 17) ? 2 * s + 1 : 16][r] * L2E - mb) : 0.f; }
#pragma unroll
            for (int r = 0; r < 8; ++r) lsum += p[r];
            uint4 w; w.x = f2bf(p[0]) | (f2bf(p[1]) << 16); w.y = f2bf(p[2]) | (f2bf(p[3]) << 16); w.z = f2bf(p[4]) | (f2bf(p[5]) << 16); w.w = f2bf(p[6]) | (f2bf(p[7]) << 16);
            pf[s] = __builtin_bit_cast(bf16x8, w);
        }
        lsum += __shfl_xor(lsum, 16); lsum += __shfl_xor(lsum, 32);
        lsum += __builtin_amdgcn_exp2f(sk * L2E - mb);
        const float rl = 1.0f / lsum;
        const LAS unsigned char* vb = lds + V_OFF + (16 * qsub + 4 * g + (i >> 2)) * KROW + (i & 3) * 8;
        bf16_t* op = AO + (m0 + tok) * DBB + head * HD + 4 * g;
#pragma unroll
        for (int dt = 0; dt < 4; ++dt) {
            f32x4 o = (f32x4){0.f, 0.f, 0.f, 0.f};
#pragma unroll
            for (int s = 0; s < 9; ++s) {
                const v4i16_t lo = __builtin_amdgcn_ds_read_tr16_b64_v4i16((LAS v4i16_t*)(vb + (32 * s) * KROW + dt * 32));
                const v4i16_t hi = __builtin_amdgcn_ds_read_tr16_b64_v4i16((LAS v4i16_t*)(vb + (32 * s + 16) * KROW + dt * 32));
                const bf16x8 vf = (bf16x8){lo[0], lo[1], lo[2], lo[3], hi[0], hi[1], hi[2], hi[3]};
                o = __builtin_amdgcn_mfma_f32_16x16x32_bf16(vf, pf[s], o, 0, 0, 0);
            }
            uint2 w; w.x = f2bf(o[0] * rl) | (f2bf(o[1] * rl) << 16); w.y = f2bf(o[2] * rl) | (f2bf(o[3] * rl) << 16);
            *(uint2*)(op + dt * 16) = w;
        }
    }
}
}

constexpr size_t WS_AGG = 234 * MiB;
constexpr size_t WS_LW = WS_ROPE + 512 * 1024;
namespace lru {
constexpr int AXROW = 784, XCROW = 784, XC_OFF = 67 * AXROW, CARRY_OFF = XC_OFF + 64 * XCROW, SSQ_OFF = CARRY_OFF + 2 * DA * 4, RSTD_OFF = SSQ_OFF + 64 * 24 * 4;
__device__ __forceinline__ float fsig(float x) { return __builtin_amdgcn_rcpf(1.0f + __builtin_amdgcn_exp2f(-1.4426950408889634f * x)); }
__device__ __forceinline__ float fgelu(float x) { const float u = 0.7978845608028654f * (x + 0.044715f * x * x * x); const float e = __builtin_amdgcn_exp2f(2.8853900817779268f * u);
    const float th = 1.0f - 2.0f * __builtin_amdgcn_rcpf(1.0f + e); return 0.5f * x * (1.0f + th); }
template <bool FIN>
__device__ __forceinline__ void lru_unit(LAS unsigned char* lds, int unit, int tid, const bf16_t* __restrict__ P, const float* __restrict__ cw, const float* __restrict__ cb, const bf16_t* __restrict__ LW_l,
                                         const float* __restrict__ ba, const float* __restrict__ bx, const float* __restrict__ lam, float* __restrict__ AGG, const float* __restrict__ gn, bf16_t* __restrict__ YN) {
    asm volatile("" : "+v"(tid));
    const int b = unit >> 6, kc = unit & 63, t0 = kc * 64; const size_t m0 = (size_t)b * SL + t0;
    const int lane = tid & 63, wave = __builtin_amdgcn_readfirstlane(tid >> 6), li_ = lane & 15, g_ = lane >> 4;
    LAS unsigned char* AX = lds; LAS unsigned char* XC = lds + XC_OFF; LAS float* CARRY = (LAS float*)(lds + CARRY_OFF); LAS float* SSQ = (LAS float*)(lds + SSQ_OFF); LAS float* RSTD = (LAS float*)(lds + RSTD_OFF);
    __syncthreads();
    for (int it = tid; it < 67 * 48; it += NTHREADS) { const int r = it / 48, c8 = it % 48, t = t0 - 2 + r;
        uint4 v = make_uint4(0u, 0u, 0u, 0u);
        if (t >= 0 && t < SL) v = *(const uint4*)(P + (m0 + r - 2) * DINP + P_AX + c8 * 8);
        *(LAS v4u*)(AX + r * AXROW + c8 * 16) = (v4u){v.x, v.y, v.z, v.w}; }
    if (FIN) { if (tid < DA) { const int ch = tid; const float* ag = AGG + (size_t)b * 64 * 4 * DA + ch;
        float hf = 0.f; for (int j = 0; j < kc; ++j) hf = ag[(size_t)j * 4 * DA] * hf + ag[(size_t)j * 4 * DA + DA];
        float hb = 0.f; for (int j = 63; j > kc; --j) hb = ag[(size_t)j * 4 * DA + 2 * DA] * hb + ag[(size_t)j * 4 * DA + 3 * DA];
        CARRY[ch] = hf; CARRY[DA + ch] = hb; } }
    __syncthreads();
    if (tid < 384) { const int c8 = tid % 48, tg = tid / 48, ch0 = c8 * 8;
        float w[4][8], bb[8];
#pragma unroll
        for (int e = 0; e < 8; ++e) { bb[e] = cb[ch0 + e];
#pragma unroll
            for (int k = 0; k < 4; ++k) w[k][e] = cw[k * DA + ch0 + e]; }
        for (int q = 0; q < 8; ++q) { const int tok = tg * 8 + q; float acc[8];
#pragma unroll
            for (int e = 0; e < 8; ++e) acc[e] = bb[e];
#pragma unroll
            for (int k = 0; k < 4; ++k) { const v4u v = *(const LAS v4u*)(AX + (tok + k) * AXROW + c8 * 16);
#pragma unroll
                for (int d = 0; d < 4; ++d) { acc[2 * d] += w[k][2 * d] * at::blo(v[d]); acc[2 * d + 1] += w[k][2 * d + 1] * at::bhi(v[d]); } }
            *(LAS v4u*)(XC + tok * XCROW + c8 * 16) = (v4u){pk2(acc[0], acc[1]), pk2(acc[2], acc[3]), pk2(acc[4], acc[5]), pk2(acc[6], acc[7])}; }
    }
    __syncthreads();
    float yk[3][4][4];
#pragma unroll
    for (int rd = 0; rd < 3; ++rd) {
        asm volatile("" ::: "memory"); __builtin_amdgcn_sched_barrier(0);
        int li = li_, g = g_; asm volatile("" : "+v"(li), "+v"(g));
        const int h = 2 * rd + (wave >> 2), ct = wave & 3, ch = 64 * h + 16 * ct + li;
        f32x4 acc[4][4];
        {   bf16x8 af[4][2], bfr[4][2];
#pragma unroll
            for (int mt = 0; mt < 4; ++mt)
#pragma unroll
                for (int ks = 0; ks < 2; ++ks) af[mt][ks] = *(const LAS bf16x8*)(XC + (16 * mt + li) * XCROW + (64 * h + 32 * ks + 8 * g) * 2);
#pragma unroll
            for (int mat = 0; mat < 4; ++mat)
#pragma unroll
                for (int ks = 0; ks < 2; ++ks) bfr[mat][ks] = *(const bf16x8*)(LW_l + ((size_t)((h * 4 + mat) * 64 + 16 * ct + li)) * 64 + 32 * ks + 8 * g);
#pragma unroll
            for (int mat = 0; mat < 4; ++mat)
#pragma unroll
                for (int mt = 0; mt < 4; ++mt) { f32x4 c = __builtin_amdgcn_mfma_f32_16x16x32_bf16(af[mt][0], bfr[mat][0], (f32x4){0.f, 0.f, 0.f, 0.f}, 0, 0, 0);
                    acc[mat][mt] = __builtin_amdgcn_mfma_f32_16x16x32_bf16(af[mt][1], bfr[mat][1], c, 0, 0, 0); } }
        {   const float cw0 = cw[ch], cw1 = cw[DA + ch], cw2 = cw[2 * DA + ch], cw3 = cw[3 * DA + ch], cbv = cb[ch];
            float ban[2] = {ba[ch], ba[DA + ch]}, bxn[2] = {bx[ch], bx[DA + ch]}, spn[2];
#pragma unroll
            for (int n = 0; n < 2; ++n) { const float l = lam[n * DA + ch]; spn[n] = (-l > 20.f) ? -l : log1pf(expf(-l)); }
#pragma unroll
            for (int mt = 0; mt < 4; ++mt)
#pragma unroll
                for (int r = 0; r < 4; ++r) { const int tok = 16 * mt + 4 * g + r; const LAS unsigned char* ap = AX + tok * AXROW + ch * 2;
                    const float xcv = cbv + cw0 * bf2f(*(const LAS bf16_t*)ap) + cw1 * bf2f(*(const LAS bf16_t*)(ap + AXROW)) + cw2 * bf2f(*(const LAS bf16_t*)(ap + 2 * AXROW)) + cw3 * bf2f(*(const LAS bf16_t*)(ap + 3 * AXROW));
#pragma unroll
                    for (int n = 0; n < 2; ++n) { const float rg = fsig(acc[2 * n][mt][r] + ban[n]), ig = fsig(acc[2 * n + 1][mt][r] + bxn[n]);
                        const float la = -8.0f * rg * spn[n]; const float av = __builtin_amdgcn_exp2f(1.4426950408889634f * la); const float u = 2.0f * la;
                        const float ser = -u * (1.0f + u * (0.5f + u * (0.16666667f + u * (0.041666668f + u * 0.0083333338f))));
                        const float om = (u > -0.25f) ? ser : (1.0f - av * av);
                        acc[2 * n][mt][r] = av; acc[2 * n + 1][mt][r] = __builtin_amdgcn_sqrtf(om) * (ig * xcv); } } }
        f32x4 hs[4];
        {   float hin = FIN ? CARRY[ch] : 0.f, atot = 1.f;
#pragma unroll
            for (int mt = 0; mt < 4; ++mt) { const f32x4 a = acc[0][mt], bb = acc[1][mt];
                float Ai = (a[0] * a[1]) * (a[2] * a[3]), Bi = ((bb[0] * a[1] + bb[1]) * a[2] + bb[2]) * a[3] + bb[3];
                { const float A1 = __shfl_up(Ai, 16), B1 = __shfl_up(Bi, 16); if (g >= 1) { Bi = B1 * Ai + Bi; Ai = A1 * Ai; } }
                { const float A2 = __shfl_up(Ai, 32), B2 = __shfl_up(Bi, 32); if (g >= 2) { Bi = B2 * Ai + Bi; Ai = A2 * Ai; } }
                float Ae = __shfl_up(Ai, 16), Be = __shfl_up(Bi, 16); if (g == 0) { Ae = 1.f; Be = 0.f; }
                float hh = Ae * hin + Be;
#pragma unroll
                for (int r = 0; r < 4; ++r) { hh = a[r] * hh + bb[r]; hs[mt][r] = hh; }
                const float At = __shfl(Ai, li + 48), Bt = __shfl(Bi, li + 48); hin = At * hin + Bt; atot *= At; }
            if (!FIN && g == 0) { float* ag = AGG + ((size_t)(b * 64 + kc) * 4) * DA + ch; ag[0] = atot; ag[DA] = hin; } }
        {   float hin = FIN ? CARRY[DA + ch] : 0.f, atot = 1.f;
#pragma unroll
            for (int mt = 3; mt >= 0; --mt) { const f32x4 a = acc[2][mt], bb = acc[3][mt];
                float Ai = (a[0] * a[1]) * (a[2] * a[3]), Bi = ((bb[3] * a[2] + bb[2]) * a[1] + bb[1]) * a[0] + bb[0];
                { const float A1 = __shfl_down(Ai, 16), B1 = __shfl_down(Bi, 16); if (g <= 2) { Bi = B1 * Ai + Bi; Ai = A1 * Ai; } }
                { const float A2 = __shfl_down(Ai, 32), B2 = __shfl_down(Bi, 32); if (g <= 1) { Bi = B2 * Ai + Bi; Ai = A2 * Ai; } }
                float Ae = __shfl_down(Ai, 16), Be = __shfl_down(Bi, 16); if (g == 3) { Ae = 1.f; Be = 0.f; }
                float hh = Ae * hin + Be;
#pragma unroll
                for (int r = 3; r >= 0; --r) { hh = a[r] * hh + bb[r]; hs[mt][r] += hh; }
                const float At = __shfl(Ai, li), Bt = __shfl(Bi, li); hin = At * hin + Bt; atot *= At; }
            if (!FIN && g == 0) { float* ag = AGG + ((size_t)(b * 64 + kc) * 4) * DA + ch; ag[2 * DA] = atot; ag[3 * DA] = hin; } }
        if (FIN) {
#pragma unroll
            for (int mt = 0; mt < 4; ++mt)
#pragma unroll
                for (int r = 0; r < 4; ++r) { const int tok = 16 * mt + 4 * g + r; const float y = hs[mt][r] * fgelu(bf2f(P[(m0 + tok) * DINP + P_AG + ch])); yk[rd][mt][r] = y;
                    float s = y * y; s += __shfl_xor(s, 1); s += __shfl_xor(s, 2); s += __shfl_xor(s, 4); s += __shfl_xor(s, 8);
                    if (li == 0) SSQ[tok * 24 + rd * 8 + wave] = s; }
        }
    }
    if (FIN) {
        __syncthreads();
        if (tid < 64) { float s = 0.f;
#pragma unroll
            for (int q = 0; q < 24; ++q) s += SSQ[tid * 24 + q];
            RSTD[tid] = 1.0f / sqrtf(s * (1.0f / DA) + EPS); }
        __syncthreads();
#pragma unroll
        for (int rd = 0; rd < 3; ++rd) { const int li = li_, g = g_; const int h = 2 * rd + (wave >> 2), ct = wave & 3, ch = 64 * h + 16 * ct + li; const float gv = gn[ch];
#pragma unroll
            for (int mt = 0; mt < 4; ++mt)
#pragma unroll
                for (int r = 0; r < 4; ++r) { const int tok = 16 * mt + 4 * g + r; YN[(m0 + tok) * DM + ch] = (bf16_t)f2bf(yk[rd][mt][r] * RSTD[tok] * gv); } }
    }
}
}

namespace fin {
constexpr int TROW = 528;
__device__ __forceinline__ float wsum(float v) {
#pragma unroll
    for (int o = 1; o < 64; o <<= 1) v += __shfl_xor(v, o);
    return v;
}
__device__ __forceinline__ void norm_bc_unit(LAS unsigned char* lds, int unit, int tid, const bf16_t* __restrict__ AO, const bf16_t* __restrict__ YCT, const float* __restrict__ gnb, const float* __restrict__ gnc, bf16_t* __restrict__ YN) {
    asm volatile("" : "+v"(tid));
    const int b = unit >> 6, t0 = (unit & 63) * 64; const size_t m0 = (size_t)b * SL + t0;
    const int lane = tid & 63, wave = __builtin_amdgcn_readfirstlane(tid >> 6);
    __syncthreads();
    {   const int c = tid >> 1, hf = tid & 1; const bf16_t* src = YCT + ((size_t)b * DC + c) * SL + t0 + hf * 32;
#pragma unroll
        for (int q = 0; q < 4; ++q) { const uint4 v = *(const uint4*)(src + q * 8); const unsigned w[4] = {v.x, v.y, v.z, v.w};
#pragma unroll
            for (int d = 0; d < 4; ++d) { const int tok = hf * 32 + q * 8 + 2 * d;
                *(LAS bf16_t*)(lds + tok * TROW + c * 2) = (bf16_t)(w[d] & 0xffffu); *(LAS bf16_t*)(lds + (tok + 1) * TROW + c * 2) = (bf16_t)(w[d] >> 16); } } }
    for (int q = 0; q < 8; ++q) { const int tok = wave * 8 + q; const unsigned* src = (const unsigned*)(AO + (m0 + tok) * DBB);
        float v[6]; float s = 0.f;
#pragma unroll
        for (int j = 0; j < 3; ++j) { const unsigned w = src[lane + 64 * j]; v[2 * j] = at::blo(w); v[2 * j + 1] = at::bhi(w); s += v[2 * j] * v[2 * j] + v[2 * j + 1] * v[2 * j + 1]; }
        const float r = 1.0f / sqrtf(wsum(s) * (1.0f / DBB) + EPS);
        unsigned* dst = (unsigned*)(YN + (m0 + tok) * DM + DA);
#pragma unroll
        for (int j = 0; j < 3; ++j) { const int c0 = 2 * (lane + 64 * j); dst[lane + 64 * j] = pk2(v[2 * j] * r * gnb[c0], v[2 * j + 1] * r * gnb[c0 + 1]); } }
    __syncthreads();
    for (int q = 0; q < 8; ++q) { const int tok = wave * 8 + q; typedef unsigned u32x2v __attribute__((ext_vector_type(2))); const u32x2v w = *(const LAS u32x2v*)(lds + tok * TROW + lane * 8);
        const float v0 = at::blo(w.x), v1 = at::bhi(w.x), v2 = at::blo(w.y), v3 = at::bhi(w.y);
        const float r = 1.0f / sqrtf(wsum(v0 * v0 + v1 * v1 + v2 * v2 + v3 * v3) * (1.0f / DC) + EPS);
        const f32x4 gg = *(const f32x4*)(gnc + lane * 4);
        uint2 o; o.x = pk2(v0 * r * gg[0], v1 * r * gg[1]); o.y = pk2(v2 * r * gg[2], v3 * r * gg[3]);
        *(uint2*)(YN + (m0 + tok) * DM + DA + DBB + lane * 4) = o; }
}
}

__device__ __forceinline__ int fresh_tid() { int t = threadIdx.x; asm volatile("" : "+v"(t)); return t; }
#define FTID fresh_tid()
#define FLANE (fresh_tid() & 63)
struct Frame {
    LAS unsigned char* lds;
    volatile LAS unsigned* MISC;
    int wave, vcu, G;
};
__device__ __forceinline__ void p0_transpose_item(const float* W, int K, int N, bf16_t* WT, LAS float* scr, int item, int lane) {
    const int nblk = N / 32, kb = item / nblk, nb = item % nblk, k0 = 64 * kb, n0 = 32 * nb;
#pragma unroll 8
    for (int i = 0; i < 32; ++i) { const int kk = 2 * i + (lane >> 5); scr[kk * 33 + (lane & 31)] = W[(size_t)(k0 + kk) * N + n0 + (lane & 31)]; }
    LDS_WAIT(); asm volatile("" ::: "memory");
    const int c = lane & 7;
#pragma unroll
    for (int j = 0; j < 4; ++j) { const int n = (lane >> 3) + 8 * j; const LAS float* s = scr + (8 * c) * 33 + n;
        v4u o; o.x = pk2(s[0 * 33], s[1 * 33]); o.y = pk2(s[2 * 33], s[3 * 33]); o.z = pk2(s[4 * 33], s[5 * 33]); o.w = pk2(s[6 * 33], s[7 * 33]);
        *(GAS v4u*)(WT + (size_t)(n0 + n) * K + k0 + 8 * c) = o; }
    LDS_WAIT(); asm volatile("" ::: "memory");
}
__device__ __forceinline__ void xg_row(const float* xrow, const float* g, bf16_t* orow, float* ssrow, int lane) {
    const GAS f32x4* xr = (const GAS f32x4*)xrow + lane; const GAS f32x4* gr = (const GAS f32x4*)g + lane;
    f32x4 v[4]; float s = 0.f;
#pragma unroll
    for (int j = 0; j < 4; ++j) { v[j] = xr[64 * j]; s += (v[j][0] * v[j][0] + v[j][1] * v[j][1]) + (v[j][2] * v[j][2] + v[j][3] * v[j][3]); }
    s += __shfl_xor(s, 1); s += __shfl_xor(s, 2);
    if ((lane & 3) == 0) ssrow[lane >> 2] = s;
    GAS unsigned long long* o8 = (GAS unsigned long long*)orow + lane;
#pragma unroll
    for (int j = 0; j < 4; ++j) { const f32x4 gg = gr[64 * j]; o8[64 * j] = (unsigned long long)pk2(v[j][0] * gg[0], v[j][1] * gg[1]) | ((unsigned long long)pk2(v[j][2] * gg[2], v[j][3] * gg[3]) << 32); }
}
__device__ __forceinline__ void final_row(const float* xrow, const float* g, const float* SS, int row, float* orow, int lane) {
    const GAS f32x4* xr = (const GAS f32x4*)xrow + lane; const GAS f32x4* gr = (const GAS f32x4*)g + lane; GAS f32x4* o = (GAS f32x4*)orow + lane;
    const float r = pg8::rstd16(SS, row);
#pragma unroll
    for (int j = 0; j < 4; ++j) { const f32x4 v = xr[64 * j], gg = gr[64 * j]; o[64 * j] = v * gg * r; }
}

template <int I> __device__ __forceinline__ const float* in_ptr() {
    unsigned long long v;
    asm volatile("s_load_dwordx2 %0, %1, %2\n\ts_waitcnt lgkmcnt(0)" : "=s"(v) : "s"(__builtin_amdgcn_kernarg_segment_ptr()), "n"(I * 8) : "memory");
    return (const float*)v;
}
#define INP(i) in_ptr<i>()
struct Args { const float* in[28]; float* out; unsigned char* ws; int ph_lo, ph_hi, li, pad; };

#define ws ((unsigned char*)in_ptr<29>())
#define XR ((float*)in_ptr<28>())
#define Win_t ((bf16_t*)(ws + WS_WIN))
#define Wout_t ((bf16_t*)(ws + WS_WOUT))
#define Wup_t ((bf16_t*)(ws + WS_WUP))
#define Wdn_t ((bf16_t*)(ws + WS_WDN))
#define XG ((bf16_t*)(ws + WS_XG))
#define P ((bf16_t*)(ws + WS_P))
#define YN ((bf16_t*)(ws + WS_YN))
#define HB ((bf16_t*)(ws + WS_H))
#define SS ((float*)(ws + WS_SS))
__global__ void __launch_bounds__(NTHREADS, 2) mega(Args args) {
    extern __shared__ __attribute__((aligned(16))) unsigned char lds[];
    Frame F;
    F.lds = (LAS unsigned char*)lds; F.MISC = (volatile LAS unsigned*)(F.lds + MISC_OFF);
    F.wave = __builtin_amdgcn_readfirstlane((int)threadIdx.x >> 6);
    F.G = gridDim.x; { const int bx = blockIdx.x; F.vcu = (F.G % 8 == 0) ? (bx % 8) * (F.G / 8) + bx / 8 : bx; }
    gu32* ctl = (gu32*)(ws + WS_CTL);
    for (int u = threadIdx.x; u < (LDS_BYTES - MISC_OFF) / 4; u += NTHREADS) ((LAS unsigned*)(F.lds + MISC_OFF))[u] = 0u;
    __syncthreads();
    const int lo = args.ph_lo, hi = args.ph_hi;
    XcdBarrier bar; bar.bar = (unsigned*)(ctl + CW_BAR) + args.li * XCD_BAR_WORDS; bar.x = 0; bar.st = nullptr;
    if (hi - lo > 1) bar = xcd_barrier_post((unsigned*)(ctl + CW_BAR) + args.li * XCD_BAR_WORDS, F.MISC + 8);

    const int gw = F.vcu * NWAVES + F.wave, NGW = F.G * NWAVES;

#define IN(k) (lo <= (k) && (k) < hi)
#define SEAM(k) do { if (IN(k) && IN((k) + 1)) xcd_barrier(bar); } while (0)
#ifndef DUP_PRO
#define DUP_PRO(x)
#endif
    if (IN(PH_PRO)) {
        auto pro_body = [&]() __attribute__((always_inline)) {
        LAS float* scr = (LAS float*)(F.lds + RING_OFF + F.wave * 16384);
        constexpr int I_IN = (DM / 64) * (DIN / 32), I_OUT = (DM / 64) * (DM / 32), I_UP = (DM / 64) * (DFF / 32), I_DN = (DFF / 64) * (DM / 32), I_L = I_IN + I_OUT + I_UP + I_DN;
        for (int it = gw; it < DEPTH * I_L; it += NGW) {
            const int l = it / I_L; int r = it % I_L;
            if (r < I_IN) { p0_transpose_item(INP(2) + (size_t)l * DM * DIN, DM, DIN, Win_t + (size_t)l * DINP * DM, scr, r, FLANE); continue; } r -= I_IN;
            if (r < I_OUT) { p0_transpose_item(INP(23) + (size_t)l * DM * DM, DM, DM, Wout_t + (size_t)l * DM * DM, scr, r, FLANE); continue; } r -= I_OUT;
            if (r < I_UP) { p0_transpose_item(INP(25) + (size_t)l * DM * DFF, DM, DFF, Wup_t + (size_t)l * DFF * DM, scr, r, FLANE); continue; } r -= I_UP;
            p0_transpose_item(INP(26) + (size_t)l * DFF * DM, DFF, DM, Wdn_t + (size_t)l * DM * DFF, scr, r, FLANE);
        }
        for (int i = blockIdx.x * NTHREADS + FTID; i < DEPTH * 16384; i += F.G * NTHREADS) { const int l = i >> 14, r = i & 16383;
            *(GAS v4u*)((GAS unsigned char*)(Win_t + (size_t)l * DINP * DM + (size_t)DIN * DM) + (size_t)r * 16) = (v4u){0u, 0u, 0u, 0u}; }
        {
            float* TWf = (float*)(ws + WS_TW); float* rope = (float*)(ws + WS_ROPE);
            for (int i = blockIdx.x * NTHREADS + FTID; i < 8192; i += F.G * NTHREADS) { const double a = 6.283185307179586476925286766559 * (double)i / 8192.0; TWf[2 * i] = (float)cos(a); TWf[2 * i + 1] = (float)(-sin(a)); }
            for (int i = blockIdx.x * NTHREADS + FTID; i < SL * 8; i += F.G * NTHREADS) { const int pos = i >> 3, j = i & 7; const double ang = (double)pos * pow(500000.0, -(double)j / 8.0);
                rope[pos * 16 + j] = (float)cos(ang); rope[pos * 16 + 8 + j] = (float)sin(ang); }
        }
        {
            bf16_t* LW = (bf16_t*)(ws + WS_LW); const float* wa = INP(5); const float* wx = INP(7);
            for (int o = blockIdx.x * NTHREADS + FTID; o < DEPTH * LRU_BLK * 4 * 64 * 64; o += F.G * NTHREADS) {
                const int i = o & 63, j = (o >> 6) & 63, mat = (o >> 12) & 3, lh = o >> 14, h = lh % LRU_BLK, l = lh / LRU_BLK, n = mat >> 1;
                const float* src = (mat & 1) ? wx : wa;
                LW[o] = (bf16_t)f2bf(src[((((size_t)l * 2 + n) * LRU_BLK + h) * 64 + i) * 64 + j]); }
        }
        {
            const float* w1 = INP(13); const float* b1 = INP(14); const float* fq = INP(15); const float* w2 = INP(16); const float* b2 = INP(17); const float* w3 = INP(18);
            for (int u = F.vcu; u < DEPTH * 128; u += F.G) { const int l = u >> 7;
                hy::filter_unit(F.lds, u & 127, FTID, w1 + (size_t)l * HY_EMB * HY_W, b1 + l * HY_W, fq + l * HY_W, w2 + (size_t)l * HY_W * HY_W, b2 + l * HY_W, w3 + (size_t)l * HY_W * 2 * DC,
                                (float*)(ws + WS_HF) + (size_t)l * DC * 8192); }
            __syncthreads();
        }
        { const float* x0 = INP(0); const float* g0 = INP(1);
          for (int m = gw; m < MT; m += NGW) xg_row(x0 + (size_t)m * DM, g0, XG + (size_t)m * DM, SS + (size_t)m * 16, FLANE); }
        };
        pro_body(); DUP_PRO(xcd_barrier(bar); pro_body();)
    }
    SEAM(PH_PRO);
#ifndef DUP_MIX1
#define DUP_MIX1(x)
#endif
#ifndef DUP_FFT
#define DUP_FFT(x)
#endif
#ifndef DUP_FIN
#define DUP_FIN(x)
#endif
#ifndef DUP_WIN
#define DUP_WIN(x)
#endif
#ifndef DUP_WUP
#define DUP_WUP(x)
#endif
#define WIN_BODY(l) { \
        pg8::Gemm g{XG, Win_t + (size_t)(l) * DINP * DM, MT, DINP, DM}; pg8::StaticOrder S; S.init(MT, DINP, F.G, (int)blockIdx.x); \
        pg8::EpiScaleBf16<0> E{P, DINP, SS}; \
        pg8::gemm_phase<pg8::EpiScaleBf16<0>, pg8::StaticOrder, true, true>(F.lds + RING_OFF, g, S, E); }
#define MIX1_BODY(l) { const float* cw = INP(11) + (l) * 9 * DC; const float* cb = INP(12) + (l) * 3 * DC; \
        for (int u = F.vcu; u < 256; u += F.G) hy::hyprep_unit(F.lds, u, FTID, P, cw, cb, (bf16_t*)(ws + WS_ZT), (bf16_t*)(ws + WS_X0T)); \
        { const float* cwa = INP(3) + (l) * 4 * DA; const float* cba = INP(4) + (l) * DA; const float* ba = INP(6) + (l) * 2 * DA; const float* bx = INP(8) + (l) * 2 * DA; const float* lam = INP(9) + (l) * 2 * DA; \
          for (int u = F.vcu; u < 256; u += F.G) lru::lru_unit<false>(F.lds, u, FTID, P, cwa, cba, (const bf16_t*)(ws + WS_LW) + (size_t)(l) * LRU_BLK * 4 * 4096, ba, bx, lam, (float*)(ws + WS_AGG), nullptr, YN); } \
        { const float* sk = INP(10) + (l) * NQH; \
          for (int u = F.vcu; u < 256; u += F.G) at::attn_unit(F.lds, u, FTID, P, (const float*)(ws + WS_ROPE), sk, (bf16_t*)(ws + WS_AO)); } }
#define FFT_BODY(l) { const float* hb = INP(19) + (l) * DC; \
        for (int u = F.vcu; u < DC; u += F.G) hy::fft_unit(F.lds, u, FTID, (const float*)(ws + WS_HF) + (size_t)(l) * DC * 8192, (const hy::cf*)(ws + WS_TW), (const bf16_t*)(ws + WS_ZT), (const bf16_t*)(ws + WS_X0T), \
                                                           (bf16_t*)(ws + WS_YCT), hb[u]); }
#define FIN_BODY(l) { \
        { const float* cwa = INP(3) + (l) * 4 * DA; const float* cba = INP(4) + (l) * DA; const float* ba = INP(6) + (l) * 2 * DA; const float* bx = INP(8) + (l) * 2 * DA; const float* lam = INP(9) + (l) * 2 * DA; const float* gna = INP(20) + (l) * DA; \
          for (int u = F.vcu; u < 256; u += F.G) lru::lru_unit<true>(F.lds, u, FTID, P, cwa, cba, (const bf16_t*)(ws + WS_LW) + (size_t)(l) * LRU_BLK * 4 * 4096, ba, bx, lam, (float*)(ws + WS_AGG), gna, YN); } \
        { const float* gnb = INP(21) + (l) * DBB; const float* gnc = INP(22) + (l) * DC; \
          for (int u = F.vcu; u < 256; u += F.G) fin::norm_bc_unit(F.lds, u, FTID, (const bf16_t*)(ws + WS_AO), (const bf16_t*)(ws + WS_YCT), gnb, gnc, YN); } }
#define WUP_BODY(l) { \
        pg8::Gemm g{XG, Wup_t + (size_t)(l) * DFF * DM, MT, DFF, DM}; pg8::StaticOrder S; S.init(MT, DFF, F.G, (int)blockIdx.x); \
        pg8::EpiScaleBf16<1> E{HB, DFF, SS}; \
        pg8::gemm_phase<pg8::EpiScaleBf16<1>, pg8::StaticOrder, true, true>(F.lds + RING_OFF, g, S, E); }
#define LAYER(l) do { constexpr int pb = 1 + PH_PER_LAYER * (l); \
    if (IN(pb + PL_WIN)) { WIN_BODY(l) DUP_WIN(xcd_barrier(bar); WIN_BODY(l)) } \
    SEAM(pb + PL_WIN); \
    if (IN(pb + PL_MIX1)) { MIX1_BODY(l) DUP_MIX1(xcd_barrier(bar); MIX1_BODY(l)) } \
    SEAM(pb + PL_MIX1); \
    if (IN(pb + PL_FFT)) { FFT_BODY(l) DUP_FFT(xcd_barrier(bar); FFT_BODY(l)) } \
    SEAM(pb + PL_FFT); \
    if (IN(pb + PL_FIN)) { FIN_BODY(l) DUP_FIN(xcd_barrier(bar); FIN_BODY(l)) } \
    SEAM(pb + PL_FIN); \
    if (IN(pb + PL_WOUT)) { \
        pg8::Gemm g{YN, Wout_t + (size_t)(l) * DM * DM, MT, DM, DM}; pg8::StaticOrder S; S.init(MT, DM, F.G, (int)blockIdx.x); \
        pg8::EpiRes E{(l) == 0 ? INP(0) : (const float*)XR, XR, XG, INP(24) + (l) * DM, SS}; \
        pg8::gemm_phase<pg8::EpiRes, pg8::StaticOrder, true, true>(F.lds + RING_OFF, g, S, E); } \
    SEAM(pb + PL_WOUT); \
    if (IN(pb + PL_WUP)) { WUP_BODY(l) DUP_WUP(xcd_barrier(bar); WUP_BODY(l)) } \
    SEAM(pb + PL_WUP); \
    if (IN(pb + PL_WDN)) { \
        pg8::Gemm g{HB, Wdn_t + (size_t)(l) * DM * DFF, MT, DM, DFF}; pg8::StaticOrder S; S.init(MT, DM, F.G, (int)blockIdx.x); \
        pg8::EpiRes E{XR, XR, ((l) + 1 < DEPTH) ? XG : (bf16_t*)nullptr, INP(1) + (((l) + 1 < DEPTH) ? ((l) + 1) * DM : 0), SS}; \
        pg8::gemm_phase<pg8::EpiRes, pg8::StaticOrder, true, true>(F.lds + RING_OFF, g, S, E); } \
    SEAM(pb + PL_WDN); } while (0)
    LAYER(0);
    LAYER(1);
    if (IN(PH_FINAL)) { const float* gf = INP(27);
        for (int m = gw; m < MT; m += NGW) final_row(XR + (size_t)m * DM, gf, SS, m, XR + (size_t)m * DM, FLANE); }
#undef IN
#undef SEAM
#undef LAYER
}

#undef ws
#undef XR
#undef Win_t
#undef Wout_t
#undef Wup_t
#undef Wdn_t
#undef XG
#undef P
#undef YN
#undef HB
#undef SS
static int g_grid = 0, g_li = 0;
static void launch_mega(Args a, int lo, int hi, hipStream_t stream) {
    a.ph_lo = lo; a.ph_hi = hi; a.li = (hi - lo > 1) ? g_li++ : 0;
    void* kargs[] = {&a};
    hipLaunchCooperativeKernel((const void*)mega, dim3(g_grid), dim3(NTHREADS), kargs, LDS_BYTES, stream);
}
extern "C" void kernel_launch(void* const* d_in, const int* in_sizes, int n_in, void* d_out, int out_size, void* d_ws, size_t ws_size, hipStream_t stream) {
    if (n_in != 28 || ws_size < WS_END) return;
    if (g_grid == 0) {
        int dev = 0, cus = 0, per_cu = 0;
        hipGetDevice(&dev); hipDeviceGetAttribute(&cus, hipDeviceAttributeMultiprocessorCount, dev);
        hipFuncSetAttribute((const void*)mega, hipFuncAttributeMaxDynamicSharedMemorySize, LDS_BYTES);
        hipOccupancyMaxActiveBlocksPerMultiprocessor(&per_cu, (const void*)mega, NTHREADS, LDS_BYTES);
        (void)hipGetLastError();
        if (per_cu < 1) per_cu = 1;
        if (per_cu > 1) per_cu = 1;
        g_grid = cus * per_cu;
    }
    g_li = 0;
    unsigned char* ws = (unsigned char*)d_ws;
    auto F = [&](int i) { return (const float*)d_in[i]; };
    hipMemsetAsync(ws + WS_CTL, 0, 1 * MiB, stream);
    Args a{};
    for (int i = 0; i < 28; ++i) a.in[i] = (const float*)d_in[i];
    a.out = (float*)d_out; a.ws = ws;
    float* rope = (float*)(ws + WS_ROPE); float* HF = (float*)(ws + WS_HF);
    bf16_t* P = (bf16_t*)(ws + WS_P); bf16_t* YN = (bf16_t*)(ws + WS_YN);
    float* nA = (float*)(ws + NV_A); float* nB = (float*)(ws + NV_B); float* nHS = (float*)(ws + NV_HS); float* nZ = (float*)(ws + NV_Z); float* nX0 = (float*)(ws + NV_X0); float* nYC = (float*)(ws + NV_YC);

    launch_mega(a, 0, NPH, stream);
}
```

```cpp
#define DUP_BAR(...)
#include <hip/hip_runtime.h>
#include <stdint.h>
#include <math.h>

typedef unsigned short bf16_t;
typedef short bf16x8 __attribute__((ext_vector_type(8)));
typedef float f32x4 __attribute__((ext_vector_type(4)));

constexpr int NB = 4, SL = 4096, DM = 1024, MT = NB * SL, DEPTH = 2;
constexpr int DA = 384, DBB = 384, DC = 256, HD = 64, NQH = 6, NKVH = 2, DIN = 2176, DINP = 2304, DFF = 4096;
constexpr int P_AX = 0, P_AG = 384, P_Q = 768, P_K = 1152, P_V = 1280, P_CU = 1408;
constexpr int LRU_BLK = 6, LRU_BW = 64, WIN = 128, HY_EMB = 33, HY_W = 64;
constexpr float EPS = 1e-6f;

constexpr size_t MiB = 1u << 20;
constexpr size_t WS_WIN = 0;
constexpr size_t WS_WOUT = 9 * MiB;
constexpr size_t WS_WUP = 13 * MiB;
constexpr size_t WS_WDN = 29 * MiB;
constexpr size_t WS_ROPE = 45 * MiB;
constexpr size_t WS_HF = 46 * MiB;
constexpr size_t WS_XG = 62 * MiB;
constexpr size_t WS_BIG = 94 * MiB;
constexpr size_t WS_H = WS_BIG;
constexpr size_t WS_P = WS_BIG;
constexpr size_t WS_YN = WS_BIG + 72 * MiB;
constexpr size_t WS_SCR = WS_BIG + 104 * MiB;
constexpr size_t WS_CTL = 254 * MiB;
constexpr size_t WS_SS = 255 * MiB;
constexpr size_t WS_END = 256 * MiB;
constexpr size_t NV_A = WS_XG;
constexpr size_t NV_B = WS_SCR;
constexpr size_t NV_HS = WS_SCR + 24 * MiB;
constexpr size_t NV_Z = WS_SCR;
constexpr size_t NV_X0 = WS_SCR + 16 * MiB;
constexpr size_t NV_YC = WS_SCR + 32 * MiB;

__device__ __forceinline__ unsigned f2bf(float f) { unsigned u = __builtin_bit_cast(unsigned, f); return (u + 0x7fffu + ((u >> 16) & 1u)) >> 16; }
__device__ __forceinline__ float bf2f(bf16_t h) { return __builtin_bit_cast(float, (unsigned)h << 16); }
__device__ __forceinline__ float sigmoidf_(float x) { return 1.f / (1.f + expf(-x)); }
__device__ __forceinline__ float gelu_tanh(float x) { const float u = 0.7978845608028654f * (x + 0.044715f * x * x * x); return 0.5f * x * (1.f + tanhf(u)); }

__device__ __forceinline__ float block_sum(float v, float* red) {
    for (int o = 32; o > 0; o >>= 1) v += __shfl_xor(v, o);
    const int w = threadIdx.x >> 6, nw = blockDim.x >> 6;
    __syncthreads();
    if ((threadIdx.x & 63) == 0) red[w] = v;
    __syncthreads();
    float s = 0.f;
    for (int i = 0; i < nw; ++i) s += red[i];
    return s;
}

__global__ void k_rope(float* __restrict__ tab) {
    const int i = blockIdx.x * blockDim.x + threadIdx.x; if (i >= SL * 8) return;
    const int pos = i >> 3, j = i & 7;
    const double inv = pow(500000.0, -(double)j / 8.0), ang = (double)pos * inv;
    tab[pos * 16 + j] = (float)cos(ang); tab[pos * 16 + 8 + j] = (float)sin(ang);
}

__global__ void k_hy_filter(const float* __restrict__ w1, const float* __restrict__ b1, const float* __restrict__ freq, const float* __restrict__ w2,
                            const float* __restrict__ b2, const float* __restrict__ w3, float* __restrict__ HF) {
    __shared__ float z[HY_EMB], h1[HY_W], h2[HY_W];
    const int t = blockIdx.x, tid = threadIdx.x;
    const double PI2 = 6.283185307179586476925286766559;
    const float tt = (float)((double)t / (double)(SL - 1));
    if (tid < HY_EMB) {
        float v;
        if (tid == 0) v = tt;
        else { const int bi = (tid - 1) & 15; const double f = 1e-4 + (double)bi * ((15.0 - 1e-4) / 15.0); const double w = PI2 * (double)t / (double)SL;
               v = (tid <= 16) ? (float)cos(f * w) : (float)(-sin(f * w)); }
        z[tid] = v;
    }
    __syncthreads();
    if (tid < HY_W) { float a = b1[tid]; for (int i = 0; i < HY_EMB; ++i) a += z[i] * w1[i * HY_W + tid]; h1[tid] = sinf(freq[tid] * a); }
    __syncthreads();
    if (tid < HY_W) { float a = b2[tid]; for (int i = 0; i < HY_W; ++i) a += h1[i] * w2[i * HY_W + tid]; h2[tid] = sinf(freq[tid] * a); }
    __syncthreads();
    const double mind = log(1e-2) / 1.5, maxd = log(1e-2) / 0.3;
    for (int o = tid; o < 2 * DC; o += 256) {
        float a = 0.f; for (int i = 0; i < HY_W; ++i) a += h2[i] * w3[i * 2 * DC + o];
        const int c = o & 255, dir = o >> 8;
        const float delta = fabsf((float)(mind + (maxd - mind) * (double)c / 255.0));
        HF[((size_t)dir * SL + t) * DC + c] = a * expf(-tt * delta);
    }
}

__global__ __launch_bounds__(384) void k_lru_ab(const bf16_t* __restrict__ P, const float* __restrict__ cw, const float* __restrict__ cb, const float* __restrict__ wa, const float* __restrict__ ba,
                                               const float* __restrict__ wx, const float* __restrict__ bx, const float* __restrict__ lam, float* __restrict__ Aout, float* __restrict__ Bout, int n) {
    __shared__ float xc[DA];
    const int m = blockIdx.x, t = m % SL, j = threadIdx.x;
    float v = cb[j];
#pragma unroll
    for (int k = 0; k < 4; ++k) { const int tt = t + k - 2; if (tt >= 0 && tt < SL) v += cw[k * DA + j] * bf2f(P[(size_t)(m + k - 2) * DINP + P_AX + j]); }
    xc[j] = v;
    __syncthreads();
    const int blk = j >> 6, jj = j & 63;
    {
        float ra = ba[n * DA + j], ia = bx[n * DA + j];
        const float* wap = wa + ((size_t)(n * LRU_BLK + blk) * 64) * 64 + jj; const float* wxp = wx + ((size_t)(n * LRU_BLK + blk) * 64) * 64 + jj;
        for (int i = 0; i < 64; ++i) { const float xi = xc[blk * 64 + i]; ra += xi * wap[i * 64]; ia += xi * wxp[i * 64]; }
        const float r = sigmoidf_(ra), ig = sigmoidf_(ia);
        const float l = lam[n * DA + j]; const float sp = (-l > 20.f) ? -l : log1pf(expf(-l));
        const float log_a = -8.f * r * sp;
        const float a = expf(log_a), bb = sqrtf(-expm1f(2.f * log_a)) * (ig * v);
        Aout[(size_t)m * DA + j] = a; Bout[(size_t)m * DA + j] = bb;
    }
}
__global__ void k_lru_scan(const float* __restrict__ A, const float* __restrict__ Bv, float* __restrict__ HS, int n) {
    const int id = blockIdx.x * blockDim.x + threadIdx.x; if (id >= NB * DA) return;
    const int ch = id % DA, b = id / DA;
    float h = 0.f;
    for (int s = 0; s < SL; ++s) { const int t = n ? (SL - 1 - s) : s; const size_t o = ((size_t)b * SL + t) * DA + ch; h = A[o] * h + Bv[o]; HS[o] = n ? (HS[o] + h) : h; }
}
__global__ __launch_bounds__(384) void k_lru_out(const bf16_t* __restrict__ P, const float* __restrict__ HS, const float* __restrict__ gn, bf16_t* __restrict__ YN) {
    __shared__ float red[8];
    const int m = blockIdx.x, j = threadIdx.x;
    const float h = HS[(size_t)m * DA + j];
    const float y = h * gelu_tanh(bf2f(P[(size_t)m * DINP + P_AG + j]));
    const float ss = block_sum(y * y, red);
    const float r = 1.f / sqrtf(ss * (1.f / DA) + EPS);
    YN[(size_t)m * DM + j] = (bf16_t)f2bf(y * r * gn[j]);
}

__global__ __launch_bounds__(384) void k_attn(const bf16_t* __restrict__ P, const float* __restrict__ rope, const float* __restrict__ sink, const float* __restrict__ gn, bf16_t* __restrict__ YN) {
    __shared__ float qs[NQH][HD], ps[NQH][320], red[8];
    const int m = blockIdx.x, t = m % SL, w = threadIdx.x >> 6, lane = threadIdx.x & 63, kvh = w / 3;
    const float* rt = rope + t * 16;
    const bf16_t* qp = P + (size_t)m * DINP + P_Q + w * HD;
    {   float q = bf2f(qp[lane]);
        if (lane < 8) q = q * rt[lane] - bf2f(qp[lane + 8]) * rt[8 + lane];
        else if (lane < 16) q = q * rt[lane - 8] + bf2f(qp[lane - 8]) * rt[lane];
        qs[w][lane] = q; }
    __syncthreads();
    float sv[5]; float mx = sink[w];
#pragma unroll
    for (int pss = 0; pss < 5; ++pss) {
        const int jrel = pss * 64 + lane, jt = t - WIN + jrel; float s = -1e30f;
        if (jrel <= 2 * WIN && jt >= 0 && jt < SL) {
            const bf16_t* kp = P + (size_t)(m - WIN + jrel) * DINP + P_K + kvh * HD; const float* rk = rope + jt * 16;
            float acc = 0.f;
            for (int d = 0; d < 8; ++d) { const float k1 = bf2f(kp[d]), k2 = bf2f(kp[d + 8]); acc += qs[w][d] * (k1 * rk[d] - k2 * rk[8 + d]) + qs[w][d + 8] * (k2 * rk[d] + k1 * rk[8 + d]); }
            for (int d = 16; d < HD; ++d) acc += qs[w][d] * bf2f(kp[d]);
            s = acc * 0.125f;
        }
        sv[pss] = s; mx = fmaxf(mx, s);
    }
    for (int o = 32; o > 0; o >>= 1) mx = fmaxf(mx, __shfl_xor(mx, o));
    float den = 0.f;
#pragma unroll
    for (int pss = 0; pss < 5; ++pss) { const float p = (sv[pss] > -1e29f) ? expf(sv[pss] - mx) : 0.f; ps[w][pss * 64 + lane] = p; den += p; }
    for (int o = 32; o > 0; o >>= 1) den += __shfl_xor(den, o);
    den += expf(sink[w] - mx);
    __syncthreads();
    float o = 0.f;
    for (int jrel = 0; jrel <= 2 * WIN; ++jrel) { const int jt = t - WIN + jrel; if (jt < 0 || jt >= SL) continue; o += ps[w][jrel] * bf2f(P[(size_t)(m - WIN + jrel) * DINP + P_V + kvh * HD + lane]); }
    o /= den;
    const float ss = block_sum(o * o, red);
    const float r = 1.f / sqrtf(ss * (1.f / DBB) + EPS);
    YN[(size_t)m * DM + DA + w * HD + lane] = (bf16_t)f2bf(o * r * gn[w * HD + lane]);
}

__global__ __launch_bounds__(384) void k_attn_norm(const bf16_t* __restrict__ AO, const float* __restrict__ gn, bf16_t* __restrict__ YN) {
    __shared__ float red[8];
    const int m = blockIdx.x, j = threadIdx.x; const float o = bf2f(AO[(size_t)m * DBB + j]);
    const float ss = block_sum(o * o, red); const float r = 1.f / sqrtf(ss * (1.f / DBB) + EPS);
    YN[(size_t)m * DM + DA + j] = (bf16_t)f2bf(o * r * gn[j]);
}
__global__ __launch_bounds__(256) void k_hy_prep(const bf16_t* __restrict__ P, const float* __restrict__ cw, const float* __restrict__ cb, float* __restrict__ Z, float* __restrict__ X0) {
    const int m = blockIdx.x, t = m % SL, c = threadIdx.x;
    float u[3];
#pragma unroll
    for (int part = 0; part < 3; ++part) { const int ch = part * DC + c; float v = cb[ch];
#pragma unroll
        for (int k = 0; k < 3; ++k) { const int tt = t + k - 1; if (tt >= 0 && tt < SL) v += cw[k * 3 * DC + ch] * bf2f(P[(size_t)(m + k - 1) * DINP + P_CU + ch]); }
        u[part] = v; }
    Z[(size_t)m * DC + c] = u[2] * u[1]; X0[(size_t)m * DC + c] = u[0];
}
__global__ __launch_bounds__(256) void k_hy_conv(const float* __restrict__ Z, const float* __restrict__ X0, const float* __restrict__ HF, const float* __restrict__ bias, float* __restrict__ YC) {
    const int m = blockIdx.x, b = m / SL, t = m % SL, c = threadIdx.x;
    const float* zb = Z + (size_t)b * SL * DC + c; const float* hf = HF + c; const float* hb = HF + (size_t)SL * DC + c;
    float y = 0.f;
    for (int s = 0; s <= t; ++s) y += hf[(size_t)(t - s) * DC] * zb[(size_t)s * DC];
    for (int s = t + 1; s < SL; ++s) y += hb[(size_t)(s - t) * DC] * zb[(size_t)s * DC];
    YC[(size_t)m * DC + c] = (y + zb[(size_t)t * DC] * bias[c]) * X0[(size_t)m * DC + c];
}
__global__ __launch_bounds__(256) void k_hy_norm(const bf16_t* __restrict__ YCT, const float* __restrict__ gn, bf16_t* __restrict__ YN) {
    __shared__ float red[8];
    const int m = blockIdx.x, c = threadIdx.x; const float y = bf2f(YCT[((size_t)(m / SL) * DC + c) * SL + (m % SL)]);
    const float ss = block_sum(y * y, red); const float r = 1.f / sqrtf(ss * (1.f / DC) + EPS);
    YN[(size_t)m * DM + DA + DBB + c] = (bf16_t)f2bf(y * r * gn[c]);
}

namespace pg8 {
#define PG8_LAS __attribute__((address_space(3)))
typedef unsigned short bf16_t;
typedef short bf16x8 __attribute__((ext_vector_type(8)));
typedef float f32x4 __attribute__((ext_vector_type(4)));
typedef unsigned u32x4 __attribute__((ext_vector_type(4)));
constexpr int BM = 256, BK = 64, HALF = 128, HTB = HALF * BK * 2  , STAGE_BYTES = 8 * HTB, NXCD = 8, WGM = 8;

__host__ __device__ __forceinline__ int lds_byte(int r, int c) { const int st = (r >> 4) * 2 + (c >> 5), rr = r & 15, cc = c & 31, ob = rr * 64 + cc * 2; return st * 1024 + (ob ^ (((ob >> 9) & 1) << 5)); }
__host__ __device__ __forceinline__ void stage_rc(int b, int& R, int& C) { const int st = b / 1024, sb = b % 1024, swz = sb ^ (((sb >> 9) & 1) << 5); R = (st >> 1) * 16 + swz / 64; C = (st & 1) * 32 + (swz % 64) / 2; }
__host__ __device__ __forceinline__ int perm32(int rho) { const int n = rho >> 4, i = rho & 15; return 8 * (i >> 2) + 4 * n + (i & 3); }

struct Unit { int pm, pn; };
struct Gemm { const bf16_t* A; const bf16_t* Bt; int M, N, K; };

struct StaticOrder {
    int nM, nN, nwg, G, c;
    __host__ __device__ void init(int M, int N, int G_, int c_) { nM = M / BM; nN = N / BM; nwg = nM * nN; G = G_; c = c_; }
    __host__ __device__ bool next(int i, Unit& u) const {
        const long L = (long)i * G + c; if (L >= nwg) return false;
        int wgid = (int)L; { const int q = nwg / NXCD, r = nwg % NXCD, xcd = wgid % NXCD, off = wgid / NXCD; wgid = (xcd < r ? xcd * (q + 1) : r * (q + 1) + (xcd - r) * q) + off; }
        const int nig = WGM * nN, gid = wgid / nig, fm = gid * WGM, gsz = (nM - fm) < WGM ? (nM - fm) : WGM;
        u.pm = fm + ((wgid % nig) % gsz); u.pn = (wgid % nig) / gsz; return true;
    }
    __device__ __forceinline__ void a_ready(const Unit&) const {}
    __device__ __forceinline__ void done(const Unit&) const {}
};

__device__ __forceinline__ unsigned cvt_pk_bf16(float lo, float hi) { unsigned r; asm volatile("v_cvt_pk_bf16_f32 %0, %1, %2" : "=v"(r) : "v"(lo), "v"(hi)); return r; }

constexpr int E_DM = 1024, E_DINP = 2304, E_DFF = 4096; constexpr float E_EPS = 1e-6f;
__device__ __forceinline__ float rstd16(const float* SS, int row) {
    const f32x4* p = (const f32x4*)(SS + (size_t)row * 16); const f32x4 a = (p[0] + p[1]) + (p[2] + p[3]);
    return 1.0f / sqrtf(((a[0] + a[1]) + (a[2] + a[3])) * (1.0f / E_DM) + E_EPS);
}
template <int ACT> struct EpiScaleBf16 {
    static constexpr bool PERM = true, AFTER_DRAIN = false;
    bf16_t* O; int ldc; const float* SS;
    __device__ __forceinline__ void operator()(const f32x4 (&acc)[2][2][4][2], const Unit& u, int wr, int wc, int fr, int fq) const {
        const int row0 = u.pm * BM + wr * 64 + fr, col0 = u.pn * BM + wc * 32 + 8 * fq;
#pragma unroll
        for (int ai = 0; ai < 2; ++ai)
#pragma unroll
            for (int m = 0; m < 4; ++m) { const int row = row0 + ai * HALF + m * 16; const float r = rstd16(SS, row); bf16_t* rowp = O + (size_t)row * ldc + col0;
#pragma unroll
                for (int bj = 0; bj < 2; ++bj) { f32x4 v0 = acc[ai][bj][m][0] * r, v1 = acc[ai][bj][m][1] * r;
                    if (ACT == 1) {
#pragma unroll
                        for (int i = 0; i < 4; ++i) { const float a = fmaxf(v0[i], 0.f), b = fmaxf(v1[i], 0.f); v0[i] = a * a; v1[i] = b * b; } }
                    u32x4 w; w.x = cvt_pk_bf16(v0[0], v0[1]); w.y = cvt_pk_bf16(v0[2], v0[3]); w.z = cvt_pk_bf16(v1[0], v1[1]); w.w = cvt_pk_bf16(v1[2], v1[3]);
                    *(u32x4*)(rowp + bj * HALF) = w; } }
    }
};
struct EpiRes {
    static constexpr bool PERM = false, AFTER_DRAIN = false;
    const float* base; float* out; bf16_t* XG; const float* g; float* SS; float scale;
    __device__ __forceinline__ void operator()(const f32x4 (&acc)[2][2][4][2], const Unit& u, int wr, int wc, int fr, int fq) const {
        typedef unsigned u32x2v __attribute__((ext_vector_type(2)));
        const int row0 = u.pm * BM + wr * 64 + fr, col0 = u.pn * BM + wc * 32 + 4 * fq;
        f32x4 gv[2][2];
#pragma unroll
        for (int bj = 0; bj < 2; ++bj)
#pragma unroll
            for (int n = 0; n < 2; ++n) gv[bj][n] = XG ? *(const f32x4*)(g + col0 + bj * HALF + n * 16) : (f32x4){0.f, 0.f, 0.f, 0.f};
#pragma unroll
        for (int ai = 0; ai < 2; ++ai)
#pragma unroll
            for (int m = 0; m < 4; ++m) { const int row = row0 + ai * HALF + m * 16; const size_t off = (size_t)row * E_DM + col0; float s = 0.f;
#pragma unroll
                for (int bj = 0; bj < 2; ++bj)
#pragma unroll
                    for (int n = 0; n < 2; ++n) { const f32x4 b = *(const f32x4*)(base + off + bj * HALF + n * 16); const f32x4 v = b + acc[ai][bj][m][n] * scale;
                        *(f32x4*)(out + off + bj * HALF + n * 16) = v; s += (v[0] * v[0] + v[1] * v[1]) + (v[2] * v[2] + v[3] * v[3]);
                        if (XG) { const f32x4 x = v * gv[bj][n]; u32x2v w; w.x = cvt_pk_bf16(x[0], x[1]); w.y = cvt_pk_bf16(x[2], x[3]); *(u32x2v*)(XG + off + bj * HALF + n * 16) = w; } }
                s += __shfl_xor(s, 16); s += __shfl_xor(s, 32);
                if (fq == 0) SS[(size_t)row * 16 + u.pn * 4 + wc] = s;
                if (m & 1) asm volatile("" ::: "memory"); }
    }
};

template <class Epi, class Sched, bool ALIGN_EPI = false, bool SP2 = false>
__device__ __forceinline__ void gemm_phase(PG8_LAS unsigned char* lds, const Gemm g, const Sched& S, const Epi& E) {
    const int tid = threadIdx.x, wid = __builtin_amdgcn_readfirstlane(tid >> 6), lane = tid & 63, wr = wid >> 2, wc = wid & 3, fr = lane & 15, fq = lane >> 4;
    const int K = g.K, nt = K / BK;
    unsigned voffA[2], voffB[2];
#pragma unroll
    for (int i = 0; i < 2; ++i) { int R, C; stage_rc(tid * 16 + i * 8192, R, C); const int Rb = Epi::PERM ? ((R & ~31) + perm32(R & 31)) : R;
        voffA[i] = (unsigned)(R * K + C) * 2u; voffB[i] = (unsigned)(Rb * K + C) * 2u; }
    const size_t kstep = (size_t)(BK * 2);
    const size_t hstep = (size_t)HALF * K * 2;
    const size_t tstep = 2 * hstep;
    const unsigned ldsw = (unsigned)wid * 1024u;
    const int aoff = lds_byte(wr * 64 + fr, fq * 8), boff = lds_byte(wc * 32 + fr, fq * 8);
#define PG8_SA(b, h) (((b) * 2 + (h)) * HTB)
#define PG8_SB(b, h) ((4 + (b) * 2 + (h)) * HTB)
#define PG8_STAGE(bufoff, gbase, voff) do { _Pragma("unroll") for (int _i = 0; _i < 2; ++_i) \
        __builtin_amdgcn_global_load_lds((const unsigned*)((const char*)(gbase) + (voff)[_i]), (PG8_LAS unsigned*)(lds + (bufoff) + ldsw + _i * 8192), 16, 0, 0); } while (0)
#define PG8_LDA(dst, b, h) do { _Pragma("unroll") for (int m = 0; m < 4; ++m) _Pragma("unroll") for (int k = 0; k < 2; ++k) dst[m][k] = *(const PG8_LAS bf16x8*)(lds + PG8_SA(b, h) + aoff + m * 2048 + k * 1024); } while (0)
#define PG8_LDB(dst, b, h) do { _Pragma("unroll") for (int n = 0; n < 2; ++n) _Pragma("unroll") for (int k = 0; k < 2; ++k) dst[n][k] = *(const PG8_LAS bf16x8*)(lds + PG8_SB(b, h) + boff + n * 2048 + k * 1024); } while (0)
#define PG8_MMA(ai, bj, At, Bt) do { __builtin_amdgcn_s_setprio(1); _Pragma("unroll") for (int m = 0; m < 4; ++m) _Pragma("unroll") for (int n = 0; n < 2; ++n) _Pragma("unroll") for (int k = 0; k < 2; ++k) \
        acc[ai][bj][m][n] = __builtin_amdgcn_mfma_f32_16x16x32_bf16(Bt[n][k], At[m][k], acc[ai][bj][m][n], 0, 0, 0); __builtin_amdgcn_s_setprio(0); } while (0)
#define PG8_WAIT_V(n) asm volatile("s_waitcnt vmcnt(" #n ")" ::: "memory")
#define PG8_WAIT_L(n) asm volatile("s_waitcnt lgkmcnt(" #n ")" ::: "memory")
#define PG8_BAR __builtin_amdgcn_s_barrier()
#define PG8_SCHED __builtin_amdgcn_sched_barrier(0)
    Unit cur, nxt; int ui = 0;
    if (!S.next(0, cur)) return;
    f32x4 acc[2][2][4][2];
#pragma unroll
    for (int a = 0; a < 2; ++a)
#pragma unroll
        for (int b = 0; b < 2; ++b)
#pragma unroll
            for (int m = 0; m < 4; ++m)
#pragma unroll
                for (int n = 0; n < 2; ++n) acc[a][b][m][n] = (f32x4){0.f, 0.f, 0.f, 0.f};
    bf16x8 At[4][2], B0[2][2], B1[2][2];
    const char* cA = (const char*)g.A + (size_t)cur.pm * tstep; const char* cB = (const char*)g.Bt + (size_t)cur.pn * tstep;
    S.a_ready(cur);
    if constexpr (SP2) {
        PG8_STAGE(PG8_SB(0, 0), cB, voffB); PG8_STAGE(PG8_SB(0, 1), cB + hstep, voffB); PG8_STAGE(PG8_SA(0, 0), cA, voffA); PG8_STAGE(PG8_SA(0, 1), cA + hstep, voffA);
        if (wr == 1) PG8_BAR;
        PG8_WAIT_V(2); PG8_BAR;
        PG8_STAGE(PG8_SB(1, 0), cB + kstep, voffB); PG8_STAGE(PG8_SA(1, 0), cA + kstep, voffA); PG8_STAGE(PG8_SB(1, 1), cB + hstep + kstep, voffB);
        PG8_WAIT_V(6); PG8_BAR;
    } else {
        PG8_STAGE(PG8_SB(0, 0), cB, voffB); PG8_STAGE(PG8_SA(0, 0), cA, voffA); PG8_STAGE(PG8_SB(0, 1), cB + hstep, voffB); PG8_STAGE(PG8_SA(0, 1), cA + hstep, voffA);
        if (wr == 1) PG8_BAR;
        PG8_WAIT_V(4); PG8_BAR;
        PG8_STAGE(PG8_SB(1, 0), cB + kstep, voffB); PG8_STAGE(PG8_SA(1, 0), cA + kstep, voffA); PG8_STAGE(PG8_SB(1, 1), cB + hstep + kstep, voffB);
        PG8_WAIT_V(6); PG8_BAR;
    }
    for (;;) {
        const bool has_next = S.next(ui + 1, nxt);
        const char* nA = has_next ? (const char*)g.A + (size_t)nxt.pm * tstep : cA; const char* nB = has_next ? (const char*)g.Bt + (size_t)nxt.pn * tstep : cB;
        for (int t = 0; t < nt; t += 2) {
            const bool last = (t == nt - 2);
            const char* a1 = cA + (size_t)(t + 1) * kstep;
            const char* a2 = last ? nA : cA + (size_t)(t + 2) * kstep; const char* b2 = last ? nB : cB + (size_t)(t + 2) * kstep;
            const char* a3 = a2 + kstep; const char* b3 = b2 + kstep;
            if (last && has_next) S.a_ready(nxt);
            if constexpr (SP2) {
            PG8_LDB(B0, 0, 0); PG8_LDB(B1, 0, 1); PG8_SCHED; PG8_LDA(At, 0, 0); PG8_STAGE(PG8_SA(1, 1), a1 + hstep, voffA);
            PG8_WAIT_V(8); PG8_WAIT_L(0); PG8_BAR; PG8_MMA(0, 0, At, B0); PG8_MMA(0, 1, At, B1); PG8_BAR; PG8_SCHED;
            PG8_LDA(At, 0, 1); PG8_STAGE(PG8_SB(0, 0), b2, voffB); PG8_STAGE(PG8_SB(0, 1), b2 + hstep, voffB); PG8_STAGE(PG8_SA(0, 0), a2, voffA);
            PG8_WAIT_V(8); PG8_WAIT_L(0); PG8_BAR; PG8_MMA(1, 0, At, B0); PG8_MMA(1, 1, At, B1); PG8_BAR; PG8_SCHED;
            PG8_LDB(B0, 1, 0); PG8_LDB(B1, 1, 1); PG8_SCHED; PG8_LDA(At, 1, 0); PG8_STAGE(PG8_SA(0, 1), a2 + hstep, voffA);
            PG8_WAIT_V(8); PG8_WAIT_L(0); PG8_BAR; PG8_MMA(0, 0, At, B0); PG8_MMA(0, 1, At, B1); PG8_BAR; PG8_SCHED;
            PG8_LDA(At, 1, 1); PG8_STAGE(PG8_SB(1, 0), b3, voffB); PG8_STAGE(PG8_SB(1, 1), b3 + hstep, voffB); PG8_STAGE(PG8_SA(1, 0), a3, voffA);
            PG8_WAIT_V(8); PG8_WAIT_L(0); PG8_BAR; PG8_MMA(1, 0, At, B0); PG8_MMA(1, 1, At, B1); PG8_BAR; PG8_SCHED;
            } else {
            PG8_LDB(B0, 0, 0); PG8_SCHED; PG8_LDA(At, 0, 0); PG8_STAGE(PG8_SA(1, 1), a1 + hstep, voffA);
            PG8_WAIT_L(8); PG8_BAR; PG8_WAIT_L(0); PG8_MMA(0, 0, At, B0); PG8_BAR; PG8_SCHED;
            PG8_LDB(B1, 0, 1); PG8_STAGE(PG8_SB(0, 0), b2, voffB);
            PG8_BAR; PG8_WAIT_L(0); PG8_MMA(0, 1, At, B1); PG8_BAR;
            PG8_LDA(At, 0, 1); PG8_STAGE(PG8_SA(0, 0), a2, voffA);
            PG8_BAR; PG8_WAIT_L(0); PG8_MMA(1, 0, At, B0); PG8_BAR; PG8_SCHED;
            PG8_STAGE(PG8_SB(0, 1), b2 + hstep, voffB);
            PG8_WAIT_V(6); PG8_BAR; PG8_MMA(1, 1, At, B1); PG8_BAR;
            PG8_LDB(B0, 1, 0); PG8_SCHED; PG8_LDA(At, 1, 0); PG8_STAGE(PG8_SA(0, 1), a2 + hstep, voffA);
            PG8_WAIT_L(8); PG8_BAR; PG8_WAIT_L(0); PG8_MMA(0, 0, At, B0); PG8_BAR; PG8_SCHED;
            PG8_LDB(B1, 1, 1); PG8_STAGE(PG8_SB(1, 0), b3, voffB);
            PG8_BAR; PG8_WAIT_L(0); PG8_MMA(0, 1, At, B1); PG8_BAR;
            PG8_LDA(At, 1, 1); PG8_STAGE(PG8_SA(1, 0), a3, voffA);
            PG8_BAR; PG8_WAIT_L(0); PG8_MMA(1, 0, At, B0); PG8_BAR; PG8_SCHED;
            PG8_STAGE(PG8_SB(1, 1), b3 + hstep, voffB);
            PG8_WAIT_V(6); PG8_BAR; PG8_MMA(1, 1, At, B1); PG8_BAR;
            }
        }
        if constexpr (ALIGN_EPI) { if (wr == 0) PG8_BAR; }
        if constexpr (!Epi::AFTER_DRAIN) { E(acc, cur, wr, wc, fr, fq); S.done(cur); }
        if (!has_next) break;
#pragma unroll
        for (int a = 0; a < 2; ++a)
#pragma unroll
            for (int b = 0; b < 2; ++b)
#pragma unroll
                for (int m = 0; m < 4; ++m)
#pragma unroll
                    for (int n = 0; n < 2; ++n) acc[a][b][m][n] = (f32x4){0.f, 0.f, 0.f, 0.f};
        cur = nxt; cA = nA; cB = nB; ++ui;
        if constexpr (ALIGN_EPI) { if (wr == 1) PG8_BAR; }
    }
    PG8_WAIT_V(0);
    if constexpr (!ALIGN_EPI) { if (wr == 0) PG8_BAR; }
    PG8_BAR;
    if constexpr (Epi::AFTER_DRAIN) { E.fused(acc, cur, wr, wc, fr, fq, lds, wid, lane); S.done(cur); }
#undef PG8_SA
#undef PG8_SB
#undef PG8_STAGE
#undef PG8_LDA
#undef PG8_LDB
#undef PG8_MMA
#undef PG8_WAIT_V
#undef PG8_WAIT_L
#undef PG8_BAR
#undef PG8_SCHED
}
}

constexpr int NWAVES = 8, NTHREADS = 512;
constexpr int LDS_BYTES = 163840;
constexpr int RING_OFF = 0, RING_BYTES = 131072;
constexpr int MISC_OFF = LDS_BYTES - 256;
constexpr int PH_PRO = 0, PH_PER_LAYER = 7, PH_FINAL = 1 + PH_PER_LAYER * DEPTH, NPH = PH_FINAL + 1;
constexpr int PL_WIN = 0, PL_MIX1 = 1, PL_FFT = 2, PL_FIN = 3, PL_WOUT = 4, PL_WUP = 5, PL_WDN = 6;
constexpr int CW_BAR = 4096, N_BAR_REG = 12;

#define GAS __attribute__((address_space(1)))
#define LAS __attribute__((address_space(3)))
typedef unsigned v4u __attribute__((ext_vector_type(4)));
typedef GAS unsigned gu32;
#define RLX_AGENT __ATOMIC_RELAXED, __HIP_MEMORY_SCOPE_AGENT
#define LDS_WAIT() asm volatile("s_waitcnt lgkmcnt(0)" ::: "memory")
#define VM_WAIT() asm volatile("s_waitcnt vmcnt(0)" ::: "memory")
__device__ __forceinline__ unsigned pk2(float lo, float hi) { return f2bf(lo) | (f2bf(hi) << 16); }

#define XB_TMO      128
#define XB_XCNT(j)  (256  + 64 * (j))
#define XB_XSUB(j)  (1280 + 64 * (j))
#define XB_XGEN(j)  (2304 + 64 * (j))
#define XB_TOP      3328
#define XB_TOPGEN   3392
#define XCD_BAR_WORDS 3456
#define XB_SPIN_CAP (1u << 18)

__device__ __forceinline__ unsigned xb_ld(unsigned* p)              { return __hip_atomic_load(p, __ATOMIC_RELAXED, __HIP_MEMORY_SCOPE_AGENT); }
__device__ __forceinline__ unsigned xb_add(unsigned* p, unsigned v) { return __hip_atomic_fetch_add(p, v, __ATOMIC_RELAXED, __HIP_MEMORY_SCOPE_AGENT); }
__device__ __forceinline__ unsigned xb_xcc_id() { return (unsigned)__builtin_amdgcn_s_getreg((3 << 11) | 20) & 0xFu; }
#define XB_SPIN(cond, bar) do { unsigned _sp = 0; while (cond) { __builtin_amdgcn_s_sleep(1); \
    if ((++_sp & 255u) == 0u) { if (xb_ld(&(bar)[XB_TMO])) break; if (_sp > XB_SPIN_CAP) { atomicAdd(&(bar)[XB_TMO], 1u); break; } } } } while (0)

struct XcdBarrier {
    unsigned* bar; unsigned x;
    volatile LAS unsigned* st;
};

__device__ __forceinline__ XcdBarrier xcd_barrier_post(unsigned* bar, volatile LAS unsigned* st) {
    XcdBarrier b; b.bar = bar; b.x = xb_xcc_id(); b.st = st;
    if (threadIdx.x == 0) (void)xb_add(&bar[XB_XCNT(b.x)], 1u);
    return b;
}
__device__ __forceinline__ void xcd_barrier_complete(unsigned* bar, unsigned x, unsigned& nloc, unsigned& nx) {
    const unsigned G = gridDim.x * gridDim.y * gridDim.z;
    unsigned sum, cnt, mine, sp = 0u;
    for (;;) {
        sum = 0u; cnt = 0u; mine = 0u;
#pragma unroll
        for (unsigned j = 0; j < 16; ++j) { const unsigned c = xb_ld(&bar[XB_XCNT(j)]); sum += c; cnt += (c > 0u) ? 1u : 0u; mine = (j == x) ? c : mine; }
        if (sum == G) break;
        __builtin_amdgcn_s_sleep(1);
        if ((++sp & 255u) == 0u) { if (xb_ld(&bar[XB_TMO])) break; if (sp > XB_SPIN_CAP) { atomicAdd(&bar[XB_TMO], 1u); break; } }
    }
    nloc = mine > 0u ? mine : 1u; nx = cnt > 0u ? cnt : 1u;
}

__device__ __forceinline__ void xcd_barrier(const XcdBarrier& b) {
    asm volatile("s_waitcnt vmcnt(0)" ::: "memory");
    __syncthreads();
    if (threadIdx.x == 0) {
        unsigned* bar = b.bar;
        __builtin_amdgcn_s_waitcnt(0);
        unsigned nloc = b.st[0], nx = b.st[1];
        if (nloc == 0u) { xcd_barrier_complete(bar, b.x, nloc, nx); b.st[0] = nloc; b.st[1] = nx; }
        const unsigned old = xb_add(&bar[XB_XSUB(b.x)], 1u);
        const unsigned gen = old / nloc;
        if (old + 1u == (gen + 1u) * nloc) {
            __builtin_amdgcn_fence(__ATOMIC_RELEASE, "agent");
            asm volatile("s_waitcnt vmcnt(0)" ::: "memory");
            const unsigned og = xb_add(&bar[XB_TOP], 1u);
            const unsigned tg = og / nx;
            if (og + 1u == (tg + 1u) * nx) xb_add(&bar[XB_TOPGEN], 1u);
            else XB_SPIN(xb_ld(&bar[XB_TOPGEN]) == tg, bar);
            __builtin_amdgcn_fence(__ATOMIC_ACQUIRE, "agent");
            xb_add(&bar[XB_XGEN(b.x)], 1u);
            asm volatile("s_waitcnt vmcnt(0)" ::: "memory");
        } else {
            XB_SPIN(xb_ld(&bar[XB_XGEN(b.x)]) == gen, bar);
            __builtin_amdgcn_fence(__ATOMIC_ACQUIRE, "agent");
            asm volatile("s_waitcnt vmcnt(0)" ::: "memory");
        }
    }
    __syncthreads();
}

constexpr size_t WS_ZT = WS_SCR, WS_X0T = WS_SCR + 8 * MiB, WS_YCT = WS_SCR + 16 * MiB;
constexpr size_t WS_TW = WS_ROPE + 256 * 1024;
namespace hy {
typedef float cf __attribute__((ext_vector_type(2)));
__device__ __forceinline__ cf cmul(cf a, cf b) { return {a.x * b.x - a.y * b.y, a.x * b.y + a.y * b.x}; }
__device__ __forceinline__ cf cmulc(cf a, cf b) { return {a.x * b.x + a.y * b.y, a.y * b.x - a.x * b.y}; }
__device__ __forceinline__ cf cadd(cf a, cf b) { return {a.x + b.x, a.y + b.y}; }
__device__ __forceinline__ cf csub(cf a, cf b) { return {a.x - b.x, a.y - b.y}; }
__device__ __forceinline__ int pidx(int i) { return i + (i >> 5); }
constexpr int FBUF = 8192 + 256;
template <bool INV> __device__ __forceinline__ cf tw16(cf d, int K) {
    float c, s;
    switch (K) {
        case 0: return d;
        case 4: return INV ? cf{-d.y, d.x} : cf{d.y, -d.x};
        case 1: c = 0.92387953251128674f; s = 0.38268343236508977f; break;
        case 2: c = 0.70710678118654752f; s = 0.70710678118654752f; break;
        case 3: c = 0.38268343236508977f; s = 0.92387953251128674f; break;
        case 5: c = -0.38268343236508977f; s = 0.92387953251128674f; break;
        case 6: c = -0.70710678118654752f; s = 0.70710678118654752f; break;
        default: c = -0.92387953251128674f; s = 0.38268343236508977f; break;
    }
    const cf w = {c, INV ? s : -s};
    return cmul(d, w);
}
template <int H, bool INV> __device__ __forceinline__ void stage16(cf (&v)[16]) {
#pragma unroll
    for (int blk = 0; blk < 16; blk += 2 * H)
#pragma unroll
        for (int j = 0; j < H; ++j) {
            if (!INV) { const cf a = v[blk + j], b = v[blk + j + H]; v[blk + j] = cadd(a, b); v[blk + j + H] = tw16<false>(csub(a, b), j * (8 / H)); }
            else { const cf A = v[blk + j], B = tw16<true>(v[blk + j + H], j * (8 / H)); v[blk + j] = cadd(A, B); v[blk + j + H] = csub(A, B); }
        }
}
template <bool INV> __device__ __forceinline__ void dft16(cf (&v)[16]) {
    if (!INV) { stage16<8, false>(v); stage16<4, false>(v); stage16<2, false>(v); stage16<1, false>(v); }
    else { stage16<1, true>(v); stage16<2, true>(v); stage16<4, true>(v); stage16<8, true>(v); }
}
__device__ __forceinline__ constexpr int br4(int r) { return ((r & 1) << 3) | ((r & 2) << 1) | ((r & 4) >> 1) | ((r & 8) >> 3); }
template <bool INV, int LSL> __device__ __forceinline__ void pass16(LAS cf* buf, int tid, const cf* __restrict__ TW) {
    constexpr int SH = LSL - 4, st = 1 << SH;
    asm volatile("" : "+v"(tid));
    const int sub = tid >> SH, n2 = tid & (st - 1), base = (sub << LSL) + n2;
    cf v[16];
#pragma unroll
    for (int r = 0; r < 16; ++r) v[r] = buf[pidx(base + r * st)];
    cf wp[16];
    wp[1] = TW[n2 << (13 - LSL)];
    asm volatile("" : "+v"(wp[1].x), "+v"(wp[1].y));
    wp[2] = cmul(wp[1], wp[1]); wp[4] = cmul(wp[2], wp[2]); wp[8] = cmul(wp[4], wp[4]);
    wp[3] = cmul(wp[2], wp[1]); wp[5] = cmul(wp[4], wp[1]); wp[6] = cmul(wp[4], wp[2]); wp[7] = cmul(wp[4], wp[3]);
    wp[9] = cmul(wp[8], wp[1]); wp[10] = cmul(wp[8], wp[2]); wp[11] = cmul(wp[8], wp[3]); wp[12] = cmul(wp[8], wp[4]);
    wp[13] = cmul(wp[8], wp[5]); wp[14] = cmul(wp[8], wp[6]); wp[15] = cmul(wp[8], wp[7]);
    if (!INV) {
        dft16<false>(v);
#pragma unroll
        for (int r = 1; r < 16; ++r) v[r] = cmul(v[r], wp[br4(r)]);
    } else {
#pragma unroll
        for (int r = 1; r < 16; ++r) v[r] = cmulc(v[r], wp[br4(r)]);
        dft16<true>(v);
    }
#pragma unroll
    for (int r = 0; r < 16; ++r) buf[pidx(base + r * st)] = v[r];
}
template <bool MUL> __device__ __forceinline__ void mid2(LAS cf* D, const LAS cf* Hs, int tid) {
    asm volatile("" : "+v"(tid));
#pragma unroll
    for (int e = 0; e < 8; ++e) { const int i = 16 * tid + 2 * e; const cf a = D[pidx(i)], b = D[pidx(i + 1)]; cf A = cadd(a, b), B = csub(a, b);
        if (MUL) { A = cmul(A, Hs[pidx(i)]); B = cmul(B, Hs[pidx(i + 1)]); D[pidx(i)] = cadd(A, B); D[pidx(i + 1)] = csub(A, B); }
        else { D[pidx(i)] = A; D[pidx(i + 1)] = B; } }
}
#define HY_SYNC() __syncthreads()
__device__ __forceinline__ void fft_unit(LAS unsigned char* lds, int c, int tid, const float* __restrict__ HFT_l, const cf* __restrict__ TW, const bf16_t* __restrict__ ZT, const bf16_t* __restrict__ X0T,
                                         bf16_t* __restrict__ YCT, float bias) {
    asm volatile("" : "+v"(tid));
    LAS cf* D = (LAS cf*)lds; LAS cf* Hs = D + FBUF;
    const float* hsrc = HFT_l + (size_t)c * 8192;
#pragma unroll
    for (int k = 0; k < 16; ++k) { const int i = k * 512 + tid; Hs[pidx(i)] = cf{hsrc[i], 0.f}; }
    HY_SYNC();
    pass16<false, 13>(Hs, tid, TW); HY_SYNC();
    pass16<false, 9>(Hs, tid, TW); HY_SYNC();
    pass16<false, 5>(Hs, tid, TW); HY_SYNC();
    mid2<false>(Hs, Hs, tid); HY_SYNC();
    for (int pr = 0; pr < 2; ++pr) {
        const size_t o0 = ((size_t)(2 * pr) * DC + c) * SL, o1 = ((size_t)(2 * pr + 1) * DC + c) * SL;
#pragma unroll
        for (int k = 0; k < 8; ++k) { const int i = k * 512 + tid; D[pidx(i)] = cf{bf2f(ZT[o0 + i]), bf2f(ZT[o1 + i])}; D[pidx(i + 4096)] = cf{0.f, 0.f}; }
        HY_SYNC();
        pass16<false, 13>(D, tid, TW); HY_SYNC();
        pass16<false, 9>(D, tid, TW); HY_SYNC();
        pass16<false, 5>(D, tid, TW); HY_SYNC();
        mid2<true>(D, Hs, tid); HY_SYNC();
        pass16<true, 5>(D, tid, TW); HY_SYNC();
        pass16<true, 9>(D, tid, TW); HY_SYNC();
        pass16<true, 13>(D, tid, TW); HY_SYNC();
#pragma unroll
        for (int k = 0; k < 8; ++k) { const int i = k * 512 + tid; const cf y = D[pidx(i)];
            const float z0 = bf2f(ZT[o0 + i]), z1 = bf2f(ZT[o1 + i]), a0 = bf2f(X0T[o0 + i]), a1 = bf2f(X0T[o1 + i]);
            YCT[o0 + i] = (bf16_t)f2bf((y.x * (1.f / 8192.f) + z0 * bias) * a0); YCT[o1 + i] = (bf16_t)f2bf((y.y * (1.f / 8192.f) + z1 * bias) * a1); }
        HY_SYNC();
    }
}
constexpr int HP_ROWB = 1540;
__device__ __forceinline__ void hyprep_unit(LAS unsigned char* lds, int unit, int tid, const bf16_t* __restrict__ P, const float* __restrict__ cw, const float* __restrict__ cb,
                                            bf16_t* __restrict__ ZT, bf16_t* __restrict__ X0T) {
    asm volatile("" : "+v"(tid));
    const int b = unit >> 6, t0 = (unit & 63) * 64; const size_t m0 = (size_t)b * SL + t0;
    LAS float* CWL = (LAS float*)(lds + 101648);
    __syncthreads();
#pragma unroll
    for (int hb = 0; hb < 2; ++hb) { uint4 sv[7];
#pragma unroll
        for (int q = 0; q < 7; ++q) { const int i = tid + (hb * 7 + q) * NTHREADS, r = i / 96, ch8 = i % 96, t = t0 - 1 + r; const bool inb = (i < 66 * 96) && t >= 0 && t < SL;
            sv[q] = *(const uint4*)(P + (inb ? ((m0 + r - 1) * DINP + P_CU + ch8 * 8) : (m0 * DINP + P_CU))); if (!inb) sv[q] = make_uint4(0u, 0u, 0u, 0u); }
#pragma unroll
        for (int q = 0; q < 7; ++q) { const int i = tid + (hb * 7 + q) * NTHREADS, r = i / 96, ch8 = i % 96;
            if (i < 66 * 96) { LAS unsigned* d = (LAS unsigned*)(lds + r * HP_ROWB + ch8 * 16); d[0] = sv[q].x; d[1] = sv[q].y; d[2] = sv[q].z; d[3] = sv[q].w; } } }
    for (int i = tid; i < 4 * 768; i += NTHREADS) CWL[i] = (i < 3 * 768) ? cw[i] : cb[i - 3 * 768];
    __syncthreads();
    const int tok = tid & 63, wv = tid >> 6;
    for (int j = 0; j < 32; ++j) { const int c = wv * 32 + j; float u[3];
#pragma unroll
        for (int part = 0; part < 3; ++part) { const int ch = part * DC + c; float a = CWL[3 * 768 + ch];
#pragma unroll
            for (int k = 0; k < 3; ++k) a += CWL[k * 768 + ch] * bf2f(*(const LAS bf16_t*)(lds + (tok + k) * HP_ROWB + ch * 2));
            u[part] = a; }
        const size_t o = ((size_t)b * DC + c) * SL + t0 + tok;
        ZT[o] = (bf16_t)f2bf(u[2] * u[1]); X0T[o] = (bf16_t)f2bf(u[0]); }
    __syncthreads();
}
__device__ __forceinline__ void filter_unit(LAS unsigned char* lds, int tb, int tid, const float* __restrict__ w1, const float* __restrict__ b1, const float* __restrict__ freq,
                                            const float* __restrict__ w2, const float* __restrict__ b2, const float* __restrict__ w3, float* __restrict__ HFT_l) {
    asm volatile("" : "+v"(tid));
    LAS float* Z = (LAS float*)lds;
    LAS float* H1T = Z + 32 * 36;
    LAS float* H2T = H1T + 64 * 32;
    const int t0 = tb * 32;
    __syncthreads();
    {   const int pos = tid >> 4, f = tid & 15, t = t0 + pos;
        const double fb = 1e-4 + (double)f * ((15.0 - 1e-4) / 15.0), w = 6.283185307179586476925286766559 * (double)t / (double)SL;
        Z[pos * 36 + 1 + f] = (float)cos(fb * w); Z[pos * 36 + 17 + f] = (float)(-sin(fb * w));
        if (f == 0) Z[pos * 36] = (float)((double)t / (double)(SL - 1)); }
    __syncthreads();
    {   const int j = tid & 63; const float fj = freq[j], bj = b1[j];
#pragma unroll
        for (int q = 0; q < 4; ++q) { const int pos = (tid >> 6) + 8 * q; float a = bj;
            for (int i = 0; i < HY_EMB; ++i) a += Z[pos * 36 + i] * w1[i * HY_W + j];
            H1T[j * 32 + pos] = sinf(fj * a); } }
    __syncthreads();
    {   const int j = tid & 63; const float fj = freq[j], bj = b2[j];
#pragma unroll
        for (int q = 0; q < 4; ++q) { const int pos = (tid >> 6) + 8 * q; float a = bj;
            for (int i = 0; i < HY_W; ++i) a += H1T[i * 32 + pos] * w2[i * HY_W + j];
            H2T[j * 32 + pos] = sinf(fj * a); } }
    __syncthreads();
    {   const int o = tid, c = o & 255, dir = o >> 8;
        float acc[32];
#pragma unroll
        for (int p = 0; p < 32; ++p) acc[p] = 0.f;
        for (int i = 0; i < HY_W; ++i) { const float w = w3[i * 2 * DC + o];
#pragma unroll
            for (int p4 = 0; p4 < 8; ++p4) { const f32x4 h = *(const LAS f32x4*)(H2T + i * 32 + p4 * 4);
                acc[4 * p4] += h[0] * w; acc[4 * p4 + 1] += h[1] * w; acc[4 * p4 + 2] += h[2] * w; acc[4 * p4 + 3] += h[3] * w; } }
        const double mind = log(1e-2) / 1.5, maxd = log(1e-2) / 0.3;
        const float delta = fabsf((float)(mind + (maxd - mind) * (double)c / 255.0));
#pragma unroll
        for (int p = 0; p < 32; ++p) { const int t = t0 + p; const float tt = (float)((double)t / (double)(SL - 1)); acc[p] *= __builtin_amdgcn_exp2f(-1.4426950408889634f * tt * delta); }
        float* row = HFT_l + (size_t)c * 8192;
        if (dir == 0) {
#pragma unroll
            for (int p4 = 0; p4 < 8; ++p4) *(f32x4*)(row + t0 + 4 * p4) = (f32x4){acc[4 * p4], acc[4 * p4 + 1], acc[4 * p4 + 2], acc[4 * p4 + 3]};
            if (t0 == 0) row[4096] = 0.f;
        } else {
#pragma unroll
            for (int p = 0; p < 32; ++p) if (t0 + p > 0) row[8192 - t0 - p] = acc[p];
        } }
}
}

constexpr size_t WS_AO = 222 * MiB;
namespace at {
typedef short v4i16_t __attribute__((ext_vector_type(4)));
constexpr int KROW = 144, NKEY = 400, V_OFF = NKEY * KROW;
__device__ __forceinline__ float blo(unsigned u) { return __builtin_bit_cast(float, u << 16); }
__device__ __forceinline__ float bhi(unsigned u) { return __builtin_bit_cast(float, u & 0xffff0000u); }
__device__ __forceinline__ void rope16(uint4& A, uint4& B, const float* __restrict__ cs, float scale) {
    const f32x4 c0 = *(const f32x4*)cs, c1 = *(const f32x4*)(cs + 4), s0 = *(const f32x4*)(cs + 8), s1 = *(const f32x4*)(cs + 12);
    const float c[8] = {c0[0], c0[1], c0[2], c0[3], c1[0], c1[1], c1[2], c1[3]}, s[8] = {s0[0], s0[1], s0[2], s0[3], s1[0], s1[1], s1[2], s1[3]};
    unsigned a[4] = {A.x, A.y, A.z, A.w}, b[4] = {B.x, B.y, B.z, B.w};
#pragma unroll
    for (int d = 0; d < 4; ++d) {
        const float t1l = blo(a[d]), t1h = bhi(a[d]), t2l = blo(b[d]), t2h = bhi(b[d]);
        const float o1l = (t1l * c[2 * d] - t2l * s[2 * d]) * scale, o1h = (t1h * c[2 * d + 1] - t2h * s[2 * d + 1]) * scale;
        const float o2l = (t2l * c[2 * d] + t1l * s[2 * d]) * scale, o2h = (t2h * c[2 * d + 1] + t1h * s[2 * d + 1]) * scale;
        a[d] = f2bf(o1l) | (f2bf(o1h) << 16); b[d] = f2bf(o2l) | (f2bf(o2h) << 16);
    }
    A = make_uint4(a[0], a[1], a[2], a[3]); B = make_uint4(b[0], b[1], b[2], b[3]);
}
__device__ __forceinline__ void rope16s(uint4& A, uint4& B, const float (&cs)[16], float scale) {
    unsigned a[4] = {A.x, A.y, A.z, A.w}, b[4] = {B.x, B.y, B.z, B.w};
#pragma unroll
    for (int d = 0; d < 4; ++d) {
        const float t1l = blo(a[d]), t1h = bhi(a[d]), t2l = blo(b[d]), t2h = bhi(b[d]);
        const float o1l = (t1l * cs[2 * d] - t2l * cs[8 + 2 * d]) * scale, o1h = (t1h * cs[2 * d + 1] - t2h * cs[8 + 2 * d + 1]) * scale;
        const float o2l = (t2l * cs[2 * d] + t1l * cs[8 + 2 * d]) * scale, o2h = (t2h * cs[2 * d + 1] + t1h * cs[8 + 2 * d + 1]) * scale;
        a[d] = f2bf(o1l) | (f2bf(o1h) << 16); b[d] = f2bf(o2l) | (f2bf(o2h) << 16);
    }
    A = make_uint4(a[0], a[1], a[2], a[3]); B = make_uint4(b[0], b[1], b[2], b[3]);
}
__device__ __forceinline__ unsigned scale2(unsigned u, float sc) { return f2bf(blo(u) * sc) | (f2bf(bhi(u) * sc) << 16); }
__device__ __forceinline__ void attn_unit(LAS unsigned char* lds, int unit, int tid, const bf16_t* __restrict__ P, const float* __restrict__ rope, const float* __restrict__ sink_l, bf16_t* __restrict__ AO) {
    asm volatile("" : "+v"(tid));
    const int b = unit >> 6, kvh = (unit >> 5) & 1, q0 = (unit & 31) * 128, W0 = q0 - 128;
    const size_t m0 = (size_t)b * SL;
    const int lane = tid & 63, wave = __builtin_amdgcn_readfirstlane(tid >> 6), i = lane & 15, g = lane >> 4;
    __syncthreads();
    {   uint4 va[6], vb[6];
#pragma unroll
        for (int q = 0; q < 6; ++q) { const int j = tid + q * NTHREADS; const bool isV = j >= 1200; const int jj = isV ? j - 1200 : j, kk = isV ? (jj >> 2) : (jj / 3), ch = isV ? (jj & 3) : (1 + jj % 3), pos = W0 + kk;
            const bool inb = (j < 2800) && pos >= 0 && pos < SL;
            const bf16_t* src = P + (inb ? ((m0 + pos) * DINP + (isV ? P_V : P_K) + kvh * HD + ch * 16) : (m0 * DINP + P_K));
            va[q] = *(const uint4*)src; vb[q] = *(const uint4*)(src + 8); if (!inb) { va[q] = make_uint4(0u, 0u, 0u, 0u); vb[q] = va[q]; } }
        uint4 ra = make_uint4(0u, 0u, 0u, 0u), rb = ra; f32x4 rc[4];
        {   const int pos = W0 + tid; const bool inb = (tid < NKEY) && pos >= 0 && pos < SL; const int pc = inb ? pos : 0;
            const bf16_t* src = P + (m0 + pc) * DINP + P_K + kvh * HD; ra = *(const uint4*)src; rb = *(const uint4*)(src + 8);
#pragma unroll
            for (int q = 0; q < 4; ++q) rc[q] = *(const f32x4*)(rope + pc * 16 + 4 * q);
            float cs[16];
#pragma unroll
            for (int q = 0; q < 16; ++q) cs[q] = rc[q >> 2][q & 3];
            rope16s(ra, rb, cs, 1.0f);
            if (!inb) { ra = make_uint4(0u, 0u, 0u, 0u); rb = ra; } }
#pragma unroll
        for (int q = 0; q < 6; ++q) { const int j = tid + q * NTHREADS; const bool isV = j >= 1200; const int jj = isV ? j - 1200 : j, kk = isV ? (jj >> 2) : (jj / 3), ch = isV ? (jj & 3) : (1 + jj % 3);
            if (j < 2800) { LAS unsigned char* dst = lds + (isV ? V_OFF : 0) + kk * KROW + ch * 32;
                *(LAS v4u*)dst = (v4u){va[q].x, va[q].y, va[q].z, va[q].w}; *(LAS v4u*)(dst + 16) = (v4u){vb[q].x, vb[q].y, vb[q].z, vb[q].w}; } }
        if (tid < NKEY) { LAS unsigned char* dst = lds + tid * KROW; *(LAS v4u*)dst = (v4u){ra.x, ra.y, ra.z, ra.w}; *(LAS v4u*)(dst + 16) = (v4u){rb.x, rb.y, rb.z, rb.w}; }
    }
    __syncthreads();
    const bool edge = (q0 == 0) || (q0 == SL - 128);
#pragma unroll 1
    for (int gi = 0; gi < 3; ++gi) {
        const int grp = wave * 3 + gi, hl = grp >> 3, qsub = grp & 7, head = kvh * 3 + hl;
        const int tok = q0 + 16 * qsub + i;
        bf16x8 qf[2];
        {   const bf16_t* qp = P + (m0 + tok) * DINP + P_Q + head * HD + g * 8;
            uint4 own = *(const uint4*)qp, hi2 = *(const uint4*)(qp + 32);
            uint4 oth; oth.x = __shfl_xor(own.x, 16); oth.y = __shfl_xor(own.y, 16); oth.z = __shfl_xor(own.z, 16); oth.w = __shfl_xor(own.w, 16);
            uint4 t1 = (g == 0) ? own : oth, t2 = (g == 0) ? oth : own;
            rope16(t1, t2, rope + tok * 16, 0.125f);
            uint4 r0;
            if (g == 0) r0 = t1; else if (g == 1) r0 = t2; else r0 = make_uint4(scale2(own.x, 0.125f), scale2(own.y, 0.125f), scale2(own.z, 0.125f), scale2(own.w, 0.125f));
            hi2 = make_uint4(scale2(hi2.x, 0.125f), scale2(hi2.y, 0.125f), scale2(hi2.z, 0.125f), scale2(hi2.w, 0.125f));
            qf[0] = __builtin_bit_cast(bf16x8, r0); qf[1] = __builtin_bit_cast(bf16x8, hi2); }
        f32x4 st[17];
        const LAS unsigned char* kb = lds + (16 * qsub + i) * KROW + g * 16;
#pragma unroll
        for (int tt = 0; tt < 17; ++tt) {
            const bf16x8 k0 = *(const LAS bf16x8*)(kb + tt * 16 * KROW), k1 = *(const LAS bf16x8*)(kb + tt * 16 * KROW + 64);
            f32x4 acc = __builtin_amdgcn_mfma_f32_16x16x32_bf16(k0, qf[0], (f32x4){0.f, 0.f, 0.f, 0.f}, 0, 0, 0);
            st[tt] = __builtin_amdgcn_mfma_f32_16x16x32_bf16(k1, qf[1], acc, 0, 0, 0);
        }
        const float NEGF = -1e30f;
#pragma unroll
        for (int r = 0; r < 4; ++r) { if (4 * g + r < i) st[0][r] = NEGF; if (4 * g + r > i) st[16][r] = NEGF; }
        if (edge) {
#pragma unroll
            for (int tt = 0; tt < 17; ++tt)
#pragma unroll
                for (int r = 0; r < 4; ++r) { const int pos = W0 + 16 * (qsub + tt) + 4 * g + r; if (pos < 0 || pos >= SL) st[tt][r] = NEGF; }
        }
        const float sk = sink_l[head];
        float mx = sk;
#pragma unroll
        for (int tt = 0; tt < 17; ++tt) mx = fmaxf(fmaxf(mx, fmaxf(st[tt][0], st[tt][1])), fmaxf(st[tt][2], st[tt][3]));
        mx = fmaxf(mx, __shfl_xor(mx, 16)); mx = fmaxf(mx, __shfl_xor(mx, 32));
        const float L2E = 1.4426950408889634f, mb = mx * L2E;
        float lsum = 0.f;
        bf16x8 pf[9];
#pragma unroll
        for (int s = 0; s < 9; ++s) {
            float p[8];
#pragma unroll
            for (int r = 0; r < 4; ++r) { p[r] = __builtin_amdgcn_exp2f(st[2 * s][r] * L2E - mb); p[4 + r] = (2 * s + 1 < 17) ? __builtin_amdgcn_exp2f(st[(2 * s + 1 < 17) ? 2 * s + 1 : 16][r] * L2E - mb) : 0.f; }
#pragma unroll
            for (int r = 0; r < 8; ++r) lsum += p[r];
            uint4 w; w.x = f2bf(p[0]) | (f2bf(p[1]) << 16); w.y = f2bf(p[2]) | (f2bf(p[3]) << 16); w.z = f2bf(p[4]) | (f2bf(p[5]) << 16); w.w = f2bf(p[6]) | (f2bf(p[7]) << 16);
            pf[s] = __builtin_bit_cast(bf16x8, w);
        }
        lsum += __shfl_xor(lsum, 16); lsum += __shfl_xor(lsum, 32);
        lsum += __builtin_amdgcn_exp2f(sk * L2E - mb);
        const float rl = 1.0f / lsum;
        const LAS unsigned char* vb = lds + V_OFF + (16 * qsub + 4 * g + (i >> 2)) * KROW + (i & 3) * 8;
        bf16_t* op = AO + (m0 + tok) * DBB + head * HD + 4 * g;
#pragma unroll
        for (int dt = 0; dt < 4; ++dt) {
            f32x4 o = (f32x4){0.f, 0.f, 0.f, 0.f};
#pragma unroll
            for (int s = 0; s < 9; ++s) {
                const v4i16_t lo = __builtin_amdgcn_ds_read_tr16_b64_v4i16((LAS v4i16_t*)(vb + (32 * s) * KROW + dt * 32));
                const v4i16_t hi = __builtin_amdgcn_ds_read_tr16_b64_v4i16((LAS v4i16_t*)(vb + (32 * s + 16) * KROW + dt * 32));
                const bf16x8 vf = (bf16x8){lo[0], lo[1], lo[2], lo[3], hi[0], hi[1], hi[2], hi[3]};
                o = __builtin_amdgcn_mfma_f32_16x16x32_bf16(vf, pf[s], o, 0, 0, 0);
            }
            uint2 w; w.x = f2bf(o[0] * rl) | (f2bf(o[1] * rl) << 16); w.y = f2bf(o[2] * rl) | (f2bf(o[3] * rl) << 16);
            *(uint2*)(op + dt * 16) = w;
        }
    }
}
}

constexpr size_t WS_AGG = 234 * MiB;
constexpr size_t WS_LW = WS_ROPE + 512 * 1024;
namespace lru {
constexpr int AXROW = 784, XCROW = 784, XC_OFF = 67 * AXROW, CARRY_OFF = XC_OFF + 64 * XCROW, SSQ_OFF = CARRY_OFF + 2 * DA * 4, RSTD_OFF = SSQ_OFF + 64 * 24 * 4;
__device__ __forceinline__ float fsig(float x) { return __builtin_amdgcn_rcpf(1.0f + __builtin_amdgcn_exp2f(-1.4426950408889634f * x)); }
__device__ __forceinline__ float fgelu(float x) { const float u = 0.7978845608028654f * (x + 0.044715f * x * x * x); const float e = __builtin_amdgcn_exp2f(2.8853900817779268f * u);
    const float th = 1.0f - 2.0f * __builtin_amdgcn_rcpf(1.0f + e); return 0.5f * x * (1.0f + th); }
template <int CTRL> __device__ __forceinline__ float dppf(float v) { return __builtin_bit_cast(float, __builtin_amdgcn_update_dpp(0, __builtin_bit_cast(int, v), CTRL, 0xf, 0xf, true)); }
__device__ __forceinline__ float row16_sum(float v) { v += dppf<0xB1>(v); v += dppf<0x4E>(v); v += dppf<0x141>(v); v += dppf<0x140>(v); return v; }
template <bool FIN>
__device__ __forceinline__ void lru_unit(LAS unsigned char* lds, int unit, int tid, const bf16_t* __restrict__ P, const float* __restrict__ cw, const float* __restrict__ cb, const bf16_t* __restrict__ LW_l,
                                         const float* __restrict__ ba, const float* __restrict__ bx, const float* __restrict__ lam, float* __restrict__ AGG, const float* __restrict__ gn, bf16_t* __restrict__ YN) {
    asm volatile("" : "+v"(tid));
    const int b = unit >> 6, kc = unit & 63, t0 = kc * 64; const size_t m0 = (size_t)b * SL + t0;
    const int lane = tid & 63, wave = __builtin_amdgcn_readfirstlane(tid >> 6), li_ = lane & 15, g_ = lane >> 4;
    LAS unsigned char* AX = lds; LAS unsigned char* XC = lds + XC_OFF; LAS float* CARRY = (LAS float*)(lds + CARRY_OFF); LAS float* SSQ = (LAS float*)(lds + SSQ_OFF); LAS float* RSTD = (LAS float*)(lds + RSTD_OFF);
    __syncthreads();
    {   uint4 sv[7];
#pragma unroll
        for (int q = 0; q < 7; ++q) { const int it = tid + q * NTHREADS, r = it / 48, c8 = it % 48, t = t0 - 2 + r; const bool inb = (it < 67 * 48) && t >= 0 && t < SL;
            sv[q] = *(const uint4*)(P + (inb ? ((m0 + r - 2) * DINP + P_AX + c8 * 8) : (m0 * DINP + P_AX))); if (!inb) sv[q] = make_uint4(0u, 0u, 0u, 0u); }
#pragma unroll
        for (int q = 0; q < 7; ++q) { const int it = tid + q * NTHREADS, r = it / 48, c8 = it % 48;
            if (it < 67 * 48) *(LAS v4u*)(AX + r * AXROW + c8 * 16) = (v4u){sv[q].x, sv[q].y, sv[q].z, sv[q].w}; } }
    if (FIN) { if (tid < DA) { const int ch = tid; const float* ag = AGG + (size_t)b * 64 * 4 * DA + ch;
        float hf = 0.f, hb = 0.f;
#pragma unroll 16
        for (int j = 0; j < 64; ++j) { const float A = ag[(size_t)j * 4 * DA], B = ag[(size_t)j * 4 * DA + DA]; const bool on = j < kc; hf = (on ? A : 1.f) * hf + (on ? B : 0.f); }
#pragma unroll 16
        for (int j = 63; j >= 0; --j) { const float A = ag[(size_t)j * 4 * DA + 2 * DA], B = ag[(size_t)j * 4 * DA + 3 * DA]; const bool on = j > kc; hb = (on ? A : 1.f) * hb + (on ? B : 0.f); }
        CARRY[ch] = hf; CARRY[DA + ch] = hb; } }
    __syncthreads();
    if (tid < 384) { const int c8 = tid % 48, tg = tid / 48, ch0 = c8 * 8;
        float w[4][8], bb[8];
#pragma unroll
        for (int e = 0; e < 8; ++e) { bb[e] = cb[ch0 + e];
#pragma unroll
            for (int k = 0; k < 4; ++k) w[k][e] = cw[k * DA + ch0 + e]; }
        for (int q = 0; q < 8; ++q) { const int tok = tg * 8 + q; float acc[8];
#pragma unroll
            for (int e = 0; e < 8; ++e) acc[e] = bb[e];
#pragma unroll
            for (int k = 0; k < 4; ++k) { const v4u v = *(const LAS v4u*)(AX + (tok + k) * AXROW + c8 * 16);
#pragma unroll
                for (int d = 0; d < 4; ++d) { acc[2 * d] += w[k][2 * d] * at::blo(v[d]); acc[2 * d + 1] += w[k][2 * d + 1] * at::bhi(v[d]); } }
            *(LAS v4u*)(XC + tok * XCROW + c8 * 16) = (v4u){pk2(acc[0], acc[1]), pk2(acc[2], acc[3]), pk2(acc[4], acc[5]), pk2(acc[6], acc[7])}; }
    }
    __syncthreads();
    float yk[3][4][4];
#pragma unroll
    for (int rd = 0; rd < 3; ++rd) {
        asm volatile("" ::: "memory"); __builtin_amdgcn_sched_barrier(0);
        int li = li_, g = g_; asm volatile("" : "+v"(li), "+v"(g));
        const int h = 2 * rd + (wave >> 2), ct = wave & 3, ch = 64 * h + 16 * ct + li;
        bf16_t gt[4][4];
        if (FIN) {
#pragma unroll
            for (int mt = 0; mt < 4; ++mt)
#pragma unroll
                for (int r = 0; r < 4; ++r) gt[mt][r] = P[(m0 + 16 * mt + 4 * g + r) * DINP + P_AG + ch]; }
        f32x4 acc[4][4];
        {   bf16x8 af[4][2], bfr[4][2];
#pragma unroll
            for (int mt = 0; mt < 4; ++mt)
#pragma unroll
                for (int ks = 0; ks < 2; ++ks) af[mt][ks] = *(const LAS bf16x8*)(XC + (16 * mt + li) * XCROW + (64 * h + 32 * ks + 8 * g) * 2);
#pragma unroll
            for (int mat = 0; mat < 4; ++mat)
#pragma unroll
                for (int ks = 0; ks < 2; ++ks) bfr[mat][ks] = *(const bf16x8*)(LW_l + ((size_t)((h * 4 + mat) * 64 + 16 * ct + li)) * 64 + 32 * ks + 8 * g);
#pragma unroll
            for (int mat = 0; mat < 4; ++mat)
#pragma unroll
                for (int mt = 0; mt < 4; ++mt) { f32x4 c = __builtin_amdgcn_mfma_f32_16x16x32_bf16(af[mt][0], bfr[mat][0], (f32x4){0.f, 0.f, 0.f, 0.f}, 0, 0, 0);
                    acc[mat][mt] = __builtin_amdgcn_mfma_f32_16x16x32_bf16(af[mt][1], bfr[mat][1], c, 0, 0, 0); } }
        {   const float cw0 = cw[ch], cw1 = cw[DA + ch], cw2 = cw[2 * DA + ch], cw3 = cw[3 * DA + ch], cbv = cb[ch];
            float ban[2] = {ba[ch], ba[DA + ch]}, bxn[2] = {bx[ch], bx[DA + ch]}, spn[2];
#pragma unroll
            for (int n = 0; n < 2; ++n) { const float l = lam[n * DA + ch]; spn[n] = (-l > 20.f) ? -l : log1pf(expf(-l)); }
#pragma unroll
            for (int mt = 0; mt < 4; ++mt)
#pragma unroll
                for (int r = 0; r < 4; ++r) { const int tok = 16 * mt + 4 * g + r; const LAS unsigned char* ap = AX + tok * AXROW + ch * 2;
                    const float xcv = cbv + cw0 * bf2f(*(const LAS bf16_t*)ap) + cw1 * bf2f(*(const LAS bf16_t*)(ap + AXROW)) + cw2 * bf2f(*(const LAS bf16_t*)(ap + 2 * AXROW)) + cw3 * bf2f(*(const LAS bf16_t*)(ap + 3 * AXROW));
#pragma unroll
                    for (int n = 0; n < 2; ++n) { const float rg = fsig(acc[2 * n][mt][r] + ban[n]), ig = fsig(acc[2 * n + 1][mt][r] + bxn[n]);
                        const float la = -8.0f * rg * spn[n]; const float av = __builtin_amdgcn_exp2f(1.4426950408889634f * la); const float u = 2.0f * la;
                        const float ser = -u * (1.0f + u * (0.5f + u * (0.16666667f + u * (0.041666668f + u * 0.0083333338f))));
                        const float om = (u > -0.25f) ? ser : (1.0f - av * av);
                        acc[2 * n][mt][r] = av; acc[2 * n + 1][mt][r] = __builtin_amdgcn_sqrtf(om) * (ig * xcv); } } }
        f32x4 hs[4];
        {   float Af[4], Bf[4], Ab[4], Bb[4];
#pragma unroll
            for (int mt = 0; mt < 4; ++mt) { const f32x4 a = acc[0][mt], bb = acc[1][mt], c = acc[2][mt], d = acc[3][mt];
                Af[mt] = (a[0] * a[1]) * (a[2] * a[3]); Bf[mt] = ((bb[0] * a[1] + bb[1]) * a[2] + bb[2]) * a[3] + bb[3];
                Ab[mt] = (c[0] * c[1]) * (c[2] * c[3]); Bb[mt] = ((d[3] * c[2] + d[2]) * c[1] + d[1]) * c[0] + d[0]; }
            {   float t0[4], t1[4], t2[4], t3[4];
#pragma unroll
                for (int mt = 0; mt < 4; ++mt) { t0[mt] = __shfl_up(Af[mt], 16); t1[mt] = __shfl_up(Bf[mt], 16); t2[mt] = __shfl_down(Ab[mt], 16); t3[mt] = __shfl_down(Bb[mt], 16); }
#pragma unroll
                for (int mt = 0; mt < 4; ++mt) { if (g >= 1) { Bf[mt] = t1[mt] * Af[mt] + Bf[mt]; Af[mt] = t0[mt] * Af[mt]; } if (g <= 2) { Bb[mt] = t3[mt] * Ab[mt] + Bb[mt]; Ab[mt] = t2[mt] * Ab[mt]; } }
#pragma unroll
                for (int mt = 0; mt < 4; ++mt) { t0[mt] = __shfl_up(Af[mt], 32); t1[mt] = __shfl_up(Bf[mt], 32); t2[mt] = __shfl_down(Ab[mt], 32); t3[mt] = __shfl_down(Bb[mt], 32); }
#pragma unroll
                for (int mt = 0; mt < 4; ++mt) { if (g >= 2) { Bf[mt] = t1[mt] * Af[mt] + Bf[mt]; Af[mt] = t0[mt] * Af[mt]; } if (g <= 1) { Bb[mt] = t3[mt] * Ab[mt] + Bb[mt]; Ab[mt] = t2[mt] * Ab[mt]; } } }
            float Aef[4], Bef[4], Aeb[4], Beb[4], Atf[4], Btf[4], Atb[4], Btb[4];
#pragma unroll
            for (int mt = 0; mt < 4; ++mt) { Aef[mt] = __shfl_up(Af[mt], 16); Bef[mt] = __shfl_up(Bf[mt], 16); Aeb[mt] = __shfl_down(Ab[mt], 16); Beb[mt] = __shfl_down(Bb[mt], 16);
                Atf[mt] = __shfl(Af[mt], li + 48); Btf[mt] = __shfl(Bf[mt], li + 48); Atb[mt] = __shfl(Ab[mt], li); Btb[mt] = __shfl(Bb[mt], li); }
#pragma unroll
            for (int mt = 0; mt < 4; ++mt) { if (g == 0) { Aef[mt] = 1.f; Bef[mt] = 0.f; } if (g == 3) { Aeb[mt] = 1.f; Beb[mt] = 0.f; } }
            {   float hin = FIN ? CARRY[ch] : 0.f, atot = 1.f;
#pragma unroll
                for (int mt = 0; mt < 4; ++mt) { const f32x4 a = acc[0][mt], bb = acc[1][mt]; float hh = Aef[mt] * hin + Bef[mt];
#pragma unroll
                    for (int r = 0; r < 4; ++r) { hh = a[r] * hh + bb[r]; hs[mt][r] = hh; }
                    hin = Atf[mt] * hin + Btf[mt]; atot *= Atf[mt]; }
                if (!FIN && g == 0) { float* ag = AGG + ((size_t)(b * 64 + kc) * 4) * DA + ch; ag[0] = atot; ag[DA] = hin; } }
            {   float hin = FIN ? CARRY[DA + ch] : 0.f, atot = 1.f;
#pragma unroll
                for (int mt = 3; mt >= 0; --mt) { const f32x4 a = acc[2][mt], bb = acc[3][mt]; float hh = Aeb[mt] * hin + Beb[mt];
#pragma unroll
                    for (int r = 3; r >= 0; --r) { hh = a[r] * hh + bb[r]; hs[mt][r] += hh; }
                    hin = Atb[mt] * hin + Btb[mt]; atot *= Atb[mt]; }
                if (!FIN && g == 0) { float* ag = AGG + ((size_t)(b * 64 + kc) * 4) * DA + ch; ag[2 * DA] = atot; ag[3 * DA] = hin; } } }
        if (FIN) {
            float sq[4][4];
#pragma unroll
            for (int mt = 0; mt < 4; ++mt)
#pragma unroll
                for (int r = 0; r < 4; ++r) { const float y = hs[mt][r] * fgelu(bf2f(gt[mt][r])); yk[rd][mt][r] = y; sq[mt][r] = row16_sum(y * y); }
            if (li == 0) {
#pragma unroll
                for (int mt = 0; mt < 4; ++mt)
#pragma unroll
                    for (int r = 0; r < 4; ++r) SSQ[(16 * mt + 4 * g + r) * 24 + rd * 8 + wave] = sq[mt][r]; }
        }
    }
    if (FIN) {
        __syncthreads();
        if (tid < 64) { float s = 0.f;
#pragma unroll
            for (int q = 0; q < 24; ++q) s += SSQ[tid * 24 + q];
            RSTD[tid] = 1.0f / sqrtf(s * (1.0f / DA) + EPS); }
        __syncthreads();
#pragma unroll
        for (int rd = 0; rd < 3; ++rd) { const int li = li_, g = g_; const int h = 2 * rd + (wave >> 2), ct = wave & 3, ch = 64 * h + 16 * ct + li; const float gv = gn[ch];
#pragma unroll
            for (int mt = 0; mt < 4; ++mt)
#pragma unroll
                for (int r = 0; r < 4; ++r) { const int tok = 16 * mt + 4 * g + r; YN[(m0 + tok) * DM + ch] = (bf16_t)f2bf(yk[rd][mt][r] * RSTD[tok] * gv); } }
    }
}
}

namespace fin {
constexpr int TROW = 528;
__device__ __forceinline__ float wsum(float v) {
#pragma unroll
    for (int o = 1; o < 64; o <<= 1) v += __shfl_xor(v, o);
    return v;
}
__device__ __forceinline__ void norm_bc_unit(LAS unsigned char* lds, int unit, int tid, const bf16_t* __restrict__ AO, const bf16_t* __restrict__ YCT, const float* __restrict__ gnb, const float* __restrict__ gnc, bf16_t* __restrict__ YN) {
    asm volatile("" : "+v"(tid));
    const int b = unit >> 6, t0 = (unit & 63) * 64; const size_t m0 = (size_t)b * SL + t0;
    const int lane = tid & 63, wave = __builtin_amdgcn_readfirstlane(tid >> 6);
    __syncthreads();
    {   const int c = tid >> 1, hf = tid & 1; const bf16_t* src = YCT + ((size_t)b * DC + c) * SL + t0 + hf * 32;
#pragma unroll
        for (int q = 0; q < 4; ++q) { const uint4 v = *(const uint4*)(src + q * 8); const unsigned w[4] = {v.x, v.y, v.z, v.w};
#pragma unroll
            for (int d = 0; d < 4; ++d) { const int tok = hf * 32 + q * 8 + 2 * d;
                *(LAS bf16_t*)(lds + tok * TROW + c * 2) = (bf16_t)(w[d] & 0xffffu); *(LAS bf16_t*)(lds + (tok + 1) * TROW + c * 2) = (bf16_t)(w[d] >> 16); } } }
    for (int q = 0; q < 8; ++q) { const int tok = wave * 8 + q; const unsigned* src = (const unsigned*)(AO + (m0 + tok) * DBB);
        float v[6]; float s = 0.f;
#pragma unroll
        for (int j = 0; j < 3; ++j) { const unsigned w = src[lane + 64 * j]; v[2 * j] = at::blo(w); v[2 * j + 1] = at::bhi(w); s += v[2 * j] * v[2 * j] + v[2 * j + 1] * v[2 * j + 1]; }
        const float r = 1.0f / sqrtf(wsum(s) * (1.0f / DBB) + EPS);
        unsigned* dst = (unsigned*)(YN + (m0 + tok) * DM + DA);
#pragma unroll
        for (int j = 0; j < 3; ++j) { const int c0 = 2 * (lane + 64 * j); dst[lane + 64 * j] = pk2(v[2 * j] * r * gnb[c0], v[2 * j + 1] * r * gnb[c0 + 1]); } }
    __syncthreads();
    for (int q = 0; q < 8; ++q) { const int tok = wave * 8 + q; typedef unsigned u32x2v __attribute__((ext_vector_type(2))); const u32x2v w = *(const LAS u32x2v*)(lds + tok * TROW + lane * 8);
        const float v0 = at::blo(w.x), v1 = at::bhi(w.x), v2 = at::blo(w.y), v3 = at::bhi(w.y);
        const float r = 1.0f / sqrtf(wsum(v0 * v0 + v1 * v1 + v2 * v2 + v3 * v3) * (1.0f / DC) + EPS);
        const f32x4 gg = *(const f32x4*)(gnc + lane * 4);
        uint2 o; o.x = pk2(v0 * r * gg[0], v1 * r * gg[1]); o.y = pk2(v2 * r * gg[2], v3 * r * gg[3]);
        *(uint2*)(YN + (m0 + tok) * DM + DA + DBB + lane * 4) = o; }
}
}

__device__ __forceinline__ int fresh_tid() { int t = threadIdx.x; asm volatile("" : "+v"(t)); return t; }
#define FTID fresh_tid()
#define FLANE (fresh_tid() & 63)
struct Frame {
    LAS unsigned char* lds;
    volatile LAS unsigned* MISC;
    int wave, vcu, G;
};
__device__ __forceinline__ void p0_transpose_item(const float* W, int K, int N, bf16_t* WT, LAS float* scr, int item, int lane) {
    const int nblk = N / 32, kb = item / nblk, nb = item % nblk, k0 = 64 * kb, n0 = 32 * nb;
    float tv[32];
#pragma unroll
    for (int i = 0; i < 32; ++i) { const int kk = 2 * i + (lane >> 5); tv[i] = W[(size_t)(k0 + kk) * N + n0 + (lane & 31)]; }
#pragma unroll
    for (int i = 0; i < 32; ++i) { const int kk = 2 * i + (lane >> 5); scr[kk * 33 + (lane & 31)] = tv[i]; }
    LDS_WAIT(); asm volatile("" ::: "memory");
    const int c = lane & 7;
#pragma unroll
    for (int j = 0; j < 4; ++j) { const int n = (lane >> 3) + 8 * j; const LAS float* s = scr + (8 * c) * 33 + n;
        v4u o; o.x = pk2(s[0 * 33], s[1 * 33]); o.y = pk2(s[2 * 33], s[3 * 33]); o.z = pk2(s[4 * 33], s[5 * 33]); o.w = pk2(s[6 * 33], s[7 * 33]);
        *(GAS v4u*)(WT + (size_t)(n0 + n) * K + k0 + 8 * c) = o; }
    LDS_WAIT(); asm volatile("" ::: "memory");
}
__device__ __forceinline__ void xg_row(const float* xrow, const float* g, bf16_t* orow, float* ssrow, int lane) {
    const GAS f32x4* xr = (const GAS f32x4*)xrow + lane; const GAS f32x4* gr = (const GAS f32x4*)g + lane;
    f32x4 v[4]; float s = 0.f;
#pragma unroll
    for (int j = 0; j < 4; ++j) { v[j] = xr[64 * j]; s += (v[j][0] * v[j][0] + v[j][1] * v[j][1]) + (v[j][2] * v[j][2] + v[j][3] * v[j][3]); }
    s += __shfl_xor(s, 1); s += __shfl_xor(s, 2);
    if ((lane & 3) == 0) ssrow[lane >> 2] = s;
    GAS unsigned long long* o8 = (GAS unsigned long long*)orow + lane;
#pragma unroll
    for (int j = 0; j < 4; ++j) { const f32x4 gg = gr[64 * j]; o8[64 * j] = (unsigned long long)pk2(v[j][0] * gg[0], v[j][1] * gg[1]) | ((unsigned long long)pk2(v[j][2] * gg[2], v[j][3] * gg[3]) << 32); }
}
__device__ __forceinline__ void xg_rows4(const float* x, const float* g, bf16_t* XGp, float* SSp, int m, int stride, int lane) {
    f32x4 v[4][4];
#pragma unroll
    for (int q = 0; q < 4; ++q) { const int row = m + q * stride; const int rc = row < MT ? row : m; const GAS f32x4* xr = (const GAS f32x4*)(x + (size_t)rc * DM) + lane;
#pragma unroll
        for (int j = 0; j < 4; ++j) v[q][j] = xr[64 * j]; }
    const GAS f32x4* gr = (const GAS f32x4*)g + lane; f32x4 gg[4];
#pragma unroll
    for (int j = 0; j < 4; ++j) gg[j] = gr[64 * j];
#pragma unroll
    for (int q = 0; q < 4; ++q) { const int row = m + q * stride; if (row < MT) { float s = 0.f;
#pragma unroll
        for (int j = 0; j < 4; ++j) s += (v[q][j][0] * v[q][j][0] + v[q][j][1] * v[q][j][1]) + (v[q][j][2] * v[q][j][2] + v[q][j][3] * v[q][j][3]);
        s += __shfl_xor(s, 1); s += __shfl_xor(s, 2);
        if ((lane & 3) == 0) SSp[(size_t)row * 16 + (lane >> 2)] = s;
        GAS unsigned long long* o8 = (GAS unsigned long long*)(XGp + (size_t)row * DM) + lane;
#pragma unroll
        for (int j = 0; j < 4; ++j) o8[64 * j] = (unsigned long long)pk2(v[q][j][0] * gg[j][0], v[q][j][1] * gg[j][1]) | ((unsigned long long)pk2(v[q][j][2] * gg[j][2], v[q][j][3] * gg[j][3]) << 32); } }
}
__device__ __forceinline__ void final_row(const float* xrow, const float* g, const float* SS, int row, float* orow, int lane) {
    const GAS f32x4* xr = (const GAS f32x4*)xrow + lane; const GAS f32x4* gr = (const GAS f32x4*)g + lane; GAS f32x4* o = (GAS f32x4*)orow + lane;
    const float r = pg8::rstd16(SS, row);
#pragma unroll
    for (int j = 0; j < 4; ++j) { const f32x4 v = xr[64 * j], gg = gr[64 * j]; o[64 * j] = v * gg * r; }
}

template <int I> __device__ __forceinline__ const float* in_ptr() {
    unsigned long long v;
    asm volatile("s_load_dwordx2 %0, %1, %2\n\ts_waitcnt lgkmcnt(0)" : "=s"(v) : "s"(__builtin_amdgcn_kernarg_segment_ptr()), "n"(I * 8) : "memory");
    return (const float*)v;
}
#define INP(i) in_ptr<i>()
__device__ __forceinline__ void final_rows4(float* X, const float* g, const float* SS, int m, int stride, int lane) {
    f32x4 v[4][4]; float r[4];
#pragma unroll
    for (int q = 0; q < 4; ++q) { const int row = m + q * stride; const int rc = row < MT ? row : m; const GAS f32x4* xr = (const GAS f32x4*)(X + (size_t)rc * DM) + lane;
#pragma unroll
        for (int j = 0; j < 4; ++j) v[q][j] = xr[64 * j];
        r[q] = pg8::rstd16(SS, rc); }
    const GAS f32x4* gr = (const GAS f32x4*)g + lane; f32x4 gg[4];
#pragma unroll
    for (int j = 0; j < 4; ++j) gg[j] = gr[64 * j];
#pragma unroll
    for (int q = 0; q < 4; ++q) { const int row = m + q * stride; if (row < MT) { GAS f32x4* o = (GAS f32x4*)(X + (size_t)row * DM) + lane;
#pragma unroll
        for (int j = 0; j < 4; ++j) o[64 * j] = v[q][j] * gg[j] * r[q]; } }
}
struct Args { const float* in[28]; float* out; unsigned char* ws; int ph_lo, ph_hi, li, pad; };

#define ws ((unsigned char*)in_ptr<29>())
#define XR ((float*)in_ptr<28>())
#define Win_t ((bf16_t*)(ws + WS_WIN))
#define Wout_t ((bf16_t*)(ws + WS_WOUT))
#define Wup_t ((bf16_t*)(ws + WS_WUP))
#define Wdn_t ((bf16_t*)(ws + WS_WDN))
#define XG ((bf16_t*)(ws + WS_XG))
#define P ((bf16_t*)(ws + WS_P))
#define YN ((bf16_t*)(ws + WS_YN))
#define HB ((bf16_t*)(ws + WS_H))
#define SS ((float*)(ws + WS_SS))
__global__ void __launch_bounds__(NTHREADS, 2) mega(Args args) {
    extern __shared__ __attribute__((aligned(16))) unsigned char lds[];
    Frame F;
    F.lds = (LAS unsigned char*)lds; F.MISC = (volatile LAS unsigned*)(F.lds + MISC_OFF);
    F.wave = __builtin_amdgcn_readfirstlane((int)threadIdx.x >> 6);
    F.G = gridDim.x; { const int bx = blockIdx.x; F.vcu = (F.G % 8 == 0) ? (bx % 8) * (F.G / 8) + bx / 8 : bx; }
    gu32* ctl = (gu32*)(ws + WS_CTL);
    for (int u = threadIdx.x; u < (LDS_BYTES - MISC_OFF) / 4; u += NTHREADS) ((LAS unsigned*)(F.lds + MISC_OFF))[u] = 0u;
    __syncthreads();
    const int lo = args.ph_lo, hi = args.ph_hi;
    XcdBarrier bar; bar.bar = (unsigned*)(ctl + CW_BAR) + args.li * XCD_BAR_WORDS; bar.x = 0; bar.st = nullptr;
    if (hi - lo > 1) bar = xcd_barrier_post((unsigned*)(ctl + CW_BAR) + args.li * XCD_BAR_WORDS, F.MISC + 8);

    const int gw = F.vcu * NWAVES + F.wave, NGW = F.G * NWAVES;

#define IN(k) (lo <= (k) && (k) < hi)
#ifdef TPROBE
#define TSTAMP(i) do { if (blockIdx.x == 0 && threadIdx.x == 0) ((unsigned long long*)(ws + WS_CTL + 512 * 1024))[i] = __builtin_amdgcn_s_memrealtime(); } while (0)
#else
#define TSTAMP(i)
#endif
#define SEAM(k) do { if (IN(k) && IN((k) + 1)) { xcd_barrier(bar); DUP_BAR(xcd_barrier(bar);) TSTAMP((k) + 1); } } while (0)
    TSTAMP(0);
#ifndef DUP_PRO
#define DUP_PRO(...)
#endif
    if (IN(PH_PRO)) {
        auto pro_body = [&]() __attribute__((always_inline)) {
        LAS float* scr = (LAS float*)(F.lds + RING_OFF + F.wave * 16384);
        constexpr int I_IN = (DM / 64) * (DIN / 32), I_OUT = (DM / 64) * (DM / 32), I_UP = (DM / 64) * (DFF / 32), I_DN = (DFF / 64) * (DM / 32), I_L = I_IN + I_OUT + I_UP + I_DN;
        for (int it = gw; it < DEPTH * I_L; it += NGW) {
            const int l = it / I_L; int r = it % I_L;
            if (r < I_IN) { p0_transpose_item(INP(2) + (size_t)l * DM * DIN, DM, DIN, Win_t + (size_t)l * DINP * DM, scr, r, FLANE); continue; } r -= I_IN;
            if (r < I_OUT) { p0_transpose_item(INP(23) + (size_t)l * DM * DM, DM, DM, Wout_t + (size_t)l * DM * DM, scr, r, FLANE); continue; } r -= I_OUT;
            if (r < I_UP) { p0_transpose_item(INP(25) + (size_t)l * DM * DFF, DM, DFF, Wup_t + (size_t)l * DFF * DM, scr, r, FLANE); continue; } r -= I_UP;
            p0_transpose_item(INP(26) + (size_t)l * DFF * DM, DFF, DM, Wdn_t + (size_t)l * DM * DFF, scr, r, FLANE);
        }
        for (int i = blockIdx.x * NTHREADS + FTID; i < DEPTH * 16384; i += F.G * NTHREADS) { const int l = i >> 14, r = i & 16383;
            *(GAS v4u*)((GAS unsigned char*)(Win_t + (size_t)l * DINP * DM + (size_t)DIN * DM) + (size_t)r * 16) = (v4u){0u, 0u, 0u, 0u}; }
        {
            float* TWf = (float*)(ws + WS_TW); float* rope = (float*)(ws + WS_ROPE);
            for (int i = blockIdx.x * NTHREADS + FTID; i < 8192; i += F.G * NTHREADS) { const double a = 6.283185307179586476925286766559 * (double)i / 8192.0; TWf[2 * i] = (float)cos(a); TWf[2 * i + 1] = (float)(-sin(a)); }
            for (int i = blockIdx.x * NTHREADS + FTID; i < SL * 8; i += F.G * NTHREADS) { const int pos = i >> 3, j = i & 7; const double ang = (double)pos * pow(500000.0, -(double)j / 8.0);
                rope[pos * 16 + j] = (float)cos(ang); rope[pos * 16 + 8 + j] = (float)sin(ang); }
        }
        {
            bf16_t* LW = (bf16_t*)(ws + WS_LW); const float* wa = INP(5); const float* wx = INP(7);
            for (int o = blockIdx.x * NTHREADS + FTID; o < DEPTH * LRU_BLK * 4 * 64 * 64; o += F.G * NTHREADS) {
                const int i = o & 63, j = (o >> 6) & 63, mat = (o >> 12) & 3, lh = o >> 14, h = lh % LRU_BLK, l = lh / LRU_BLK, n = mat >> 1;
                const float* src = (mat & 1) ? wx : wa;
                LW[o] = (bf16_t)f2bf(src[((((size_t)l * 2 + n) * LRU_BLK + h) * 64 + i) * 64 + j]); }
        }
        {
            const float* w1 = INP(13); const float* b1 = INP(14); const float* fq = INP(15); const float* w2 = INP(16); const float* b2 = INP(17); const float* w3 = INP(18);
            for (int u = F.vcu; u < DEPTH * 128; u += F.G) { const int l = u >> 7;
                hy::filter_unit(F.lds, u & 127, FTID, w1 + (size_t)l * HY_EMB * HY_W, b1 + l * HY_W, fq + l * HY_W, w2 + (size_t)l * HY_W * HY_W, b2 + l * HY_W, w3 + (size_t)l * HY_W * 2 * DC,
                                (float*)(ws + WS_HF) + (size_t)l * DC * 8192); }
            __syncthreads();
        }
        { const float* x0 = INP(0); const float* g0 = INP(1);
          for (int m = gw; m < MT; m += 4 * NGW) xg_rows4(x0, g0, XG, SS, m, NGW, FLANE); }
        };
        pro_body(); DUP_PRO(xcd_barrier(bar); pro_body();)
    }
    SEAM(PH_PRO);
#ifndef DUP_MIX1
#define DUP_MIX1(...)
#endif
#ifndef DUP_FFT
#define DUP_FFT(...)
#endif
#ifndef DUP_FIN
#define DUP_FIN(...)
#endif
#ifndef DUP_WIN
#define DUP_WIN(...)
#endif
#ifndef DUP_WUP
#define DUP_WUP(...)
#endif
#ifndef DUP_HYP
#define DUP_HYP(...)
#endif
#ifndef DUP_AGG
#define DUP_AGG(...)
#endif
#ifndef DUP_ATT
#define DUP_ATT(...)
#endif
#ifndef DUP_WOUT
#define DUP_WOUT(...)
#endif
#ifndef DUP_LRUFIN
#define DUP_LRUFIN(...)
#endif
#ifndef DUP_NBC
#define DUP_NBC(...)
#endif
#ifndef DUP_BAR
#define DUP_BAR(...)
#endif
#ifndef DUP_WDN
#define DUP_WDN(...)
#endif
#define WIN_BODY(l) { \
        pg8::Gemm g{XG, Win_t + (size_t)(l) * DINP * DM, MT, DINP, DM}; pg8::StaticOrder S; S.init(MT, DINP, F.G, (int)blockIdx.x); \
        pg8::EpiScaleBf16<0> E{P, DINP, SS}; \
        pg8::gemm_phase<pg8::EpiScaleBf16<0>, pg8::StaticOrder, true, true>(F.lds + RING_OFF, g, S, E); }
#define MIX1_BODY(l) { const float* cw = INP(11) + (l) * 9 * DC; const float* cb = INP(12) + (l) * 3 * DC; \
        for (int u = F.vcu; u < 256; u += F.G) hy::hyprep_unit(F.lds, u, FTID, P, cw, cb, (bf16_t*)(ws + WS_ZT), (bf16_t*)(ws + WS_X0T)); \
        DUP_HYP(for (int u = F.vcu; u < 256; u += F.G) hy::hyprep_unit(F.lds, u, FTID, P, cw, cb, (bf16_t*)(ws + WS_ZT), (bf16_t*)(ws + WS_X0T));) \
        { const float* cwa = INP(3) + (l) * 4 * DA; const float* cba = INP(4) + (l) * DA; const float* ba = INP(6) + (l) * 2 * DA; const float* bx = INP(8) + (l) * 2 * DA; const float* lam = INP(9) + (l) * 2 * DA; \
          for (int u = F.vcu; u < 256; u += F.G) lru::lru_unit<false>(F.lds, u, FTID, P, cwa, cba, (const bf16_t*)(ws + WS_LW) + (size_t)(l) * LRU_BLK * 4 * 4096, ba, bx, lam, (float*)(ws + WS_AGG), nullptr, YN); \
          DUP_AGG(for (int u = F.vcu; u < 256; u += F.G) lru::lru_unit<false>(F.lds, u, FTID, P, cwa, cba, (const bf16_t*)(ws + WS_LW) + (size_t)(l) * LRU_BLK * 4 * 4096, ba, bx, lam, (float*)(ws + WS_AGG), nullptr, YN);) } \
        { const float* sk = INP(10) + (l) * NQH; \
          for (int u = F.vcu; u < 256; u += F.G) at::attn_unit(F.lds, u, FTID, P, (const float*)(ws + WS_ROPE), sk, (bf16_t*)(ws + WS_AO)); \
          DUP_ATT(for (int u = F.vcu; u < 256; u += F.G) at::attn_unit(F.lds, u, FTID, P, (const float*)(ws + WS_ROPE), sk, (bf16_t*)(ws + WS_AO));) } }
#define FFT_BODY(l) { const float* hb = INP(19) + (l) * DC; \
        for (int u = F.vcu; u < DC; u += F.G) hy::fft_unit(F.lds, u, FTID, (const float*)(ws + WS_HF) + (size_t)(l) * DC * 8192, (const hy::cf*)(ws + WS_TW), (const bf16_t*)(ws + WS_ZT), (const bf16_t*)(ws + WS_X0T), \
                                                           (bf16_t*)(ws + WS_YCT), hb[u]); }
#define FIN_BODY(l) { \
        { const float* cwa = INP(3) + (l) * 4 * DA; const float* cba = INP(4) + (l) * DA; const float* ba = INP(6) + (l) * 2 * DA; const float* bx = INP(8) + (l) * 2 * DA; const float* lam = INP(9) + (l) * 2 * DA; const float* gna = INP(20) + (l) * DA; \
          for (int u = F.vcu; u < 256; u += F.G) lru::lru_unit<true>(F.lds, u, FTID, P, cwa, cba, (const bf16_t*)(ws + WS_LW) + (size_t)(l) * LRU_BLK * 4 * 4096, ba, bx, lam, (float*)(ws + WS_AGG), gna, YN); \
          DUP_LRUFIN(for (int u = F.vcu; u < 256; u += F.G) lru::lru_unit<true>(F.lds, u, FTID, P, cwa, cba, (const bf16_t*)(ws + WS_LW) + (size_t)(l) * LRU_BLK * 4 * 4096, ba, bx, lam, (float*)(ws + WS_AGG), gna, YN);) } \
        { const float* gnb = INP(21) + (l) * DBB; const float* gnc = INP(22) + (l) * DC; \
          for (int u = F.vcu; u < 256; u += F.G) fin::norm_bc_unit(F.lds, u, FTID, (const bf16_t*)(ws + WS_AO), (const bf16_t*)(ws + WS_YCT), gnb, gnc, YN); \
          DUP_NBC(for (int u = F.vcu; u < 256; u += F.G) fin::norm_bc_unit(F.lds, u, FTID, (const bf16_t*)(ws + WS_AO), (const bf16_t*)(ws + WS_YCT), gnb, gnc, YN);) } }
#define WUP_BODY(l) { \
        pg8::Gemm g{XG, Wup_t + (size_t)(l) * DFF * DM, MT, DFF, DM}; pg8::StaticOrder S; S.init(MT, DFF, F.G, (int)blockIdx.x); \
        pg8::EpiScaleBf16<1> E{HB, DFF, SS}; \
        pg8::gemm_phase<pg8::EpiScaleBf16<1>, pg8::StaticOrder, true, true>(F.lds + RING_OFF, g, S, E); }
#define LAYER(l) do { constexpr int pb = 1 + PH_PER_LAYER * (l); \
    if (IN(pb + PL_WIN)) { WIN_BODY(l) DUP_WIN(xcd_barrier(bar); WIN_BODY(l)) } \
    SEAM(pb + PL_WIN); \
    if (IN(pb + PL_MIX1)) { MIX1_BODY(l) DUP_MIX1(xcd_barrier(bar); MIX1_BODY(l)) } \
    SEAM(pb + PL_MIX1); \
    if (IN(pb + PL_FFT)) { FFT_BODY(l) DUP_FFT(xcd_barrier(bar); FFT_BODY(l)) } \
    SEAM(pb + PL_FFT); \
    if (IN(pb + PL_FIN)) { FIN_BODY(l) DUP_FIN(xcd_barrier(bar); FIN_BODY(l)) } \
    SEAM(pb + PL_FIN); \
    if (IN(pb + PL_WOUT)) { \
        DUP_WOUT({ pg8::Gemm g{YN, Wout_t + (size_t)(l) * DM * DM, MT, DM, DM}; pg8::StaticOrder S; S.init(MT, DM, F.G, (int)blockIdx.x); \
        pg8::EpiRes E{(l) == 0 ? INP(0) : (const float*)XR, (float*)(ws + WS_P), (bf16_t*)nullptr, INP(24) + (l) * DM, (float*)(ws + WS_SCR), 1.0f}; \
        pg8::gemm_phase<pg8::EpiRes, pg8::StaticOrder, true, true>(F.lds + RING_OFF, g, S, E); } xcd_barrier(bar);) \
        pg8::Gemm g{YN, Wout_t + (size_t)(l) * DM * DM, MT, DM, DM}; pg8::StaticOrder S; S.init(MT, DM, F.G, (int)blockIdx.x); \
        pg8::EpiRes E{(l) == 0 ? INP(0) : (const float*)XR, XR, XG, INP(24) + (l) * DM, SS, 1.0f}; \
        pg8::gemm_phase<pg8::EpiRes, pg8::StaticOrder, true, true>(F.lds + RING_OFF, g, S, E); } \
    SEAM(pb + PL_WOUT); \
    if (IN(pb + PL_WUP)) { WUP_BODY(l) DUP_WUP(xcd_barrier(bar); WUP_BODY(l)) } \
    SEAM(pb + PL_WUP); \
    if (IN(pb + PL_WDN)) { \
        DUP_WDN({ pg8::Gemm g{HB, Wdn_t + (size_t)(l) * DM * DFF, MT, DM, DFF}; pg8::StaticOrder S; S.init(MT, DM, F.G, (int)blockIdx.x); \
        pg8::EpiRes E{XR, XR, ((l) + 1 < DEPTH) ? XG : (bf16_t*)nullptr, INP(1) + (((l) + 1 < DEPTH) ? ((l) + 1) * DM : 0), SS, 0.0f}; \
        pg8::gemm_phase<pg8::EpiRes, pg8::StaticOrder, true, true>(F.lds + RING_OFF, g, S, E); } xcd_barrier(bar);) \
        pg8::Gemm g{HB, Wdn_t + (size_t)(l) * DM * DFF, MT, DM, DFF}; pg8::StaticOrder S; S.init(MT, DM, F.G, (int)blockIdx.x); \
        pg8::EpiRes E{XR, XR, ((l) + 1 < DEPTH) ? XG : (bf16_t*)nullptr, INP(1) + (((l) + 1 < DEPTH) ? ((l) + 1) * DM : 0), SS, 1.0f}; \
        pg8::gemm_phase<pg8::EpiRes, pg8::StaticOrder, true, true>(F.lds + RING_OFF, g, S, E); } \
    SEAM(pb + PL_WDN); } while (0)
    LAYER(0);
    LAYER(1);
    if (IN(PH_FINAL)) { const float* gf = INP(27);
        for (int m = gw; m < MT; m += 4 * NGW) final_rows4(XR, gf, SS, m, NGW, FLANE);
#ifdef TPROBE
        {   const unsigned long long* T = (const unsigned long long*)(ws + WS_CTL + 512 * 1024);
            const float d2 = (TPROBE >= 100) ? (float)(T[15] - T[0]) * 0.001f : (float)(T[(TPROBE % 100) + 1] - T[TPROBE % 100]) * 0.01f;
            asm volatile("s_waitcnt vmcnt(0)" ::: "memory");
            if (gw == 0 && FLANE == 0) XR[0] += d2; }
#endif
    }
#undef IN
#undef SEAM
#undef LAYER
}

#undef ws
#undef XR
#undef Win_t
#undef Wout_t
#undef Wup_t
#undef Wdn_t
#undef XG
#undef P
#undef YN
#undef HB
#undef SS
static int g_grid = 0, g_li = 0;
static void launch_mega(Args a, int lo, int hi, hipStream_t stream) {
    a.ph_lo = lo; a.ph_hi = hi; a.li = (hi - lo > 1) ? g_li++ : 0;
    void* kargs[] = {&a};
    hipLaunchCooperativeKernel((const void*)mega, dim3(g_grid), dim3(NTHREADS), kargs, LDS_BYTES, stream);
}
extern "C" void kernel_launch(void* const* d_in, const int* in_sizes, int n_in, void* d_out, int out_size, void* d_ws, size_t ws_size, hipStream_t stream) {
    if (n_in != 28 || ws_size < WS_END) return;
    if (g_grid == 0) {
        int dev = 0, cus = 0, per_cu = 0;
        hipGetDevice(&dev); hipDeviceGetAttribute(&cus, hipDeviceAttributeMultiprocessorCount, dev);
        hipFuncSetAttribute((const void*)mega, hipFuncAttributeMaxDynamicSharedMemorySize, LDS_BYTES);
        hipOccupancyMaxActiveBlocksPerMultiprocessor(&per_cu, (const void*)mega, NTHREADS, LDS_BYTES);
        (void)hipGetLastError();
        if (per_cu < 1) per_cu = 1;
        if (per_cu > 1) per_cu = 1;
        g_grid = cus * per_cu;
    }
    g_li = 0;
    unsigned char* ws = (unsigned char*)d_ws;
    auto F = [&](int i) { return (const float*)d_in[i]; };
    hipMemsetAsync(ws + WS_CTL, 0, 1 * MiB, stream);
    Args a{};
    for (int i = 0; i < 28; ++i) a.in[i] = (const float*)d_in[i];
    a.out = (float*)d_out; a.ws = ws;
    float* rope = (float*)(ws + WS_ROPE); float* HF = (float*)(ws + WS_HF);
    bf16_t* P = (bf16_t*)(ws + WS_P); bf16_t* YN = (bf16_t*)(ws + WS_YN);
    float* nA = (float*)(ws + NV_A); float* nB = (float*)(ws + NV_B); float* nHS = (float*)(ws + NV_HS); float* nZ = (float*)(ws + NV_Z); float* nX0 = (float*)(ws + NV_X0); float* nYC = (float*)(ws + NV_YC);

    launch_mega(a, 0, NPH, stream);
}
```

```cpp
#define DUP_BAR(...)
#include <hip/hip_runtime.h>
#include <stdint.h>
#include <math.h>

typedef unsigned short bf16_t;
typedef short bf16x8 __attribute__((ext_vector_type(8)));
typedef float f32x4 __attribute__((ext_vector_type(4)));

constexpr int NB = 4, SL = 4096, DM = 1024, MT = NB * SL, DEPTH = 2;
constexpr int DA = 384, DBB = 384, DC = 256, HD = 64, NQH = 6, NKVH = 2, DIN = 2176, DINP = 2304, DFF = 4096;
constexpr int P_AX = 0, P_AG = 384, P_Q = 768, P_K = 1152, P_V = 1280, P_CU = 1408;
constexpr int LRU_BLK = 6, LRU_BW = 64, WIN = 128, HY_EMB = 33, HY_W = 64;
constexpr float EPS = 1e-6f;

constexpr size_t MiB = 1u << 20;
constexpr size_t WS_WIN = 0;
constexpr size_t WS_WOUT = 9 * MiB;
constexpr size_t WS_WUP = 13 * MiB;
constexpr size_t WS_WDN = 29 * MiB;
constexpr size_t WS_ROPE = 45 * MiB;
constexpr size_t WS_HF = 46 * MiB;
constexpr size_t WS_XG = 62 * MiB;
constexpr size_t WS_BIG = 94 * MiB;
constexpr size_t WS_H = WS_BIG;
constexpr size_t WS_P = WS_BIG;
constexpr size_t WS_YN = WS_BIG + 72 * MiB;
constexpr size_t WS_SCR = WS_BIG + 104 * MiB;
constexpr size_t WS_CTL = 254 * MiB;
constexpr size_t WS_SS = 255 * MiB;
constexpr size_t WS_END = 256 * MiB;
constexpr size_t NV_A = WS_XG;
constexpr size_t NV_B = WS_SCR;
constexpr size_t NV_HS = WS_SCR + 24 * MiB;
constexpr size_t NV_Z = WS_SCR;
constexpr size_t NV_X0 = WS_SCR + 16 * MiB;
constexpr size_t NV_YC = WS_SCR + 32 * MiB;

__device__ __forceinline__ unsigned f2bf(float f) { unsigned u = __builtin_bit_cast(unsigned, f); return (u + 0x7fffu + ((u >> 16) & 1u)) >> 16; }
__device__ __forceinline__ float bf2f(bf16_t h) { return __builtin_bit_cast(float, (unsigned)h << 16); }
__device__ __forceinline__ float sigmoidf_(float x) { return 1.f / (1.f + expf(-x)); }
__device__ __forceinline__ float gelu_tanh(float x) { const float u = 0.7978845608028654f * (x + 0.044715f * x * x * x); return 0.5f * x * (1.f + tanhf(u)); }

__device__ __forceinline__ float block_sum(float v, float* red) {
    for (int o = 32; o > 0; o >>= 1) v += __shfl_xor(v, o);
    const int w = threadIdx.x >> 6, nw = blockDim.x >> 6;
    __syncthreads();
    if ((threadIdx.x & 63) == 0) red[w] = v;
    __syncthreads();
    float s = 0.f;
    for (int i = 0; i < nw; ++i) s += red[i];
    return s;
}

__global__ void k_rope(float* __restrict__ tab) {
    const int i = blockIdx.x * blockDim.x + threadIdx.x; if (i >= SL * 8) return;
    const int pos = i >> 3, j = i & 7;
    const double inv = pow(500000.0, -(double)j / 8.0), ang = (double)pos * inv;
    tab[pos * 16 + j] = (float)cos(ang); tab[pos * 16 + 8 + j] = (float)sin(ang);
}

__global__ void k_hy_filter(const float* __restrict__ w1, const float* __restrict__ b1, const float* __restrict__ freq, const float* __restrict__ w2,
                            const float* __restrict__ b2, const float* __restrict__ w3, float* __restrict__ HF) {
    __shared__ float z[HY_EMB], h1[HY_W], h2[HY_W];
    const int t = blockIdx.x, tid = threadIdx.x;
    const double PI2 = 6.283185307179586476925286766559;
    const float tt = (float)((double)t / (double)(SL - 1));
    if (tid < HY_EMB) {
        float v;
        if (tid == 0) v = tt;
        else { const int bi = (tid - 1) & 15; const double f = 1e-4 + (double)bi * ((15.0 - 1e-4) / 15.0); const double w = PI2 * (double)t / (double)SL;
               v = (tid <= 16) ? (float)cos(f * w) : (float)(-sin(f * w)); }
        z[tid] = v;
    }
    __syncthreads();
    if (tid < HY_W) { float a = b1[tid]; for (int i = 0; i < HY_EMB; ++i) a += z[i] * w1[i * HY_W + tid]; h1[tid] = sinf(freq[tid] * a); }
    __syncthreads();
    if (tid < HY_W) { float a = b2[tid]; for (int i = 0; i < HY_W; ++i) a += h1[i] * w2[i * HY_W + tid]; h2[tid] = sinf(freq[tid] * a); }
    __syncthreads();
    const double mind = log(1e-2) / 1.5, maxd = log(1e-2) / 0.3;
    for (int o = tid; o < 2 * DC; o += 256) {
        float a = 0.f; for (int i = 0; i < HY_W; ++i) a += h2[i] * w3[i * 2 * DC + o];
        const int c = o & 255, dir = o >> 8;
        const float delta = fabsf((float)(mind + (maxd - mind) * (double)c / 255.0));
        HF[((size_t)dir * SL + t) * DC + c] = a * expf(-tt * delta);
    }
}

__global__ __launch_bounds__(384) void k_lru_ab(const bf16_t* __restrict__ P, const float* __restrict__ cw, const float* __restrict__ cb, const float* __restrict__ wa, const float* __restrict__ ba,
                                               const float* __restrict__ wx, const float* __restrict__ bx, const float* __restrict__ lam, float* __restrict__ Aout, float* __restrict__ Bout, int n) {
    __shared__ float xc[DA];
    const int m = blockIdx.x, t = m % SL, j = threadIdx.x;
    float v = cb[j];
#pragma unroll
    for (int k = 0; k < 4; ++k) { const int tt = t + k - 2; if (tt >= 0 && tt < SL) v += cw[k * DA + j] * bf2f(P[(size_t)(m + k - 2) * DINP + P_AX + j]); }
    xc[j] = v;
    __syncthreads();
    const int blk = j >> 6, jj = j & 63;
    {
        float ra = ba[n * DA + j], ia = bx[n * DA + j];
        const float* wap = wa + ((size_t)(n * LRU_BLK + blk) * 64) * 64 + jj; const float* wxp = wx + ((size_t)(n * LRU_BLK + blk) * 64) * 64 + jj;
        for (int i = 0; i < 64; ++i) { const float xi = xc[blk * 64 + i]; ra += xi * wap[i * 64]; ia += xi * wxp[i * 64]; }
        const float r = sigmoidf_(ra), ig = sigmoidf_(ia);
        const float l = lam[n * DA + j]; const float sp = (-l > 20.f) ? -l : log1pf(expf(-l));
        const float log_a = -8.f * r * sp;
        const float a = expf(log_a), bb = sqrtf(-expm1f(2.f * log_a)) * (ig * v);
        Aout[(size_t)m * DA + j] = a; Bout[(size_t)m * DA + j] = bb;
    }
}
__global__ void k_lru_scan(const float* __restrict__ A, const float* __restrict__ Bv, float* __restrict__ HS, int n) {
    const int id = blockIdx.x * blockDim.x + threadIdx.x; if (id >= NB * DA) return;
    const int ch = id % DA, b = id / DA;
    float h = 0.f;
    for (int s = 0; s < SL; ++s) { const int t = n ? (SL - 1 - s) : s; const size_t o = ((size_t)b * SL + t) * DA + ch; h = A[o] * h + Bv[o]; HS[o] = n ? (HS[o] + h) : h; }
}
__global__ __launch_bounds__(384) void k_lru_out(const bf16_t* __restrict__ P, const float* __restrict__ HS, const float* __restrict__ gn, bf16_t* __restrict__ YN) {
    __shared__ float red[8];
    const int m = blockIdx.x, j = threadIdx.x;
    const float h = HS[(size_t)m * DA + j];
    const float y = h * gelu_tanh(bf2f(P[(size_t)m * DINP + P_AG + j]));
    const float ss = block_sum(y * y, red);
    const float r = 1.f / sqrtf(ss * (1.f / DA) + EPS);
    YN[(size_t)m * DM + j] = (bf16_t)f2bf(y * r * gn[j]);
}

__global__ __launch_bounds__(384) void k_attn(const bf16_t* __restrict__ P, const float* __restrict__ rope, const float* __restrict__ sink, const float* __restrict__ gn, bf16_t* __restrict__ YN) {
    __shared__ float qs[NQH][HD], ps[NQH][320], red[8];
    const int m = blockIdx.x, t = m % SL, w = threadIdx.x >> 6, lane = threadIdx.x & 63, kvh = w / 3;
    const float* rt = rope + t * 16;
    const bf16_t* qp = P + (size_t)m * DINP + P_Q + w * HD;
    {   float q = bf2f(qp[lane]);
        if (lane < 8) q = q * rt[lane] - bf2f(qp[lane + 8]) * rt[8 + lane];
        else if (lane < 16) q = q * rt[lane - 8] + bf2f(qp[lane - 8]) * rt[lane];
        qs[w][lane] = q; }
    __syncthreads();
    float sv[5]; float mx = sink[w];
#pragma unroll
    for (int pss = 0; pss < 5; ++pss) {
        const int jrel = pss * 64 + lane, jt = t - WIN + jrel; float s = -1e30f;
        if (jrel <= 2 * WIN && jt >= 0 && jt < SL) {
            const bf16_t* kp = P + (size_t)(m - WIN + jrel) * DINP + P_K + kvh * HD; const float* rk = rope + jt * 16;
            float acc = 0.f;
            for (int d = 0; d < 8; ++d) { const float k1 = bf2f(kp[d]), k2 = bf2f(kp[d + 8]); acc += qs[w][d] * (k1 * rk[d] - k2 * rk[8 + d]) + qs[w][d + 8] * (k2 * rk[d] + k1 * rk[8 + d]); }
            for (int d = 16; d < HD; ++d) acc += qs[w][d] * bf2f(kp[d]);
            s = acc * 0.125f;
        }
        sv[pss] = s; mx = fmaxf(mx, s);
    }
    for (int o = 32; o > 0; o >>= 1) mx = fmaxf(mx, __shfl_xor(mx, o));
    float den = 0.f;
#pragma unroll
    for (int pss = 0; pss < 5; ++pss) { const float p = (sv[pss] > -1e29f) ? expf(sv[pss] - mx) : 0.f; ps[w][pss * 64 + lane] = p; den += p; }
    for (int o = 32; o > 0; o >>= 1) den += __shfl_xor(den, o);
    den += expf(sink[w] - mx);
    __syncthreads();
    float o = 0.f;
    for (int jrel = 0; jrel <= 2 * WIN; ++jrel) { const int jt = t - WIN + jrel; if (jt < 0 || jt >= SL) continue; o += ps[w][jrel] * bf2f(P[(size_t)(m - WIN + jrel) * DINP + P_V + kvh * HD + lane]); }
    o /= den;
    const float ss = block_sum(o * o, red);
    const float r = 1.f / sqrtf(ss * (1.f / DBB) + EPS);
    YN[(size_t)m * DM + DA + w * HD + lane] = (bf16_t)f2bf(o * r * gn[w * HD + lane]);
}

__global__ __launch_bounds__(384) void k_attn_norm(const bf16_t* __restrict__ AO, const float* __restrict__ gn, bf16_t* __restrict__ YN) {
    __shared__ float red[8];
    const int m = blockIdx.x, j = threadIdx.x; const float o = bf2f(AO[(size_t)m * DBB + j]);
    const float ss = block_sum(o * o, red); const float r = 1.f / sqrtf(ss * (1.f / DBB) + EPS);
    YN[(size_t)m * DM + DA + j] = (bf16_t)f2bf(o * r * gn[j]);
}
__global__ __launch_bounds__(256) void k_hy_prep(const bf16_t* __restrict__ P, const float* __restrict__ cw, const float* __restrict__ cb, float* __restrict__ Z, float* __restrict__ X0) {
    const int m = blockIdx.x, t = m % SL, c = threadIdx.x;
    float u[3];
#pragma unroll
    for (int part = 0; part < 3; ++part) { const int ch = part * DC + c; float v = cb[ch];
#pragma unroll
        for (int k = 0; k < 3; ++k) { const int tt = t + k - 1; if (tt >= 0 && tt < SL) v += cw[k * 3 * DC + ch] * bf2f(P[(size_t)(m + k - 1) * DINP + P_CU + ch]); }
        u[part] = v; }
    Z[(size_t)m * DC + c] = u[2] * u[1]; X0[(size_t)m * DC + c] = u[0];
}
__global__ __launch_bounds__(256) void k_hy_conv(const float* __restrict__ Z, const float* __restrict__ X0, const float* __restrict__ HF, const float* __restrict__ bias, float* __restrict__ YC) {
    const int m = blockIdx.x, b = m / SL, t = m % SL, c = threadIdx.x;
    const float* zb = Z + (size_t)b * SL * DC + c; const float* hf = HF + c; const float* hb = HF + (size_t)SL * DC + c;
    float y = 0.f;
    for (int s = 0; s <= t; ++s) y += hf[(size_t)(t - s) * DC] * zb[(size_t)s * DC];
    for (int s = t + 1; s < SL; ++s) y += hb[(size_t)(s - t) * DC] * zb[(size_t)s * DC];
    YC[(size_t)m * DC + c] = (y + zb[(size_t)t * DC] * bias[c]) * X0[(size_t)m * DC + c];
}
__global__ __launch_bounds__(256) void k_hy_norm(const bf16_t* __restrict__ YCT, const float* __restrict__ gn, bf16_t* __restrict__ YN) {
    __shared__ float red[8];
    const int m = blockIdx.x, c = threadIdx.x; const float y = bf2f(YCT[((size_t)(m / SL) * DC + c) * SL + (m % SL)]);
    const float ss = block_sum(y * y, red); const float r = 1.f / sqrtf(ss * (1.f / DC) + EPS);
    YN[(size_t)m * DM + DA + DBB + c] = (bf16_t)f2bf(y * r * gn[c]);
}

namespace pg8 {
#define PG8_LAS __attribute__((address_space(3)))
typedef unsigned short bf16_t;
typedef short bf16x8 __attribute__((ext_vector_type(8)));
typedef float f32x4 __attribute__((ext_vector_type(4)));
typedef unsigned u32x4 __attribute__((ext_vector_type(4)));
constexpr int BM = 256, BK = 64, HALF = 128, HTB = HALF * BK * 2  , STAGE_BYTES = 8 * HTB, NXCD = 8, WGM = 8;

__host__ __device__ __forceinline__ int lds_byte(int r, int c) { const int st = (r >> 4) * 2 + (c >> 5), rr = r & 15, cc = c & 31, ob = rr * 64 + cc * 2; return st * 1024 + (ob ^ (((ob >> 9) & 1) << 5)); }
__host__ __device__ __forceinline__ void stage_rc(int b, int& R, int& C) { const int st = b / 1024, sb = b % 1024, swz = sb ^ (((sb >> 9) & 1) << 5); R = (st >> 1) * 16 + swz / 64; C = (st & 1) * 32 + (swz % 64) / 2; }
__host__ __device__ __forceinline__ int perm32(int rho) { const int n = rho >> 4, i = rho & 15; return 8 * (i >> 2) + 4 * n + (i & 3); }

struct Unit { int pm, pn; };
struct Gemm { const bf16_t* A; const bf16_t* Bt; int M, N, K; };

struct StaticOrder {
    int nM, nN, nwg, G, c;
    __host__ __device__ void init(int M, int N, int G_, int c_) { nM = M / BM; nN = N / BM; nwg = nM * nN; G = G_; c = c_; }
    __host__ __device__ bool next(int i, Unit& u) const {
        const long L = (long)i * G + c; if (L >= nwg) return false;
        int wgid = (int)L; { const int q = nwg / NXCD, r = nwg % NXCD, xcd = wgid % NXCD, off = wgid / NXCD; wgid = (xcd < r ? xcd * (q + 1) : r * (q + 1) + (xcd - r) * q) + off; }
        const int nig = WGM * nN, gid = wgid / nig, fm = gid * WGM, gsz = (nM - fm) < WGM ? (nM - fm) : WGM;
        u.pm = fm + ((wgid % nig) % gsz); u.pn = (wgid % nig) / gsz; return true;
    }
    __device__ __forceinline__ void a_ready(const Unit&) const {}
    __device__ __forceinline__ void done(const Unit&) const {}
};

__device__ __forceinline__ unsigned cvt_pk_bf16(float lo, float hi) { unsigned r; asm volatile("v_cvt_pk_bf16_f32 %0, %1, %2" : "=v"(r) : "v"(lo), "v"(hi)); return r; }

constexpr int E_DM = 1024, E_DINP = 2304, E_DFF = 4096; constexpr float E_EPS = 1e-6f;
__device__ __forceinline__ float rstd16(const float* SS, int row) {
    const f32x4* p = (const f32x4*)(SS + (size_t)row * 16); const f32x4 a = (p[0] + p[1]) + (p[2] + p[3]);
    return 1.0f / sqrtf(((a[0] + a[1]) + (a[2] + a[3])) * (1.0f / E_DM) + E_EPS);
}
template <int ACT> struct EpiScaleBf16 {
    static constexpr bool PERM = true, AFTER_DRAIN = false;
    bf16_t* O; int ldc; const float* SS;
    __device__ __forceinline__ void operator()(const f32x4 (&acc)[2][2][4][2], const Unit& u, int wr, int wc, int fr, int fq) const {
        const int row0 = u.pm * BM + wr * 64 + fr, col0 = u.pn * BM + wc * 32 + 8 * fq;
#pragma unroll
        for (int ai = 0; ai < 2; ++ai)
#pragma unroll
            for (int m = 0; m < 4; ++m) { const int row = row0 + ai * HALF + m * 16; const float r = rstd16(SS, row); bf16_t* rowp = O + (size_t)row * ldc + col0;
#pragma unroll
                for (int bj = 0; bj < 2; ++bj) { f32x4 v0 = acc[ai][bj][m][0] * r, v1 = acc[ai][bj][m][1] * r;
                    if (ACT == 1) {
#pragma unroll
                        for (int i = 0; i < 4; ++i) { const float a = fmaxf(v0[i], 0.f), b = fmaxf(v1[i], 0.f); v0[i] = a * a; v1[i] = b * b; } }
                    u32x4 w; w.x = cvt_pk_bf16(v0[0], v0[1]); w.y = cvt_pk_bf16(v0[2], v0[3]); w.z = cvt_pk_bf16(v1[0], v1[1]); w.w = cvt_pk_bf16(v1[2], v1[3]);
                    *(u32x4*)(rowp + bj * HALF) = w; } }
    }
};
__device__ __forceinline__ float bflo(unsigned u) { return __builtin_bit_cast(float, u << 16); }
__device__ __forceinline__ float bfhi(unsigned u) { return __builtin_bit_cast(float, u & 0xffff0000u); }
template <bool BASEF32> struct EpiResB {
    static constexpr bool PERM = true, AFTER_DRAIN = false;
    const void* base; bf16_t* out; bf16_t* XG; const float* g; float* SS;
    __device__ __forceinline__ void operator()(const f32x4 (&acc)[2][2][4][2], const Unit& u, int wr, int wc, int fr, int fq) const {
        const int row0 = u.pm * BM + wr * 64 + fr, col0 = u.pn * BM + wc * 32 + 8 * fq;
        f32x4 gv[2][2];
#pragma unroll
        for (int bj = 0; bj < 2; ++bj)
#pragma unroll
            for (int n = 0; n < 2; ++n) gv[bj][n] = XG ? *(const f32x4*)(g + col0 + bj * HALF + 4 * n) : (f32x4){0.f, 0.f, 0.f, 0.f};
#pragma unroll
        for (int ai = 0; ai < 2; ++ai)
#pragma unroll
            for (int m = 0; m < 4; ++m) { const int row = row0 + ai * HALF + m * 16; const size_t off = (size_t)row * E_DM + col0; float s = 0.f;
#pragma unroll
                for (int bj = 0; bj < 2; ++bj) { f32x4 b0, b1;
                    if (BASEF32) { b0 = *(const f32x4*)((const float*)base + off + bj * HALF); b1 = *(const f32x4*)((const float*)base + off + bj * HALF + 4); }
                    else { const u32x4 w = *(const u32x4*)((const bf16_t*)base + off + bj * HALF); b0 = (f32x4){bflo(w.x), bfhi(w.x), bflo(w.y), bfhi(w.y)}; b1 = (f32x4){bflo(w.z), bfhi(w.z), bflo(w.w), bfhi(w.w)}; }
                    const f32x4 v0 = b0 + acc[ai][bj][m][0], v1 = b1 + acc[ai][bj][m][1];
                    u32x4 o; o.x = cvt_pk_bf16(v0[0], v0[1]); o.y = cvt_pk_bf16(v0[2], v0[3]); o.z = cvt_pk_bf16(v1[0], v1[1]); o.w = cvt_pk_bf16(v1[2], v1[3]);
                    *(u32x4*)(out + off + bj * HALF) = o;
                    s += ((v0[0] * v0[0] + v0[1] * v0[1]) + (v0[2] * v0[2] + v0[3] * v0[3])) + ((v1[0] * v1[0] + v1[1] * v1[1]) + (v1[2] * v1[2] + v1[3] * v1[3]));
                    if (XG) { const f32x4 x0 = v0 * gv[bj][0], x1 = v1 * gv[bj][1]; u32x4 w; w.x = cvt_pk_bf16(x0[0], x0[1]); w.y = cvt_pk_bf16(x0[2], x0[3]); w.z = cvt_pk_bf16(x1[0], x1[1]); w.w = cvt_pk_bf16(x1[2], x1[3]);
                        *(u32x4*)(XG + off + bj * HALF) = w; } }
                s += __shfl_xor(s, 16); s += __shfl_xor(s, 32);
                if (fq == 0) SS[(size_t)row * 16 + u.pn * 4 + wc] = s;
                if (m & 1) asm volatile("" ::: "memory"); }
    }
};

template <class Epi, class Sched, bool ALIGN_EPI = false, bool SP2 = false>
__device__ __forceinline__ void gemm_phase(PG8_LAS unsigned char* lds, const Gemm g, const Sched& S, const Epi& E) {
    const int tid = threadIdx.x, wid = __builtin_amdgcn_readfirstlane(tid >> 6), lane = tid & 63, wr = wid >> 2, wc = wid & 3, fr = lane & 15, fq = lane >> 4;
    const int K = g.K, nt = K / BK;
    unsigned voffA[2], voffB[2];
#pragma unroll
    for (int i = 0; i < 2; ++i) { int R, C; stage_rc(tid * 16 + i * 8192, R, C); const int Rb = Epi::PERM ? ((R & ~31) + perm32(R & 31)) : R;
        voffA[i] = (unsigned)(R * K + C) * 2u; voffB[i] = (unsigned)(Rb * K + C) * 2u; }
    const size_t kstep = (size_t)(BK * 2);
    const size_t hstep = (size_t)HALF * K * 2;
    const size_t tstep = 2 * hstep;
    const unsigned ldsw = (unsigned)wid * 1024u;
    const int aoff = lds_byte(wr * 64 + fr, fq * 8), boff = lds_byte(wc * 32 + fr, fq * 8);
#define PG8_SA(b, h) (((b) * 2 + (h)) * HTB)
#define PG8_SB(b, h) ((4 + (b) * 2 + (h)) * HTB)
#define PG8_STAGE(bufoff, gbase, voff) do { _Pragma("unroll") for (int _i = 0; _i < 2; ++_i) \
        __builtin_amdgcn_global_load_lds((const unsigned*)((const char*)(gbase) + (voff)[_i]), (PG8_LAS unsigned*)(lds + (bufoff) + ldsw + _i * 8192), 16, 0, 0); } while (0)
#define PG8_LDA(dst, b, h) do { _Pragma("unroll") for (int m = 0; m < 4; ++m) _Pragma("unroll") for (int k = 0; k < 2; ++k) dst[m][k] = *(const PG8_LAS bf16x8*)(lds + PG8_SA(b, h) + aoff + m * 2048 + k * 1024); } while (0)
#define PG8_LDB(dst, b, h) do { _Pragma("unroll") for (int n = 0; n < 2; ++n) _Pragma("unroll") for (int k = 0; k < 2; ++k) dst[n][k] = *(const PG8_LAS bf16x8*)(lds + PG8_SB(b, h) + boff + n * 2048 + k * 1024); } while (0)
#define PG8_MMA(ai, bj, At, Bt) do { __builtin_amdgcn_s_setprio(1); _Pragma("unroll") for (int m = 0; m < 4; ++m) _Pragma("unroll") for (int n = 0; n < 2; ++n) _Pragma("unroll") for (int k = 0; k < 2; ++k) \
        acc[ai][bj][m][n] = __builtin_amdgcn_mfma_f32_16x16x32_bf16(Bt[n][k], At[m][k], acc[ai][bj][m][n], 0, 0, 0); __builtin_amdgcn_s_setprio(0); } while (0)
#define PG8_WAIT_V(n) asm volatile("s_waitcnt vmcnt(" #n ")" ::: "memory")
#define PG8_WAIT_L(n) asm volatile("s_waitcnt lgkmcnt(" #n ")" ::: "memory")
#define PG8_BAR __builtin_amdgcn_s_barrier()
#define PG8_SCHED __builtin_amdgcn_sched_barrier(0)
    Unit cur, nxt; int ui = 0;
    if (!S.next(0, cur)) return;
    f32x4 acc[2][2][4][2];
#pragma unroll
    for (int a = 0; a < 2; ++a)
#pragma unroll
        for (int b = 0; b < 2; ++b)
#pragma unroll
            for (int m = 0; m < 4; ++m)
#pragma unroll
                for (int n = 0; n < 2; ++n) acc[a][b][m][n] = (f32x4){0.f, 0.f, 0.f, 0.f};
    bf16x8 At[4][2], B0[2][2], B1[2][2];
    const char* cA = (const char*)g.A + (size_t)cur.pm * tstep; const char* cB = (const char*)g.Bt + (size_t)cur.pn * tstep;
    S.a_ready(cur);
    if constexpr (SP2) {
        PG8_STAGE(PG8_SB(0, 0), cB, voffB); PG8_STAGE(PG8_SB(0, 1), cB + hstep, voffB); PG8_STAGE(PG8_SA(0, 0), cA, voffA); PG8_STAGE(PG8_SA(0, 1), cA + hstep, voffA);
        if (wr == 1) PG8_BAR;
        PG8_WAIT_V(2); PG8_BAR;
        PG8_STAGE(PG8_SB(1, 0), cB + kstep, voffB); PG8_STAGE(PG8_SA(1, 0), cA + kstep, voffA); PG8_STAGE(PG8_SB(1, 1), cB + hstep + kstep, voffB);
        PG8_WAIT_V(6); PG8_BAR;
    } else {
        PG8_STAGE(PG8_SB(0, 0), cB, voffB); PG8_STAGE(PG8_SA(0, 0), cA, voffA); PG8_STAGE(PG8_SB(0, 1), cB + hstep, voffB); PG8_STAGE(PG8_SA(0, 1), cA + hstep, voffA);
        if (wr == 1) PG8_BAR;
        PG8_WAIT_V(4); PG8_BAR;
        PG8_STAGE(PG8_SB(1, 0), cB + kstep, voffB); PG8_STAGE(PG8_SA(1, 0), cA + kstep, voffA); PG8_STAGE(PG8_SB(1, 1), cB + hstep + kstep, voffB);
        PG8_WAIT_V(6); PG8_BAR;
    }
    for (;;) {
        const bool has_next = S.next(ui + 1, nxt);
        const char* nA = has_next ? (const char*)g.A + (size_t)nxt.pm * tstep : cA; const char* nB = has_next ? (const char*)g.Bt + (size_t)nxt.pn * tstep : cB;
        for (int t = 0; t < nt; t += 2) {
            const bool last = (t == nt - 2);
            const char* a1 = cA + (size_t)(t + 1) * kstep;
            const char* a2 = last ? nA : cA + (size_t)(t + 2) * kstep; const char* b2 = last ? nB : cB + (size_t)(t + 2) * kstep;
            const char* a3 = a2 + kstep; const char* b3 = b2 + kstep;
            if (last && has_next) S.a_ready(nxt);
            if constexpr (SP2) {
            PG8_LDB(B0, 0, 0); PG8_LDB(B1, 0, 1); PG8_SCHED; PG8_LDA(At, 0, 0); PG8_STAGE(PG8_SA(1, 1), a1 + hstep, voffA);
            PG8_WAIT_V(8); PG8_WAIT_L(0); PG8_BAR; PG8_MMA(0, 0, At, B0); PG8_MMA(0, 1, At, B1); PG8_BAR; PG8_SCHED;
            PG8_LDA(At, 0, 1); PG8_STAGE(PG8_SB(0, 0), b2, voffB); PG8_STAGE(PG8_SB(0, 1), b2 + hstep, voffB); PG8_STAGE(PG8_SA(0, 0), a2, voffA);
            PG8_WAIT_V(8); PG8_WAIT_L(0); PG8_BAR; PG8_MMA(1, 0, At, B0); PG8_MMA(1, 1, At, B1); PG8_BAR; PG8_SCHED;
            PG8_LDB(B0, 1, 0); PG8_LDB(B1, 1, 1); PG8_SCHED; PG8_LDA(At, 1, 0); PG8_STAGE(PG8_SA(0, 1), a2 + hstep, voffA);
            PG8_WAIT_V(8); PG8_WAIT_L(0); PG8_BAR; PG8_MMA(0, 0, At, B0); PG8_MMA(0, 1, At, B1); PG8_BAR; PG8_SCHED;
            PG8_LDA(At, 1, 1); PG8_STAGE(PG8_SB(1, 0), b3, voffB); PG8_STAGE(PG8_SB(1, 1), b3 + hstep, voffB); PG8_STAGE(PG8_SA(1, 0), a3, voffA);
            PG8_WAIT_V(8); PG8_WAIT_L(0); PG8_BAR; PG8_MMA(1, 0, At, B0); PG8_MMA(1, 1, At, B1); PG8_BAR; PG8_SCHED;
            } else {
            PG8_LDB(B0, 0, 0); PG8_SCHED; PG8_LDA(At, 0, 0); PG8_STAGE(PG8_SA(1, 1), a1 + hstep, voffA);
            PG8_WAIT_L(8); PG8_BAR; PG8_WAIT_L(0); PG8_MMA(0, 0, At, B0); PG8_BAR; PG8_SCHED;
            PG8_LDB(B1, 0, 1); PG8_STAGE(PG8_SB(0, 0), b2, voffB);
            PG8_BAR; PG8_WAIT_L(0); PG8_MMA(0, 1, At, B1); PG8_BAR;
            PG8_LDA(At, 0, 1); PG8_STAGE(PG8_SA(0, 0), a2, voffA);
            PG8_BAR; PG8_WAIT_L(0); PG8_MMA(1, 0, At, B0); PG8_BAR; PG8_SCHED;
            PG8_STAGE(PG8_SB(0, 1), b2 + hstep, voffB);
            PG8_WAIT_V(6); PG8_BAR; PG8_MMA(1, 1, At, B1); PG8_BAR;
            PG8_LDB(B0, 1, 0); PG8_SCHED; PG8_LDA(At, 1, 0); PG8_STAGE(PG8_SA(0, 1), a2 + hstep, voffA);
            PG8_WAIT_L(8); PG8_BAR; PG8_WAIT_L(0); PG8_MMA(0, 0, At, B0); PG8_BAR; PG8_SCHED;
            PG8_LDB(B1, 1, 1); PG8_STAGE(PG8_SB(1, 0), b3, voffB);
            PG8_BAR; PG8_WAIT_L(0); PG8_MMA(0, 1, At, B1); PG8_BAR;
            PG8_LDA(At, 1, 1); PG8_STAGE(PG8_SA(1, 0), a3, voffA);
            PG8_BAR; PG8_WAIT_L(0); PG8_MMA(1, 0, At, B0); PG8_BAR; PG8_SCHED;
            PG8_STAGE(PG8_SB(1, 1), b3 + hstep, voffB);
            PG8_WAIT_V(6); PG8_BAR; PG8_MMA(1, 1, At, B1); PG8_BAR;
            }
        }
        if constexpr (ALIGN_EPI) { if (wr == 0) PG8_BAR; }
        if constexpr (!Epi::AFTER_DRAIN) { E(acc, cur, wr, wc, fr, fq); S.done(cur); }
        if (!has_next) break;
#pragma unroll
        for (int a = 0; a < 2; ++a)
#pragma unroll
            for (int b = 0; b < 2; ++b)
#pragma unroll
                for (int m = 0; m < 4; ++m)
#pragma unroll
                    for (int n = 0; n < 2; ++n) acc[a][b][m][n] = (f32x4){0.f, 0.f, 0.f, 0.f};
        cur = nxt; cA = nA; cB = nB; ++ui;
        if constexpr (ALIGN_EPI) { if (wr == 1) PG8_BAR; }
    }
    PG8_WAIT_V(0);
    if constexpr (!ALIGN_EPI) { if (wr == 0) PG8_BAR; }
    PG8_BAR;
    if constexpr (Epi::AFTER_DRAIN) { E.fused(acc, cur, wr, wc, fr, fq, lds, wid, lane); S.done(cur); }
#undef PG8_SA
#undef PG8_SB
#undef PG8_STAGE
#undef PG8_LDA
#undef PG8_LDB
#undef PG8_MMA
#undef PG8_WAIT_V
#undef PG8_WAIT_L
#undef PG8_BAR
#undef PG8_SCHED
}
}

constexpr int NWAVES = 8, NTHREADS = 512;
constexpr int LDS_BYTES = 163840;
constexpr int RING_OFF = 0, RING_BYTES = 131072;
constexpr int MISC_OFF = LDS_BYTES - 256;
constexpr int PH_PRO = 0, PH_PER_LAYER = 7, PH_FINAL = 1 + PH_PER_LAYER * DEPTH, NPH = PH_FINAL + 1;
constexpr int PL_WIN = 0, PL_MIX1 = 1, PL_FFT = 2, PL_FIN = 3, PL_WOUT = 4, PL_WUP = 5, PL_WDN = 6;
constexpr int CW_BAR = 4096, N_BAR_REG = 12;

#define GAS __attribute__((address_space(1)))
#define LAS __attribute__((address_space(3)))
typedef unsigned v4u __attribute__((ext_vector_type(4)));
typedef GAS unsigned gu32;
#define RLX_AGENT __ATOMIC_RELAXED, __HIP_MEMORY_SCOPE_AGENT
#define LDS_WAIT() asm volatile("s_waitcnt lgkmcnt(0)" ::: "memory")
#define VM_WAIT() asm volatile("s_waitcnt vmcnt(0)" ::: "memory")
__device__ __forceinline__ unsigned pk2(float lo, float hi) { return f2bf(lo) | (f2bf(hi) << 16); }

#define XB_TMO      128
#define XB_XCNT(j)  (256  + 64 * (j))
#define XB_XSUB(j)  (1280 + 64 * (j))
#define XB_XGEN(j)  (2304 + 64 * (j))
#define XB_TOP      3328
#define XB_TOPGEN   3392
#define XCD_BAR_WORDS 3456
#define XB_SPIN_CAP (1u << 18)

__device__ __forceinline__ unsigned xb_ld(unsigned* p)              { return __hip_atomic_load(p, __ATOMIC_RELAXED, __HIP_MEMORY_SCOPE_AGENT); }
__device__ __forceinline__ unsigned xb_add(unsigned* p, unsigned v) { return __hip_atomic_fetch_add(p, v, __ATOMIC_RELAXED, __HIP_MEMORY_SCOPE_AGENT); }
__device__ __forceinline__ unsigned xb_xcc_id() { return (unsigned)__builtin_amdgcn_s_getreg((3 << 11) | 20) & 0xFu; }
#define XB_SPIN(cond, bar) do { unsigned _sp = 0; while (cond) { __builtin_amdgcn_s_sleep(1); \
    if ((++_sp & 255u) == 0u) { if (xb_ld(&(bar)[XB_TMO])) break; if (_sp > XB_SPIN_CAP) { atomicAdd(&(bar)[XB_TMO], 1u); break; } } } } while (0)

struct XcdBarrier {
    unsigned* bar; unsigned x;
    volatile LAS unsigned* st;
};

__device__ __forceinline__ XcdBarrier xcd_barrier_post(unsigned* bar, volatile LAS unsigned* st) {
    XcdBarrier b; b.bar = bar; b.x = xb_xcc_id(); b.st = st;
    if (threadIdx.x == 0) (void)xb_add(&bar[XB_XCNT(b.x)], 1u);
    return b;
}
__device__ __forceinline__ void xcd_barrier_complete(unsigned* bar, unsigned x, unsigned& nloc, unsigned& nx) {
    const unsigned G = gridDim.x * gridDim.y * gridDim.z;
    unsigned sum, cnt, mine, sp = 0u;
    for (;;) {
        sum = 0u; cnt = 0u; mine = 0u;
#pragma unroll
        for (unsigned j = 0; j < 16; ++j) { const unsigned c = xb_ld(&bar[XB_XCNT(j)]); sum += c; cnt += (c > 0u) ? 1u : 0u; mine = (j == x) ? c : mine; }
        if (sum == G) break;
        __builtin_amdgcn_s_sleep(1);
        if ((++sp & 255u) == 0u) { if (xb_ld(&bar[XB_TMO])) break; if (sp > XB_SPIN_CAP) { atomicAdd(&bar[XB_TMO], 1u); break; } }
    }
    nloc = mine > 0u ? mine : 1u; nx = cnt > 0u ? cnt : 1u;
}

__device__ __forceinline__ void xcd_barrier(const XcdBarrier& b) {
    asm volatile("s_waitcnt vmcnt(0)" ::: "memory");
    __syncthreads();
    if (threadIdx.x == 0) {
        unsigned* bar = b.bar;
        __builtin_amdgcn_s_waitcnt(0);
        unsigned nloc = b.st[0], nx = b.st[1];
        if (nloc == 0u) { xcd_barrier_complete(bar, b.x, nloc, nx); b.st[0] = nloc; b.st[1] = nx; }
        const unsigned old = xb_add(&bar[XB_XSUB(b.x)], 1u);
        const unsigned gen = old / nloc;
        if (old + 1u == (gen + 1u) * nloc) {
            __builtin_amdgcn_fence(__ATOMIC_RELEASE, "agent");
            asm volatile("s_waitcnt vmcnt(0)" ::: "memory");
            const unsigned og = xb_add(&bar[XB_TOP], 1u);
            const unsigned tg = og / nx;
            if (og + 1u == (tg + 1u) * nx) xb_add(&bar[XB_TOPGEN], 1u);
            else XB_SPIN(xb_ld(&bar[XB_TOPGEN]) == tg, bar);
            __builtin_amdgcn_fence(__ATOMIC_ACQUIRE, "agent");
            xb_add(&bar[XB_XGEN(b.x)], 1u);
            asm volatile("s_waitcnt vmcnt(0)" ::: "memory");
        } else {
            XB_SPIN(xb_ld(&bar[XB_XGEN(b.x)]) == gen, bar);
            __builtin_amdgcn_fence(__ATOMIC_ACQUIRE, "agent");
            asm volatile("s_waitcnt vmcnt(0)" ::: "memory");
        }
    }
    __syncthreads();
}

constexpr size_t WS_ZT = WS_SCR, WS_X0T = WS_SCR + 8 * MiB, WS_YCT = WS_SCR + 16 * MiB;
constexpr size_t WS_TW = WS_ROPE + 256 * 1024;
namespace hy {
typedef float cf __attribute__((ext_vector_type(2)));
__device__ __forceinline__ cf cmul(cf a, cf b) { return {a.x * b.x - a.y * b.y, a.x * b.y + a.y * b.x}; }
__device__ __forceinline__ cf cmulc(cf a, cf b) { return {a.x * b.x + a.y * b.y, a.y * b.x - a.x * b.y}; }
__device__ __forceinline__ cf cadd(cf a, cf b) { return {a.x + b.x, a.y + b.y}; }
__device__ __forceinline__ cf csub(cf a, cf b) { return {a.x - b.x, a.y - b.y}; }
__device__ __forceinline__ int pidx(int i) { return i + (i >> 5); }
constexpr int FBUF = 8192 + 256;
template <bool INV> __device__ __forceinline__ cf tw16(cf d, int K) {
    float c, s;
    switch (K) {
        case 0: return d;
        case 4: return INV ? cf{-d.y, d.x} : cf{d.y, -d.x};
        case 1: c = 0.92387953251128674f; s = 0.38268343236508977f; break;
        case 2: c = 0.70710678118654752f; s = 0.70710678118654752f; break;
        case 3: c = 0.38268343236508977f; s = 0.92387953251128674f; break;
        case 5: c = -0.38268343236508977f; s = 0.92387953251128674f; break;
        case 6: c = -0.70710678118654752f; s = 0.70710678118654752f; break;
        default: c = -0.92387953251128674f; s = 0.38268343236508977f; break;
    }
    const cf w = {c, INV ? s : -s};
    return cmul(d, w);
}
template <int H, bool INV> __device__ __forceinline__ void stage16(cf (&v)[16]) {
#pragma unroll
    for (int blk = 0; blk < 16; blk += 2 * H)
#pragma unroll
        for (int j = 0; j < H; ++j) {
            if (!INV) { const cf a = v[blk + j], b = v[blk + j + H]; v[blk + j] = cadd(a, b); v[blk + j + H] = tw16<false>(csub(a, b), j * (8 / H)); }
            else { const cf A = v[blk + j], B = tw16<true>(v[blk + j + H], j * (8 / H)); v[blk + j] = cadd(A, B); v[blk + j + H] = csub(A, B); }
        }
}
template <bool INV> __device__ __forceinline__ void dft16(cf (&v)[16]) {
    if (!INV) { stage16<8, false>(v); stage16<4, false>(v); stage16<2, false>(v); stage16<1, false>(v); }
    else { stage16<1, true>(v); stage16<2, true>(v); stage16<4, true>(v); stage16<8, true>(v); }
}
__device__ __forceinline__ constexpr int br4(int r) { return ((r & 1) << 3) | ((r & 2) << 1) | ((r & 4) >> 1) | ((r & 8) >> 3); }
template <bool INV, int LSL> __device__ __forceinline__ void pass16(LAS cf* buf, int tid, const cf* __restrict__ TW) {
    constexpr int SH = LSL - 4, st = 1 << SH;
    asm volatile("" : "+v"(tid));
    const int sub = tid >> SH, n2 = tid & (st - 1), base = (sub << LSL) + n2;
    cf v[16];
#pragma unroll
    for (int r = 0; r < 16; ++r) v[r] = buf[pidx(base + r * st)];
    cf wp[16];
    wp[1] = TW[n2 << (13 - LSL)];
    asm volatile("" : "+v"(wp[1].x), "+v"(wp[1].y));
    wp[2] = cmul(wp[1], wp[1]); wp[4] = cmul(wp[2], wp[2]); wp[8] = cmul(wp[4], wp[4]);
    wp[3] = cmul(wp[2], wp[1]); wp[5] = cmul(wp[4], wp[1]); wp[6] = cmul(wp[4], wp[2]); wp[7] = cmul(wp[4], wp[3]);
    wp[9] = cmul(wp[8], wp[1]); wp[10] = cmul(wp[8], wp[2]); wp[11] = cmul(wp[8], wp[3]); wp[12] = cmul(wp[8], wp[4]);
    wp[13] = cmul(wp[8], wp[5]); wp[14] = cmul(wp[8], wp[6]); wp[15] = cmul(wp[8], wp[7]);
    if (!INV) {
        dft16<false>(v);
#pragma unroll
        for (int r = 1; r < 16; ++r) v[r] = cmul(v[r], wp[br4(r)]);
    } else {
#pragma unroll
        for (int r = 1; r < 16; ++r) v[r] = cmulc(v[r], wp[br4(r)]);
        dft16<true>(v);
    }
#pragma unroll
    for (int r = 0; r < 16; ++r) buf[pidx(base + r * st)] = v[r];
}
template <bool MUL> __device__ __forceinline__ void mid2(LAS cf* D, const LAS cf* Hs, int tid) {
    asm volatile("" : "+v"(tid));
#pragma unroll
    for (int e = 0; e < 8; ++e) { const int i = 16 * tid + 2 * e; const cf a = D[pidx(i)], b = D[pidx(i + 1)]; cf A = cadd(a, b), B = csub(a, b);
        if (MUL) { A = cmul(A, Hs[pidx(i)]); B = cmul(B, Hs[pidx(i + 1)]); D[pidx(i)] = cadd(A, B); D[pidx(i + 1)] = csub(A, B); }
        else { D[pidx(i)] = A; D[pidx(i + 1)] = B; } }
}
#define HY_SYNC() __syncthreads()
__device__ __forceinline__ void fft_unit(LAS unsigned char* lds, int c, int tid, const float* __restrict__ HFT_l, const cf* __restrict__ TW, const bf16_t* __restrict__ ZT, const bf16_t* __restrict__ X0T,
                                         bf16_t* __restrict__ YCT, float bias) {
    asm volatile("" : "+v"(tid));
    LAS cf* D = (LAS cf*)lds; LAS cf* Hs = D + FBUF;
    const float* hsrc = HFT_l + (size_t)c * 8192;
#pragma unroll
    for (int k = 0; k < 16; ++k) { const int i = k * 512 + tid; Hs[pidx(i)] = cf{hsrc[i], 0.f}; }
    HY_SYNC();
    pass16<false, 13>(Hs, tid, TW); HY_SYNC();
    pass16<false, 9>(Hs, tid, TW); HY_SYNC();
    pass16<false, 5>(Hs, tid, TW); HY_SYNC();
    mid2<false>(Hs, Hs, tid); HY_SYNC();
    for (int pr = 0; pr < 2; ++pr) {
        const size_t o0 = ((size_t)(2 * pr) * DC + c) * SL, o1 = ((size_t)(2 * pr + 1) * DC + c) * SL;
#pragma unroll
        for (int k = 0; k < 8; ++k) { const int i = k * 512 + tid; D[pidx(i)] = cf{bf2f(ZT[o0 + i]), bf2f(ZT[o1 + i])}; D[pidx(i + 4096)] = cf{0.f, 0.f}; }
        HY_SYNC();
        pass16<false, 13>(D, tid, TW); HY_SYNC();
        pass16<false, 9>(D, tid, TW); HY_SYNC();
        pass16<false, 5>(D, tid, TW); HY_SYNC();
        mid2<true>(D, Hs, tid); HY_SYNC();
        pass16<true, 5>(D, tid, TW); HY_SYNC();
        pass16<true, 9>(D, tid, TW); HY_SYNC();
        pass16<true, 13>(D, tid, TW); HY_SYNC();
#pragma unroll
        for (int k = 0; k < 8; ++k) { const int i = k * 512 + tid; const cf y = D[pidx(i)];
            const float z0 = bf2f(ZT[o0 + i]), z1 = bf2f(ZT[o1 + i]), a0 = bf2f(X0T[o0 + i]), a1 = bf2f(X0T[o1 + i]);
            YCT[o0 + i] = (bf16_t)f2bf((y.x * (1.f / 8192.f) + z0 * bias) * a0); YCT[o1 + i] = (bf16_t)f2bf((y.y * (1.f / 8192.f) + z1 * bias) * a1); }
        HY_SYNC();
    }
}
constexpr int HP_ROWB = 1540;
__device__ __forceinline__ void hyprep_unit(LAS unsigned char* lds, int unit, int tid, const bf16_t* __restrict__ P, const float* __restrict__ cw, const float* __restrict__ cb,
                                            bf16_t* __restrict__ ZT, bf16_t* __restrict__ X0T) {
    asm volatile("" : "+v"(tid));
    const int b = unit >> 6, t0 = (unit & 63) * 64; const size_t m0 = (size_t)b * SL + t0;
    LAS float* CWL = (LAS float*)(lds + 101648);
    __syncthreads();
#pragma unroll
    for (int hb = 0; hb < 2; ++hb) { uint4 sv[7];
#pragma unroll
        for (int q = 0; q < 7; ++q) { const int i = tid + (hb * 7 + q) * NTHREADS, r = i / 96, ch8 = i % 96, t = t0 - 1 + r; const bool inb = (i < 66 * 96) && t >= 0 && t < SL;
            sv[q] = *(const uint4*)(P + (inb ? ((m0 + r - 1) * DINP + P_CU + ch8 * 8) : (m0 * DINP + P_CU))); if (!inb) sv[q] = make_uint4(0u, 0u, 0u, 0u); }
#pragma unroll
        for (int q = 0; q < 7; ++q) { const int i = tid + (hb * 7 + q) * NTHREADS, r = i / 96, ch8 = i % 96;
            if (i < 66 * 96) { LAS unsigned* d = (LAS unsigned*)(lds + r * HP_ROWB + ch8 * 16); d[0] = sv[q].x; d[1] = sv[q].y; d[2] = sv[q].z; d[3] = sv[q].w; } } }
    for (int i = tid; i < 4 * 768; i += NTHREADS) CWL[i] = (i < 3 * 768) ? cw[i] : cb[i - 3 * 768];
    __syncthreads();
    const int tok = tid & 63, wv = tid >> 6;
    for (int j = 0; j < 32; ++j) { const int c = wv * 32 + j; float u[3];
#pragma unroll
        for (int part = 0; part < 3; ++part) { const int ch = part * DC + c; float a = CWL[3 * 768 + ch];
#pragma unroll
            for (int k = 0; k < 3; ++k) a += CWL[k * 768 + ch] * bf2f(*(const LAS bf16_t*)(lds + (tok + k) * HP_ROWB + ch * 2));
            u[part] = a; }
        const size_t o = ((size_t)b * DC + c) * SL + t0 + tok;
        ZT[o] = (bf16_t)f2bf(u[2] * u[1]); X0T[o] = (bf16_t)f2bf(u[0]); }
    __syncthreads();
}
__device__ __forceinline__ void filter_unit(LAS unsigned char* lds, int tb, int tid, const float* __restrict__ w1, const float* __restrict__ b1, const float* __restrict__ freq,
                                            const float* __restrict__ w2, const float* __restrict__ b2, const float* __restrict__ w3, float* __restrict__ HFT_l) {
    asm volatile("" : "+v"(tid));
    LAS float* Z = (LAS float*)lds;
    LAS float* H1T = Z + 32 * 36;
    LAS float* H2T = H1T + 64 * 32;
    const int t0 = tb * 32;
    __syncthreads();
    {   const int pos = tid >> 4, f = tid & 15, t = t0 + pos;
        const double fb = 1e-4 + (double)f * ((15.0 - 1e-4) / 15.0), w = 6.283185307179586476925286766559 * (double)t / (double)SL;
        Z[pos * 36 + 1 + f] = (float)cos(fb * w); Z[pos * 36 + 17 + f] = (float)(-sin(fb * w));
        if (f == 0) Z[pos * 36] = (float)((double)t / (double)(SL - 1)); }
    __syncthreads();
    {   const int j = tid & 63; const float fj = freq[j], bj = b1[j];
#pragma unroll
        for (int q = 0; q < 4; ++q) { const int pos = (tid >> 6) + 8 * q; float a = bj;
#pragma unroll 11
            for (int i = 0; i < HY_EMB; ++i) a += Z[pos * 36 + i] * w1[i * HY_W + j];
            H1T[j * 32 + pos] = sinf(fj * a); } }
    __syncthreads();
    {   const int j = tid & 63; const float fj = freq[j], bj = b2[j];
#pragma unroll
        for (int q = 0; q < 4; ++q) { const int pos = (tid >> 6) + 8 * q; float a = bj;
#pragma unroll 16
            for (int i = 0; i < HY_W; ++i) a += H1T[i * 32 + pos] * w2[i * HY_W + j];
            H2T[j * 32 + pos] = sinf(fj * a); } }
    __syncthreads();
    {   const int o = tid, c = o & 255, dir = o >> 8;
        float acc[32];
#pragma unroll
        for (int p = 0; p < 32; ++p) acc[p] = 0.f;
#pragma unroll 8
        for (int i = 0; i < HY_W; ++i) { const float w = w3[i * 2 * DC + o];
#pragma unroll
            for (int p4 = 0; p4 < 8; ++p4) { const f32x4 h = *(const LAS f32x4*)(H2T + i * 32 + p4 * 4);
                acc[4 * p4] += h[0] * w; acc[4 * p4 + 1] += h[1] * w; acc[4 * p4 + 2] += h[2] * w; acc[4 * p4 + 3] += h[3] * w; } }
        const double mind = log(1e-2) / 1.5, maxd = log(1e-2) / 0.3;
        const float delta = fabsf((float)(mind + (maxd - mind) * (double)c / 255.0));
#pragma unroll
        for (int p = 0; p < 32; ++p) { const int t = t0 + p; const float tt = (float)((double)t / (double)(SL - 1)); acc[p] *= __builtin_amdgcn_exp2f(-1.4426950408889634f * tt * delta); }
        float* row = HFT_l + (size_t)c * 8192;
        if (dir == 0) {
#pragma unroll
            for (int p4 = 0; p4 < 8; ++p4) *(f32x4*)(row + t0 + 4 * p4) = (f32x4){acc[4 * p4], acc[4 * p4 + 1], acc[4 * p4 + 2], acc[4 * p4 + 3]};
            if (t0 == 0) row[4096] = 0.f;
        } else {
#pragma unroll
            for (int p = 0; p < 32; ++p) if (t0 + p > 0) row[8192 - t0 - p] = acc[p];
        } }
}
}

constexpr size_t WS_AO = 222 * MiB;
namespace at {
typedef short v4i16_t __attribute__((ext_vector_type(4)));
constexpr int KROW = 144, NKEY = 400, V_OFF = NKEY * KROW;
__device__ __forceinline__ float blo(unsigned u) { return __builtin_bit_cast(float, u << 16); }
__device__ __forceinline__ float bhi(unsigned u) { return __builtin_bit_cast(float, u & 0xffff0000u); }
__device__ __forceinline__ void rope16(uint4& A, uint4& B, const float* __restrict__ cs, float scale) {
    const f32x4 c0 = *(const f32x4*)cs, c1 = *(const f32x4*)(cs + 4), s0 = *(const f32x4*)(cs + 8), s1 = *(const f32x4*)(cs + 12);
    const float c[8] = {c0[0], c0[1], c0[2], c0[3], c1[0], c1[1], c1[2], c1[3]}, s[8] = {s0[0], s0[1], s0[2], s0[3], s1[0], s1[1], s1[2], s1[3]};
    unsigned a[4] = {A.x, A.y, A.z, A.w}, b[4] = {B.x, B.y, B.z, B.w};
#pragma unroll
    for (int d = 0; d < 4; ++d) {
        const float t1l = blo(a[d]), t1h = bhi(a[d]), t2l = blo(b[d]), t2h = bhi(b[d]);
        const float o1l = (t1l * c[2 * d] - t2l * s[2 * d]) * scale, o1h = (t1h * c[2 * d + 1] - t2h * s[2 * d + 1]) * scale;
        const float o2l = (t2l * c[2 * d] + t1l * s[2 * d]) * scale, o2h = (t2h * c[2 * d + 1] + t1h * s[2 * d + 1]) * scale;
        a[d] = f2bf(o1l) | (f2bf(o1h) << 16); b[d] = f2bf(o2l) | (f2bf(o2h) << 16);
    }
    A = make_uint4(a[0], a[1], a[2], a[3]); B = make_uint4(b[0], b[1], b[2], b[3]);
}
__device__ __forceinline__ void rope16s(uint4& A, uint4& B, const float (&cs)[16], float scale) {
    unsigned a[4] = {A.x, A.y, A.z, A.w}, b[4] = {B.x, B.y, B.z, B.w};
#pragma unroll
    for (int d = 0; d < 4; ++d) {
        const float t1l = blo(a[d]), t1h = bhi(a[d]), t2l = blo(b[d]), t2h = bhi(b[d]);
        const float o1l = (t1l * cs[2 * d] - t2l * cs[8 + 2 * d]) * scale, o1h = (t1h * cs[2 * d + 1] - t2h * cs[8 + 2 * d + 1]) * scale;
        const float o2l = (t2l * cs[2 * d] + t1l * cs[8 + 2 * d]) * scale, o2h = (t2h * cs[2 * d + 1] + t1h * cs[8 + 2 * d + 1]) * scale;
        a[d] = f2bf(o1l) | (f2bf(o1h) << 16); b[d] = f2bf(o2l) | (f2bf(o2h) << 16);
    }
    A = make_uint4(a[0], a[1], a[2], a[3]); B = make_uint4(b[0], b[1], b[2], b[3]);
}
__device__ __forceinline__ unsigned scale2(unsigned u, float sc) { return f2bf(blo(u) * sc) | (f2bf(bhi(u) * sc) << 16); }
__device__ __forceinline__ void attn_unit(LAS unsigned char* lds, int unit, int tid, const bf16_t* __restrict__ P, const float* __restrict__ rope, const float* __restrict__ sink_l, bf16_t* __restrict__ AO) {
    asm volatile("" : "+v"(tid));
    const int b = unit >> 6, kvh = (unit >> 5) & 1, q0 = (unit & 31) * 128, W0 = q0 - 128;
    const size_t m0 = (size_t)b * SL;
    const int lane = tid & 63, wave = __builtin_amdgcn_readfirstlane(tid >> 6), i = lane & 15, g = lane >> 4;
    __syncthreads();
    {   uint4 va[6], vb[6];
#pragma unroll
        for (int q = 0; q < 6; ++q) { const int j = tid + q * NTHREADS; const bool isV = j >= 1200; const int jj = isV ? j - 1200 : j, kk = isV ? (jj >> 2) : (jj / 3), ch = isV ? (jj & 3) : (1 + jj % 3), pos = W0 + kk;
            const bool inb = (j < 2800) && pos >= 0 && pos < SL;
            const bf16_t* src = P + (inb ? ((m0 + pos) * DINP + (isV ? P_V : P_K) + kvh * HD + ch * 16) : (m0 * DINP + P_K));
            va[q] = *(const uint4*)src; vb[q] = *(const uint4*)(src + 8); if (!inb) { va[q] = make_uint4(0u, 0u, 0u, 0u); vb[q] = va[q]; } }
        uint4 ra = make_uint4(0u, 0u, 0u, 0u), rb = ra; f32x4 rc[4];
        {   const int pos = W0 + tid; const bool inb = (tid < NKEY) && pos >= 0 && pos < SL; const int pc = inb ? pos : 0;
            const bf16_t* src = P + (m0 + pc) * DINP + P_K + kvh * HD; ra = *(const uint4*)src; rb = *(const uint4*)(src + 8);
#pragma unroll
            for (int q = 0; q < 4; ++q) rc[q] = *(const f32x4*)(rope + pc * 16 + 4 * q);
            float cs[16];
#pragma unroll
            for (int q = 0; q < 16; ++q) cs[q] = rc[q >> 2][q & 3];
            rope16s(ra, rb, cs, 1.0f);
            if (!inb) { ra = make_uint4(0u, 0u, 0u, 0u); rb = ra; } }
#pragma unroll
        for (int q = 0; q < 6; ++q) { const int j = tid + q * NTHREADS; const bool isV = j >= 1200; const int jj = isV ? j - 1200 : j, kk = isV ? (jj >> 2) : (jj / 3), ch = isV ? (jj & 3) : (1 + jj % 3);
            if (j < 2800) { LAS unsigned char* dst = lds + (isV ? V_OFF : 0) + kk * KROW + ch * 32;
                *(LAS v4u*)dst = (v4u){va[q].x, va[q].y, va[q].z, va[q].w}; *(LAS v4u*)(dst + 16) = (v4u){vb[q].x, vb[q].y, vb[q].z, vb[q].w}; } }
        if (tid < NKEY) { LAS unsigned char* dst = lds + tid * KROW; *(LAS v4u*)dst = (v4u){ra.x, ra.y, ra.z, ra.w}; *(LAS v4u*)(dst + 16) = (v4u){rb.x, rb.y, rb.z, rb.w}; }
    }
    __syncthreads();
    const bool edge = (q0 == 0) || (q0 == SL - 128);
#pragma unroll 1
    for (int gi = 0; gi < 3; ++gi) {
        const int grp = wave * 3 + gi, hl = grp >> 3, qsub = grp & 7, head = kvh * 3 + hl;
        const int tok = q0 + 16 * qsub + i;
        bf16x8 qf[2];
        {   const bf16_t* qp = P + (m0 + tok) * DINP + P_Q + head * HD + g * 8;
            uint4 own = *(const uint4*)qp, hi2 = *(const uint4*)(qp + 32);
            uint4 oth; oth.x = __shfl_xor(own.x, 16); oth.y = __shfl_xor(own.y, 16); oth.z = __shfl_xor(own.z, 16); oth.w = __shfl_xor(own.w, 16);
            uint4 t1 = (g == 0) ? own : oth, t2 = (g == 0) ? oth : own;
            rope16(t1, t2, rope + tok * 16, 0.125f);
            uint4 r0;
            if (g == 0) r0 = t1; else if (g == 1) r0 = t2; else r0 = make_uint4(scale2(own.x, 0.125f), scale2(own.y, 0.125f), scale2(own.z, 0.125f), scale2(own.w, 0.125f));
            hi2 = make_uint4(scale2(hi2.x, 0.125f), scale2(hi2.y, 0.125f), scale2(hi2.z, 0.125f), scale2(hi2.w, 0.125f));
            qf[0] = __builtin_bit_cast(bf16x8, r0); qf[1] = __builtin_bit_cast(bf16x8, hi2); }
        f32x4 st[17];
        const LAS unsigned char* kb = lds + (16 * qsub + i) * KROW + g * 16;
#pragma unroll
        for (int tt = 0; tt < 17; ++tt) {
            const bf16x8 k0 = *(const LAS bf16x8*)(kb + tt * 16 * KROW), k1 = *(const LAS bf16x8*)(kb + tt * 16 * KROW + 64);
            f32x4 acc = __builtin_amdgcn_mfma_f32_16x16x32_bf16(k0, qf[0], (f32x4){0.f, 0.f, 0.f, 0.f}, 0, 0, 0);
            st[tt] = __builtin_amdgcn_mfma_f32_16x16x32_bf16(k1, qf[1], acc, 0, 0, 0);
        }
        const float NEGF = -1e30f;
#pragma unroll
        for (int r = 0; r < 4; ++r) { if (4 * g + r < i) st[0][r] = NEGF; if (4 * g + r > i) st[16][r] = NEGF; }
        if (edge) {
#pragma unroll
            for (int tt = 0; tt < 17; ++tt)
#pragma unroll
                for (int r = 0; r < 4; ++r) { const int pos = W0 + 16 * (qsub + tt) + 4 * g + r; if (pos < 0 || pos >= SL) st[tt][r] = NEGF; }
        }
        const float sk = sink_l[head];
        float mx = sk;
#pragma unroll
        for (int tt = 0; tt < 17; ++tt) mx = fmaxf(fmaxf(mx, fmaxf(st[tt][0], st[tt][1])), fmaxf(st[tt][2], st[tt][3]));
        mx = fmaxf(mx, __shfl_xor(mx, 16)); mx = fmaxf(mx, __shfl_xor(mx, 32));
        const float L2E = 1.4426950408889634f, mb = mx * L2E;
        float lsum = 0.f;
        bf16x8 pf[9];
#pragma unroll
        for (int s = 0; s < 9; ++s) {
            float p[8];
#pragma unroll
            for (int r = 0; r < 4; ++r) { p[r] = __builtin_amdgcn_exp2f(st[2 * s][r] * L2E - mb); p[4 + r] = (2 * s + 1 < 17) ? __builtin_amdgcn_exp2f(st[(2 * s + 1 < 17) ? 2 * s + 1 : 16][r] * L2E - mb) : 0.f; }
#pragma unroll
            for (int r = 0; r < 8; ++r) lsum += p[r];
            uint4 w; w.x = f2bf(p[0]) | (f2bf(p[1]) << 16); w.y = f2bf(p[2]) | (f2bf(p[3]) << 16); w.z = f2bf(p[4]) | (f2bf(p[5]) << 16); w.w = f2bf(p[6]) | (f2bf(p[7]) << 16);
            pf[s] = __builtin_bit_cast(bf16x8, w);
        }
        lsum += __shfl_xor(lsum, 16); lsum += __shfl_xor(lsum, 32);
        lsum += __builtin_amdgcn_exp2f(sk * L2E - mb);
        const float rl = 1.0f / lsum;
        const LAS unsigned char* vb = lds + V_OFF + (16 * qsub + 4 * g + (i >> 2)) * KROW + (i & 3) * 8;
        bf16_t* op = AO + (m0 + tok) * DBB + head * HD + 4 * g;
#pragma unroll
        for (int dt = 0; dt < 4; ++dt) {
            f32x4 o = (f32x4){0.f, 0.f, 0.f, 0.f};
#pragma unroll
            for (int s = 0; s < 9; ++s) {
                const v4i16_t lo = __builtin_amdgcn_ds_read_tr16_b64_v4i16((LAS v4i16_t*)(vb + (32 * s) * KROW + dt * 32));
                const v4i16_t hi = __builtin_amdgcn_ds_read_tr16_b64_v4i16((LAS v4i16_t*)(vb + (32 * s + 16) * KROW + dt * 32));
                const bf16x8 vf = (bf16x8){lo[0], lo[1], lo[2], lo[3], hi[0], hi[1], hi[2], hi[3]};
                o = __builtin_amdgcn_mfma_f32_16x16x32_bf16(vf, pf[s], o, 0, 0, 0);
            }
            uint2 w; w.x = f2bf(o[0] * rl) | (f2bf(o[1] * rl) << 16); w.y = f2bf(o[2] * rl) | (f2bf(o[3] * rl) << 16);
            *(uint2*)(op + dt * 16) = w;
        }
    }
}
}

constexpr size_t WS_AGG = 234 * MiB;
constexpr size_t WS_LS = WS_XG, WS_LPF = WS_XG + 12 * MiB, WS_LPB = 236 * MiB;
constexpr size_t WS_LW = WS_ROPE + 512 * 1024;
namespace lru {
constexpr int AXROW = 784, XCROW = 784, XC_OFF = 67 * AXROW, CARRY_OFF = XC_OFF + 64 * XCROW, SSQ_OFF = CARRY_OFF + 2 * DA * 4, RSTD_OFF = SSQ_OFF + 64 * 24 * 4;
__device__ __forceinline__ float fsig(float x) { return __builtin_amdgcn_rcpf(1.0f + __builtin_amdgcn_exp2f(-1.4426950408889634f * x)); }
__device__ __forceinline__ float fgelu(float x) { const float u = 0.7978845608028654f * (x + 0.044715f * x * x * x); const float e = __builtin_amdgcn_exp2f(2.8853900817779268f * u);
    const float th = 1.0f - 2.0f * __builtin_amdgcn_rcpf(1.0f + e); return 0.5f * x * (1.0f + th); }
template <int CTRL> __device__ __forceinline__ float dppf(float v) { return __builtin_bit_cast(float, __builtin_amdgcn_update_dpp(0, __builtin_bit_cast(int, v), CTRL, 0xf, 0xf, true)); }
__device__ __forceinline__ float row16_sum(float v) { v += dppf<0xB1>(v); v += dppf<0x4E>(v); v += dppf<0x141>(v); v += dppf<0x140>(v); return v; }
__device__ __forceinline__ void lru_unit(LAS unsigned char* lds, int unit, int tid, const bf16_t* __restrict__ P, const float* __restrict__ cw, const float* __restrict__ cb, const bf16_t* __restrict__ LW_l,
                                         const float* __restrict__ ba, const float* __restrict__ bx, const float* __restrict__ lam, float* __restrict__ AGG, bf16_t* __restrict__ LS, bf16_t* __restrict__ LPF, bf16_t* __restrict__ LPB) {
    asm volatile("" : "+v"(tid));
    const int b = unit >> 6, kc = unit & 63, t0 = kc * 64; const size_t m0 = (size_t)b * SL + t0;
    const int lane = tid & 63, wave = __builtin_amdgcn_readfirstlane(tid >> 6), li_ = lane & 15, g_ = lane >> 4;
    LAS unsigned char* AX = lds; LAS unsigned char* XC = lds + XC_OFF;
    __syncthreads();
    {   uint4 sv[7];
#pragma unroll
        for (int q = 0; q < 7; ++q) { const int it = tid + q * NTHREADS, r = it / 48, c8 = it % 48, t = t0 - 2 + r; const bool inb = (it < 67 * 48) && t >= 0 && t < SL;
            sv[q] = *(const uint4*)(P + (inb ? ((m0 + r - 2) * DINP + P_AX + c8 * 8) : (m0 * DINP + P_AX))); if (!inb) sv[q] = make_uint4(0u, 0u, 0u, 0u); }
#pragma unroll
        for (int q = 0; q < 7; ++q) { const int it = tid + q * NTHREADS, r = it / 48, c8 = it % 48;
            if (it < 67 * 48) *(LAS v4u*)(AX + r * AXROW + c8 * 16) = (v4u){sv[q].x, sv[q].y, sv[q].z, sv[q].w}; } }
    __syncthreads();
    if (tid < 384) { const int c8 = tid % 48, tg = tid / 48, ch0 = c8 * 8;
        float w[4][8], bb[8];
#pragma unroll
        for (int e = 0; e < 8; ++e) { bb[e] = cb[ch0 + e];
#pragma unroll
            for (int k = 0; k < 4; ++k) w[k][e] = cw[k * DA + ch0 + e]; }
        for (int q = 0; q < 8; ++q) { const int tok = tg * 8 + q; float acc[8];
#pragma unroll
            for (int e = 0; e < 8; ++e) acc[e] = bb[e];
#pragma unroll
            for (int k = 0; k < 4; ++k) { const v4u v = *(const LAS v4u*)(AX + (tok + k) * AXROW + c8 * 16);
#pragma unroll
                for (int d = 0; d < 4; ++d) { acc[2 * d] += w[k][2 * d] * at::blo(v[d]); acc[2 * d + 1] += w[k][2 * d + 1] * at::bhi(v[d]); } }
            *(LAS v4u*)(XC + tok * XCROW + c8 * 16) = (v4u){pk2(acc[0], acc[1]), pk2(acc[2], acc[3]), pk2(acc[4], acc[5]), pk2(acc[6], acc[7])}; }
    }
    __syncthreads();
#pragma unroll
    for (int rd = 0; rd < 3; ++rd) {
        asm volatile("" ::: "memory"); __builtin_amdgcn_sched_barrier(0);
        int li = li_, g = g_; asm volatile("" : "+v"(li), "+v"(g));
        const int h = 2 * rd + (wave >> 2), ct = wave & 3, ch = 64 * h + 16 * ct + li;
        f32x4 acc[4][4];
        {   bf16x8 af[4][2], bfr[4][2];
#pragma unroll
            for (int mt = 0; mt < 4; ++mt)
#pragma unroll
                for (int ks = 0; ks < 2; ++ks) af[mt][ks] = *(const LAS bf16x8*)(XC + (16 * mt + li) * XCROW + (64 * h + 32 * ks + 8 * g) * 2);
#pragma unroll
            for (int mat = 0; mat < 4; ++mat)
#pragma unroll
                for (int ks = 0; ks < 2; ++ks) bfr[mat][ks] = *(const bf16x8*)(LW_l + ((size_t)((h * 4 + mat) * 64 + 16 * ct + li)) * 64 + 32 * ks + 8 * g);
#pragma unroll
            for (int mat = 0; mat < 4; ++mat)
#pragma unroll
                for (int mt = 0; mt < 4; ++mt) { f32x4 c = __builtin_amdgcn_mfma_f32_16x16x32_bf16(af[mt][0], bfr[mat][0], (f32x4){0.f, 0.f, 0.f, 0.f}, 0, 0, 0);
                    acc[mat][mt] = __builtin_amdgcn_mfma_f32_16x16x32_bf16(af[mt][1], bfr[mat][1], c, 0, 0, 0); } }
        {   const float cw0 = cw[ch], cw1 = cw[DA + ch], cw2 = cw[2 * DA + ch], cw3 = cw[3 * DA + ch], cbv = cb[ch];
            float ban[2] = {ba[ch], ba[DA + ch]}, bxn[2] = {bx[ch], bx[DA + ch]}, spn[2];
#pragma unroll
            for (int n = 0; n < 2; ++n) { const float l = lam[n * DA + ch]; spn[n] = (-l > 20.f) ? -l : log1pf(expf(-l)); }
#pragma unroll
            for (int mt = 0; mt < 4; ++mt)
#pragma unroll
                for (int r = 0; r < 4; ++r) { const int tok = 16 * mt + 4 * g + r; const LAS unsigned char* ap = AX + tok * AXROW + ch * 2;
                    const float xcv = cbv + cw0 * bf2f(*(const LAS bf16_t*)ap) + cw1 * bf2f(*(const LAS bf16_t*)(ap + AXROW)) + cw2 * bf2f(*(const LAS bf16_t*)(ap + 2 * AXROW)) + cw3 * bf2f(*(const LAS bf16_t*)(ap + 3 * AXROW));
#pragma unroll
                    for (int n = 0; n < 2; ++n) { const float rg = fsig(acc[2 * n][mt][r] + ban[n]), ig = fsig(acc[2 * n + 1][mt][r] + bxn[n]);
                        const float la = -8.0f * rg * spn[n]; const float av = __builtin_amdgcn_exp2f(1.4426950408889634f * la); const float u = 2.0f * la;
                        const float ser = -u * (1.0f + u * (0.5f + u * (0.16666667f + u * (0.041666668f + u * 0.0083333338f))));
                        const float om = (u > -0.25f) ? ser : (1.0f - av * av);
                        acc[2 * n][mt][r] = av; acc[2 * n + 1][mt][r] = __builtin_amdgcn_sqrtf(om) * (ig * xcv); } } }
        f32x4 hs[4];
        {   float Af[4], Bf[4], Ab[4], Bb[4];
#pragma unroll
            for (int mt = 0; mt < 4; ++mt) { const f32x4 a = acc[0][mt], bb = acc[1][mt], c = acc[2][mt], d = acc[3][mt];
                Af[mt] = (a[0] * a[1]) * (a[2] * a[3]); Bf[mt] = ((bb[0] * a[1] + bb[1]) * a[2] + bb[2]) * a[3] + bb[3];
                Ab[mt] = (c[0] * c[1]) * (c[2] * c[3]); Bb[mt] = ((d[3] * c[2] + d[2]) * c[1] + d[1]) * c[0] + d[0]; }
            {   float t0[4], t1[4], t2[4], t3[4];
#pragma unroll
                for (int mt = 0; mt < 4; ++mt) { t0[mt] = __shfl_up(Af[mt], 16); t1[mt] = __shfl_up(Bf[mt], 16); t2[mt] = __shfl_down(Ab[mt], 16); t3[mt] = __shfl_down(Bb[mt], 16); }
#pragma unroll
                for (int mt = 0; mt < 4; ++mt) { if (g >= 1) { Bf[mt] = t1[mt] * Af[mt] + Bf[mt]; Af[mt] = t0[mt] * Af[mt]; } if (g <= 2) { Bb[mt] = t3[mt] * Ab[mt] + Bb[mt]; Ab[mt] = t2[mt] * Ab[mt]; } }
#pragma unroll
                for (int mt = 0; mt < 4; ++mt) { t0[mt] = __shfl_up(Af[mt], 32); t1[mt] = __shfl_up(Bf[mt], 32); t2[mt] = __shfl_down(Ab[mt], 32); t3[mt] = __shfl_down(Bb[mt], 32); }
#pragma unroll
                for (int mt = 0; mt < 4; ++mt) { if (g >= 2) { Bf[mt] = t1[mt] * Af[mt] + Bf[mt]; Af[mt] = t0[mt] * Af[mt]; } if (g <= 1) { Bb[mt] = t3[mt] * Ab[mt] + Bb[mt]; Ab[mt] = t2[mt] * Ab[mt]; } } }
            float Aef[4], Bef[4], Aeb[4], Beb[4], Atf[4], Btf[4], Atb[4], Btb[4];
#pragma unroll
            for (int mt = 0; mt < 4; ++mt) { Aef[mt] = __shfl_up(Af[mt], 16); Bef[mt] = __shfl_up(Bf[mt], 16); Aeb[mt] = __shfl_down(Ab[mt], 16); Beb[mt] = __shfl_down(Bb[mt], 16);
                Atf[mt] = __shfl(Af[mt], li + 48); Btf[mt] = __shfl(Bf[mt], li + 48); Atb[mt] = __shfl(Ab[mt], li); Btb[mt] = __shfl(Bb[mt], li); }
#pragma unroll
            for (int mt = 0; mt < 4; ++mt) { if (g == 0) { Aef[mt] = 1.f; Bef[mt] = 0.f; } if (g == 3) { Aeb[mt] = 1.f; Beb[mt] = 0.f; } }
            f32x4 pf[4], pb[4];
            {   float hin = 0.f, atot = 1.f;
#pragma unroll
                for (int mt = 0; mt < 4; ++mt) { const f32x4 a = acc[0][mt], bb = acc[1][mt]; float hh = Aef[mt] * hin + Bef[mt], pp = Aef[mt] * atot;
#pragma unroll
                    for (int r = 0; r < 4; ++r) { hh = a[r] * hh + bb[r]; hs[mt][r] = hh; pp *= a[r]; pf[mt][r] = pp; }
                    hin = Atf[mt] * hin + Btf[mt]; atot *= Atf[mt]; }
                if (g == 0) { float* ag = AGG + ((size_t)(b * 64 + kc) * 4) * DA + ch; ag[0] = atot; ag[DA] = hin; } }
            {   float hin = 0.f, atot = 1.f;
#pragma unroll
                for (int mt = 3; mt >= 0; --mt) { const f32x4 a = acc[2][mt], bb = acc[3][mt]; float hh = Aeb[mt] * hin + Beb[mt], pp = Aeb[mt] * atot;
#pragma unroll
                    for (int r = 3; r >= 0; --r) { hh = a[r] * hh + bb[r]; hs[mt][r] += hh; pp *= a[r]; pb[mt][r] = pp; }
                    hin = Atb[mt] * hin + Btb[mt]; atot *= Atb[mt]; }
                if (g == 0) { float* ag = AGG + ((size_t)(b * 64 + kc) * 4) * DA + ch; ag[2 * DA] = atot; ag[3 * DA] = hin; } }
#pragma unroll
            for (int mt = 0; mt < 4; ++mt)
#pragma unroll
                for (int r = 0; r < 4; ++r) { const size_t o = (m0 + 16 * mt + 4 * g + r) * DA + ch;
                    LS[o] = (bf16_t)f2bf(hs[mt][r]); LPF[o] = (bf16_t)f2bf(pf[mt][r]); LPB[o] = (bf16_t)f2bf(pb[mt][r]); } }
    }
}
__device__ __forceinline__ void lru_fin_unit(LAS unsigned char* lds, int unit, int tid, const bf16_t* __restrict__ P, const float* __restrict__ AGG, const bf16_t* __restrict__ LS, const bf16_t* __restrict__ LPF,
                                             const bf16_t* __restrict__ LPB, const float* __restrict__ gn, bf16_t* __restrict__ YN) {
    asm volatile("" : "+v"(tid));
    const int b = unit >> 6, kc = unit & 63, t0 = kc * 64; const size_t m0 = (size_t)b * SL + t0;
    const int lane = tid & 63, wave = __builtin_amdgcn_readfirstlane(tid >> 6);
    LAS float* CARRY = (LAS float*)lds;
    __syncthreads();
    if (tid < DA) { const int ch = tid; const float* ag = AGG + (size_t)b * 64 * 4 * DA + ch;
        float hf = 0.f, hb = 0.f;
#pragma unroll 16
        for (int j = 0; j < 64; ++j) { const float A = ag[(size_t)j * 4 * DA], B = ag[(size_t)j * 4 * DA + DA]; const bool on = j < kc; hf = (on ? A : 1.f) * hf + (on ? B : 0.f); }
#pragma unroll 16
        for (int j = 63; j >= 0; --j) { const float A = ag[(size_t)j * 4 * DA + 2 * DA], B = ag[(size_t)j * 4 * DA + 3 * DA]; const bool on = j > kc; hb = (on ? A : 1.f) * hb + (on ? B : 0.f); }
        CARRY[ch] = hf; CARRY[DA + ch] = hb; }
    __syncthreads();
    float cf[6], cbk[6], gv[6];
#pragma unroll
    for (int j = 0; j < 3; ++j) { const int c0 = 2 * (lane + 64 * j); cf[2 * j] = CARRY[c0]; cf[2 * j + 1] = CARRY[c0 + 1]; cbk[2 * j] = CARRY[DA + c0]; cbk[2 * j + 1] = CARRY[DA + c0 + 1]; gv[2 * j] = gn[c0]; gv[2 * j + 1] = gn[c0 + 1]; }
#pragma unroll 2
    for (int q = 0; q < 8; ++q) { const int tok = wave * 8 + q; const size_t ro = (m0 + tok) * DA;
        const unsigned* sS = (const unsigned*)(LS + ro); const unsigned* sF = (const unsigned*)(LPF + ro); const unsigned* sB = (const unsigned*)(LPB + ro); const unsigned* sG = (const unsigned*)(P + (m0 + tok) * DINP + P_AG);
        unsigned wS[3], wF[3], wB[3], wG[3];
#pragma unroll
        for (int j = 0; j < 3; ++j) { wS[j] = sS[lane + 64 * j]; wF[j] = sF[lane + 64 * j]; wB[j] = sB[lane + 64 * j]; wG[j] = sG[lane + 64 * j]; }
        float y[6]; float ss = 0.f;
#pragma unroll
        for (int j = 0; j < 3; ++j) {
            y[2 * j] = (at::blo(wS[j]) + at::blo(wF[j]) * cf[2 * j] + at::blo(wB[j]) * cbk[2 * j]) * fgelu(at::blo(wG[j]));
            y[2 * j + 1] = (at::bhi(wS[j]) + at::bhi(wF[j]) * cf[2 * j + 1] + at::bhi(wB[j]) * cbk[2 * j + 1]) * fgelu(at::bhi(wG[j]));
            ss += y[2 * j] * y[2 * j] + y[2 * j + 1] * y[2 * j + 1]; }
#pragma unroll
        for (int o = 1; o < 64; o <<= 1) ss += __shfl_xor(ss, o);
        const float r = 1.0f / sqrtf(ss * (1.0f / DA) + EPS);
        unsigned* dst = (unsigned*)(YN + (m0 + tok) * DM);
#pragma unroll
        for (int j = 0; j < 3; ++j) dst[lane + 64 * j] = pk2(y[2 * j] * r * gv[2 * j], y[2 * j + 1] * r * gv[2 * j + 1]); }
}
}

namespace fin {
constexpr int TROW = 528;
__device__ __forceinline__ float wsum(float v) {
#pragma unroll
    for (int o = 1; o < 64; o <<= 1) v += __shfl_xor(v, o);
    return v;
}
__device__ __forceinline__ void norm_bc_unit(LAS unsigned char* lds, int unit, int tid, const bf16_t* __restrict__ AO, const bf16_t* __restrict__ YCT, const float* __restrict__ gnb, const float* __restrict__ gnc, bf16_t* __restrict__ YN) {
    asm volatile("" : "+v"(tid));
    const int b = unit >> 6, t0 = (unit & 63) * 64; const size_t m0 = (size_t)b * SL + t0;
    const int lane = tid & 63, wave = __builtin_amdgcn_readfirstlane(tid >> 6);
    __syncthreads();
    {   const int c = tid >> 1, hf = tid & 1; const bf16_t* src = YCT + ((size_t)b * DC + c) * SL + t0 + hf * 32;
#pragma unroll
        for (int q = 0; q < 4; ++q) { const uint4 v = *(const uint4*)(src + q * 8); const unsigned w[4] = {v.x, v.y, v.z, v.w};
#pragma unroll
            for (int d = 0; d < 4; ++d) { const int tok = hf * 32 + q * 8 + 2 * d;
                *(LAS bf16_t*)(lds + tok * TROW + c * 2) = (bf16_t)(w[d] & 0xffffu); *(LAS bf16_t*)(lds + (tok + 1) * TROW + c * 2) = (bf16_t)(w[d] >> 16); } } }
    for (int q = 0; q < 8; ++q) { const int tok = wave * 8 + q; const unsigned* src = (const unsigned*)(AO + (m0 + tok) * DBB);
        float v[6]; float s = 0.f;
#pragma unroll
        for (int j = 0; j < 3; ++j) { const unsigned w = src[lane + 64 * j]; v[2 * j] = at::blo(w); v[2 * j + 1] = at::bhi(w); s += v[2 * j] * v[2 * j] + v[2 * j + 1] * v[2 * j + 1]; }
        const float r = 1.0f / sqrtf(wsum(s) * (1.0f / DBB) + EPS);
        unsigned* dst = (unsigned*)(YN + (m0 + tok) * DM + DA);
#pragma unroll
        for (int j = 0; j < 3; ++j) { const int c0 = 2 * (lane + 64 * j); dst[lane + 64 * j] = pk2(v[2 * j] * r * gnb[c0], v[2 * j + 1] * r * gnb[c0 + 1]); } }
    __syncthreads();
    for (int q = 0; q < 8; ++q) { const int tok = wave * 8 + q; typedef unsigned u32x2v __attribute__((ext_vector_type(2))); const u32x2v w = *(const LAS u32x2v*)(lds + tok * TROW + lane * 8);
        const float v0 = at::blo(w.x), v1 = at::bhi(w.x), v2 = at::blo(w.y), v3 = at::bhi(w.y);
        const float r = 1.0f / sqrtf(wsum(v0 * v0 + v1 * v1 + v2 * v2 + v3 * v3) * (1.0f / DC) + EPS);
        const f32x4 gg = *(const f32x4*)(gnc + lane * 4);
        uint2 o; o.x = pk2(v0 * r * gg[0], v1 * r * gg[1]); o.y = pk2(v2 * r * gg[2], v3 * r * gg[3]);
        *(uint2*)(YN + (m0 + tok) * DM + DA + DBB + lane * 4) = o; }
}
}

__device__ __forceinline__ int fresh_tid() { int t = threadIdx.x; asm volatile("" : "+v"(t)); return t; }
#define FTID fresh_tid()
#define FLANE (fresh_tid() & 63)
struct Frame {
    LAS unsigned char* lds;
    volatile LAS unsigned* MISC;
    int wave, vcu, G;
};
__device__ __forceinline__ void p0_transpose_item(const float* W, int K, int N, bf16_t* WT, LAS float* scr, int item, int lane) {
    const int nblk = N / 32, kb = item / nblk, nb = item % nblk, k0 = 64 * kb, n0 = 32 * nb;
    float tv[32];
#pragma unroll
    for (int i = 0; i < 32; ++i) { const int kk = 2 * i + (lane >> 5); tv[i] = W[(size_t)(k0 + kk) * N + n0 + (lane & 31)]; }
#pragma unroll
    for (int i = 0; i < 32; ++i) { const int kk = 2 * i + (lane >> 5); scr[kk * 33 + (lane & 31)] = tv[i]; }
    LDS_WAIT(); asm volatile("" ::: "memory");
    const int c = lane & 7;
#pragma unroll
    for (int j = 0; j < 4; ++j) { const int n = (lane >> 3) + 8 * j; const LAS float* s = scr + (8 * c) * 33 + n;
        v4u o; o.x = pk2(s[0 * 33], s[1 * 33]); o.y = pk2(s[2 * 33], s[3 * 33]); o.z = pk2(s[4 * 33], s[5 * 33]); o.w = pk2(s[6 * 33], s[7 * 33]);
        *(GAS v4u*)(WT + (size_t)(n0 + n) * K + k0 + 8 * c) = o; }
    LDS_WAIT(); asm volatile("" ::: "memory");
}
__device__ __forceinline__ void xg_row(const float* xrow, const float* g, bf16_t* orow, float* ssrow, int lane) {
    const GAS f32x4* xr = (const GAS f32x4*)xrow + lane; const GAS f32x4* gr = (const GAS f32x4*)g + lane;
    f32x4 v[4]; float s = 0.f;
#pragma unroll
    for (int j = 0; j < 4; ++j) { v[j] = xr[64 * j]; s += (v[j][0] * v[j][0] + v[j][1] * v[j][1]) + (v[j][2] * v[j][2] + v[j][3] * v[j][3]); }
    s += __shfl_xor(s, 1); s += __shfl_xor(s, 2);
    if ((lane & 3) == 0) ssrow[lane >> 2] = s;
    GAS unsigned long long* o8 = (GAS unsigned long long*)orow + lane;
#pragma unroll
    for (int j = 0; j < 4; ++j) { const f32x4 gg = gr[64 * j]; o8[64 * j] = (unsigned long long)pk2(v[j][0] * gg[0], v[j][1] * gg[1]) | ((unsigned long long)pk2(v[j][2] * gg[2], v[j][3] * gg[3]) << 32); }
}
__device__ __forceinline__ void xg_rows4(const float* x, const float* g, bf16_t* XGp, float* SSp, int m, int stride, int lane) {
    f32x4 v[4][4];
#pragma unroll
    for (int q = 0; q < 4; ++q) { const int row = m + q * stride; const int rc = row < MT ? row : m; const GAS f32x4* xr = (const GAS f32x4*)(x + (size_t)rc * DM) + lane;
#pragma unroll
        for (int j = 0; j < 4; ++j) v[q][j] = xr[64 * j]; }
    const GAS f32x4* gr = (const GAS f32x4*)g + lane; f32x4 gg[4];
#pragma unroll
    for (int j = 0; j < 4; ++j) gg[j] = gr[64 * j];
#pragma unroll
    for (int q = 0; q < 4; ++q) { const int row = m + q * stride; if (row < MT) { float s = 0.f;
#pragma unroll
        for (int j = 0; j < 4; ++j) s += (v[q][j][0] * v[q][j][0] + v[q][j][1] * v[q][j][1]) + (v[q][j][2] * v[q][j][2] + v[q][j][3] * v[q][j][3]);
        s += __shfl_xor(s, 1); s += __shfl_xor(s, 2);
        if ((lane & 3) == 0) SSp[(size_t)row * 16 + (lane >> 2)] = s;
        GAS unsigned long long* o8 = (GAS unsigned long long*)(XGp + (size_t)row * DM) + lane;
#pragma unroll
        for (int j = 0; j < 4; ++j) o8[64 * j] = (unsigned long long)pk2(v[q][j][0] * gg[j][0], v[q][j][1] * gg[j][1]) | ((unsigned long long)pk2(v[q][j][2] * gg[j][2], v[q][j][3] * gg[j][3]) << 32); } }
}
__device__ __forceinline__ void final_row(const float* xrow, const float* g, const float* SS, int row, float* orow, int lane) {
    const GAS f32x4* xr = (const GAS f32x4*)xrow + lane; const GAS f32x4* gr = (const GAS f32x4*)g + lane; GAS f32x4* o = (GAS f32x4*)orow + lane;
    const float r = pg8::rstd16(SS, row);
#pragma unroll
    for (int j = 0; j < 4; ++j) { const f32x4 v = xr[64 * j], gg = gr[64 * j]; o[64 * j] = v * gg * r; }
}

template <int I> __device__ __forceinline__ const float* in_ptr() {
    unsigned long long v;
    asm volatile("s_load_dwordx2 %0, %1, %2\n\ts_waitcnt lgkmcnt(0)" : "=s"(v) : "s"(__builtin_amdgcn_kernarg_segment_ptr()), "n"(I * 8) : "memory");
    return (const float*)v;
}
#define INP(i) in_ptr<i>()
__device__ __forceinline__ void final_rows4(float* X, const float* g, const float* SS, int m, int stride, int lane) {
    f32x4 v[4][4]; float r[4];
#pragma unroll
    for (int q = 0; q < 4; ++q) { const int row = m + q * stride; const int rc = row < MT ? row : m; const GAS f32x4* xr = (const GAS f32x4*)(X + (size_t)rc * DM) + lane;
#pragma unroll
        for (int j = 0; j < 4; ++j) v[q][j] = xr[64 * j];
        r[q] = pg8::rstd16(SS, rc); }
    const GAS f32x4* gr = (const GAS f32x4*)g + lane; f32x4 gg[4];
#pragma unroll
    for (int j = 0; j < 4; ++j) gg[j] = gr[64 * j];
#pragma unroll
    for (int q = 0; q < 4; ++q) { const int row = m + q * stride; if (row < MT) { GAS f32x4* o = (GAS f32x4*)(X + (size_t)row * DM) + lane;
#pragma unroll
        for (int j = 0; j < 4; ++j) o[64 * j] = v[q][j] * gg[j] * r[q]; } }
}
struct Args { const float* in[28]; float* out; unsigned char* ws; int ph_lo, ph_hi, li, pad; };

#define ws ((unsigned char*)in_ptr<29>())
#define XR ((float*)in_ptr<28>())
#define XRB ((bf16_t*)in_ptr<28>())
#define Win_t ((bf16_t*)(ws + WS_WIN))
#define Wout_t ((bf16_t*)(ws + WS_WOUT))
#define Wup_t ((bf16_t*)(ws + WS_WUP))
#define Wdn_t ((bf16_t*)(ws + WS_WDN))
#define XG ((bf16_t*)(ws + WS_XG))
#define P ((bf16_t*)(ws + WS_P))
#define YN ((bf16_t*)(ws + WS_YN))
#define HB ((bf16_t*)(ws + WS_H))
#define SS ((float*)(ws + WS_SS))
__global__ void __launch_bounds__(NTHREADS, 2) mega(Args args) {
    extern __shared__ __attribute__((aligned(16))) unsigned char lds[];
    Frame F;
    F.lds = (LAS unsigned char*)lds; F.MISC = (volatile LAS unsigned*)(F.lds + MISC_OFF);
    F.wave = __builtin_amdgcn_readfirstlane((int)threadIdx.x >> 6);
    F.G = gridDim.x; { const int bx = blockIdx.x; F.vcu = (F.G % 8 == 0) ? (bx % 8) * (F.G / 8) + bx / 8 : bx; }
    gu32* ctl = (gu32*)(ws + WS_CTL);
    for (int u = threadIdx.x; u < (LDS_BYTES - MISC_OFF) / 4; u += NTHREADS) ((LAS unsigned*)(F.lds + MISC_OFF))[u] = 0u;
    __syncthreads();
    const int lo = args.ph_lo, hi = args.ph_hi;
    XcdBarrier bar; bar.bar = (unsigned*)(ctl + CW_BAR) + args.li * XCD_BAR_WORDS; bar.x = 0; bar.st = nullptr;
    if (hi - lo > 1) bar = xcd_barrier_post((unsigned*)(ctl + CW_BAR) + args.li * XCD_BAR_WORDS, F.MISC + 8);

    const int gw = F.vcu * NWAVES + F.wave, NGW = F.G * NWAVES;

#define IN(k) (lo <= (k) && (k) < hi)
#ifdef TPROBE
#define TSTAMP(i) do { if (blockIdx.x == 0 && threadIdx.x == 0) ((unsigned long long*)(ws + WS_CTL + 512 * 1024))[i] = __builtin_amdgcn_s_memrealtime(); } while (0)
#else
#define TSTAMP(i)
#endif
#define SEAM(k) do { if (IN(k) && IN((k) + 1)) { xcd_barrier(bar); DUP_BAR(xcd_barrier(bar);) TSTAMP((k) + 1); } } while (0)
    TSTAMP(0);
#ifndef DUP_PRO
#define DUP_PRO(...)
#endif
    if (IN(PH_PRO)) {
        auto pro_body = [&]() __attribute__((always_inline)) {
        LAS float* scr = (LAS float*)(F.lds + RING_OFF + F.wave * 16384);
        constexpr int I_IN = (DM / 64) * (DIN / 32), I_OUT = (DM / 64) * (DM / 32), I_UP = (DM / 64) * (DFF / 32), I_DN = (DFF / 64) * (DM / 32), I_L = I_IN + I_OUT + I_UP + I_DN;
        for (int it = gw; it < DEPTH * I_L; it += NGW) {
            const int l = it / I_L; int r = it % I_L;
            if (r < I_IN) { p0_transpose_item(INP(2) + (size_t)l * DM * DIN, DM, DIN, Win_t + (size_t)l * DINP * DM, scr, r, FLANE); continue; } r -= I_IN;
            if (r < I_OUT) { p0_transpose_item(INP(23) + (size_t)l * DM * DM, DM, DM, Wout_t + (size_t)l * DM * DM, scr, r, FLANE); continue; } r -= I_OUT;
            if (r < I_UP) { p0_transpose_item(INP(25) + (size_t)l * DM * DFF, DM, DFF, Wup_t + (size_t)l * DFF * DM, scr, r, FLANE); continue; } r -= I_UP;
            p0_transpose_item(INP(26) + (size_t)l * DFF * DM, DFF, DM, Wdn_t + (size_t)l * DM * DFF, scr, r, FLANE);
        }
        for (int i = blockIdx.x * NTHREADS + FTID; i < DEPTH * 16384; i += F.G * NTHREADS) { const int l = i >> 14, r = i & 16383;
            *(GAS v4u*)((GAS unsigned char*)(Win_t + (size_t)l * DINP * DM + (size_t)DIN * DM) + (size_t)r * 16) = (v4u){0u, 0u, 0u, 0u}; }
        {
            float* TWf = (float*)(ws + WS_TW); float* rope = (float*)(ws + WS_ROPE);
            for (int i = blockIdx.x * NTHREADS + FTID; i < 8192; i += F.G * NTHREADS) { const double a = 6.283185307179586476925286766559 * (double)i / 8192.0; TWf[2 * i] = (float)cos(a); TWf[2 * i + 1] = (float)(-sin(a)); }
            for (int i = blockIdx.x * NTHREADS + FTID; i < SL * 8; i += F.G * NTHREADS) { const int pos = i >> 3, j = i & 7; const double ang = (double)pos * pow(500000.0, -(double)j / 8.0);
                rope[pos * 16 + j] = (float)cos(ang); rope[pos * 16 + 8 + j] = (float)sin(ang); }
        }
        {
            bf16_t* LW = (bf16_t*)(ws + WS_LW); const float* wa = INP(5); const float* wx = INP(7);
            for (int o = blockIdx.x * NTHREADS + FTID; o < DEPTH * LRU_BLK * 4 * 64 * 64; o += F.G * NTHREADS) {
                const int i = o & 63, j = (o >> 6) & 63, mat = (o >> 12) & 3, lh = o >> 14, h = lh % LRU_BLK, l = lh / LRU_BLK, n = mat >> 1;
                const float* src = (mat & 1) ? wx : wa;
                LW[o] = (bf16_t)f2bf(src[((((size_t)l * 2 + n) * LRU_BLK + h) * 64 + i) * 64 + j]); }
        }
        {
            const float* w1 = INP(13); const float* b1 = INP(14); const float* fq = INP(15); const float* w2 = INP(16); const float* b2 = INP(17); const float* w3 = INP(18);
            for (int u = F.vcu; u < DEPTH * 128; u += F.G) { const int l = u >> 7;
                hy::filter_unit(F.lds, u & 127, FTID, w1 + (size_t)l * HY_EMB * HY_W, b1 + l * HY_W, fq + l * HY_W, w2 + (size_t)l * HY_W * HY_W, b2 + l * HY_W, w3 + (size_t)l * HY_W * 2 * DC,
                                (float*)(ws + WS_HF) + (size_t)l * DC * 8192); }
            __syncthreads();
        }
        { const float* x0 = INP(0); const float* g0 = INP(1);
          for (int m = gw; m < MT; m += 4 * NGW) xg_rows4(x0, g0, XG, SS, m, NGW, FLANE); }
        };
        pro_body(); DUP_PRO(xcd_barrier(bar); pro_body();)
    }
    SEAM(PH_PRO);
#ifndef DUP_MIX1
#define DUP_MIX1(...)
#endif
#ifndef DUP_FFT
#define DUP_FFT(...)
#endif
#ifndef DUP_FIN
#define DUP_FIN(...)
#endif
#ifndef DUP_WIN
#define DUP_WIN(...)
#endif
#ifndef DUP_WUP
#define DUP_WUP(...)
#endif
#ifndef DUP_HYP
#define DUP_HYP(...)
#endif
#ifndef DUP_AGG
#define DUP_AGG(...)
#endif
#ifndef DUP_ATT
#define DUP_ATT(...)
#endif
#ifndef DUP_WOUT
#define DUP_WOUT(...)
#endif
#ifndef DUP_LRUFIN
#define DUP_LRUFIN(...)
#endif
#ifndef DUP_NBC
#define DUP_NBC(...)
#endif
#ifndef DUP_BAR
#define DUP_BAR(...)
#endif
#ifndef DUP_WDN
#define DUP_WDN(...)
#endif
#define WIN_BODY(l) { \
        pg8::Gemm g{XG, Win_t + (size_t)(l) * DINP * DM, MT, DINP, DM}; pg8::StaticOrder S; S.init(MT, DINP, F.G, (int)blockIdx.x); \
        pg8::EpiScaleBf16<0> E{P, DINP, SS}; \
        pg8::gemm_phase<pg8::EpiScaleBf16<0>, pg8::StaticOrder, true, true>(F.lds + RING_OFF, g, S, E); }
#define MIX1_BODY(l) { const float* cw = INP(11) + (l) * 9 * DC; const float* cb = INP(12) + (l) * 3 * DC; \
        for (int u = F.vcu; u < 256; u += F.G) hy::hyprep_unit(F.lds, u, FTID, P, cw, cb, (bf16_t*)(ws + WS_ZT), (bf16_t*)(ws + WS_X0T)); \
        DUP_HYP(for (int u = F.vcu; u < 256; u += F.G) hy::hyprep_unit(F.lds, u, FTID, P, cw, cb, (bf16_t*)(ws + WS_ZT), (bf16_t*)(ws + WS_X0T));) \
        { const float* cwa = INP(3) + (l) * 4 * DA; const float* cba = INP(4) + (l) * DA; const float* ba = INP(6) + (l) * 2 * DA; const float* bx = INP(8) + (l) * 2 * DA; const float* lam = INP(9) + (l) * 2 * DA; \
          for (int u = F.vcu; u < 256; u += F.G) lru::lru_unit(F.lds, u, FTID, P, cwa, cba, (const bf16_t*)(ws + WS_LW) + (size_t)(l) * LRU_BLK * 4 * 4096, ba, bx, lam, (float*)(ws + WS_AGG), (bf16_t*)(ws + WS_LS), (bf16_t*)(ws + WS_LPF), (bf16_t*)(ws + WS_LPB)); \
          DUP_AGG(for (int u = F.vcu; u < 256; u += F.G) lru::lru_unit(F.lds, u, FTID, P, cwa, cba, (const bf16_t*)(ws + WS_LW) + (size_t)(l) * LRU_BLK * 4 * 4096, ba, bx, lam, (float*)(ws + WS_AGG), (bf16_t*)(ws + WS_LS), (bf16_t*)(ws + WS_LPF), (bf16_t*)(ws + WS_LPB));) } \
        { const float* sk = INP(10) + (l) * NQH; \
          for (int u = F.vcu; u < 256; u += F.G) at::attn_unit(F.lds, u, FTID, P, (const float*)(ws + WS_ROPE), sk, (bf16_t*)(ws + WS_AO)); \
          DUP_ATT(for (int u = F.vcu; u < 256; u += F.G) at::attn_unit(F.lds, u, FTID, P, (const float*)(ws + WS_ROPE), sk, (bf16_t*)(ws + WS_AO));) } }
#define FFT_BODY(l) { const float* hb = INP(19) + (l) * DC; \
        for (int u = F.vcu; u < DC; u += F.G) hy::fft_unit(F.lds, u, FTID, (const float*)(ws + WS_HF) + (size_t)(l) * DC * 8192, (const hy::cf*)(ws + WS_TW), (const bf16_t*)(ws + WS_ZT), (const bf16_t*)(ws + WS_X0T), \
                                                           (bf16_t*)(ws + WS_YCT), hb[u]); }
#define FIN_BODY(l) { \
        { const float* cwa = INP(3) + (l) * 4 * DA; const float* cba = INP(4) + (l) * DA; const float* ba = INP(6) + (l) * 2 * DA; const float* bx = INP(8) + (l) * 2 * DA; const float* lam = INP(9) + (l) * 2 * DA; const float* gna = INP(20) + (l) * DA; \
          for (int u = F.vcu; u < 256; u += F.G) lru::lru_fin_unit(F.lds, u, FTID, P, (const float*)(ws + WS_AGG), (const bf16_t*)(ws + WS_LS), (const bf16_t*)(ws + WS_LPF), (const bf16_t*)(ws + WS_LPB), gna, YN); \
          DUP_LRUFIN(for (int u = F.vcu; u < 256; u += F.G) lru::lru_fin_unit(F.lds, u, FTID, P, (const float*)(ws + WS_AGG), (const bf16_t*)(ws + WS_LS), (const bf16_t*)(ws + WS_LPF), (const bf16_t*)(ws + WS_LPB), gna, YN);) } \
        { const float* gnb = INP(21) + (l) * DBB; const float* gnc = INP(22) + (l) * DC; \
          for (int u = F.vcu; u < 256; u += F.G) fin::norm_bc_unit(F.lds, u, FTID, (const bf16_t*)(ws + WS_AO), (const bf16_t*)(ws + WS_YCT), gnb, gnc, YN); \
          DUP_NBC(for (int u = F.vcu; u < 256; u += F.G) fin::norm_bc_unit(F.lds, u, FTID, (const bf16_t*)(ws + WS_AO), (const bf16_t*)(ws + WS_YCT), gnb, gnc, YN);) } }
#define WUP_BODY(l) { \
        pg8::Gemm g{XG, Wup_t + (size_t)(l) * DFF * DM, MT, DFF, DM}; pg8::StaticOrder S; S.init(MT, DFF, F.G, (int)blockIdx.x); \
        pg8::EpiScaleBf16<1> E{HB, DFF, SS}; \
        pg8::gemm_phase<pg8::EpiScaleBf16<1>, pg8::StaticOrder, true, true>(F.lds + RING_OFF, g, S, E); }
#define LAYER(l) do { constexpr int pb = 1 + PH_PER_LAYER * (l); \
    if (IN(pb + PL_WIN)) { WIN_BODY(l) DUP_WIN(xcd_barrier(bar); WIN_BODY(l)) } \
    SEAM(pb + PL_WIN); \
    if (IN(pb + PL_MIX1)) { MIX1_BODY(l) DUP_MIX1(xcd_barrier(bar); MIX1_BODY(l)) } \
    SEAM(pb + PL_MIX1); \
    if (IN(pb + PL_FFT)) { FFT_BODY(l) DUP_FFT(xcd_barrier(bar); FFT_BODY(l)) } \
    SEAM(pb + PL_FFT); \
    if (IN(pb + PL_FIN)) { FIN_BODY(l) DUP_FIN(xcd_barrier(bar); FIN_BODY(l)) } \
    SEAM(pb + PL_FIN); \
    if (IN(pb + PL_WOUT)) { \
        pg8::Gemm g{YN, Wout_t + (size_t)(l) * DM * DM, MT, DM, DM}; pg8::StaticOrder S; S.init(MT, DM, F.G, (int)blockIdx.x); \
        if ((l) == 0) { pg8::EpiResB<true> E{(const void*)INP(0), XRB, XG, INP(24) + (l) * DM, SS}; \
            pg8::gemm_phase<pg8::EpiResB<true>, pg8::StaticOrder, true, true>(F.lds + RING_OFF, g, S, E); } \
        else { pg8::EpiResB<false> E{(const void*)XRB, XRB, XG, INP(24) + (l) * DM, SS}; \
            pg8::gemm_phase<pg8::EpiResB<false>, pg8::StaticOrder, true, true>(F.lds + RING_OFF, g, S, E); } } \
    SEAM(pb + PL_WOUT); \
    if (IN(pb + PL_WUP)) { WUP_BODY(l) DUP_WUP(xcd_barrier(bar); WUP_BODY(l)) } \
    SEAM(pb + PL_WUP); \
    if (IN(pb + PL_WDN)) { \
        pg8::Gemm g{HB, Wdn_t + (size_t)(l) * DM * DFF, MT, DM, DFF}; pg8::StaticOrder S; S.init(MT, DM, F.G, (int)blockIdx.x); \
        pg8::EpiResB<false> E{(const void*)XRB, XRB, ((l) + 1 < DEPTH) ? XG : (bf16_t*)nullptr, INP(1) + (((l) + 1 < DEPTH) ? ((l) + 1) * DM : 0), SS}; \
        pg8::gemm_phase<pg8::EpiResB<false>, pg8::StaticOrder, true, true>(F.lds + RING_OFF, g, S, E); } \
    SEAM(pb + PL_WDN); } while (0)
    LAYER(0);
    LAYER(1);
    if (IN(PH_FINAL)) { const float* gf = INP(27);
        static_assert(MT % (NWAVES * 256) == 0, "rows per wave");
        v4u xv[8][2]; float rr[8]; const int ln = FLANE;
#pragma unroll
        for (int q = 0; q < 8; ++q) { const int row = gw + q * NGW; const int rc = row < MT ? row : gw; const v4u* src = (const v4u*)(XRB + (size_t)rc * DM) + ln;
            xv[q][0] = src[0]; xv[q][1] = src[64]; rr[q] = pg8::rstd16(SS, rc); }
        xcd_barrier(bar);
        const GAS f32x4* gr = (const GAS f32x4*)gf;
        f32x4 gg[4];
#pragma unroll
        for (int j = 0; j < 2; ++j) { gg[2 * j] = gr[2 * ln + 128 * j]; gg[2 * j + 1] = gr[2 * ln + 128 * j + 1]; }
#pragma unroll
        for (int q = 0; q < 8; ++q) { const int row = gw + q * NGW; if (row < MT) { GAS f32x4* o = (GAS f32x4*)(XR + (size_t)row * DM);
#pragma unroll
            for (int j = 0; j < 2; ++j) { const v4u w = xv[q][j];
                const f32x4 a = (f32x4){pg8::bflo(w.x), pg8::bfhi(w.x), pg8::bflo(w.y), pg8::bfhi(w.y)}, c = (f32x4){pg8::bflo(w.z), pg8::bfhi(w.z), pg8::bflo(w.w), pg8::bfhi(w.w)};
                o[2 * ln + 128 * j] = a * gg[2 * j] * rr[q]; o[2 * ln + 128 * j + 1] = c * gg[2 * j + 1] * rr[q]; } } }
#ifdef TPROBE
        {   const unsigned long long* T = (const unsigned long long*)(ws + WS_CTL + 512 * 1024);
            const float d2 = (TPROBE >= 100) ? (float)(T[15] - T[0]) * 0.00001f : (float)(T[(TPROBE % 100) + 1] - T[TPROBE % 100]) * 0.0001f;
            asm volatile("s_waitcnt vmcnt(0)" ::: "memory");
            if (gw == 0 && FLANE == 0) XR[0] += d2; }
#endif
    }
#undef IN
#undef SEAM
#undef LAYER
}

#undef ws
#undef XR
#undef Win_t
#undef Wout_t
#undef Wup_t
#undef Wdn_t
#undef XG
#undef P
#undef YN
#undef HB
#undef SS
static int g_grid = 0, g_li = 0;
static void launch_mega(Args a, int lo, int hi, hipStream_t stream) {
    a.ph_lo = lo; a.ph_hi = hi; a.li = (hi - lo > 1) ? g_li++ : 0;
    void* kargs[] = {&a};
    hipLaunchCooperativeKernel((const void*)mega, dim3(g_grid), dim3(NTHREADS), kargs, LDS_BYTES, stream);
}
extern "C" void kernel_launch(void* const* d_in, const int* in_sizes, int n_in, void* d_out, int out_size, void* d_ws, size_t ws_size, hipStream_t stream) {
    if (n_in != 28 || ws_size < WS_END) return;
    if (g_grid == 0) {
        int dev = 0, cus = 0, per_cu = 0;
        hipGetDevice(&dev); hipDeviceGetAttribute(&cus, hipDeviceAttributeMultiprocessorCount, dev);
        hipFuncSetAttribute((const void*)mega, hipFuncAttributeMaxDynamicSharedMemorySize, LDS_BYTES);
        hipOccupancyMaxActiveBlocksPerMultiprocessor(&per_cu, (const void*)mega, NTHREADS, LDS_BYTES);
        (void)hipGetLastError();
        if (per_cu < 1) per_cu = 1;
        if (per_cu > 1) per_cu = 1;
        g_grid = cus * per_cu;
    }
    g_li = 0;
    unsigned char* ws = (unsigned char*)d_ws;
    auto F = [&](int i) { return (const float*)d_in[i]; };
    hipMemsetAsync(ws + WS_CTL, 0, 1 * MiB, stream);
    Args a{};
    for (int i = 0; i < 28; ++i) a.in[i] = (const float*)d_in[i];
    a.out = (float*)d_out; a.ws = ws;
    float* rope = (float*)(ws + WS_ROPE); float* HF = (float*)(ws + WS_HF);
    bf16_t* P = (bf16_t*)(ws + WS_P); bf16_t* YN = (bf16_t*)(ws + WS_YN);
    float* nA = (float*)(ws + NV_A); float* nB = (float*)(ws + NV_B); float* nHS = (float*)(ws + NV_HS); float* nZ = (float*)(ws + NV_Z); float* nX0 = (float*)(ws + NV_X0); float* nYC = (float*)(ws + NV_YC);

    launch_mega(a, 0, NPH, stream);
}
```

```cpp
#define DUP_BAR(...)
#include <hip/hip_runtime.h>
#include <stdint.h>
#include <math.h>

typedef unsigned short bf16_t;
typedef short bf16x8 __attribute__((ext_vector_type(8)));
typedef float f32x4 __attribute__((ext_vector_type(4)));

constexpr int NB = 4, SL = 4096, DM = 1024, MT = NB * SL, DEPTH = 2;
constexpr int DA = 384, DBB = 384, DC = 256, HD = 64, NQH = 6, NKVH = 2, DIN = 2176, DINP = 2304, DFF = 4096;
constexpr int P_AX = 0, P_AG = 384, P_Q = 768, P_K = 1152, P_V = 1280, P_CU = 1408;
constexpr int LRU_BLK = 6, LRU_BW = 64, WIN = 128, HY_EMB = 33, HY_W = 64;
constexpr float EPS = 1e-6f;

constexpr size_t MiB = 1u << 20;
constexpr size_t WS_WIN = 0;
constexpr size_t WS_WOUT = 9 * MiB;
constexpr size_t WS_WUP = 13 * MiB;
constexpr size_t WS_WDN = 29 * MiB;
constexpr size_t WS_ROPE = 45 * MiB;
constexpr size_t WS_HF = 46 * MiB;
constexpr size_t WS_XG = 62 * MiB;
constexpr size_t WS_BIG = 94 * MiB;
constexpr size_t WS_H = WS_BIG;
constexpr size_t WS_P = WS_BIG;
constexpr size_t WS_YN = WS_BIG + 72 * MiB;
constexpr size_t WS_SCR = WS_BIG + 104 * MiB;
constexpr size_t WS_CTL = 254 * MiB;
constexpr size_t WS_SS = 255 * MiB;
constexpr size_t WS_END = 256 * MiB;
constexpr size_t NV_A = WS_XG;
constexpr size_t NV_B = WS_SCR;
constexpr size_t NV_HS = WS_SCR + 24 * MiB;
constexpr size_t NV_Z = WS_SCR;
constexpr size_t NV_X0 = WS_SCR + 16 * MiB;
constexpr size_t NV_YC = WS_SCR + 32 * MiB;

__device__ __forceinline__ unsigned f2bf(float f) { unsigned u = __builtin_bit_cast(unsigned, f); return (u + 0x7fffu + ((u >> 16) & 1u)) >> 16; }
__device__ __forceinline__ float bf2f(bf16_t h) { return __builtin_bit_cast(float, (unsigned)h << 16); }
__device__ __forceinline__ float sigmoidf_(float x) { return 1.f / (1.f + expf(-x)); }
__device__ __forceinline__ float gelu_tanh(float x) { const float u = 0.7978845608028654f * (x + 0.044715f * x * x * x); return 0.5f * x * (1.f + tanhf(u)); }

__device__ __forceinline__ float block_sum(float v, float* red) {
    for (int o = 32; o > 0; o >>= 1) v += __shfl_xor(v, o);
    const int w = threadIdx.x >> 6, nw = blockDim.x >> 6;
    __syncthreads();
    if ((threadIdx.x & 63) == 0) red[w] = v;
    __syncthreads();
    float s = 0.f;
    for (int i = 0; i < nw; ++i) s += red[i];
    return s;
}

__global__ void k_rope(float* __restrict__ tab) {
    const int i = blockIdx.x * blockDim.x + threadIdx.x; if (i >= SL * 8) return;
    const int pos = i >> 3, j = i & 7;
    const double inv = pow(500000.0, -(double)j / 8.0), ang = (double)pos * inv;
    tab[pos * 16 + j] = (float)cos(ang); tab[pos * 16 + 8 + j] = (float)sin(ang);
}

__global__ void k_hy_filter(const float* __restrict__ w1, const float* __restrict__ b1, const float* __restrict__ freq, const float* __restrict__ w2,
                            const float* __restrict__ b2, const float* __restrict__ w3, float* __restrict__ HF) {
    __shared__ float z[HY_EMB], h1[HY_W], h2[HY_W];
    const int t = blockIdx.x, tid = threadIdx.x;
    const double PI2 = 6.283185307179586476925286766559;
    const float tt = (float)((double)t / (double)(SL - 1));
    if (tid < HY_EMB) {
        float v;
        if (tid == 0) v = tt;
        else { const int bi = (tid - 1) & 15; const double f = 1e-4 + (double)bi * ((15.0 - 1e-4) / 15.0); const double w = PI2 * (double)t / (double)SL;
               v = (tid <= 16) ? (float)cos(f * w) : (float)(-sin(f * w)); }
        z[tid] = v;
    }
    __syncthreads();
    if (tid < HY_W) { float a = b1[tid]; for (int i = 0; i < HY_EMB; ++i) a += z[i] * w1[i * HY_W + tid]; h1[tid] = sinf(freq[tid] * a); }
    __syncthreads();
    if (tid < HY_W) { float a = b2[tid]; for (int i = 0; i < HY_W; ++i) a += h1[i] * w2[i * HY_W + tid]; h2[tid] = sinf(freq[tid] * a); }
    __syncthreads();
    const double mind = log(1e-2) / 1.5, maxd = log(1e-2) / 0.3;
    for (int o = tid; o < 2 * DC; o += 256) {
        float a = 0.f; for (int i = 0; i < HY_W; ++i) a += h2[i] * w3[i * 2 * DC + o];
        const int c = o & 255, dir = o >> 8;
        const float delta = fabsf((float)(mind + (maxd - mind) * (double)c / 255.0));
        HF[((size_t)dir * SL + t) * DC + c] = a * expf(-tt * delta);
    }
}

__global__ __launch_bounds__(384) void k_lru_ab(const bf16_t* __restrict__ P, const float* __restrict__ cw, const float* __restrict__ cb, const float* __restrict__ wa, const float* __restrict__ ba,
                                               const float* __restrict__ wx, const float* __restrict__ bx, const float* __restrict__ lam, float* __restrict__ Aout, float* __restrict__ Bout, int n) {
    __shared__ float xc[DA];
    const int m = blockIdx.x, t = m % SL, j = threadIdx.x;
    float v = cb[j];
#pragma unroll
    for (int k = 0; k < 4; ++k) { const int tt = t + k - 2; if (tt >= 0 && tt < SL) v += cw[k * DA + j] * bf2f(P[(size_t)(m + k - 2) * DINP + P_AX + j]); }
    xc[j] = v;
    __syncthreads();
    const int blk = j >> 6, jj = j & 63;
    {
        float ra = ba[n * DA + j], ia = bx[n * DA + j];
        const float* wap = wa + ((size_t)(n * LRU_BLK + blk) * 64) * 64 + jj; const float* wxp = wx + ((size_t)(n * LRU_BLK + blk) * 64) * 64 + jj;
        for (int i = 0; i < 64; ++i) { const float xi = xc[blk * 64 + i]; ra += xi * wap[i * 64]; ia += xi * wxp[i * 64]; }
        const float r = sigmoidf_(ra), ig = sigmoidf_(ia);
        const float l = lam[n * DA + j]; const float sp = (-l > 20.f) ? -l : log1pf(expf(-l));
        const float log_a = -8.f * r * sp;
        const float a = expf(log_a), bb = sqrtf(-expm1f(2.f * log_a)) * (ig * v);
        Aout[(size_t)m * DA + j] = a; Bout[(size_t)m * DA + j] = bb;
    }
}
__global__ void k_lru_scan(const float* __restrict__ A, const float* __restrict__ Bv, float* __restrict__ HS, int n) {
    const int id = blockIdx.x * blockDim.x + threadIdx.x; if (id >= NB * DA) return;
    const int ch = id % DA, b = id / DA;
    float h = 0.f;
    for (int s = 0; s < SL; ++s) { const int t = n ? (SL - 1 - s) : s; const size_t o = ((size_t)b * SL + t) * DA + ch; h = A[o] * h + Bv[o]; HS[o] = n ? (HS[o] + h) : h; }
}
__global__ __launch_bounds__(384) void k_lru_out(const bf16_t* __restrict__ P, const float* __restrict__ HS, const float* __restrict__ gn, bf16_t* __restrict__ YN) {
    __shared__ float red[8];
    const int m = blockIdx.x, j = threadIdx.x;
    const float h = HS[(size_t)m * DA + j];
    const float y = h * gelu_tanh(bf2f(P[(size_t)m * DINP + P_AG + j]));
    const float ss = block_sum(y * y, red);
    const float r = 1.f / sqrtf(ss * (1.f / DA) + EPS);
    YN[(size_t)m * DM + j] = (bf16_t)f2bf(y * r * gn[j]);
}

__global__ __launch_bounds__(384) void k_attn(const bf16_t* __restrict__ P, const float* __restrict__ rope, const float* __restrict__ sink, const float* __restrict__ gn, bf16_t* __restrict__ YN) {
    __shared__ float qs[NQH][HD], ps[NQH][320], red[8];
    const int m = blockIdx.x, t = m % SL, w = threadIdx.x >> 6, lane = threadIdx.x & 63, kvh = w / 3;
    const float* rt = rope + t * 16;
    const bf16_t* qp = P + (size_t)m * DINP + P_Q + w * HD;
    {   float q = bf2f(qp[lane]);
        if (lane < 8) q = q * rt[lane] - bf2f(qp[lane + 8]) * rt[8 + lane];
        else if (lane < 16) q = q * rt[lane - 8] + bf2f(qp[lane - 8]) * rt[lane];
        qs[w][lane] = q; }
    __syncthreads();
    float sv[5]; float mx = sink[w];
#pragma unroll
    for (int pss = 0; pss < 5; ++pss) {
        const int jrel = pss * 64 + lane, jt = t - WIN + jrel; float s = -1e30f;
        if (jrel <= 2 * WIN && jt >= 0 && jt < SL) {
            const bf16_t* kp = P + (size_t)(m - WIN + jrel) * DINP + P_K + kvh * HD; const float* rk = rope + jt * 16;
            float acc = 0.f;
            for (int d = 0; d < 8; ++d) { const float k1 = bf2f(kp[d]), k2 = bf2f(kp[d + 8]); acc += qs[w][d] * (k1 * rk[d] - k2 * rk[8 + d]) + qs[w][d + 8] * (k2 * rk[d] + k1 * rk[8 + d]); }
            for (int d = 16; d < HD; ++d) acc += qs[w][d] * bf2f(kp[d]);
            s = acc * 0.125f;
        }
        sv[pss] = s; mx = fmaxf(mx, s);
    }
    for (int o = 32; o > 0; o >>= 1) mx = fmaxf(mx, __shfl_xor(mx, o));
    float den = 0.f;
#pragma unroll
    for (int pss = 0; pss < 5; ++pss) { const float p = (sv[pss] > -1e29f) ? expf(sv[pss] - mx) : 0.f; ps[w][pss * 64 + lane] = p; den += p; }
    for (int o = 32; o > 0; o >>= 1) den += __shfl_xor(den, o);
    den += expf(sink[w] - mx);
    __syncthreads();
    float o = 0.f;
    for (int jrel = 0; jrel <= 2 * WIN; ++jrel) { const int jt = t - WIN + jrel; if (jt < 0 || jt >= SL) continue; o += ps[w][jrel] * bf2f(P[(size_t)(m - WIN + jrel) * DINP + P_V + kvh * HD + lane]); }
    o /= den;
    const float ss = block_sum(o * o, red);
    const float r = 1.f / sqrtf(ss * (1.f / DBB) + EPS);
    YN[(size_t)m * DM + DA + w * HD + lane] = (bf16_t)f2bf(o * r * gn[w * HD + lane]);
}

__global__ __launch_bounds__(384) void k_attn_norm(const bf16_t* __restrict__ AO, const float* __restrict__ gn, bf16_t* __restrict__ YN) {
    __shared__ float red[8];
    const int m = blockIdx.x, j = threadIdx.x; const float o = bf2f(AO[(size_t)m * DBB + j]);
    const float ss = block_sum(o * o, red); const float r = 1.f / sqrtf(ss * (1.f / DBB) + EPS);
    YN[(size_t)m * DM + DA + j] = (bf16_t)f2bf(o * r * gn[j]);
}
__global__ __launch_bounds__(256) void k_hy_prep(const bf16_t* __restrict__ P, const float* __restrict__ cw, const float* __restrict__ cb, float* __restrict__ Z, float* __restrict__ X0) {
    const int m = blockIdx.x, t = m % SL, c = threadIdx.x;
    float u[3];
#pragma unroll
    for (int part = 0; part < 3; ++part) { const int ch = part * DC + c; float v = cb[ch];
#pragma unroll
        for (int k = 0; k < 3; ++k) { const int tt = t + k - 1; if (tt >= 0 && tt < SL) v += cw[k * 3 * DC + ch] * bf2f(P[(size_t)(m + k - 1) * DINP + P_CU + ch]); }
        u[part] = v; }
    Z[(size_t)m * DC + c] = u[2] * u[1]; X0[(size_t)m * DC + c] = u[0];
}
__global__ __launch_bounds__(256) void k_hy_conv(const float* __restrict__ Z, const float* __restrict__ X0, const float* __restrict__ HF, const float* __restrict__ bias, float* __restrict__ YC) {
    const int m = blockIdx.x, b = m / SL, t = m % SL, c = threadIdx.x;
    const float* zb = Z + (size_t)b * SL * DC + c; const float* hf = HF + c; const float* hb = HF + (size_t)SL * DC + c;
    float y = 0.f;
    for (int s = 0; s <= t; ++s) y += hf[(size_t)(t - s) * DC] * zb[(size_t)s * DC];
    for (int s = t + 1; s < SL; ++s) y += hb[(size_t)(s - t) * DC] * zb[(size_t)s * DC];
    YC[(size_t)m * DC + c] = (y + zb[(size_t)t * DC] * bias[c]) * X0[(size_t)m * DC + c];
}
__global__ __launch_bounds__(256) void k_hy_norm(const bf16_t* __restrict__ YCT, const float* __restrict__ gn, bf16_t* __restrict__ YN) {
    __shared__ float red[8];
    const int m = blockIdx.x, c = threadIdx.x; const float y = bf2f(YCT[((size_t)(m / SL) * DC + c) * SL + (m % SL)]);
    const float ss = block_sum(y * y, red); const float r = 1.f / sqrtf(ss * (1.f / DC) + EPS);
    YN[(size_t)m * DM + DA + DBB + c] = (bf16_t)f2bf(y * r * gn[c]);
}

namespace pg8 {
#define PG8_LAS __attribute__((address_space(3)))
typedef unsigned short bf16_t;
typedef short bf16x8 __attribute__((ext_vector_type(8)));
typedef float f32x4 __attribute__((ext_vector_type(4)));
typedef unsigned u32x4 __attribute__((ext_vector_type(4)));
constexpr int BM = 256, BK = 64, HALF = 128, HTB = HALF * BK * 2  , STAGE_BYTES = 8 * HTB, NXCD = 8, WGM = 8;

__host__ __device__ __forceinline__ int lds_byte(int r, int c) { const int st = (r >> 4) * 2 + (c >> 5), rr = r & 15, cc = c & 31, ob = rr * 64 + cc * 2; return st * 1024 + (ob ^ (((ob >> 9) & 1) << 5)); }
__host__ __device__ __forceinline__ void stage_rc(int b, int& R, int& C) { const int st = b / 1024, sb = b % 1024, swz = sb ^ (((sb >> 9) & 1) << 5); R = (st >> 1) * 16 + swz / 64; C = (st & 1) * 32 + (swz % 64) / 2; }
__host__ __device__ __forceinline__ int perm32(int rho) { const int n = rho >> 4, i = rho & 15; return 8 * (i >> 2) + 4 * n + (i & 3); }

struct Unit { int pm, pn; };
struct Gemm { const bf16_t* A; const bf16_t* Bt; int M, N, K, ld; };

struct StaticOrder {
    int nM, nN, nwg, G, c;
    __host__ __device__ void init(int M, int N, int G_, int c_) { nM = M / BM; nN = N / BM; nwg = nM * nN; G = G_; c = c_; }
    __host__ __device__ bool next(int i, Unit& u) const {
        const long L = (long)i * G + c; if (L >= nwg) return false;
        int wgid = (int)L; { const int q = nwg / NXCD, r = nwg % NXCD, xcd = wgid % NXCD, off = wgid / NXCD; wgid = (xcd < r ? xcd * (q + 1) : r * (q + 1) + (xcd - r) * q) + off; }
        const int nig = WGM * nN, gid = wgid / nig, fm = gid * WGM, gsz = (nM - fm) < WGM ? (nM - fm) : WGM;
        u.pm = fm + ((wgid % nig) % gsz); u.pn = (wgid % nig) / gsz; return true;
    }
    __device__ __forceinline__ void a_ready(const Unit&) const {}
    __device__ __forceinline__ void done(const Unit&) const {}
};

__device__ __forceinline__ unsigned cvt_pk_bf16(float lo, float hi) { unsigned r; asm volatile("v_cvt_pk_bf16_f32 %0, %1, %2" : "=v"(r) : "v"(lo), "v"(hi)); return r; }

constexpr int E_DM = 1024, E_DINP = 2304, E_DFF = 4096; constexpr float E_EPS = 1e-6f;
__device__ __forceinline__ float rstd16(const float* SS, int row) {
    const f32x4* p = (const f32x4*)(SS + (size_t)row * 16); const f32x4 a = (p[0] + p[1]) + (p[2] + p[3]);
    return 1.0f / sqrtf(((a[0] + a[1]) + (a[2] + a[3])) * (1.0f / E_DM) + E_EPS);
}
template <int ACT> struct EpiScaleBf16 {
    static constexpr bool PERM = true, AFTER_DRAIN = false;
    bf16_t* O; int ldc; const float* SS;
    __device__ __forceinline__ void operator()(const f32x4 (&acc)[2][2][4][2], const Unit& u, int wr, int wc, int fr, int fq) const {
        const int row0 = u.pm * BM + wr * 64 + fr, col0 = u.pn * BM + wc * 32 + 8 * fq;
        float rs[2][4];
        {   f32x4 p[2][4];
#pragma unroll
            for (int ai = 0; ai < 2; ++ai) { const f32x4* src = (const f32x4*)(SS + (size_t)(row0 + ai * HALF + fq * 16) * 16);
#pragma unroll
                for (int q = 0; q < 4; ++q) p[ai][q] = src[q]; }
            float mine[2];
#pragma unroll
            for (int ai = 0; ai < 2; ++ai) { const f32x4 a = (p[ai][0] + p[ai][1]) + (p[ai][2] + p[ai][3]); mine[ai] = 1.0f / sqrtf(((a[0] + a[1]) + (a[2] + a[3])) * (1.0f / E_DM) + E_EPS); }
#pragma unroll
            for (int ai = 0; ai < 2; ++ai)
#pragma unroll
                for (int m = 0; m < 4; ++m) rs[ai][m] = __shfl(mine[ai], fr + 16 * m); }
#pragma unroll
        for (int ai = 0; ai < 2; ++ai)
#pragma unroll
            for (int m = 0; m < 4; ++m) { const int row = row0 + ai * HALF + m * 16; const float r = rs[ai][m]; bf16_t* rowp = O + (size_t)row * ldc + col0;
#pragma unroll
                for (int bj = 0; bj < 2; ++bj) { f32x4 v0 = acc[ai][bj][m][0] * r, v1 = acc[ai][bj][m][1] * r;
                    if (ACT == 1) {
#pragma unroll
                        for (int i = 0; i < 4; ++i) { const float a = fmaxf(v0[i], 0.f), b = fmaxf(v1[i], 0.f); v0[i] = a * a; v1[i] = b * b; } }
                    u32x4 w; w.x = cvt_pk_bf16(v0[0], v0[1]); w.y = cvt_pk_bf16(v0[2], v0[3]); w.z = cvt_pk_bf16(v1[0], v1[1]); w.w = cvt_pk_bf16(v1[2], v1[3]);
                    *(u32x4*)(rowp + bj * HALF) = w; } }
    }
};
struct QuarterOrder { int pm0, G;
    __device__ __forceinline__ bool next(int i, Unit& u) const { const int pm = pm0 + i * (G >> 2); if (pm >= 64) return false; u.pm = pm; u.pn = 0; return true; }
    __device__ __forceinline__ void a_ready(const Unit&) const {}
    __device__ __forceinline__ void done(const Unit&) const {} };
struct EpiSlab {
    static constexpr bool PERM = true, AFTER_DRAIN = false;
    bf16_t* S; const float* SS;
    __device__ __forceinline__ void operator()(const f32x4 (&acc)[2][2][4][2], const Unit& u, int wr, int wc, int fr, int fq) const {
        const int row0 = u.pm * BM + wr * 64 + fr, col0 = wc * 32 + 8 * fq;
        float rs[2][4];
        {   f32x4 p[2][4];
#pragma unroll
            for (int ai = 0; ai < 2; ++ai) { const f32x4* src = (const f32x4*)(SS + (size_t)(row0 + ai * HALF + fq * 16) * 16);
#pragma unroll
                for (int q = 0; q < 4; ++q) p[ai][q] = src[q]; }
            float mine[2];
#pragma unroll
            for (int ai = 0; ai < 2; ++ai) { const f32x4 a = (p[ai][0] + p[ai][1]) + (p[ai][2] + p[ai][3]); mine[ai] = 1.0f / sqrtf(((a[0] + a[1]) + (a[2] + a[3])) * (1.0f / E_DM) + E_EPS); }
#pragma unroll
            for (int ai = 0; ai < 2; ++ai)
#pragma unroll
                for (int m = 0; m < 4; ++m) rs[ai][m] = __shfl(mine[ai], fr + 16 * m); }
#pragma unroll
        for (int ai = 0; ai < 2; ++ai)
#pragma unroll
            for (int m = 0; m < 4; ++m) { const int row = row0 + ai * HALF + m * 16; const float r = rs[ai][m];
                const f32x4 v0 = acc[ai][0][m][0] * r, v1 = acc[ai][0][m][1] * r;
                u32x4 w; w.x = cvt_pk_bf16(v0[0], v0[1]); w.y = cvt_pk_bf16(v0[2], v0[3]); w.z = cvt_pk_bf16(v1[0], v1[1]); w.w = cvt_pk_bf16(v1[2], v1[3]);
                *(u32x4*)(S + (size_t)row * 128 + col0) = w; }
    }
};
__device__ __forceinline__ float bflo(unsigned u) { return __builtin_bit_cast(float, u << 16); }
__device__ __forceinline__ float bfhi(unsigned u) { return __builtin_bit_cast(float, u & 0xffff0000u); }
template <bool BASEF32> struct EpiResB {
    static constexpr bool PERM = true, AFTER_DRAIN = false;
    const void* base; bf16_t* out; bf16_t* XG; const float* g; float* SS;
    __device__ __forceinline__ void operator()(const f32x4 (&acc)[2][2][4][2], const Unit& u, int wr, int wc, int fr, int fq) const {
        const int row0 = u.pm * BM + wr * 64 + fr, col0 = u.pn * BM + wc * 32 + 8 * fq;
        f32x4 gv[2][2];
#pragma unroll
        for (int bj = 0; bj < 2; ++bj)
#pragma unroll
            for (int n = 0; n < 2; ++n) gv[bj][n] = XG ? *(const f32x4*)(g + col0 + bj * HALF + 4 * n) : (f32x4){0.f, 0.f, 0.f, 0.f};
        if (!BASEF32) {
            u32x4 bw[2][4][2];
#pragma unroll
            for (int ai = 0; ai < 2; ++ai)
#pragma unroll
                for (int m = 0; m < 4; ++m)
#pragma unroll
                    for (int bj = 0; bj < 2; ++bj) bw[ai][m][bj] = *(const u32x4*)((const bf16_t*)base + (size_t)(row0 + ai * HALF + m * 16) * E_DM + col0 + bj * HALF);
#pragma unroll
            for (int ai = 0; ai < 2; ++ai)
#pragma unroll
                for (int m = 0; m < 4; ++m) { const int row = row0 + ai * HALF + m * 16; const size_t off = (size_t)row * E_DM + col0; float s = 0.f;
#pragma unroll
                    for (int bj = 0; bj < 2; ++bj) { const u32x4 w = bw[ai][m][bj];
                        const f32x4 v0 = (f32x4){bflo(w.x), bfhi(w.x), bflo(w.y), bfhi(w.y)} + acc[ai][bj][m][0], v1 = (f32x4){bflo(w.z), bfhi(w.z), bflo(w.w), bfhi(w.w)} + acc[ai][bj][m][1];
                        u32x4 o; o.x = cvt_pk_bf16(v0[0], v0[1]); o.y = cvt_pk_bf16(v0[2], v0[3]); o.z = cvt_pk_bf16(v1[0], v1[1]); o.w = cvt_pk_bf16(v1[2], v1[3]);
                        *(u32x4*)(out + off + bj * HALF) = o;
                        s += ((v0[0] * v0[0] + v0[1] * v0[1]) + (v0[2] * v0[2] + v0[3] * v0[3])) + ((v1[0] * v1[0] + v1[1] * v1[1]) + (v1[2] * v1[2] + v1[3] * v1[3]));
                        if (XG) { const f32x4 x0 = v0 * gv[bj][0], x1 = v1 * gv[bj][1]; u32x4 q; q.x = cvt_pk_bf16(x0[0], x0[1]); q.y = cvt_pk_bf16(x0[2], x0[3]); q.z = cvt_pk_bf16(x1[0], x1[1]); q.w = cvt_pk_bf16(x1[2], x1[3]);
                            *(u32x4*)(XG + off + bj * HALF) = q; } }
                    s += __shfl_xor(s, 16); s += __shfl_xor(s, 32);
                    if (fq == 0) SS[(size_t)row * 16 + u.pn * 4 + wc] = s; }
        } else {
#pragma unroll
            for (int ai = 0; ai < 2; ++ai)
#pragma unroll
                for (int m = 0; m < 4; ++m) { const int row = row0 + ai * HALF + m * 16; const size_t off = (size_t)row * E_DM + col0; float s = 0.f;
#pragma unroll
                    for (int bj = 0; bj < 2; ++bj) { const f32x4 b0 = *(const f32x4*)((const float*)base + off + bj * HALF), b1 = *(const f32x4*)((const float*)base + off + bj * HALF + 4);
                        const f32x4 v0 = b0 + acc[ai][bj][m][0], v1 = b1 + acc[ai][bj][m][1];
                        u32x4 o; o.x = cvt_pk_bf16(v0[0], v0[1]); o.y = cvt_pk_bf16(v0[2], v0[3]); o.z = cvt_pk_bf16(v1[0], v1[1]); o.w = cvt_pk_bf16(v1[2], v1[3]);
                        *(u32x4*)(out + off + bj * HALF) = o;
                        s += ((v0[0] * v0[0] + v0[1] * v0[1]) + (v0[2] * v0[2] + v0[3] * v0[3])) + ((v1[0] * v1[0] + v1[1] * v1[1]) + (v1[2] * v1[2] + v1[3] * v1[3]));
                        if (XG) { const f32x4 x0 = v0 * gv[bj][0], x1 = v1 * gv[bj][1]; u32x4 q; q.x = cvt_pk_bf16(x0[0], x0[1]); q.y = cvt_pk_bf16(x0[2], x0[3]); q.z = cvt_pk_bf16(x1[0], x1[1]); q.w = cvt_pk_bf16(x1[2], x1[3]);
                            *(u32x4*)(XG + off + bj * HALF) = q; } }
                    s += __shfl_xor(s, 16); s += __shfl_xor(s, 32);
                    if (fq == 0) SS[(size_t)row * 16 + u.pn * 4 + wc] = s;
                    if (m & 1) asm volatile("" ::: "memory"); }
        }
    }
};

template <class Epi, class Sched, bool ALIGN_EPI = false, bool SP2 = false>
__device__ __forceinline__ void gemm_phase(PG8_LAS unsigned char* lds, const Gemm g, const Sched& S, const Epi& E) {
    const int tid = threadIdx.x, wid = __builtin_amdgcn_readfirstlane(tid >> 6), lane = tid & 63, wr = wid >> 2, wc = wid & 3, fr = lane & 15, fq = lane >> 4;
    const int K = g.ld, nt = g.K / BK;
    unsigned voffA[2], voffB[2];
#pragma unroll
    for (int i = 0; i < 2; ++i) { int R, C; stage_rc(tid * 16 + i * 8192, R, C); const int Rb = Epi::PERM ? ((R & ~31) + perm32(R & 31)) : R;
        voffA[i] = (unsigned)(R * K + C) * 2u; voffB[i] = (unsigned)(Rb * K + C) * 2u; }
    const size_t kstep = (size_t)(BK * 2);
    const size_t hstep = (size_t)HALF * K * 2;
    const size_t tstep = 2 * hstep;
    const unsigned ldsw = (unsigned)wid * 1024u;
    const int aoff = lds_byte(wr * 64 + fr, fq * 8), boff = lds_byte(wc * 32 + fr, fq * 8);
#define PG8_SA(b, h) (((b) * 2 + (h)) * HTB)
#define PG8_SB(b, h) ((4 + (b) * 2 + (h)) * HTB)
#define PG8_STAGE(bufoff, gbase, voff) do { _Pragma("unroll") for (int _i = 0; _i < 2; ++_i) \
        __builtin_amdgcn_global_load_lds((const unsigned*)((const char*)(gbase) + (voff)[_i]), (PG8_LAS unsigned*)(lds + (bufoff) + ldsw + _i * 8192), 16, 0, 0); } while (0)
#define PG8_LDA(dst, b, h) do { _Pragma("unroll") for (int m = 0; m < 4; ++m) _Pragma("unroll") for (int k = 0; k < 2; ++k) dst[m][k] = *(const PG8_LAS bf16x8*)(lds + PG8_SA(b, h) + aoff + m * 2048 + k * 1024); } while (0)
#define PG8_LDB(dst, b, h) do { _Pragma("unroll") for (int n = 0; n < 2; ++n) _Pragma("unroll") for (int k = 0; k < 2; ++k) dst[n][k] = *(const PG8_LAS bf16x8*)(lds + PG8_SB(b, h) + boff + n * 2048 + k * 1024); } while (0)
#define PG8_MMA(ai, bj, At, Bt) do { __builtin_amdgcn_s_setprio(1); _Pragma("unroll") for (int m = 0; m < 4; ++m) _Pragma("unroll") for (int n = 0; n < 2; ++n) _Pragma("unroll") for (int k = 0; k < 2; ++k) \
        acc[ai][bj][m][n] = __builtin_amdgcn_mfma_f32_16x16x32_bf16(Bt[n][k], At[m][k], acc[ai][bj][m][n], 0, 0, 0); __builtin_amdgcn_s_setprio(0); } while (0)
#define PG8_WAIT_V(n) asm volatile("s_waitcnt vmcnt(" #n ")" ::: "memory")
#define PG8_WAIT_L(n) asm volatile("s_waitcnt lgkmcnt(" #n ")" ::: "memory")
#define PG8_BAR __builtin_amdgcn_s_barrier()
#define PG8_SCHED __builtin_amdgcn_sched_barrier(0)
    Unit cur, nxt; int ui = 0;
    if (!S.next(0, cur)) return;
    f32x4 acc[2][2][4][2];
#pragma unroll
    for (int a = 0; a < 2; ++a)
#pragma unroll
        for (int b = 0; b < 2; ++b)
#pragma unroll
            for (int m = 0; m < 4; ++m)
#pragma unroll
                for (int n = 0; n < 2; ++n) acc[a][b][m][n] = (f32x4){0.f, 0.f, 0.f, 0.f};
    bf16x8 At[4][2], B0[2][2], B1[2][2];
    const char* cA = (const char*)g.A + (size_t)cur.pm * tstep; const char* cB = (const char*)g.Bt + (size_t)cur.pn * tstep;
    S.a_ready(cur);
    if constexpr (SP2) {
        PG8_STAGE(PG8_SB(0, 0), cB, voffB); PG8_STAGE(PG8_SB(0, 1), cB + hstep, voffB); PG8_STAGE(PG8_SA(0, 0), cA, voffA); PG8_STAGE(PG8_SA(0, 1), cA + hstep, voffA);
        if (wr == 1) PG8_BAR;
        PG8_WAIT_V(2); PG8_BAR;
        PG8_STAGE(PG8_SB(1, 0), cB + kstep, voffB); PG8_STAGE(PG8_SA(1, 0), cA + kstep, voffA); PG8_STAGE(PG8_SB(1, 1), cB + hstep + kstep, voffB);
        PG8_WAIT_V(6); PG8_BAR;
    } else {
        PG8_STAGE(PG8_SB(0, 0), cB, voffB); PG8_STAGE(PG8_SA(0, 0), cA, voffA); PG8_STAGE(PG8_SB(0, 1), cB + hstep, voffB); PG8_STAGE(PG8_SA(0, 1), cA + hstep, voffA);
        if (wr == 1) PG8_BAR;
        PG8_WAIT_V(4); PG8_BAR;
        PG8_STAGE(PG8_SB(1, 0), cB + kstep, voffB); PG8_STAGE(PG8_SA(1, 0), cA + kstep, voffA); PG8_STAGE(PG8_SB(1, 1), cB + hstep + kstep, voffB);
        PG8_WAIT_V(6); PG8_BAR;
    }
    for (;;) {
        const bool has_next = S.next(ui + 1, nxt);
        const char* nA = has_next ? (const char*)g.A + (size_t)nxt.pm * tstep : cA; const char* nB = has_next ? (const char*)g.Bt + (size_t)nxt.pn * tstep : cB;
        for (int t = 0; t < nt; t += 2) {
            const bool last = (t == nt - 2);
            const char* a1 = cA + (size_t)(t + 1) * kstep;
            const char* a2 = last ? nA : cA + (size_t)(t + 2) * kstep; const char* b2 = last ? nB : cB + (size_t)(t + 2) * kstep;
            const char* a3 = a2 + kstep; const char* b3 = b2 + kstep;
            if (last && has_next) S.a_ready(nxt);
            if constexpr (SP2) {
            PG8_LDB(B0, 0, 0); PG8_LDB(B1, 0, 1); PG8_SCHED; PG8_LDA(At, 0, 0); PG8_STAGE(PG8_SA(1, 1), a1 + hstep, voffA);
            PG8_WAIT_V(8); PG8_WAIT_L(0); PG8_BAR; PG8_MMA(0, 0, At, B0); PG8_MMA(0, 1, At, B1); PG8_BAR; PG8_SCHED;
            PG8_LDA(At, 0, 1); PG8_STAGE(PG8_SB(0, 0), b2, voffB); PG8_STAGE(PG8_SB(0, 1), b2 + hstep, voffB); PG8_STAGE(PG8_SA(0, 0), a2, voffA);
            PG8_WAIT_V(8); PG8_WAIT_L(0); PG8_BAR; PG8_MMA(1, 0, At, B0); PG8_MMA(1, 1, At, B1); PG8_BAR; PG8_SCHED;
            PG8_LDB(B0, 1, 0); PG8_LDB(B1, 1, 1); PG8_SCHED; PG8_LDA(At, 1, 0); PG8_STAGE(PG8_SA(0, 1), a2 + hstep, voffA);
            PG8_WAIT_V(8); PG8_WAIT_L(0); PG8_BAR; PG8_MMA(0, 0, At, B0); PG8_MMA(0, 1, At, B1); PG8_BAR; PG8_SCHED;
            PG8_LDA(At, 1, 1); PG8_STAGE(PG8_SB(1, 0), b3, voffB); PG8_STAGE(PG8_SB(1, 1), b3 + hstep, voffB); PG8_STAGE(PG8_SA(1, 0), a3, voffA);
            PG8_WAIT_V(8); PG8_WAIT_L(0); PG8_BAR; PG8_MMA(1, 0, At, B0); PG8_MMA(1, 1, At, B1); PG8_BAR; PG8_SCHED;
            } else {
            PG8_LDB(B0, 0, 0); PG8_SCHED; PG8_LDA(At, 0, 0); PG8_STAGE(PG8_SA(1, 1), a1 + hstep, voffA);
            PG8_WAIT_L(8); PG8_BAR; PG8_WAIT_L(0); PG8_MMA(0, 0, At, B0); PG8_BAR; PG8_SCHED;
            PG8_LDB(B1, 0, 1); PG8_STAGE(PG8_SB(0, 0), b2, voffB);
            PG8_BAR; PG8_WAIT_L(0); PG8_MMA(0, 1, At, B1); PG8_BAR;
            PG8_LDA(At, 0, 1); PG8_STAGE(PG8_SA(0, 0), a2, voffA);
            PG8_BAR; PG8_WAIT_L(0); PG8_MMA(1, 0, At, B0); PG8_BAR; PG8_SCHED;
            PG8_STAGE(PG8_SB(0, 1), b2 + hstep, voffB);
            PG8_WAIT_V(6); PG8_BAR; PG8_MMA(1, 1, At, B1); PG8_BAR;
            PG8_LDB(B0, 1, 0); PG8_SCHED; PG8_LDA(At, 1, 0); PG8_STAGE(PG8_SA(0, 1), a2 + hstep, voffA);
            PG8_WAIT_L(8); PG8_BAR; PG8_WAIT_L(0); PG8_MMA(0, 0, At, B0); PG8_BAR; PG8_SCHED;
            PG8_LDB(B1, 1, 1); PG8_STAGE(PG8_SB(1, 0), b3, voffB);
            PG8_BAR; PG8_WAIT_L(0); PG8_MMA(0, 1, At, B1); PG8_BAR;
            PG8_LDA(At, 1, 1); PG8_STAGE(PG8_SA(1, 0), a3, voffA);
            PG8_BAR; PG8_WAIT_L(0); PG8_MMA(1, 0, At, B0); PG8_BAR; PG8_SCHED;
            PG8_STAGE(PG8_SB(1, 1), b3 + hstep, voffB);
            PG8_WAIT_V(6); PG8_BAR; PG8_MMA(1, 1, At, B1); PG8_BAR;
            }
        }
        if constexpr (ALIGN_EPI) { if (wr == 0) PG8_BAR; }
        if constexpr (!Epi::AFTER_DRAIN) { E(acc, cur, wr, wc, fr, fq); S.done(cur); }
        if (!has_next) break;
#pragma unroll
        for (int a = 0; a < 2; ++a)
#pragma unroll
            for (int b = 0; b < 2; ++b)
#pragma unroll
                for (int m = 0; m < 4; ++m)
#pragma unroll
                    for (int n = 0; n < 2; ++n) acc[a][b][m][n] = (f32x4){0.f, 0.f, 0.f, 0.f};
        cur = nxt; cA = nA; cB = nB; ++ui;
        if constexpr (ALIGN_EPI) { if (wr == 1) PG8_BAR; }
    }
    PG8_WAIT_V(0);
    if constexpr (!ALIGN_EPI) { if (wr == 0) PG8_BAR; }
    PG8_BAR;
    if constexpr (Epi::AFTER_DRAIN) { E.fused(acc, cur, wr, wc, fr, fq, lds, wid, lane); S.done(cur); }
#undef PG8_SA
#undef PG8_SB
#undef PG8_STAGE
#undef PG8_LDA
#undef PG8_LDB
#undef PG8_MMA
#undef PG8_WAIT_V
#undef PG8_WAIT_L
#undef PG8_BAR
#undef PG8_SCHED
}
}

constexpr int NWAVES = 8, NTHREADS = 512;
constexpr int LDS_BYTES = 163840;
constexpr int RING_OFF = 0, RING_BYTES = 131072;
constexpr int MISC_OFF = LDS_BYTES - 256;
constexpr int PH_PRO = 0, PH_PER_LAYER = 7, PH_FINAL = 1 + PH_PER_LAYER * DEPTH, NPH = PH_FINAL + 1;
constexpr int PL_WIN = 0, PL_MIX1 = 1, PL_FFT = 2, PL_FIN = 3, PL_WOUT = 4, PL_WUP = 5, PL_WDN = 6;
constexpr int CW_BAR = 4096, N_BAR_REG = 12;

#define GAS __attribute__((address_space(1)))
#define LAS __attribute__((address_space(3)))
typedef unsigned v4u __attribute__((ext_vector_type(4)));
typedef GAS unsigned gu32;
#define RLX_AGENT __ATOMIC_RELAXED, __HIP_MEMORY_SCOPE_AGENT
#define LDS_WAIT() asm volatile("s_waitcnt lgkmcnt(0)" ::: "memory")
#define VM_WAIT() asm volatile("s_waitcnt vmcnt(0)" ::: "memory")
__device__ __forceinline__ unsigned pk2(float lo, float hi) { return f2bf(lo) | (f2bf(hi) << 16); }

#define XB_TMO      128
#define XB_XCNT(j)  (256  + 64 * (j))
#define XB_XSUB(j)  (1280 + 64 * (j))
#define XB_XGEN(j)  (2304 + 64 * (j))
#define XB_TOP      3328
#define XB_TOPGEN   3392
#define XCD_BAR_WORDS 3456
#define XB_SPIN_CAP (1u << 18)

__device__ __forceinline__ unsigned xb_ld(unsigned* p)              { return __hip_atomic_load(p, __ATOMIC_RELAXED, __HIP_MEMORY_SCOPE_AGENT); }
__device__ __forceinline__ unsigned xb_add(unsigned* p, unsigned v) { return __hip_atomic_fetch_add(p, v, __ATOMIC_RELAXED, __HIP_MEMORY_SCOPE_AGENT); }
__device__ __forceinline__ unsigned xb_xcc_id() { return (unsigned)__builtin_amdgcn_s_getreg((3 << 11) | 20) & 0xFu; }
#define XB_SPIN(cond, bar) do { unsigned _sp = 0; while (cond) { __builtin_amdgcn_s_sleep(1); \
    if ((++_sp & 255u) == 0u) { if (xb_ld(&(bar)[XB_TMO])) break; if (_sp > XB_SPIN_CAP) { atomicAdd(&(bar)[XB_TMO], 1u); break; } } } } while (0)

struct XcdBarrier {
    unsigned* bar; unsigned x;
    volatile LAS unsigned* st;
};

__device__ __forceinline__ XcdBarrier xcd_barrier_post(unsigned* bar, volatile LAS unsigned* st) {
    XcdBarrier b; b.bar = bar; b.x = xb_xcc_id(); b.st = st;
    if (threadIdx.x == 0) (void)xb_add(&bar[XB_XCNT(b.x)], 1u);
    return b;
}
__device__ __forceinline__ void xcd_barrier_complete(unsigned* bar, unsigned x, unsigned& nloc, unsigned& nx) {
    const unsigned G = gridDim.x * gridDim.y * gridDim.z;
    unsigned sum, cnt, mine, sp = 0u;
    for (;;) {
        sum = 0u; cnt = 0u; mine = 0u;
#pragma unroll
        for (unsigned j = 0; j < 16; ++j) { const unsigned c = xb_ld(&bar[XB_XCNT(j)]); sum += c; cnt += (c > 0u) ? 1u : 0u; mine = (j == x) ? c : mine; }
        if (sum == G) break;
        __builtin_amdgcn_s_sleep(1);
        if ((++sp & 255u) == 0u) { if (xb_ld(&bar[XB_TMO])) break; if (sp > XB_SPIN_CAP) { atomicAdd(&bar[XB_TMO], 1u); break; } }
    }
    nloc = mine > 0u ? mine : 1u; nx = cnt > 0u ? cnt : 1u;
}

__device__ __forceinline__ void xcd_barrier(const XcdBarrier& b) {
    asm volatile("s_waitcnt vmcnt(0)" ::: "memory");
    __syncthreads();
    if (threadIdx.x == 0) {
        unsigned* bar = b.bar;
        __builtin_amdgcn_s_waitcnt(0);
        unsigned nloc = b.st[0], nx = b.st[1];
        if (nloc == 0u) { xcd_barrier_complete(bar, b.x, nloc, nx); b.st[0] = nloc; b.st[1] = nx; }
        const unsigned old = xb_add(&bar[XB_XSUB(b.x)], 1u);
        const unsigned gen = old / nloc;
        if (old + 1u == (gen + 1u) * nloc) {
            __builtin_amdgcn_fence(__ATOMIC_RELEASE, "agent");
            asm volatile("s_waitcnt vmcnt(0)" ::: "memory");
            const unsigned og = xb_add(&bar[XB_TOP], 1u);
            const unsigned tg = og / nx;
            if (og + 1u == (tg + 1u) * nx) xb_add(&bar[XB_TOPGEN], 1u);
            else XB_SPIN(xb_ld(&bar[XB_TOPGEN]) == tg, bar);
            __builtin_amdgcn_fence(__ATOMIC_ACQUIRE, "agent");
            xb_add(&bar[XB_XGEN(b.x)], 1u);
            asm volatile("s_waitcnt vmcnt(0)" ::: "memory");
        } else {
            XB_SPIN(xb_ld(&bar[XB_XGEN(b.x)]) == gen, bar);
            __builtin_amdgcn_fence(__ATOMIC_ACQUIRE, "agent");
            asm volatile("s_waitcnt vmcnt(0)" ::: "memory");
        }
    }
    __syncthreads();
}

constexpr size_t WS_SLAB = WS_YN;
constexpr size_t WS_ZT = WS_SCR, WS_X0T = WS_SCR + 8 * MiB, WS_YCT = WS_SCR + 16 * MiB;
constexpr size_t WS_TW = WS_ROPE + 256 * 1024;
namespace hy {
typedef float cf __attribute__((ext_vector_type(2)));
__device__ __forceinline__ cf cmul(cf a, cf b) { return {a.x * b.x - a.y * b.y, a.x * b.y + a.y * b.x}; }
__device__ __forceinline__ cf cmulc(cf a, cf b) { return {a.x * b.x + a.y * b.y, a.y * b.x - a.x * b.y}; }
__device__ __forceinline__ cf cadd(cf a, cf b) { return {a.x + b.x, a.y + b.y}; }
__device__ __forceinline__ cf csub(cf a, cf b) { return {a.x - b.x, a.y - b.y}; }
__device__ __forceinline__ int pidx(int i) { return i + (i >> 5); }
constexpr int FBUF = 8192 + 256;
template <bool INV> __device__ __forceinline__ cf tw16(cf d, int K) {
    float c, s;
    switch (K) {
        case 0: return d;
        case 4: return INV ? cf{-d.y, d.x} : cf{d.y, -d.x};
        case 1: c = 0.92387953251128674f; s = 0.38268343236508977f; break;
        case 2: c = 0.70710678118654752f; s = 0.70710678118654752f; break;
        case 3: c = 0.38268343236508977f; s = 0.92387953251128674f; break;
        case 5: c = -0.38268343236508977f; s = 0.92387953251128674f; break;
        case 6: c = -0.70710678118654752f; s = 0.70710678118654752f; break;
        default: c = -0.92387953251128674f; s = 0.38268343236508977f; break;
    }
    const cf w = {c, INV ? s : -s};
    return cmul(d, w);
}
template <int H, bool INV> __device__ __forceinline__ void stage16(cf (&v)[16]) {
#pragma unroll
    for (int blk = 0; blk < 16; blk += 2 * H)
#pragma unroll
        for (int j = 0; j < H; ++j) {
            if (!INV) { const cf a = v[blk + j], b = v[blk + j + H]; v[blk + j] = cadd(a, b); v[blk + j + H] = tw16<false>(csub(a, b), j * (8 / H)); }
            else { const cf A = v[blk + j], B = tw16<true>(v[blk + j + H], j * (8 / H)); v[blk + j] = cadd(A, B); v[blk + j + H] = csub(A, B); }
        }
}
template <bool INV> __device__ __forceinline__ void dft16(cf (&v)[16]) {
    if (!INV) { stage16<8, false>(v); stage16<4, false>(v); stage16<2, false>(v); stage16<1, false>(v); }
    else { stage16<1, true>(v); stage16<2, true>(v); stage16<4, true>(v); stage16<8, true>(v); }
}
__device__ __forceinline__ constexpr int br4(int r) { return ((r & 1) << 3) | ((r & 2) << 1) | ((r & 4) >> 1) | ((r & 8) >> 3); }
template <bool INV, int LSL> __device__ __forceinline__ void pass16(LAS cf* buf, int tid, const cf* __restrict__ TW) {
    constexpr int SH = LSL - 4, st = 1 << SH;
    asm volatile("" : "+v"(tid));
    const int sub = tid >> SH, n2 = tid & (st - 1), base = (sub << LSL) + n2;
    cf v[16];
#pragma unroll
    for (int r = 0; r < 16; ++r) v[r] = buf[pidx(base + r * st)];
    cf wp[16];
    wp[1] = TW[n2 << (13 - LSL)];
    asm volatile("" : "+v"(wp[1].x), "+v"(wp[1].y));
    wp[2] = cmul(wp[1], wp[1]); wp[4] = cmul(wp[2], wp[2]); wp[8] = cmul(wp[4], wp[4]);
    wp[3] = cmul(wp[2], wp[1]); wp[5] = cmul(wp[4], wp[1]); wp[6] = cmul(wp[4], wp[2]); wp[7] = cmul(wp[4], wp[3]);
    wp[9] = cmul(wp[8], wp[1]); wp[10] = cmul(wp[8], wp[2]); wp[11] = cmul(wp[8], wp[3]); wp[12] = cmul(wp[8], wp[4]);
    wp[13] = cmul(wp[8], wp[5]); wp[14] = cmul(wp[8], wp[6]); wp[15] = cmul(wp[8], wp[7]);
    if (!INV) {
        dft16<false>(v);
#pragma unroll
        for (int r = 1; r < 16; ++r) v[r] = cmul(v[r], wp[br4(r)]);
    } else {
#pragma unroll
        for (int r = 1; r < 16; ++r) v[r] = cmulc(v[r], wp[br4(r)]);
        dft16<true>(v);
    }
#pragma unroll
    for (int r = 0; r < 16; ++r) buf[pidx(base + r * st)] = v[r];
}
template <bool MUL> __device__ __forceinline__ void mid2(LAS cf* D, const LAS cf* Hs, int tid) {
    asm volatile("" : "+v"(tid));
#pragma unroll
    for (int e = 0; e < 8; ++e) { const int i = 16 * tid + 2 * e; const cf a = D[pidx(i)], b = D[pidx(i + 1)]; cf A = cadd(a, b), B = csub(a, b);
        if (MUL) { A = cmul(A, Hs[pidx(i)]); B = cmul(B, Hs[pidx(i + 1)]); D[pidx(i)] = cadd(A, B); D[pidx(i + 1)] = csub(A, B); }
        else { D[pidx(i)] = A; D[pidx(i + 1)] = B; } }
}
#define HY_SYNC() __syncthreads()
__device__ __forceinline__ void fft_unit(LAS unsigned char* lds, int c, int tid, const float* __restrict__ HFT_l, const cf* __restrict__ TW, const bf16_t* __restrict__ ZT, const bf16_t* __restrict__ X0T,
                                         bf16_t* __restrict__ YCT, float bias) {
    asm volatile("" : "+v"(tid));
    LAS cf* D = (LAS cf*)lds; LAS cf* Hs = D + FBUF;
    const float* hsrc = HFT_l + (size_t)c * 8192;
#pragma unroll
    for (int k = 0; k < 16; ++k) { const int i = k * 512 + tid; Hs[pidx(i)] = cf{hsrc[i], 0.f}; }
    HY_SYNC();
    pass16<false, 13>(Hs, tid, TW); HY_SYNC();
    pass16<false, 9>(Hs, tid, TW); HY_SYNC();
    pass16<false, 5>(Hs, tid, TW); HY_SYNC();
    mid2<false>(Hs, Hs, tid); HY_SYNC();
    for (int pr = 0; pr < 2; ++pr) {
        const size_t o0 = ((size_t)(2 * pr) * DC + c) * SL, o1 = ((size_t)(2 * pr + 1) * DC + c) * SL;
#pragma unroll
        for (int k = 0; k < 8; ++k) { const int i = k * 512 + tid; D[pidx(i)] = cf{bf2f(ZT[o0 + i]), bf2f(ZT[o1 + i])}; D[pidx(i + 4096)] = cf{0.f, 0.f}; }
        HY_SYNC();
        pass16<false, 13>(D, tid, TW); HY_SYNC();
        pass16<false, 9>(D, tid, TW); HY_SYNC();
        pass16<false, 5>(D, tid, TW); HY_SYNC();
        mid2<true>(D, Hs, tid); HY_SYNC();
        pass16<true, 5>(D, tid, TW); HY_SYNC();
        pass16<true, 9>(D, tid, TW); HY_SYNC();
        pass16<true, 13>(D, tid, TW); HY_SYNC();
#pragma unroll
        for (int k = 0; k < 8; ++k) { const int i = k * 512 + tid; const cf y = D[pidx(i)];
            const float z0 = bf2f(ZT[o0 + i]), z1 = bf2f(ZT[o1 + i]), a0 = bf2f(X0T[o0 + i]), a1 = bf2f(X0T[o1 + i]);
            YCT[o0 + i] = (bf16_t)f2bf((y.x * (1.f / 8192.f) + z0 * bias) * a0); YCT[o1 + i] = (bf16_t)f2bf((y.y * (1.f / 8192.f) + z1 * bias) * a1); }
        HY_SYNC();
    }
}
__device__ __forceinline__ float at_blo(unsigned u) { return __builtin_bit_cast(float, u << 16); }
__device__ __forceinline__ float at_bhi(unsigned u) { return __builtin_bit_cast(float, u & 0xffff0000u); }
constexpr int HP_ROWB = 1540;
__device__ __forceinline__ void hyprep_unit(LAS unsigned char* lds, int unit, int tid, const bf16_t* __restrict__ P, const bf16_t* __restrict__ SLAB, const float* __restrict__ cw, const float* __restrict__ cb,
                                            bf16_t* __restrict__ ZT, bf16_t* __restrict__ X0T) {
    asm volatile("" : "+v"(tid));
    const int b = unit >> 6, t0 = (unit & 63) * 64; const size_t m0 = (size_t)b * SL + t0;
    LAS float* CWL = (LAS float*)(lds + 101648);
    __syncthreads();
#pragma unroll
    for (int hb = 0; hb < 2; ++hb) { uint4 sv[7];
#pragma unroll
        for (int q = 0; q < 7; ++q) { const int i = tid + (hb * 7 + q) * NTHREADS, r = i / 96, ch8 = i % 96, t = t0 - 1 + r; const bool inb = (i < 66 * 96) && t >= 0 && t < SL;
            sv[q] = *(const uint4*)(P + (inb ? ((m0 + r - 1) * DINP + P_CU + ch8 * 8) : (m0 * DINP + P_CU))); if (!inb) sv[q] = make_uint4(0u, 0u, 0u, 0u); }
#pragma unroll
        for (int q = 0; q < 7; ++q) { const int i = tid + (hb * 7 + q) * NTHREADS, r = i / 96, ch8 = i % 96;
            if (i < 66 * 96 && ch8 < 80) { LAS unsigned* d = (LAS unsigned*)(lds + r * HP_ROWB + ch8 * 16); d[0] = sv[q].x; d[1] = sv[q].y; d[2] = sv[q].z; d[3] = sv[q].w; } } }
    {
        uint4 sl[3][4];
#pragma unroll
        for (int q = 0; q < 3; ++q) { const int i = tid + q * NTHREADS, r = i >> 4, c8 = i & 15, t = t0 - 1 + r; const bool inb = (i < 66 * 16) && t >= 0 && t < SL;
            const size_t ro = inb ? ((m0 + r - 1) * 128 + c8 * 8) : (m0 * 128);
#pragma unroll
            for (int k = 0; k < 4; ++k) { sl[q][k] = *(const uint4*)(SLAB + (size_t)k * MT * 128 + ro); if (!inb) sl[q][k] = make_uint4(0u, 0u, 0u, 0u); } }
#pragma unroll
        for (int q = 0; q < 3; ++q) { const int i = tid + q * NTHREADS, r = i >> 4, c8 = i & 15;
            if (i < 66 * 16) { unsigned o[4];
                const unsigned a0[4] = {sl[q][0].x, sl[q][0].y, sl[q][0].z, sl[q][0].w}, a1[4] = {sl[q][1].x, sl[q][1].y, sl[q][1].z, sl[q][1].w}, a2[4] = {sl[q][2].x, sl[q][2].y, sl[q][2].z, sl[q][2].w}, a3[4] = {sl[q][3].x, sl[q][3].y, sl[q][3].z, sl[q][3].w};
#pragma unroll
                for (int d = 0; d < 4; ++d) o[d] = pk2((at_blo(a0[d]) + at_blo(a1[d])) + (at_blo(a2[d]) + at_blo(a3[d])), (at_bhi(a0[d]) + at_bhi(a1[d])) + (at_bhi(a2[d]) + at_bhi(a3[d])));
                LAS unsigned* dd = (LAS unsigned*)(lds + r * HP_ROWB + (80 + c8) * 16); dd[0] = o[0]; dd[1] = o[1]; dd[2] = o[2]; dd[3] = o[3]; } } }
    for (int i = tid; i < 4 * 768; i += NTHREADS) CWL[i] = (i < 3 * 768) ? cw[i] : cb[i - 3 * 768];
    __syncthreads();
    const int tok = tid & 63, wv = tid >> 6;
    for (int j = 0; j < 32; ++j) { const int c = wv * 32 + j; float u[3];
#pragma unroll
        for (int part = 0; part < 3; ++part) { const int ch = part * DC + c; float a = CWL[3 * 768 + ch];
#pragma unroll
            for (int k = 0; k < 3; ++k) a += CWL[k * 768 + ch] * bf2f(*(const LAS bf16_t*)(lds + (tok + k) * HP_ROWB + ch * 2));
            u[part] = a; }
        const size_t o = ((size_t)b * DC + c) * SL + t0 + tok;
        ZT[o] = (bf16_t)f2bf(u[2] * u[1]); X0T[o] = (bf16_t)f2bf(u[0]); }
    __syncthreads();
}
__device__ __forceinline__ void filter_unit(LAS unsigned char* lds, int tb, int tid, const float* __restrict__ w1, const float* __restrict__ b1, const float* __restrict__ freq,
                                            const float* __restrict__ w2, const float* __restrict__ b2, const float* __restrict__ w3, float* __restrict__ HFT_l) {
    asm volatile("" : "+v"(tid));
    LAS float* Z = (LAS float*)lds;
    LAS float* H1T = Z + 32 * 36;
    LAS float* H2T = H1T + 64 * 32;
    const int t0 = tb * 32;
    __syncthreads();
    {   const int pos = tid >> 4, f = tid & 15, t = t0 + pos;
        const float fb = (float)(1e-4 + (double)f * ((15.0 - 1e-4) / 15.0)), w = 6.283185307179586f * (float)t * (1.0f / (float)SL);
        float sn, cs; sincosf(fb * w, &sn, &cs);
        Z[pos * 36 + 1 + f] = cs; Z[pos * 36 + 17 + f] = -sn;
        if (f == 0) Z[pos * 36] = (float)((double)t / (double)(SL - 1)); }
    __syncthreads();
    {   const int j = tid & 63; const float fj = freq[j], bj = b1[j];
#pragma unroll
        for (int q = 0; q < 4; ++q) { const int pos = (tid >> 6) + 8 * q; float a = bj;
#pragma unroll 11
            for (int i = 0; i < HY_EMB; ++i) a += Z[pos * 36 + i] * w1[i * HY_W + j];
            H1T[j * 32 + pos] = sinf(fj * a); } }
    __syncthreads();
    {   const int j = tid & 63; const float fj = freq[j], bj = b2[j];
#pragma unroll
        for (int q = 0; q < 4; ++q) { const int pos = (tid >> 6) + 8 * q; float a = bj;
#pragma unroll 16
            for (int i = 0; i < HY_W; ++i) a += H1T[i * 32 + pos] * w2[i * HY_W + j];
            H2T[j * 32 + pos] = sinf(fj * a); } }
    __syncthreads();
    {   const int o = tid, c = o & 255, dir = o >> 8;
        float acc[32];
#pragma unroll
        for (int p = 0; p < 32; ++p) acc[p] = 0.f;
#pragma unroll 16
        for (int i = 0; i < HY_W; ++i) { const float w = w3[i * 2 * DC + o];
#pragma unroll
            for (int p4 = 0; p4 < 8; ++p4) { const f32x4 h = *(const LAS f32x4*)(H2T + i * 32 + p4 * 4);
                acc[4 * p4] += h[0] * w; acc[4 * p4 + 1] += h[1] * w; acc[4 * p4 + 2] += h[2] * w; acc[4 * p4 + 3] += h[3] * w; } }
        const double mind = log(1e-2) / 1.5, maxd = log(1e-2) / 0.3;
        const float delta = fabsf((float)(mind + (maxd - mind) * (double)c / 255.0));
#pragma unroll
        for (int p = 0; p < 32; ++p) { const int t = t0 + p; const float tt = (float)((double)t / (double)(SL - 1)); acc[p] *= __builtin_amdgcn_exp2f(-1.4426950408889634f * tt * delta); }
        float* row = HFT_l + (size_t)c * 8192;
        if (dir == 0) {
#pragma unroll
            for (int p4 = 0; p4 < 8; ++p4) *(f32x4*)(row + t0 + 4 * p4) = (f32x4){acc[4 * p4], acc[4 * p4 + 1], acc[4 * p4 + 2], acc[4 * p4 + 3]};
            if (t0 == 0) row[4096] = 0.f;
        } else {
#pragma unroll
            for (int p = 0; p < 32; ++p) if (t0 + p > 0) row[8192 - t0 - p] = acc[p];
        } }
}
}

constexpr size_t WS_AO = 222 * MiB;
namespace at {
typedef short v4i16_t __attribute__((ext_vector_type(4)));
constexpr int KROW = 144, NKEY = 400, V_OFF = NKEY * KROW;
__device__ __forceinline__ float blo(unsigned u) { return __builtin_bit_cast(float, u << 16); }
__device__ __forceinline__ float bhi(unsigned u) { return __builtin_bit_cast(float, u & 0xffff0000u); }
__device__ __forceinline__ void rope16(uint4& A, uint4& B, const float* __restrict__ cs, float scale) {
    const f32x4 c0 = *(const f32x4*)cs, c1 = *(const f32x4*)(cs + 4), s0 = *(const f32x4*)(cs + 8), s1 = *(const f32x4*)(cs + 12);
    const float c[8] = {c0[0], c0[1], c0[2], c0[3], c1[0], c1[1], c1[2], c1[3]}, s[8] = {s0[0], s0[1], s0[2], s0[3], s1[0], s1[1], s1[2], s1[3]};
    unsigned a[4] = {A.x, A.y, A.z, A.w}, b[4] = {B.x, B.y, B.z, B.w};
#pragma unroll
    for (int d = 0; d < 4; ++d) {
        const float t1l = blo(a[d]), t1h = bhi(a[d]), t2l = blo(b[d]), t2h = bhi(b[d]);
        const float o1l = (t1l * c[2 * d] - t2l * s[2 * d]) * scale, o1h = (t1h * c[2 * d + 1] - t2h * s[2 * d + 1]) * scale;
        const float o2l = (t2l * c[2 * d] + t1l * s[2 * d]) * scale, o2h = (t2h * c[2 * d + 1] + t1h * s[2 * d + 1]) * scale;
        a[d] = f2bf(o1l) | (f2bf(o1h) << 16); b[d] = f2bf(o2l) | (f2bf(o2h) << 16);
    }
    A = make_uint4(a[0], a[1], a[2], a[3]); B = make_uint4(b[0], b[1], b[2], b[3]);
}
__device__ __forceinline__ void rope16s(uint4& A, uint4& B, const float (&cs)[16], float scale) {
    unsigned a[4] = {A.x, A.y, A.z, A.w}, b[4] = {B.x, B.y, B.z, B.w};
#pragma unroll
    for (int d = 0; d < 4; ++d) {
        const float t1l = blo(a[d]), t1h = bhi(a[d]), t2l = blo(b[d]), t2h = bhi(b[d]);
        const float o1l = (t1l * cs[2 * d] - t2l * cs[8 + 2 * d]) * scale, o1h = (t1h * cs[2 * d + 1] - t2h * cs[8 + 2 * d + 1]) * scale;
        const float o2l = (t2l * cs[2 * d] + t1l * cs[8 + 2 * d]) * scale, o2h = (t2h * cs[2 * d + 1] + t1h * cs[8 + 2 * d + 1]) * scale;
        a[d] = f2bf(o1l) | (f2bf(o1h) << 16); b[d] = f2bf(o2l) | (f2bf(o2h) << 16);
    }
    A = make_uint4(a[0], a[1], a[2], a[3]); B = make_uint4(b[0], b[1], b[2], b[3]);
}
__device__ __forceinline__ unsigned scale2(unsigned u, float sc) { return f2bf(blo(u) * sc) | (f2bf(bhi(u) * sc) << 16); }
__device__ __forceinline__ void attn_unit(LAS unsigned char* lds, int unit, int tid, const bf16_t* __restrict__ P, const float* __restrict__ rope, const float* __restrict__ sink_l, bf16_t* __restrict__ AO) {
    asm volatile("" : "+v"(tid));
    const int b = unit >> 6, kvh = (unit >> 5) & 1, q0 = (unit & 31) * 128, W0 = q0 - 128;
    const size_t m0 = (size_t)b * SL;
    const int lane = tid & 63, wave = __builtin_amdgcn_readfirstlane(tid >> 6), i = lane & 15, g = lane >> 4;
    __syncthreads();
    {   uint4 va[6], vb[6];
#pragma unroll
        for (int q = 0; q < 6; ++q) { const int j = tid + q * NTHREADS; const bool isV = j >= 1200; const int jj = isV ? j - 1200 : j, kk = isV ? (jj >> 2) : (jj / 3), ch = isV ? (jj & 3) : (1 + jj % 3), pos = W0 + kk;
            const bool inb = (j < 2800) && pos >= 0 && pos < SL;
            const bf16_t* src = P + (inb ? ((m0 + pos) * DINP + (isV ? P_V : P_K) + kvh * HD + ch * 16) : (m0 * DINP + P_K));
            va[q] = *(const uint4*)src; vb[q] = *(const uint4*)(src + 8); if (!inb) { va[q] = make_uint4(0u, 0u, 0u, 0u); vb[q] = va[q]; } }
        uint4 ra = make_uint4(0u, 0u, 0u, 0u), rb = ra; f32x4 rc[4];
        {   const int pos = W0 + tid; const bool inb = (tid < NKEY) && pos >= 0 && pos < SL; const int pc = inb ? pos : 0;
            const bf16_t* src = P + (m0 + pc) * DINP + P_K + kvh * HD; ra = *(const uint4*)src; rb = *(const uint4*)(src + 8);
#pragma unroll
            for (int q = 0; q < 4; ++q) rc[q] = *(const f32x4*)(rope + pc * 16 + 4 * q);
            float cs[16];
#pragma unroll
            for (int q = 0; q < 16; ++q) cs[q] = rc[q >> 2][q & 3];
            rope16s(ra, rb, cs, 1.0f);
            if (!inb) { ra = make_uint4(0u, 0u, 0u, 0u); rb = ra; } }
#pragma unroll
        for (int q = 0; q < 6; ++q) { const int j = tid + q * NTHREADS; const bool isV = j >= 1200; const int jj = isV ? j - 1200 : j, kk = isV ? (jj >> 2) : (jj / 3), ch = isV ? (jj & 3) : (1 + jj % 3);
            if (j < 2800) { LAS unsigned char* dst = lds + (isV ? V_OFF : 0) + kk * KROW + ch * 32;
                *(LAS v4u*)dst = (v4u){va[q].x, va[q].y, va[q].z, va[q].w}; *(LAS v4u*)(dst + 16) = (v4u){vb[q].x, vb[q].y, vb[q].z, vb[q].w}; } }
        if (tid < NKEY) { LAS unsigned char* dst = lds + tid * KROW; *(LAS v4u*)dst = (v4u){ra.x, ra.y, ra.z, ra.w}; *(LAS v4u*)(dst + 16) = (v4u){rb.x, rb.y, rb.z, rb.w}; }
    }
    __syncthreads();
    const bool edge = (q0 == 0) || (q0 == SL - 128);
#pragma unroll 1
    for (int gi = 0; gi < 3; ++gi) {
        const int grp = wave * 3 + gi, hl = grp >> 3, qsub = grp & 7, head = kvh * 3 + hl;
        const int tok = q0 + 16 * qsub + i;
        bf16x8 qf[2];
        {   const bf16_t* qp = P + (m0 + tok) * DINP + P_Q + head * HD + g * 8;
            uint4 own = *(const uint4*)qp, hi2 = *(const uint4*)(qp + 32);
            uint4 oth; oth.x = __shfl_xor(own.x, 16); oth.y = __shfl_xor(own.y, 16); oth.z = __shfl_xor(own.z, 16); oth.w = __shfl_xor(own.w, 16);
            uint4 t1 = (g == 0) ? own : oth, t2 = (g == 0) ? oth : own;
            rope16(t1, t2, rope + tok * 16, 0.125f);
            uint4 r0;
            if (g == 0) r0 = t1; else if (g == 1) r0 = t2; else r0 = make_uint4(scale2(own.x, 0.125f), scale2(own.y, 0.125f), scale2(own.z, 0.125f), scale2(own.w, 0.125f));
            hi2 = make_uint4(scale2(hi2.x, 0.125f), scale2(hi2.y, 0.125f), scale2(hi2.z, 0.125f), scale2(hi2.w, 0.125f));
            qf[0] = __builtin_bit_cast(bf16x8, r0); qf[1] = __builtin_bit_cast(bf16x8, hi2); }
        f32x4 st[17];
        const LAS unsigned char* kb = lds + (16 * qsub + i) * KROW + g * 16;
#pragma unroll
        for (int tt = 0; tt < 17; ++tt) {
            const bf16x8 k0 = *(const LAS bf16x8*)(kb + tt * 16 * KROW), k1 = *(const LAS bf16x8*)(kb + tt * 16 * KROW + 64);
            f32x4 acc = __builtin_amdgcn_mfma_f32_16x16x32_bf16(k0, qf[0], (f32x4){0.f, 0.f, 0.f, 0.f}, 0, 0, 0);
            st[tt] = __builtin_amdgcn_mfma_f32_16x16x32_bf16(k1, qf[1], acc, 0, 0, 0);
        }
        const float NEGF = -1e30f;
#pragma unroll
        for (int r = 0; r < 4; ++r) { if (4 * g + r < i) st[0][r] = NEGF; if (4 * g + r > i) st[16][r] = NEGF; }
        if (edge) {
#pragma unroll
            for (int tt = 0; tt < 17; ++tt)
#pragma unroll
                for (int r = 0; r < 4; ++r) { const int pos = W0 + 16 * (qsub + tt) + 4 * g + r; if (pos < 0 || pos >= SL) st[tt][r] = NEGF; }
        }
        const float sk = sink_l[head];
        float mx = sk;
#pragma unroll
        for (int tt = 0; tt < 17; ++tt) mx = fmaxf(fmaxf(mx, fmaxf(st[tt][0], st[tt][1])), fmaxf(st[tt][2], st[tt][3]));
        mx = fmaxf(mx, __shfl_xor(mx, 16)); mx = fmaxf(mx, __shfl_xor(mx, 32));
        const float L2E = 1.4426950408889634f, mb = mx * L2E;
        float lsum = 0.f;
        bf16x8 pf[9];
#pragma unroll
        for (int s = 0; s < 9; ++s) {
            float p[8];
#pragma unroll
            for (int r = 0; r < 4; ++r) { p[r] = __builtin_amdgcn_exp2f(st[2 * s][r] * L2E - mb); p[4 + r] = (2 * s + 1 < 17) ? __builtin_amdgcn_exp2f(st[(2 * s + 1 < 17) ? 2 * s + 1 : 16][r] * L2E - mb) : 0.f; }
#pragma unroll
            for (int r = 0; r < 8; ++r) lsum += p[r];
            uint4 w; w.x = f2bf(p[0]) | (f2bf(p[1]) << 16); w.y = f2bf(p[2]) | (f2bf(p[3]) << 16); w.z = f2bf(p[4]) | (f2bf(p[5]) << 16); w.w = f2bf(p[6]) | (f2bf(p[7]) << 16);
            pf[s] = __builtin_bit_cast(bf16x8, w);
        }
        lsum += __shfl_xor(lsum, 16); lsum += __shfl_xor(lsum, 32);
        lsum += __builtin_amdgcn_exp2f(sk * L2E - mb);
        const float rl = 1.0f / lsum;
        const LAS unsigned char* vb = lds + V_OFF + (16 * qsub + 4 * g + (i >> 2)) * KROW + (i & 3) * 8;
        bf16_t* op = AO + (m0 + tok) * DBB + head * HD + 4 * g;
#pragma unroll
        for (int dt = 0; dt < 4; ++dt) {
            f32x4 o = (f32x4){0.f, 0.f, 0.f, 0.f};
#pragma unroll
            for (int s = 0; s < 9; ++s) {
                const v4i16_t lo = __builtin_amdgcn_ds_read_tr16_b64_v4i16((LAS v4i16_t*)(vb + (32 * s) * KROW + dt * 32));
                const v4i16_t hi = __builtin_amdgcn_ds_read_tr16_b64_v4i16((LAS v4i16_t*)(vb + (32 * s + 16) * KROW + dt * 32));
                const bf16x8 vf = (bf16x8){lo[0], lo[1], lo[2], lo[3], hi[0], hi[1], hi[2], hi[3]};
                o = __builtin_amdgcn_mfma_f32_16x16x32_bf16(vf, pf[s], o, 0, 0, 0);
            }
            uint2 w; w.x = f2bf(o[0] * rl) | (f2bf(o[1] * rl) << 16); w.y = f2bf(o[2] * rl) | (f2bf(o[3] * rl) << 16);
            *(uint2*)(op + dt * 16) = w;
        }
    }
}
}

constexpr size_t WS_AGG = 234 * MiB;
constexpr size_t WS_LS = WS_XG, WS_LPF = WS_XG + 12 * MiB, WS_LPB = 236 * MiB;
constexpr size_t WS_LW = WS_ROPE + 512 * 1024;
namespace lru {
constexpr int AXROW = 784, XCROW = 784, XC_OFF = 67 * AXROW, CARRY_OFF = XC_OFF + 64 * XCROW, SSQ_OFF = CARRY_OFF + 2 * DA * 4, RSTD_OFF = SSQ_OFF + 64 * 24 * 4;
__device__ __forceinline__ float fsig(float x) { return __builtin_amdgcn_rcpf(1.0f + __builtin_amdgcn_exp2f(-1.4426950408889634f * x)); }
__device__ __forceinline__ float fgelu(float x) { const float u = 0.7978845608028654f * (x + 0.044715f * x * x * x); const float e = __builtin_amdgcn_exp2f(2.8853900817779268f * u);
    const float th = 1.0f - 2.0f * __builtin_amdgcn_rcpf(1.0f + e); return 0.5f * x * (1.0f + th); }
template <int CTRL> __device__ __forceinline__ float dppf(float v) { return __builtin_bit_cast(float, __builtin_amdgcn_update_dpp(0, __builtin_bit_cast(int, v), CTRL, 0xf, 0xf, true)); }
__device__ __forceinline__ float row16_sum(float v) { v += dppf<0xB1>(v); v += dppf<0x4E>(v); v += dppf<0x141>(v); v += dppf<0x140>(v); return v; }
__device__ __forceinline__ void lru_unit(LAS unsigned char* lds, int unit, int tid, const bf16_t* __restrict__ P, const float* __restrict__ cw, const float* __restrict__ cb, const bf16_t* __restrict__ LW_l,
                                         const float* __restrict__ ba, const float* __restrict__ bx, const float* __restrict__ lam, float* __restrict__ AGG, bf16_t* __restrict__ LS, bf16_t* __restrict__ LPF, bf16_t* __restrict__ LPB) {
    asm volatile("" : "+v"(tid));
    const int b = unit >> 6, kc = unit & 63, t0 = kc * 64; const size_t m0 = (size_t)b * SL + t0;
    const int lane = tid & 63, wave = __builtin_amdgcn_readfirstlane(tid >> 6), li_ = lane & 15, g_ = lane >> 4;
    LAS unsigned char* AX = lds; LAS unsigned char* XC = lds + XC_OFF;
    __syncthreads();
    {   uint4 sv[7];
#pragma unroll
        for (int q = 0; q < 7; ++q) { const int it = tid + q * NTHREADS, r = it / 48, c8 = it % 48, t = t0 - 2 + r; const bool inb = (it < 67 * 48) && t >= 0 && t < SL;
            sv[q] = *(const uint4*)(P + (inb ? ((m0 + r - 2) * DINP + P_AX + c8 * 8) : (m0 * DINP + P_AX))); if (!inb) sv[q] = make_uint4(0u, 0u, 0u, 0u); }
#pragma unroll
        for (int q = 0; q < 7; ++q) { const int it = tid + q * NTHREADS, r = it / 48, c8 = it % 48;
            if (it < 67 * 48) *(LAS v4u*)(AX + r * AXROW + c8 * 16) = (v4u){sv[q].x, sv[q].y, sv[q].z, sv[q].w}; } }
    __syncthreads();
    if (tid < 384) { const int c8 = tid % 48, tg = tid / 48, ch0 = c8 * 8;
        float w[4][8], bb[8];
#pragma unroll
        for (int e = 0; e < 8; ++e) { bb[e] = cb[ch0 + e];
#pragma unroll
            for (int k = 0; k < 4; ++k) w[k][e] = cw[k * DA + ch0 + e]; }
        for (int q = 0; q < 8; ++q) { const int tok = tg * 8 + q; float acc[8];
#pragma unroll
            for (int e = 0; e < 8; ++e) acc[e] = bb[e];
#pragma unroll
            for (int k = 0; k < 4; ++k) { const v4u v = *(const LAS v4u*)(AX + (tok + k) * AXROW + c8 * 16);
#pragma unroll
                for (int d = 0; d < 4; ++d) { acc[2 * d] += w[k][2 * d] * at::blo(v[d]); acc[2 * d + 1] += w[k][2 * d + 1] * at::bhi(v[d]); } }
            *(LAS v4u*)(XC + tok * XCROW + c8 * 16) = (v4u){pk2(acc[0], acc[1]), pk2(acc[2], acc[3]), pk2(acc[4], acc[5]), pk2(acc[6], acc[7])}; }
    }
    __syncthreads();
#pragma unroll
    for (int rd = 0; rd < 3; ++rd) {
        asm volatile("" ::: "memory"); __builtin_amdgcn_sched_barrier(0);
        int li = li_, g = g_; asm volatile("" : "+v"(li), "+v"(g));
        const int h = 2 * rd + (wave >> 2), ct = wave & 3, ch = 64 * h + 16 * ct + li;
        f32x4 acc[4][4];
        {   bf16x8 af[4][2], bfr[4][2];
#pragma unroll
            for (int mt = 0; mt < 4; ++mt)
#pragma unroll
                for (int ks = 0; ks < 2; ++ks) af[mt][ks] = *(const LAS bf16x8*)(XC + (16 * mt + li) * XCROW + (64 * h + 32 * ks + 8 * g) * 2);
#pragma unroll
            for (int mat = 0; mat < 4; ++mat)
#pragma unroll
                for (int ks = 0; ks < 2; ++ks) bfr[mat][ks] = *(const bf16x8*)(LW_l + ((size_t)((h * 4 + mat) * 64 + 16 * ct + li)) * 64 + 32 * ks + 8 * g);
#pragma unroll
            for (int mat = 0; mat < 4; ++mat)
#pragma unroll
                for (int mt = 0; mt < 4; ++mt) { f32x4 c = __builtin_amdgcn_mfma_f32_16x16x32_bf16(af[mt][0], bfr[mat][0], (f32x4){0.f, 0.f, 0.f, 0.f}, 0, 0, 0);
                    acc[mat][mt] = __builtin_amdgcn_mfma_f32_16x16x32_bf16(af[mt][1], bfr[mat][1], c, 0, 0, 0); } }
        {   const float cw0 = cw[ch], cw1 = cw[DA + ch], cw2 = cw[2 * DA + ch], cw3 = cw[3 * DA + ch], cbv = cb[ch];
            float ban[2] = {ba[ch], ba[DA + ch]}, bxn[2] = {bx[ch], bx[DA + ch]}, spn[2];
#pragma unroll
            for (int n = 0; n < 2; ++n) { const float l = lam[n * DA + ch]; spn[n] = -8.0f * 1.4426950408889634f * ((-l > 20.f) ? -l : log1pf(expf(-l))); }
#pragma unroll
            for (int mt = 0; mt < 4; ++mt)
#pragma unroll
                for (int r = 0; r < 4; ++r) { const int tok = 16 * mt + 4 * g + r; const LAS unsigned char* ap = AX + tok * AXROW + ch * 2;
                    const float xcv = cbv + cw0 * bf2f(*(const LAS bf16_t*)ap) + cw1 * bf2f(*(const LAS bf16_t*)(ap + AXROW)) + cw2 * bf2f(*(const LAS bf16_t*)(ap + 2 * AXROW)) + cw3 * bf2f(*(const LAS bf16_t*)(ap + 3 * AXROW));
#pragma unroll
                    for (int n = 0; n < 2; ++n) { const float rg = fsig(acc[2 * n][mt][r] + ban[n]), ig = fsig(acc[2 * n + 1][mt][r] + bxn[n]);
                        const float av = __builtin_amdgcn_exp2f(rg * spn[n]);
                        acc[2 * n][mt][r] = av; acc[2 * n + 1][mt][r] = __builtin_amdgcn_sqrtf(1.0f - av * av) * (ig * xcv); } } }
        f32x4 hs[4];
        {   float Af[4], Bf[4], Ab[4], Bb[4];
#pragma unroll
            for (int mt = 0; mt < 4; ++mt) { const f32x4 a = acc[0][mt], bb = acc[1][mt], c = acc[2][mt], d = acc[3][mt];
                Af[mt] = (a[0] * a[1]) * (a[2] * a[3]); Bf[mt] = ((bb[0] * a[1] + bb[1]) * a[2] + bb[2]) * a[3] + bb[3];
                Ab[mt] = (c[0] * c[1]) * (c[2] * c[3]); Bb[mt] = ((d[3] * c[2] + d[2]) * c[1] + d[1]) * c[0] + d[0]; }
            {   float t0[4], t1[4], t2[4], t3[4];
#pragma unroll
                for (int mt = 0; mt < 4; ++mt) { t0[mt] = __shfl_up(Af[mt], 16); t1[mt] = __shfl_up(Bf[mt], 16); t2[mt] = __shfl_down(Ab[mt], 16); t3[mt] = __shfl_down(Bb[mt], 16); }
#pragma unroll
                for (int mt = 0; mt < 4; ++mt) { if (g >= 1) { Bf[mt] = t1[mt] * Af[mt] + Bf[mt]; Af[mt] = t0[mt] * Af[mt]; } if (g <= 2) { Bb[mt] = t3[mt] * Ab[mt] + Bb[mt]; Ab[mt] = t2[mt] * Ab[mt]; } }
#pragma unroll
                for (int mt = 0; mt < 4; ++mt) { t0[mt] = __shfl_up(Af[mt], 32); t1[mt] = __shfl_up(Bf[mt], 32); t2[mt] = __shfl_down(Ab[mt], 32); t3[mt] = __shfl_down(Bb[mt], 32); }
#pragma unroll
                for (int mt = 0; mt < 4; ++mt) { if (g >= 2) { Bf[mt] = t1[mt] * Af[mt] + Bf[mt]; Af[mt] = t0[mt] * Af[mt]; } if (g <= 1) { Bb[mt] = t3[mt] * Ab[mt] + Bb[mt]; Ab[mt] = t2[mt] * Ab[mt]; } } }
            float Aef[4], Bef[4], Aeb[4], Beb[4], Atf[4], Btf[4], Atb[4], Btb[4];
#pragma unroll
            for (int mt = 0; mt < 4; ++mt) { Aef[mt] = __shfl_up(Af[mt], 16); Bef[mt] = __shfl_up(Bf[mt], 16); Aeb[mt] = __shfl_down(Ab[mt], 16); Beb[mt] = __shfl_down(Bb[mt], 16);
                Atf[mt] = __shfl(Af[mt], li + 48); Btf[mt] = __shfl(Bf[mt], li + 48); Atb[mt] = __shfl(Ab[mt], li); Btb[mt] = __shfl(Bb[mt], li); }
#pragma unroll
            for (int mt = 0; mt < 4; ++mt) { if (g == 0) { Aef[mt] = 1.f; Bef[mt] = 0.f; } if (g == 3) { Aeb[mt] = 1.f; Beb[mt] = 0.f; } }
            f32x4 pf[4], pb[4];
            {   float hin = 0.f, atot = 1.f;
#pragma unroll
                for (int mt = 0; mt < 4; ++mt) { const f32x4 a = acc[0][mt], bb = acc[1][mt]; float hh = Aef[mt] * hin + Bef[mt], pp = Aef[mt] * atot;
#pragma unroll
                    for (int r = 0; r < 4; ++r) { hh = a[r] * hh + bb[r]; hs[mt][r] = hh; pp *= a[r]; pf[mt][r] = pp; }
                    hin = Atf[mt] * hin + Btf[mt]; atot *= Atf[mt]; }
                if (g == 0) { float* ag = AGG + ((size_t)(b * 64 + kc) * 4) * DA + ch; ag[0] = atot; ag[DA] = hin; } }
            {   float hin = 0.f, atot = 1.f;
#pragma unroll
                for (int mt = 3; mt >= 0; --mt) { const f32x4 a = acc[2][mt], bb = acc[3][mt]; float hh = Aeb[mt] * hin + Beb[mt], pp = Aeb[mt] * atot;
#pragma unroll
                    for (int r = 3; r >= 0; --r) { hh = a[r] * hh + bb[r]; hs[mt][r] += hh; pp *= a[r]; pb[mt][r] = pp; }
                    hin = Atb[mt] * hin + Btb[mt]; atot *= Atb[mt]; }
                if (g == 0) { float* ag = AGG + ((size_t)(b * 64 + kc) * 4) * DA + ch; ag[2 * DA] = atot; ag[3 * DA] = hin; } }
#pragma unroll
            for (int mt = 0; mt < 4; ++mt)
#pragma unroll
                for (int r = 0; r < 4; ++r) { const size_t o = (m0 + 16 * mt + 4 * g + r) * DA + ch;
                    LS[o] = (bf16_t)f2bf(hs[mt][r]); LPF[o] = (bf16_t)f2bf(pf[mt][r]); LPB[o] = (bf16_t)f2bf(pb[mt][r]); } }
    }
}
__device__ __forceinline__ void lru_fin_unit(LAS unsigned char* lds, int unit, int tid, const bf16_t* __restrict__ P, const float* __restrict__ AGG, const bf16_t* __restrict__ LS, const bf16_t* __restrict__ LPF,
                                             const bf16_t* __restrict__ LPB, const float* __restrict__ gn, bf16_t* __restrict__ YN) {
    asm volatile("" : "+v"(tid));
    const int b = unit >> 6, kc = unit & 63, t0 = kc * 64; const size_t m0 = (size_t)b * SL + t0;
    const int lane = tid & 63, wave = __builtin_amdgcn_readfirstlane(tid >> 6);
    LAS float* CARRY = (LAS float*)lds;
    __syncthreads();
    if (tid < DA) { const int ch = tid; const float* ag = AGG + (size_t)b * 64 * 4 * DA + ch;
        float hf = 0.f, hb = 0.f;
#pragma unroll 16
        for (int j = 0; j < 64; ++j) { const float A = ag[(size_t)j * 4 * DA], B = ag[(size_t)j * 4 * DA + DA]; const bool on = j < kc; hf = (on ? A : 1.f) * hf + (on ? B : 0.f); }
#pragma unroll 16
        for (int j = 63; j >= 0; --j) { const float A = ag[(size_t)j * 4 * DA + 2 * DA], B = ag[(size_t)j * 4 * DA + 3 * DA]; const bool on = j > kc; hb = (on ? A : 1.f) * hb + (on ? B : 0.f); }
        CARRY[ch] = hf; CARRY[DA + ch] = hb; }
    __syncthreads();
    float cf[6], cbk[6], gv[6];
#pragma unroll
    for (int j = 0; j < 3; ++j) { const int c0 = 2 * (lane + 64 * j); cf[2 * j] = CARRY[c0]; cf[2 * j + 1] = CARRY[c0 + 1]; cbk[2 * j] = CARRY[DA + c0]; cbk[2 * j + 1] = CARRY[DA + c0 + 1]; gv[2 * j] = gn[c0]; gv[2 * j + 1] = gn[c0 + 1]; }
#pragma unroll 2
    for (int q = 0; q < 8; ++q) { const int tok = wave * 8 + q; const size_t ro = (m0 + tok) * DA;
        const unsigned* sS = (const unsigned*)(LS + ro); const unsigned* sF = (const unsigned*)(LPF + ro); const unsigned* sB = (const unsigned*)(LPB + ro); const unsigned* sG = (const unsigned*)(P + (m0 + tok) * DINP + P_AG);
        unsigned wS[3], wF[3], wB[3], wG[3];
#pragma unroll
        for (int j = 0; j < 3; ++j) { wS[j] = sS[lane + 64 * j]; wF[j] = sF[lane + 64 * j]; wB[j] = sB[lane + 64 * j]; wG[j] = sG[lane + 64 * j]; }
        float y[6]; float ss = 0.f;
#pragma unroll
        for (int j = 0; j < 3; ++j) {
            y[2 * j] = (at::blo(wS[j]) + at::blo(wF[j]) * cf[2 * j] + at::blo(wB[j]) * cbk[2 * j]) * fgelu(at::blo(wG[j]));
            y[2 * j + 1] = (at::bhi(wS[j]) + at::bhi(wF[j]) * cf[2 * j + 1] + at::bhi(wB[j]) * cbk[2 * j + 1]) * fgelu(at::bhi(wG[j]));
            ss += y[2 * j] * y[2 * j] + y[2 * j + 1] * y[2 * j + 1]; }
#pragma unroll
        for (int o = 1; o < 64; o <<= 1) ss += __shfl_xor(ss, o);
        const float r = 1.0f / sqrtf(ss * (1.0f / DA) + EPS);
        unsigned* dst = (unsigned*)(YN + (m0 + tok) * DM);
#pragma unroll
        for (int j = 0; j < 3; ++j) dst[lane + 64 * j] = pk2(y[2 * j] * r * gv[2 * j], y[2 * j + 1] * r * gv[2 * j + 1]); }
}
}

namespace fin {
constexpr int TROW = 528;
__device__ __forceinline__ float wsum(float v) {
#pragma unroll
    for (int o = 1; o < 64; o <<= 1) v += __shfl_xor(v, o);
    return v;
}
__device__ __forceinline__ void norm_bc_unit(LAS unsigned char* lds, int unit, int tid, const bf16_t* __restrict__ AO, const bf16_t* __restrict__ YCT, const float* __restrict__ gnb, const float* __restrict__ gnc, bf16_t* __restrict__ YN) {
    asm volatile("" : "+v"(tid));
    const int b = unit >> 6, t0 = (unit & 63) * 64; const size_t m0 = (size_t)b * SL + t0;
    const int lane = tid & 63, wave = __builtin_amdgcn_readfirstlane(tid >> 6);
    __syncthreads();
    {   const int c = tid >> 1, hf = tid & 1; const bf16_t* src = YCT + ((size_t)b * DC + c) * SL + t0 + hf * 32;
#pragma unroll
        for (int q = 0; q < 4; ++q) { const uint4 v = *(const uint4*)(src + q * 8); const unsigned w[4] = {v.x, v.y, v.z, v.w};
#pragma unroll
            for (int d = 0; d < 4; ++d) { const int tok = hf * 32 + q * 8 + 2 * d;
                *(LAS bf16_t*)(lds + tok * TROW + c * 2) = (bf16_t)(w[d] & 0xffffu); *(LAS bf16_t*)(lds + (tok + 1) * TROW + c * 2) = (bf16_t)(w[d] >> 16); } } }
    for (int q = 0; q < 8; ++q) { const int tok = wave * 8 + q; const unsigned* src = (const unsigned*)(AO + (m0 + tok) * DBB);
        float v[6]; float s = 0.f;
#pragma unroll
        for (int j = 0; j < 3; ++j) { const unsigned w = src[lane + 64 * j]; v[2 * j] = at::blo(w); v[2 * j + 1] = at::bhi(w); s += v[2 * j] * v[2 * j] + v[2 * j + 1] * v[2 * j + 1]; }
        const float r = 1.0f / sqrtf(wsum(s) * (1.0f / DBB) + EPS);
        unsigned* dst = (unsigned*)(YN + (m0 + tok) * DM + DA);
#pragma unroll
        for (int j = 0; j < 3; ++j) { const int c0 = 2 * (lane + 64 * j); dst[lane + 64 * j] = pk2(v[2 * j] * r * gnb[c0], v[2 * j + 1] * r * gnb[c0 + 1]); } }
    __syncthreads();
    for (int q = 0; q < 8; ++q) { const int tok = wave * 8 + q; typedef unsigned u32x2v __attribute__((ext_vector_type(2))); const u32x2v w = *(const LAS u32x2v*)(lds + tok * TROW + lane * 8);
        const float v0 = at::blo(w.x), v1 = at::bhi(w.x), v2 = at::blo(w.y), v3 = at::bhi(w.y);
        const float r = 1.0f / sqrtf(wsum(v0 * v0 + v1 * v1 + v2 * v2 + v3 * v3) * (1.0f / DC) + EPS);
        const f32x4 gg = *(const f32x4*)(gnc + lane * 4);
        uint2 o; o.x = pk2(v0 * r * gg[0], v1 * r * gg[1]); o.y = pk2(v2 * r * gg[2], v3 * r * gg[3]);
        *(uint2*)(YN + (m0 + tok) * DM + DA + DBB + lane * 4) = o; }
}
}

__device__ __forceinline__ int fresh_tid() { int t = threadIdx.x; asm volatile("" : "+v"(t)); return t; }
#define FTID fresh_tid()
#define FLANE (fresh_tid() & 63)
struct Frame {
    LAS unsigned char* lds;
    volatile LAS unsigned* MISC;
    int wave, vcu, G;
};
__device__ __forceinline__ void p0_transpose_item(const float* W, int K, int N, bf16_t* WT, LAS float* scr, int item, int lane) {
    const int nblk = N / 32, kb = item / nblk, nb = item % nblk, k0 = 64 * kb, n0 = 32 * nb;
    float tv[32];
#pragma unroll
    for (int i = 0; i < 32; ++i) { const int kk = 2 * i + (lane >> 5); tv[i] = W[(size_t)(k0 + kk) * N + n0 + (lane & 31)]; }
#pragma unroll
    for (int i = 0; i < 32; ++i) { const int kk = 2 * i + (lane >> 5); scr[kk * 33 + (lane & 31)] = tv[i]; }
    LDS_WAIT(); asm volatile("" ::: "memory");
    const int c = lane & 7;
#pragma unroll
    for (int j = 0; j < 4; ++j) { const int n = (lane >> 3) + 8 * j; const LAS float* s = scr + (8 * c) * 33 + n;
        v4u o; o.x = pk2(s[0 * 33], s[1 * 33]); o.y = pk2(s[2 * 33], s[3 * 33]); o.z = pk2(s[4 * 33], s[5 * 33]); o.w = pk2(s[6 * 33], s[7 * 33]);
        *(GAS v4u*)(WT + (size_t)(n0 + n) * K + k0 + 8 * c) = o; }
    LDS_WAIT(); asm volatile("" ::: "memory");
}
__device__ __forceinline__ void xg_row(const float* xrow, const float* g, bf16_t* orow, float* ssrow, int lane) {
    const GAS f32x4* xr = (const GAS f32x4*)xrow + lane; const GAS f32x4* gr = (const GAS f32x4*)g + lane;
    f32x4 v[4]; float s = 0.f;
#pragma unroll
    for (int j = 0; j < 4; ++j) { v[j] = xr[64 * j]; s += (v[j][0] * v[j][0] + v[j][1] * v[j][1]) + (v[j][2] * v[j][2] + v[j][3] * v[j][3]); }
    s += __shfl_xor(s, 1); s += __shfl_xor(s, 2);
    if ((lane & 3) == 0) ssrow[lane >> 2] = s;
    GAS unsigned long long* o8 = (GAS unsigned long long*)orow + lane;
#pragma unroll
    for (int j = 0; j < 4; ++j) { const f32x4 gg = gr[64 * j]; o8[64 * j] = (unsigned long long)pk2(v[j][0] * gg[0], v[j][1] * gg[1]) | ((unsigned long long)pk2(v[j][2] * gg[2], v[j][3] * gg[3]) << 32); }
}
__device__ __forceinline__ void xg_rows4(const float* x, const float* g, bf16_t* XGp, float* SSp, int m, int stride, int lane) {
    f32x4 v[4][4];
#pragma unroll
    for (int q = 0; q < 4; ++q) { const int row = m + q * stride; const int rc = row < MT ? row : m; const GAS f32x4* xr = (const GAS f32x4*)(x + (size_t)rc * DM) + lane;
#pragma unroll
        for (int j = 0; j < 4; ++j) v[q][j] = xr[64 * j]; }
    const GAS f32x4* gr = (const GAS f32x4*)g + lane; f32x4 gg[4];
#pragma unroll
    for (int j = 0; j < 4; ++j) gg[j] = gr[64 * j];
#pragma unroll
    for (int q = 0; q < 4; ++q) { const int row = m + q * stride; if (row < MT) { float s = 0.f;
#pragma unroll
        for (int j = 0; j < 4; ++j) s += (v[q][j][0] * v[q][j][0] + v[q][j][1] * v[q][j][1]) + (v[q][j][2] * v[q][j][2] + v[q][j][3] * v[q][j][3]);
        s += __shfl_xor(s, 1); s += __shfl_xor(s, 2);
        if ((lane & 3) == 0) SSp[(size_t)row * 16 + (lane >> 2)] = s;
        GAS unsigned long long* o8 = (GAS unsigned long long*)(XGp + (size_t)row * DM) + lane;
#pragma unroll
        for (int j = 0; j < 4; ++j) o8[64 * j] = (unsigned long long)pk2(v[q][j][0] * gg[j][0], v[q][j][1] * gg[j][1]) | ((unsigned long long)pk2(v[q][j][2] * gg[j][2], v[q][j][3] * gg[j][3]) << 32); } }
}
__device__ __forceinline__ void final_row(const float* xrow, const float* g, const float* SS, int row, float* orow, int lane) {
    const GAS f32x4* xr = (const GAS f32x4*)xrow + lane; const GAS f32x4* gr = (const GAS f32x4*)g + lane; GAS f32x4* o = (GAS f32x4*)orow + lane;
    const float r = pg8::rstd16(SS, row);
#pragma unroll
    for (int j = 0; j < 4; ++j) { const f32x4 v = xr[64 * j], gg = gr[64 * j]; o[64 * j] = v * gg * r; }
}

template <int I> __device__ __forceinline__ const float* in_ptr() {
    unsigned long long v;
    asm volatile("s_load_dwordx2 %0, %1, %2\n\ts_waitcnt lgkmcnt(0)" : "=s"(v) : "s"(__builtin_amdgcn_kernarg_segment_ptr()), "n"(I * 8) : "memory");
    return (const float*)v;
}
#define INP(i) in_ptr<i>()
__device__ __forceinline__ void final_rows4(float* X, const float* g, const float* SS, int m, int stride, int lane) {
    f32x4 v[4][4]; float r[4];
#pragma unroll
    for (int q = 0; q < 4; ++q) { const int row = m + q * stride; const int rc = row < MT ? row : m; const GAS f32x4* xr = (const GAS f32x4*)(X + (size_t)rc * DM) + lane;
#pragma unroll
        for (int j = 0; j < 4; ++j) v[q][j] = xr[64 * j];
        r[q] = pg8::rstd16(SS, rc); }
    const GAS f32x4* gr = (const GAS f32x4*)g + lane; f32x4 gg[4];
#pragma unroll
    for (int j = 0; j < 4; ++j) gg[j] = gr[64 * j];
#pragma unroll
    for (int q = 0; q < 4; ++q) { const int row = m + q * stride; if (row < MT) { GAS f32x4* o = (GAS f32x4*)(X + (size_t)row * DM) + lane;
#pragma unroll
        for (int j = 0; j < 4; ++j) o[64 * j] = v[q][j] * gg[j] * r[q]; } }
}
struct Args { const float* in[28]; float* out; unsigned char* ws; int ph_lo, ph_hi, li, pad; };

#define ws ((unsigned char*)in_ptr<29>())
#define XR ((float*)in_ptr<28>())
#define XRB ((bf16_t*)in_ptr<28>())
#define Win_t ((bf16_t*)(ws + WS_WIN))
#define Wout_t ((bf16_t*)(ws + WS_WOUT))
#define Wup_t ((bf16_t*)(ws + WS_WUP))
#define Wdn_t ((bf16_t*)(ws + WS_WDN))
#define XG ((bf16_t*)(ws + WS_XG))
#define P ((bf16_t*)(ws + WS_P))
#define YN ((bf16_t*)(ws + WS_YN))
#define HB ((bf16_t*)(ws + WS_H))
#define SS ((float*)(ws + WS_SS))
__global__ void __launch_bounds__(NTHREADS, 2) mega(Args args) {
    extern __shared__ __attribute__((aligned(16))) unsigned char lds[];
    Frame F;
    F.lds = (LAS unsigned char*)lds; F.MISC = (volatile LAS unsigned*)(F.lds + MISC_OFF);
    F.wave = __builtin_amdgcn_readfirstlane((int)threadIdx.x >> 6);
    F.G = gridDim.x; { const int bx = blockIdx.x; F.vcu = (F.G % 8 == 0) ? (bx % 8) * (F.G / 8) + bx / 8 : bx; }
    gu32* ctl = (gu32*)(ws + WS_CTL);
    for (int u = threadIdx.x; u < (LDS_BYTES - MISC_OFF) / 4; u += NTHREADS) ((LAS unsigned*)(F.lds + MISC_OFF))[u] = 0u;
    __syncthreads();
    const int lo = args.ph_lo, hi = args.ph_hi;
    XcdBarrier bar; bar.bar = (unsigned*)(ctl + CW_BAR) + args.li * XCD_BAR_WORDS; bar.x = 0; bar.st = nullptr;
    if (hi - lo > 1) bar = xcd_barrier_post((unsigned*)(ctl + CW_BAR) + args.li * XCD_BAR_WORDS, F.MISC + 8);

    const int gw = F.vcu * NWAVES + F.wave, NGW = F.G * NWAVES;

#define IN(k) (lo <= (k) && (k) < hi)
#ifdef TPROBE
#define TSTAMP(i) do { if (blockIdx.x == 0 && threadIdx.x == 0) ((unsigned long long*)(ws + WS_CTL + 512 * 1024))[i] = __builtin_amdgcn_s_memrealtime(); } while (0)
#else
#define TSTAMP(i)
#endif
#define SEAM(k) do { if (IN(k) && IN((k) + 1)) { xcd_barrier(bar); DUP_BAR(xcd_barrier(bar);) TSTAMP((k) + 1); } } while (0)
    TSTAMP(0);
#ifndef DUP_PRO
#define DUP_PRO(...)
#endif
    if (IN(PH_PRO)) {
        auto pro_body = [&]() __attribute__((always_inline)) {
        LAS float* scr = (LAS float*)(F.lds + RING_OFF + F.wave * 16384);
        constexpr int I_IN = (DM / 64) * (DIN / 32), I_OUT = (DM / 64) * (DM / 32), I_UP = (DM / 64) * (DFF / 32), I_DN = (DFF / 64) * (DM / 32), I_L = I_IN + I_OUT + I_UP + I_DN;
        for (int it = gw; it < DEPTH * I_L; it += NGW) {
            const int l = it / I_L; int r = it % I_L;
            if (r < I_IN) { p0_transpose_item(INP(2) + (size_t)l * DM * DIN, DM, DIN, Win_t + (size_t)l * DINP * DM, scr, r, FLANE); continue; } r -= I_IN;
            if (r < I_OUT) { p0_transpose_item(INP(23) + (size_t)l * DM * DM, DM, DM, Wout_t + (size_t)l * DM * DM, scr, r, FLANE); continue; } r -= I_OUT;
            if (r < I_UP) { p0_transpose_item(INP(25) + (size_t)l * DM * DFF, DM, DFF, Wup_t + (size_t)l * DFF * DM, scr, r, FLANE); continue; } r -= I_UP;
            p0_transpose_item(INP(26) + (size_t)l * DFF * DM, DFF, DM, Wdn_t + (size_t)l * DM * DFF, scr, r, FLANE);
        }
        for (int i = blockIdx.x * NTHREADS + FTID; i < DEPTH * 16384; i += F.G * NTHREADS) { const int l = i >> 14, r = i & 16383;
            *(GAS v4u*)((GAS unsigned char*)(Win_t + (size_t)l * DINP * DM + (size_t)DIN * DM) + (size_t)r * 16) = (v4u){0u, 0u, 0u, 0u}; }
        {
            float* TWf = (float*)(ws + WS_TW); float* rope = (float*)(ws + WS_ROPE);
            for (int i = blockIdx.x * NTHREADS + FTID; i < 8192; i += F.G * NTHREADS) { const double a = 6.283185307179586476925286766559 * (double)i / 8192.0; TWf[2 * i] = (float)cos(a); TWf[2 * i + 1] = (float)(-sin(a)); }
            for (int i = blockIdx.x * NTHREADS + FTID; i < SL * 8; i += F.G * NTHREADS) { const int pos = i >> 3, j = i & 7; const double ang = (double)pos * pow(500000.0, -(double)j / 8.0);
                rope[pos * 16 + j] = (float)cos(ang); rope[pos * 16 + 8 + j] = (float)sin(ang); }
        }
        {
            bf16_t* LW = (bf16_t*)(ws + WS_LW); const float* wa = INP(5); const float* wx = INP(7);
            for (int o = blockIdx.x * NTHREADS + FTID; o < DEPTH * LRU_BLK * 4 * 64 * 64; o += F.G * NTHREADS) {
                const int i = o & 63, j = (o >> 6) & 63, mat = (o >> 12) & 3, lh = o >> 14, h = lh % LRU_BLK, l = lh / LRU_BLK, n = mat >> 1;
                const float* src = (mat & 1) ? wx : wa;
                LW[o] = (bf16_t)f2bf(src[((((size_t)l * 2 + n) * LRU_BLK + h) * 64 + i) * 64 + j]); }
        }
        {
            const float* w1 = INP(13); const float* b1 = INP(14); const float* fq = INP(15); const float* w2 = INP(16); const float* b2 = INP(17); const float* w3 = INP(18);
            for (int u = F.vcu; u < DEPTH * 128; u += F.G) { const int l = u >> 7;
                hy::filter_unit(F.lds, u & 127, FTID, w1 + (size_t)l * HY_EMB * HY_W, b1 + l * HY_W, fq + l * HY_W, w2 + (size_t)l * HY_W * HY_W, b2 + l * HY_W, w3 + (size_t)l * HY_W * 2 * DC,
                                (float*)(ws + WS_HF) + (size_t)l * DC * 8192); }
            __syncthreads();
        }
        { const float* x0 = INP(0); const float* g0 = INP(1);
          for (int m = gw; m < MT; m += 4 * NGW) xg_rows4(x0, g0, XG, SS, m, NGW, FLANE); }
        };
        pro_body(); DUP_PRO(xcd_barrier(bar); pro_body();)
    }
    SEAM(PH_PRO);
#ifndef DUP_MIX1
#define DUP_MIX1(...)
#endif
#ifndef DUP_FFT
#define DUP_FFT(...)
#endif
#ifndef DUP_FIN
#define DUP_FIN(...)
#endif
#ifndef DUP_WIN
#define DUP_WIN(...)
#endif
#ifndef DUP_WUP
#define DUP_WUP(...)
#endif
#ifndef DUP_HYP
#define DUP_HYP(...)
#endif
#ifndef DUP_AGG
#define DUP_AGG(...)
#endif
#ifndef DUP_ATT
#define DUP_ATT(...)
#endif
#ifndef DUP_WOUT
#define DUP_WOUT(...)
#endif
#ifndef DUP_LRUFIN
#define DUP_LRUFIN(...)
#endif
#ifndef DUP_NBC
#define DUP_NBC(...)
#endif
#ifndef DUP_BAR
#define DUP_BAR(...)
#endif
#ifndef DUP_WDN
#define DUP_WDN(...)
#endif
#define WIN_BODY(l) { \
        pg8::Gemm g{XG, Win_t + (size_t)(l) * DINP * DM, MT, 2048, DM, DM}; pg8::StaticOrder S; S.init(MT, 2048, F.G, (int)blockIdx.x); \
        pg8::EpiScaleBf16<0> E{P, DINP, SS}; \
        pg8::gemm_phase<pg8::EpiScaleBf16<0>, pg8::StaticOrder, true, true>(F.lds + RING_OFF, g, S, E); \
          \
        { const int c = (int)blockIdx.x, q = c & 3; \
          pg8::Gemm g2{XG + q * 256, Win_t + (size_t)(l) * DINP * DM + (size_t)2048 * DM + q * 256, MT, 256, 256, DM}; \
          pg8::QuarterOrder S2{c >> 2, F.G}; pg8::EpiSlab E2{(bf16_t*)(ws + WS_SLAB) + (size_t)q * MT * 128, SS}; \
          pg8::gemm_phase<pg8::EpiSlab, pg8::QuarterOrder, false, true>(F.lds + RING_OFF, g2, S2, E2); } }
#define MIX1_BODY(l) { const float* cw = INP(11) + (l) * 9 * DC; const float* cb = INP(12) + (l) * 3 * DC; \
        for (int u = F.vcu; u < 256; u += F.G) hy::hyprep_unit(F.lds, u, FTID, P, (const bf16_t*)(ws + WS_SLAB), cw, cb, (bf16_t*)(ws + WS_ZT), (bf16_t*)(ws + WS_X0T)); \
        DUP_HYP(for (int u = F.vcu; u < 256; u += F.G) hy::hyprep_unit(F.lds, u, FTID, P, (const bf16_t*)(ws + WS_SLAB), cw, cb, (bf16_t*)(ws + WS_ZT), (bf16_t*)(ws + WS_X0T));) \
        { const float* cwa = INP(3) + (l) * 4 * DA; const float* cba = INP(4) + (l) * DA; const float* ba = INP(6) + (l) * 2 * DA; const float* bx = INP(8) + (l) * 2 * DA; const float* lam = INP(9) + (l) * 2 * DA; \
          for (int u = F.vcu; u < 256; u += F.G) lru::lru_unit(F.lds, u, FTID, P, cwa, cba, (const bf16_t*)(ws + WS_LW) + (size_t)(l) * LRU_BLK * 4 * 4096, ba, bx, lam, (float*)(ws + WS_AGG), (bf16_t*)(ws + WS_LS), (bf16_t*)(ws + WS_LPF), (bf16_t*)(ws + WS_LPB)); \
          DUP_AGG(for (int u = F.vcu; u < 256; u += F.G) lru::lru_unit(F.lds, u, FTID, P, cwa, cba, (const bf16_t*)(ws + WS_LW) + (size_t)(l) * LRU_BLK * 4 * 4096, ba, bx, lam, (float*)(ws + WS_AGG), (bf16_t*)(ws + WS_LS), (bf16_t*)(ws + WS_LPF), (bf16_t*)(ws + WS_LPB));) } \
        { const float* sk = INP(10) + (l) * NQH; \
          for (int u = F.vcu; u < 256; u += F.G) at::attn_unit(F.lds, u, FTID, P, (const float*)(ws + WS_ROPE), sk, (bf16_t*)(ws + WS_AO)); \
          DUP_ATT(for (int u = F.vcu; u < 256; u += F.G) at::attn_unit(F.lds, u, FTID, P, (const float*)(ws + WS_ROPE), sk, (bf16_t*)(ws + WS_AO));) } }
#define FFT_BODY(l) { const float* hb = INP(19) + (l) * DC; \
        for (int u = F.vcu; u < DC; u += F.G) hy::fft_unit(F.lds, u, FTID, (const float*)(ws + WS_HF) + (size_t)(l) * DC * 8192, (const hy::cf*)(ws + WS_TW), (const bf16_t*)(ws + WS_ZT), (const bf16_t*)(ws + WS_X0T), \
                                                           (bf16_t*)(ws + WS_YCT), hb[u]); }
#define FIN_BODY(l) { \
        { const float* cwa = INP(3) + (l) * 4 * DA; const float* cba = INP(4) + (l) * DA; const float* ba = INP(6) + (l) * 2 * DA; const float* bx = INP(8) + (l) * 2 * DA; const float* lam = INP(9) + (l) * 2 * DA; const float* gna = INP(20) + (l) * DA; \
          for (int u = F.vcu; u < 256; u += F.G) lru::lru_fin_unit(F.lds, u, FTID, P, (const float*)(ws + WS_AGG), (const bf16_t*)(ws + WS_LS), (const bf16_t*)(ws + WS_LPF), (const bf16_t*)(ws + WS_LPB), gna, YN); \
          DUP_LRUFIN(for (int u = F.vcu; u < 256; u += F.G) lru::lru_fin_unit(F.lds, u, FTID, P, (const float*)(ws + WS_AGG), (const bf16_t*)(ws + WS_LS), (const bf16_t*)(ws + WS_LPF), (const bf16_t*)(ws + WS_LPB), gna, YN);) } \
        { const float* gnb = INP(21) + (l) * DBB; const float* gnc = INP(22) + (l) * DC; \
          for (int u = F.vcu; u < 256; u += F.G) fin::norm_bc_unit(F.lds, u, FTID, (const bf16_t*)(ws + WS_AO), (const bf16_t*)(ws + WS_YCT), gnb, gnc, YN); \
          DUP_NBC(for (int u = F.vcu; u < 256; u += F.G) fin::norm_bc_unit(F.lds, u, FTID, (const bf16_t*)(ws + WS_AO), (const bf16_t*)(ws + WS_YCT), gnb, gnc, YN);) } }
#define WUP_BODY(l) { \
        pg8::Gemm g{XG, Wup_t + (size_t)(l) * DFF * DM, MT, DFF, DM, DM}; pg8::StaticOrder S; S.init(MT, DFF, F.G, (int)blockIdx.x); \
        pg8::EpiScaleBf16<1> E{HB, DFF, SS}; \
        pg8::gemm_phase<pg8::EpiScaleBf16<1>, pg8::StaticOrder, true, true>(F.lds + RING_OFF, g, S, E); }
#define LAYER(l) do { constexpr int pb = 1 + PH_PER_LAYER * (l); \
    if (IN(pb + PL_WIN)) { WIN_BODY(l) DUP_WIN(xcd_barrier(bar); WIN_BODY(l)) } \
    SEAM(pb + PL_WIN); \
    if (IN(pb + PL_MIX1)) { MIX1_BODY(l) DUP_MIX1(xcd_barrier(bar); MIX1_BODY(l)) } \
    SEAM(pb + PL_MIX1); \
    if (IN(pb + PL_FFT)) { FFT_BODY(l) DUP_FFT(xcd_barrier(bar); FFT_BODY(l)) } \
    SEAM(pb + PL_FFT); \
    if (IN(pb + PL_FIN)) { FIN_BODY(l) DUP_FIN(xcd_barrier(bar); FIN_BODY(l)) } \
    SEAM(pb + PL_FIN); \
    if (IN(pb + PL_WOUT)) { \
        pg8::Gemm g{YN, Wout_t + (size_t)(l) * DM * DM, MT, DM, DM, DM}; pg8::StaticOrder S; S.init(MT, DM, F.G, (int)blockIdx.x); \
        if ((l) == 0) { pg8::EpiResB<true> E{(const void*)INP(0), XRB, XG, INP(24) + (l) * DM, SS}; \
            pg8::gemm_phase<pg8::EpiResB<true>, pg8::StaticOrder, true, true>(F.lds + RING_OFF, g, S, E); } \
        else { pg8::EpiResB<false> E{(const void*)XRB, XRB, XG, INP(24) + (l) * DM, SS}; \
            pg8::gemm_phase<pg8::EpiResB<false>, pg8::StaticOrder, true, true>(F.lds + RING_OFF, g, S, E); } } \
    SEAM(pb + PL_WOUT); \
    if (IN(pb + PL_WUP)) { WUP_BODY(l) DUP_WUP(xcd_barrier(bar); WUP_BODY(l)) } \
    SEAM(pb + PL_WUP); \
    if (IN(pb + PL_WDN)) { \
        pg8::Gemm g{HB, Wdn_t + (size_t)(l) * DM * DFF, MT, DM, DFF, DFF}; pg8::StaticOrder S; S.init(MT, DM, F.G, (int)blockIdx.x); \
        pg8::EpiResB<false> E{(const void*)XRB, XRB, ((l) + 1 < DEPTH) ? XG : (bf16_t*)nullptr, INP(1) + (((l) + 1 < DEPTH) ? ((l) + 1) * DM : 0), SS}; \
        pg8::gemm_phase<pg8::EpiResB<false>, pg8::StaticOrder, true, true>(F.lds + RING_OFF, g, S, E); } \
    SEAM(pb + PL_WDN); } while (0)
    LAYER(0);
    LAYER(1);
    if (IN(PH_FINAL)) { const float* gf = INP(27);
        static_assert(MT % (NWAVES * 256) == 0, "rows per wave");
        v4u xv[8][2]; float rr[8]; const int ln = FLANE;
#pragma unroll
        for (int q = 0; q < 8; ++q) { const int row = gw + q * NGW; const int rc = row < MT ? row : gw; const v4u* src = (const v4u*)(XRB + (size_t)rc * DM) + ln;
            xv[q][0] = src[0]; xv[q][1] = src[64]; rr[q] = pg8::rstd16(SS, rc); }
        xcd_barrier(bar);
        const GAS f32x4* gr = (const GAS f32x4*)gf;
        f32x4 gg[4];
#pragma unroll
        for (int j = 0; j < 2; ++j) { gg[2 * j] = gr[2 * ln + 128 * j]; gg[2 * j + 1] = gr[2 * ln + 128 * j + 1]; }
#pragma unroll
        for (int q = 0; q < 8; ++q) { const int row = gw + q * NGW; if (row < MT) { GAS f32x4* o = (GAS f32x4*)(XR + (size_t)row * DM);
#pragma unroll
            for (int j = 0; j < 2; ++j) { const v4u w = xv[q][j];
                const f32x4 a = (f32x4){pg8::bflo(w.x), pg8::bfhi(w.x), pg8::bflo(w.y), pg8::bfhi(w.y)}, c = (f32x4){pg8::bflo(w.z), pg8::bfhi(w.z), pg8::bflo(w.w), pg8::bfhi(w.w)};
                o[2 * ln + 128 * j] = a * gg[2 * j] * rr[q]; o[2 * ln + 128 * j + 1] = c * gg[2 * j + 1] * rr[q]; } } }
#ifdef TPROBE
        {   const unsigned long long* T = (const unsigned long long*)(ws + WS_CTL + 512 * 1024);
            const float d2 = (TPROBE == 102) ? ((float)(T[15] - T[0]) * 0.01f - 1000.f) * 0.002f : (TPROBE == 101) ? (float)(__builtin_amdgcn_s_memrealtime() - T[15]) * 0.0001f : (TPROBE >= 100) ? (float)(T[15] - T[0]) * 0.00001f : (float)(T[(TPROBE % 100) + 1] - T[TPROBE % 100]) * 0.0001f;
            asm volatile("s_waitcnt vmcnt(0)" ::: "memory");
            if (gw == 0 && FLANE == 0) XR[0] += d2; }
#endif
    }
#undef IN
#undef SEAM
#undef LAYER
}

#undef ws
#undef XR
#undef Win_t
#undef Wout_t
#undef Wup_t
#undef Wdn_t
#undef XG
#undef P
#undef YN
#undef HB
#undef SS
static int g_grid = 0, g_li = 0;
static void launch_mega(Args a, int lo, int hi, hipStream_t stream) {
    a.ph_lo = lo; a.ph_hi = hi; a.li = (hi - lo > 1) ? g_li++ : 0;
    void* kargs[] = {&a};
    hipLaunchCooperativeKernel((const void*)mega, dim3(g_grid), dim3(NTHREADS), kargs, LDS_BYTES, stream);
}
extern "C" void kernel_launch(void* const* d_in, const int* in_sizes, int n_in, void* d_out, int out_size, void* d_ws, size_t ws_size, hipStream_t stream) {
    if (n_in != 28 || ws_size < WS_END) return;
    if (g_grid == 0) {
        int dev = 0, cus = 0, per_cu = 0;
        hipGetDevice(&dev); hipDeviceGetAttribute(&cus, hipDeviceAttributeMultiprocessorCount, dev);
        hipFuncSetAttribute((const void*)mega, hipFuncAttributeMaxDynamicSharedMemorySize, LDS_BYTES);
        hipOccupancyMaxActiveBlocksPerMultiprocessor(&per_cu, (const void*)mega, NTHREADS, LDS_BYTES);
        (void)hipGetLastError();
        if (per_cu < 1) per_cu = 1;
        if (per_cu > 1) per_cu = 1;
        g_grid = cus * per_cu;
    }
    g_li = 0;
    unsigned char* ws = (unsigned char*)d_ws;
    auto F = [&](int i) { return (const float*)d_in[i]; };
    hipMemsetAsync(ws + WS_CTL, 0, 64 * 1024, stream);
    Args a{};
    for (int i = 0; i < 28; ++i) a.in[i] = (const float*)d_in[i];
    a.out = (float*)d_out; a.ws = ws;
    float* rope = (float*)(ws + WS_ROPE); float* HF = (float*)(ws + WS_HF);
    bf16_t* P = (bf16_t*)(ws + WS_P); bf16_t* YN = (bf16_t*)(ws + WS_YN);
    float* nA = (float*)(ws + NV_A); float* nB = (float*)(ws + NV_B); float* nHS = (float*)(ws + NV_HS); float* nZ = (float*)(ws + NV_Z); float* nX0 = (float*)(ws + NV_X0); float* nYC = (float*)(ws + NV_YC);

    launch_mega(a, 0, NPH, stream);
}
```

```cpp
#define DUP_BAR(...)
#include <hip/hip_runtime.h>
#include <stdint.h>
#include <math.h>

typedef unsigned short bf16_t;
typedef short bf16x8 __attribute__((ext_vector_type(8)));
typedef float f32x4 __attribute__((ext_vector_type(4)));

constexpr int NB = 4, SL = 4096, DM = 1024, MT = NB * SL, DEPTH = 2;
constexpr int DA = 384, DBB = 384, DC = 256, HD = 64, NQH = 6, NKVH = 2, DIN = 2176, DINP = 2304, DFF = 4096;
constexpr int P_AX = 0, P_AG = 384, P_Q = 768, P_K = 1152, P_V = 1280, P_CU = 1408;
constexpr int LRU_BLK = 6, LRU_BW = 64, WIN = 128, HY_EMB = 33, HY_W = 64;
constexpr float EPS = 1e-6f;

constexpr size_t MiB = 1u << 20;
constexpr size_t WS_WIN = 0;
constexpr size_t WS_WOUT = 9 * MiB;
constexpr size_t WS_WUP = 13 * MiB;
constexpr size_t WS_WDN = 29 * MiB;
constexpr size_t WS_ROPE = 45 * MiB;
constexpr size_t WS_HF = 46 * MiB;
constexpr size_t WS_XG = 62 * MiB;
constexpr size_t WS_BIG = 94 * MiB;
constexpr size_t WS_H = WS_BIG;
constexpr size_t WS_P = WS_BIG;
constexpr size_t WS_YN = WS_BIG + 72 * MiB;
constexpr size_t WS_SCR = WS_BIG + 104 * MiB;
constexpr size_t WS_CTL = 254 * MiB;
constexpr size_t WS_SS = 255 * MiB;
constexpr size_t WS_END = 256 * MiB;
constexpr size_t NV_A = WS_XG;
constexpr size_t NV_B = WS_SCR;
constexpr size_t NV_HS = WS_SCR + 24 * MiB;
constexpr size_t NV_Z = WS_SCR;
constexpr size_t NV_X0 = WS_SCR + 16 * MiB;
constexpr size_t NV_YC = WS_SCR + 32 * MiB;

__device__ __forceinline__ unsigned f2bf(float f) { unsigned u = __builtin_bit_cast(unsigned, f); return (u + 0x7fffu + ((u >> 16) & 1u)) >> 16; }
__device__ __forceinline__ float bf2f(bf16_t h) { return __builtin_bit_cast(float, (unsigned)h << 16); }
__device__ __forceinline__ float sigmoidf_(float x) { return 1.f / (1.f + expf(-x)); }
__device__ __forceinline__ float gelu_tanh(float x) { const float u = 0.7978845608028654f * (x + 0.044715f * x * x * x); return 0.5f * x * (1.f + tanhf(u)); }

__device__ __forceinline__ float block_sum(float v, float* red) {
    for (int o = 32; o > 0; o >>= 1) v += __shfl_xor(v, o);
    const int w = threadIdx.x >> 6, nw = blockDim.x >> 6;
    __syncthreads();
    if ((threadIdx.x & 63) == 0) red[w] = v;
    __syncthreads();
    float s = 0.f;
    for (int i = 0; i < nw; ++i) s += red[i];
    return s;
}

__global__ void k_rope(float* __restrict__ tab) {
    const int i = blockIdx.x * blockDim.x + threadIdx.x; if (i >= SL * 8) return;
    const int pos = i >> 3, j = i & 7;
    const double inv = pow(500000.0, -(double)j / 8.0), ang = (double)pos * inv;
    tab[pos * 16 + j] = (float)cos(ang); tab[pos * 16 + 8 + j] = (float)sin(ang);
}

__global__ void k_hy_filter(const float* __restrict__ w1, const float* __restrict__ b1, const float* __restrict__ freq, const float* __restrict__ w2,
                            const float* __restrict__ b2, const float* __restrict__ w3, float* __restrict__ HF) {
    __shared__ float z[HY_EMB], h1[HY_W], h2[HY_W];
    const int t = blockIdx.x, tid = threadIdx.x;
    const double PI2 = 6.283185307179586476925286766559;
    const float tt = (float)((double)t / (double)(SL - 1));
    if (tid < HY_EMB) {
        float v;
        if (tid == 0) v = tt;
        else { const int bi = (tid - 1) & 15; const double f = 1e-4 + (double)bi * ((15.0 - 1e-4) / 15.0); const double w = PI2 * (double)t / (double)SL;
               v = (tid <= 16) ? (float)cos(f * w) : (float)(-sin(f * w)); }
        z[tid] = v;
    }
    __syncthreads();
    if (tid < HY_W) { float a = b1[tid]; for (int i = 0; i < HY_EMB; ++i) a += z[i] * w1[i * HY_W + tid]; h1[tid] = sinf(freq[tid] * a); }
    __syncthreads();
    if (tid < HY_W) { float a = b2[tid]; for (int i = 0; i < HY_W; ++i) a += h1[i] * w2[i * HY_W + tid]; h2[tid] = sinf(freq[tid] * a); }
    __syncthreads();
    const double mind = log(1e-2) / 1.5, maxd = log(1e-2) / 0.3;
    for (int o = tid; o < 2 * DC; o += 256) {
        float a = 0.f; for (int i = 0; i < HY_W; ++i) a += h2[i] * w3[i * 2 * DC + o];
        const int c = o & 255, dir = o >> 8;
        const float delta = fabsf((float)(mind + (maxd - mind) * (double)c / 255.0));
        HF[((size_t)dir * SL + t) * DC + c] = a * expf(-tt * delta);
    }
}

__global__ __launch_bounds__(384) void k_lru_ab(const bf16_t* __restrict__ P, const float* __restrict__ cw, const float* __restrict__ cb, const float* __restrict__ wa, const float* __restrict__ ba,
                                               const float* __restrict__ wx, const float* __restrict__ bx, const float* __restrict__ lam, float* __restrict__ Aout, float* __restrict__ Bout, int n) {
    __shared__ float xc[DA];
    const int m = blockIdx.x, t = m % SL, j = threadIdx.x;
    float v = cb[j];
#pragma unroll
    for (int k = 0; k < 4; ++k) { const int tt = t + k - 2; if (tt >= 0 && tt < SL) v += cw[k * DA + j] * bf2f(P[(size_t)(m + k - 2) * DINP + P_AX + j]); }
    xc[j] = v;
    __syncthreads();
    const int blk = j >> 6, jj = j & 63;
    {
        float ra = ba[n * DA + j], ia = bx[n * DA + j];
        const float* wap = wa + ((size_t)(n * LRU_BLK + blk) * 64) * 64 + jj; const float* wxp = wx + ((size_t)(n * LRU_BLK + blk) * 64) * 64 + jj;
        for (int i = 0; i < 64; ++i) { const float xi = xc[blk * 64 + i]; ra += xi * wap[i * 64]; ia += xi * wxp[i * 64]; }
        const float r = sigmoidf_(ra), ig = sigmoidf_(ia);
        const float l = lam[n * DA + j]; const float sp = (-l > 20.f) ? -l : log1pf(expf(-l));
        const float log_a = -8.f * r * sp;
        const float a = expf(log_a), bb = sqrtf(-expm1f(2.f * log_a)) * (ig * v);
        Aout[(size_t)m * DA + j] = a; Bout[(size_t)m * DA + j] = bb;
    }
}
__global__ void k_lru_scan(const float* __restrict__ A, const float* __restrict__ Bv, float* __restrict__ HS, int n) {
    const int id = blockIdx.x * blockDim.x + threadIdx.x; if (id >= NB * DA) return;
    const int ch = id % DA, b = id / DA;
    float h = 0.f;
    for (int s = 0; s < SL; ++s) { const int t = n ? (SL - 1 - s) : s; const size_t o = ((size_t)b * SL + t) * DA + ch; h = A[o] * h + Bv[o]; HS[o] = n ? (HS[o] + h) : h; }
}
__global__ __launch_bounds__(384) void k_lru_out(const bf16_t* __restrict__ P, const float* __restrict__ HS, const float* __restrict__ gn, bf16_t* __restrict__ YN) {
    __shared__ float red[8];
    const int m = blockIdx.x, j = threadIdx.x;
    const float h = HS[(size_t)m * DA + j];
    const float y = h * gelu_tanh(bf2f(P[(size_t)m * DINP + P_AG + j]));
    const float ss = block_sum(y * y, red);
    const float r = 1.f / sqrtf(ss * (1.f / DA) + EPS);
    YN[(size_t)m * DM + j] = (bf16_t)f2bf(y * r * gn[j]);
}

__global__ __launch_bounds__(384) void k_attn(const bf16_t* __restrict__ P, const float* __restrict__ rope, const float* __restrict__ sink, const float* __restrict__ gn, bf16_t* __restrict__ YN) {
    __shared__ float qs[NQH][HD], ps[NQH][320], red[8];
    const int m = blockIdx.x, t = m % SL, w = threadIdx.x >> 6, lane = threadIdx.x & 63, kvh = w / 3;
    const float* rt = rope + t * 16;
    const bf16_t* qp = P + (size_t)m * DINP + P_Q + w * HD;
    {   float q = bf2f(qp[lane]);
        if (lane < 8) q = q * rt[lane] - bf2f(qp[lane + 8]) * rt[8 + lane];
        else if (lane < 16) q = q * rt[lane - 8] + bf2f(qp[lane - 8]) * rt[lane];
        qs[w][lane] = q; }
    __syncthreads();
    float sv[5]; float mx = sink[w];
#pragma unroll
    for (int pss = 0; pss < 5; ++pss) {
        const int jrel = pss * 64 + lane, jt = t - WIN + jrel; float s = -1e30f;
        if (jrel <= 2 * WIN && jt >= 0 && jt < SL) {
            const bf16_t* kp = P + (size_t)(m - WIN + jrel) * DINP + P_K + kvh * HD; const float* rk = rope + jt * 16;
            float acc = 0.f;
            for (int d = 0; d < 8; ++d) { const float k1 = bf2f(kp[d]), k2 = bf2f(kp[d + 8]); acc += qs[w][d] * (k1 * rk[d] - k2 * rk[8 + d]) + qs[w][d + 8] * (k2 * rk[d] + k1 * rk[8 + d]); }
            for (int d = 16; d < HD; ++d) acc += qs[w][d] * bf2f(kp[d]);
            s = acc * 0.125f;
        }
        sv[pss] = s; mx = fmaxf(mx, s);
    }
    for (int o = 32; o > 0; o >>= 1) mx = fmaxf(mx, __shfl_xor(mx, o));
    float den = 0.f;
#pragma unroll
    for (int pss = 0; pss < 5; ++pss) { const float p = (sv[pss] > -1e29f) ? expf(sv[pss] - mx) : 0.f; ps[w][pss * 64 + lane] = p; den += p; }
    for (int o = 32; o > 0; o >>= 1) den += __shfl_xor(den, o);
    den += expf(sink[w] - mx);
    __syncthreads();
    float o = 0.f;
    for (int jrel = 0; jrel <= 2 * WIN; ++jrel) { const int jt = t - WIN + jrel; if (jt < 0 || jt >= SL) continue; o += ps[w][jrel] * bf2f(P[(size_t)(m - WIN + jrel) * DINP + P_V + kvh * HD + lane]); }
    o /= den;
    const float ss = block_sum(o * o, red);
    const float r = 1.f / sqrtf(ss * (1.f / DBB) + EPS);
    YN[(size_t)m * DM + DA + w * HD + lane] = (bf16_t)f2bf(o * r * gn[w * HD + lane]);
}

__global__ __launch_bounds__(384) void k_attn_norm(const bf16_t* __restrict__ AO, const float* __restrict__ gn, bf16_t* __restrict__ YN) {
    __shared__ float red[8];
    const int m = blockIdx.x, j = threadIdx.x; const float o = bf2f(AO[(size_t)m * DBB + j]);
    const float ss = block_sum(o * o, red); const float r = 1.f / sqrtf(ss * (1.f / DBB) + EPS);
    YN[(size_t)m * DM + DA + j] = (bf16_t)f2bf(o * r * gn[j]);
}
__global__ __launch_bounds__(256) void k_hy_prep(const bf16_t* __restrict__ P, const float* __restrict__ cw, const float* __restrict__ cb, float* __restrict__ Z, float* __restrict__ X0) {
    const int m = blockIdx.x, t = m % SL, c = threadIdx.x;
    float u[3];
#pragma unroll
    for (int part = 0; part < 3; ++part) { const int ch = part * DC + c; float v = cb[ch];
#pragma unroll
        for (int k = 0; k < 3; ++k) { const int tt = t + k - 1; if (tt >= 0 && tt < SL) v += cw[k * 3 * DC + ch] * bf2f(P[(size_t)(m + k - 1) * DINP + P_CU + ch]); }
        u[part] = v; }
    Z[(size_t)m * DC + c] = u[2] * u[1]; X0[(size_t)m * DC + c] = u[0];
}
__global__ __launch_bounds__(256) void k_hy_conv(const float* __restrict__ Z, const float* __restrict__ X0, const float* __restrict__ HF, const float* __restrict__ bias, float* __restrict__ YC) {
    const int m = blockIdx.x, b = m / SL, t = m % SL, c = threadIdx.x;
    const float* zb = Z + (size_t)b * SL * DC + c; const float* hf = HF + c; const float* hb = HF + (size_t)SL * DC + c;
    float y = 0.f;
    for (int s = 0; s <= t; ++s) y += hf[(size_t)(t - s) * DC] * zb[(size_t)s * DC];
    for (int s = t + 1; s < SL; ++s) y += hb[(size_t)(s - t) * DC] * zb[(size_t)s * DC];
    YC[(size_t)m * DC + c] = (y + zb[(size_t)t * DC] * bias[c]) * X0[(size_t)m * DC + c];
}
__global__ __launch_bounds__(256) void k_hy_norm(const bf16_t* __restrict__ YCT, const float* __restrict__ gn, bf16_t* __restrict__ YN) {
    __shared__ float red[8];
    const int m = blockIdx.x, c = threadIdx.x; const float y = bf2f(YCT[((size_t)(m / SL) * DC + c) * SL + (m % SL)]);
    const float ss = block_sum(y * y, red); const float r = 1.f / sqrtf(ss * (1.f / DC) + EPS);
    YN[(size_t)m * DM + DA + DBB + c] = (bf16_t)f2bf(y * r * gn[c]);
}

namespace pg8 {
#define PG8_LAS __attribute__((address_space(3)))
typedef unsigned short bf16_t;
typedef short bf16x8 __attribute__((ext_vector_type(8)));
typedef float f32x4 __attribute__((ext_vector_type(4)));
typedef unsigned u32x4 __attribute__((ext_vector_type(4)));
constexpr int BM = 256, BK = 64, HALF = 128, HTB = HALF * BK * 2  , STAGE_BYTES = 8 * HTB, NXCD = 8, WGM = 8;

__host__ __device__ __forceinline__ int lds_byte(int r, int c) { const int st = (r >> 4) * 2 + (c >> 5), rr = r & 15, cc = c & 31, ob = rr * 64 + cc * 2; return st * 1024 + (ob ^ (((ob >> 9) & 1) << 5)); }
__host__ __device__ __forceinline__ void stage_rc(int b, int& R, int& C) { const int st = b / 1024, sb = b % 1024, swz = sb ^ (((sb >> 9) & 1) << 5); R = (st >> 1) * 16 + swz / 64; C = (st & 1) * 32 + (swz % 64) / 2; }
__host__ __device__ __forceinline__ int perm32(int rho) { const int n = rho >> 4, i = rho & 15; return 8 * (i >> 2) + 4 * n + (i & 3); }

struct Unit { int pm, pn; };
struct Gemm { const bf16_t* A; const bf16_t* Bt; int M, N, K, ld; };

struct StaticOrder {
    int nM, nN, nwg, G, c;
    __host__ __device__ void init(int M, int N, int G_, int c_) { nM = M / BM; nN = N / BM; nwg = nM * nN; G = G_; c = c_; }
    __host__ __device__ bool next(int i, Unit& u) const {
        const long L = (long)i * G + c; if (L >= nwg) return false;
        int wgid = (int)L; { const int q = nwg / NXCD, r = nwg % NXCD, xcd = wgid % NXCD, off = wgid / NXCD; wgid = (xcd < r ? xcd * (q + 1) : r * (q + 1) + (xcd - r) * q) + off; }
        const int nig = WGM * nN, gid = wgid / nig, fm = gid * WGM, gsz = (nM - fm) < WGM ? (nM - fm) : WGM;
        u.pm = fm + ((wgid % nig) % gsz); u.pn = (wgid % nig) / gsz; return true;
    }
    __device__ __forceinline__ void a_ready(const Unit&) const {}
    __device__ __forceinline__ void done(const Unit&) const {}
};

__device__ __forceinline__ unsigned cvt_pk_bf16(float lo, float hi) { unsigned r; asm volatile("v_cvt_pk_bf16_f32 %0, %1, %2" : "=v"(r) : "v"(lo), "v"(hi)); return r; }

constexpr int E_DM = 1024, E_DINP = 2304, E_DFF = 4096; constexpr float E_EPS = 1e-6f;
__device__ __forceinline__ float rstd16(const float* SS, int row) {
    const f32x4* p = (const f32x4*)(SS + (size_t)row * 16); const f32x4 a = (p[0] + p[1]) + (p[2] + p[3]);
    return 1.0f / sqrtf(((a[0] + a[1]) + (a[2] + a[3])) * (1.0f / E_DM) + E_EPS);
}
template <int ACT> struct EpiScaleBf16 {
    static constexpr bool PERM = true, AFTER_DRAIN = false;
    bf16_t* O; int ldc; const float* SS;
    __device__ __forceinline__ void operator()(const f32x4 (&acc)[2][2][4][2], const Unit& u, int wr, int wc, int fr, int fq) const {
        const int row0 = u.pm * BM + wr * 64 + fr, col0 = u.pn * BM + wc * 32 + 8 * fq;
        float rs[2][4];
        {   f32x4 p[2][4];
#pragma unroll
            for (int ai = 0; ai < 2; ++ai) { const f32x4* src = (const f32x4*)(SS + (size_t)(row0 + ai * HALF + fq * 16) * 16);
#pragma unroll
                for (int q = 0; q < 4; ++q) p[ai][q] = src[q]; }
            float mine[2];
#pragma unroll
            for (int ai = 0; ai < 2; ++ai) { const f32x4 a = (p[ai][0] + p[ai][1]) + (p[ai][2] + p[ai][3]); mine[ai] = 1.0f / sqrtf(((a[0] + a[1]) + (a[2] + a[3])) * (1.0f / E_DM) + E_EPS); }
#pragma unroll
            for (int ai = 0; ai < 2; ++ai)
#pragma unroll
                for (int m = 0; m < 4; ++m) rs[ai][m] = __shfl(mine[ai], fr + 16 * m); }
#pragma unroll
        for (int ai = 0; ai < 2; ++ai)
#pragma unroll
            for (int m = 0; m < 4; ++m) { const int row = row0 + ai * HALF + m * 16; const float r = rs[ai][m]; bf16_t* rowp = O + (size_t)row * ldc + col0;
#pragma unroll
                for (int bj = 0; bj < 2; ++bj) { f32x4 v0 = acc[ai][bj][m][0] * r, v1 = acc[ai][bj][m][1] * r;
                    if (ACT == 1) {
#pragma unroll
                        for (int i = 0; i < 4; ++i) { const float a = fmaxf(v0[i], 0.f), b = fmaxf(v1[i], 0.f); v0[i] = a * a; v1[i] = b * b; } }
                    u32x4 w; w.x = cvt_pk_bf16(v0[0], v0[1]); w.y = cvt_pk_bf16(v0[2], v0[3]); w.z = cvt_pk_bf16(v1[0], v1[1]); w.w = cvt_pk_bf16(v1[2], v1[3]);
                    *(u32x4*)(rowp + bj * HALF) = w; } }
    }
};
struct QuarterOrder { int pm0, G;
    __device__ __forceinline__ bool next(int i, Unit& u) const { const int pm = pm0 + i * (G >> 2); if (pm >= 64) return false; u.pm = pm; u.pn = 0; return true; }
    __device__ __forceinline__ void a_ready(const Unit&) const {}
    __device__ __forceinline__ void done(const Unit&) const {} };
struct EpiSlab {
    static constexpr bool PERM = true, AFTER_DRAIN = false;
    bf16_t* S; const float* SS;
    __device__ __forceinline__ void operator()(const f32x4 (&acc)[2][2][4][2], const Unit& u, int wr, int wc, int fr, int fq) const {
        const int row0 = u.pm * BM + wr * 64 + fr, col0 = wc * 32 + 8 * fq;
        float rs[2][4];
        {   f32x4 p[2][4];
#pragma unroll
            for (int ai = 0; ai < 2; ++ai) { const f32x4* src = (const f32x4*)(SS + (size_t)(row0 + ai * HALF + fq * 16) * 16);
#pragma unroll
                for (int q = 0; q < 4; ++q) p[ai][q] = src[q]; }
            float mine[2];
#pragma unroll
            for (int ai = 0; ai < 2; ++ai) { const f32x4 a = (p[ai][0] + p[ai][1]) + (p[ai][2] + p[ai][3]); mine[ai] = 1.0f / sqrtf(((a[0] + a[1]) + (a[2] + a[3])) * (1.0f / E_DM) + E_EPS); }
#pragma unroll
            for (int ai = 0; ai < 2; ++ai)
#pragma unroll
                for (int m = 0; m < 4; ++m) rs[ai][m] = __shfl(mine[ai], fr + 16 * m); }
#pragma unroll
        for (int ai = 0; ai < 2; ++ai)
#pragma unroll
            for (int m = 0; m < 4; ++m) { const int row = row0 + ai * HALF + m * 16; const float r = rs[ai][m];
                const f32x4 v0 = acc[ai][0][m][0] * r, v1 = acc[ai][0][m][1] * r;
                u32x4 w; w.x = cvt_pk_bf16(v0[0], v0[1]); w.y = cvt_pk_bf16(v0[2], v0[3]); w.z = cvt_pk_bf16(v1[0], v1[1]); w.w = cvt_pk_bf16(v1[2], v1[3]);
                *(u32x4*)(S + (size_t)row * 128 + col0) = w; }
    }
};
__device__ __forceinline__ float bflo(unsigned u) { return __builtin_bit_cast(float, u << 16); }
__device__ __forceinline__ float bfhi(unsigned u) { return __builtin_bit_cast(float, u & 0xffff0000u); }
template <bool BASEF32> struct EpiResB {
    static constexpr bool PERM = true, AFTER_DRAIN = false;
    const void* base; bf16_t* out; bf16_t* XG; const float* g; float* SS;
    __device__ __forceinline__ void operator()(const f32x4 (&acc)[2][2][4][2], const Unit& u, int wr, int wc, int fr, int fq) const {
        const int row0 = u.pm * BM + wr * 64 + fr, col0 = u.pn * BM + wc * 32 + 8 * fq;
        f32x4 gv[2][2];
#pragma unroll
        for (int bj = 0; bj < 2; ++bj)
#pragma unroll
            for (int n = 0; n < 2; ++n) gv[bj][n] = XG ? *(const f32x4*)(g + col0 + bj * HALF + 4 * n) : (f32x4){0.f, 0.f, 0.f, 0.f};
        if (!BASEF32) {
            u32x4 bw[2][4][2];
#pragma unroll
            for (int ai = 0; ai < 2; ++ai)
#pragma unroll
                for (int m = 0; m < 4; ++m)
#pragma unroll
                    for (int bj = 0; bj < 2; ++bj) bw[ai][m][bj] = *(const u32x4*)((const bf16_t*)base + (size_t)(row0 + ai * HALF + m * 16) * E_DM + col0 + bj * HALF);
#pragma unroll
            for (int ai = 0; ai < 2; ++ai)
#pragma unroll
                for (int m = 0; m < 4; ++m) { const int row = row0 + ai * HALF + m * 16; const size_t off = (size_t)row * E_DM + col0; float s = 0.f;
#pragma unroll
                    for (int bj = 0; bj < 2; ++bj) { const u32x4 w = bw[ai][m][bj];
                        const f32x4 v0 = (f32x4){bflo(w.x), bfhi(w.x), bflo(w.y), bfhi(w.y)} + acc[ai][bj][m][0], v1 = (f32x4){bflo(w.z), bfhi(w.z), bflo(w.w), bfhi(w.w)} + acc[ai][bj][m][1];
                        u32x4 o; o.x = cvt_pk_bf16(v0[0], v0[1]); o.y = cvt_pk_bf16(v0[2], v0[3]); o.z = cvt_pk_bf16(v1[0], v1[1]); o.w = cvt_pk_bf16(v1[2], v1[3]);
                        *(u32x4*)(out + off + bj * HALF) = o;
                        s += ((v0[0] * v0[0] + v0[1] * v0[1]) + (v0[2] * v0[2] + v0[3] * v0[3])) + ((v1[0] * v1[0] + v1[1] * v1[1]) + (v1[2] * v1[2] + v1[3] * v1[3]));
                        if (XG) { const f32x4 x0 = v0 * gv[bj][0], x1 = v1 * gv[bj][1]; u32x4 q; q.x = cvt_pk_bf16(x0[0], x0[1]); q.y = cvt_pk_bf16(x0[2], x0[3]); q.z = cvt_pk_bf16(x1[0], x1[1]); q.w = cvt_pk_bf16(x1[2], x1[3]);
                            *(u32x4*)(XG + off + bj * HALF) = q; } }
                    s += __shfl_xor(s, 16); s += __shfl_xor(s, 32);
                    if (fq == 0) SS[(size_t)row * 16 + u.pn * 4 + wc] = s; }
        } else {
#pragma unroll
            for (int ai = 0; ai < 2; ++ai)
#pragma unroll
                for (int m = 0; m < 4; ++m) { const int row = row0 + ai * HALF + m * 16; const size_t off = (size_t)row * E_DM + col0; float s = 0.f;
#pragma unroll
                    for (int bj = 0; bj < 2; ++bj) { const f32x4 b0 = *(const f32x4*)((const float*)base + off + bj * HALF), b1 = *(const f32x4*)((const float*)base + off + bj * HALF + 4);
                        const f32x4 v0 = b0 + acc[ai][bj][m][0], v1 = b1 + acc[ai][bj][m][1];
                        u32x4 o; o.x = cvt_pk_bf16(v0[0], v0[1]); o.y = cvt_pk_bf16(v0[2], v0[3]); o.z = cvt_pk_bf16(v1[0], v1[1]); o.w = cvt_pk_bf16(v1[2], v1[3]);
                        *(u32x4*)(out + off + bj * HALF) = o;
                        s += ((v0[0] * v0[0] + v0[1] * v0[1]) + (v0[2] * v0[2] + v0[3] * v0[3])) + ((v1[0] * v1[0] + v1[1] * v1[1]) + (v1[2] * v1[2] + v1[3] * v1[3]));
                        if (XG) { const f32x4 x0 = v0 * gv[bj][0], x1 = v1 * gv[bj][1]; u32x4 q; q.x = cvt_pk_bf16(x0[0], x0[1]); q.y = cvt_pk_bf16(x0[2], x0[3]); q.z = cvt_pk_bf16(x1[0], x1[1]); q.w = cvt_pk_bf16(x1[2], x1[3]);
                            *(u32x4*)(XG + off + bj * HALF) = q; } }
                    s += __shfl_xor(s, 16); s += __shfl_xor(s, 32);
                    if (fq == 0) SS[(size_t)row * 16 + u.pn * 4 + wc] = s;
                    if (m & 1) asm volatile("" ::: "memory"); }
        }
    }
};

template <class Epi, class Sched, bool ALIGN_EPI = false, bool SP2 = false>
__device__ __forceinline__ void gemm_phase(PG8_LAS unsigned char* lds, const Gemm g, const Sched& S, const Epi& E) {
    const int tid = threadIdx.x, wid = __builtin_amdgcn_readfirstlane(tid >> 6), lane = tid & 63, wr = wid >> 2, wc = wid & 3, fr = lane & 15, fq = lane >> 4;
    const int K = g.ld, nt = g.K / BK;
    unsigned voffA[2], voffB[2];
#pragma unroll
    for (int i = 0; i < 2; ++i) { int R, C; stage_rc(tid * 16 + i * 8192, R, C); const int Rb = Epi::PERM ? ((R & ~31) + perm32(R & 31)) : R;
        voffA[i] = (unsigned)(R * K + C) * 2u; voffB[i] = (unsigned)(Rb * K + C) * 2u; }
    const size_t kstep = (size_t)(BK * 2);
    const size_t hstep = (size_t)HALF * K * 2;
    const size_t tstep = 2 * hstep;
    const unsigned ldsw = (unsigned)wid * 1024u;
    const int aoff = lds_byte(wr * 64 + fr, fq * 8), boff = lds_byte(wc * 32 + fr, fq * 8);
#define PG8_SA(b, h) (((b) * 2 + (h)) * HTB)
#define PG8_SB(b, h) ((4 + (b) * 2 + (h)) * HTB)
#define PG8_STAGE(bufoff, gbase, voff) do { _Pragma("unroll") for (int _i = 0; _i < 2; ++_i) \
        __builtin_amdgcn_global_load_lds((const unsigned*)((const char*)(gbase) + (voff)[_i]), (PG8_LAS unsigned*)(lds + (bufoff) + ldsw + _i * 8192), 16, 0, 0); } while (0)
#define PG8_LDA(dst, b, h) do { _Pragma("unroll") for (int m = 0; m < 4; ++m) _Pragma("unroll") for (int k = 0; k < 2; ++k) dst[m][k] = *(const PG8_LAS bf16x8*)(lds + PG8_SA(b, h) + aoff + m * 2048 + k * 1024); } while (0)
#define PG8_LDB(dst, b, h) do { _Pragma("unroll") for (int n = 0; n < 2; ++n) _Pragma("unroll") for (int k = 0; k < 2; ++k) dst[n][k] = *(const PG8_LAS bf16x8*)(lds + PG8_SB(b, h) + boff + n * 2048 + k * 1024); } while (0)
#define PG8_MMA(ai, bj, At, Bt) do { __builtin_amdgcn_s_setprio(1); _Pragma("unroll") for (int m = 0; m < 4; ++m) _Pragma("unroll") for (int n = 0; n < 2; ++n) _Pragma("unroll") for (int k = 0; k < 2; ++k) \
        acc[ai][bj][m][n] = __builtin_amdgcn_mfma_f32_16x16x32_bf16(Bt[n][k], At[m][k], acc[ai][bj][m][n], 0, 0, 0); __builtin_amdgcn_s_setprio(0); } while (0)
#define PG8_WAIT_V(n) asm volatile("s_waitcnt vmcnt(" #n ")" ::: "memory")
#define PG8_WAIT_L(n) asm volatile("s_waitcnt lgkmcnt(" #n ")" ::: "memory")
#define PG8_BAR __builtin_amdgcn_s_barrier()
#define PG8_SCHED __builtin_amdgcn_sched_barrier(0)
    Unit cur, nxt; int ui = 0;
    if (!S.next(0, cur)) return;
    f32x4 acc[2][2][4][2];
#pragma unroll
    for (int a = 0; a < 2; ++a)
#pragma unroll
        for (int b = 0; b < 2; ++b)
#pragma unroll
            for (int m = 0; m < 4; ++m)
#pragma unroll
                for (int n = 0; n < 2; ++n) acc[a][b][m][n] = (f32x4){0.f, 0.f, 0.f, 0.f};
    bf16x8 At[4][2], B0[2][2], B1[2][2];
    const char* cA = (const char*)g.A + (size_t)cur.pm * tstep; const char* cB = (const char*)g.Bt + (size_t)cur.pn * tstep;
    S.a_ready(cur);
    if constexpr (SP2) {
        PG8_STAGE(PG8_SB(0, 0), cB, voffB); PG8_STAGE(PG8_SB(0, 1), cB + hstep, voffB); PG8_STAGE(PG8_SA(0, 0), cA, voffA); PG8_STAGE(PG8_SA(0, 1), cA + hstep, voffA);
        if (wr == 1) PG8_BAR;
        PG8_WAIT_V(2); PG8_BAR;
        PG8_STAGE(PG8_SB(1, 0), cB + kstep, voffB); PG8_STAGE(PG8_SA(1, 0), cA + kstep, voffA); PG8_STAGE(PG8_SB(1, 1), cB + hstep + kstep, voffB);
        PG8_WAIT_V(6); PG8_BAR;
    } else {
        PG8_STAGE(PG8_SB(0, 0), cB, voffB); PG8_STAGE(PG8_SA(0, 0), cA, voffA); PG8_STAGE(PG8_SB(0, 1), cB + hstep, voffB); PG8_STAGE(PG8_SA(0, 1), cA + hstep, voffA);
        if (wr == 1) PG8_BAR;
        PG8_WAIT_V(4); PG8_BAR;
        PG8_STAGE(PG8_SB(1, 0), cB + kstep, voffB); PG8_STAGE(PG8_SA(1, 0), cA + kstep, voffA); PG8_STAGE(PG8_SB(1, 1), cB + hstep + kstep, voffB);
        PG8_WAIT_V(6); PG8_BAR;
    }
    for (;;) {
        const bool has_next = S.next(ui + 1, nxt);
        const char* nA = has_next ? (const char*)g.A + (size_t)nxt.pm * tstep : cA; const char* nB = has_next ? (const char*)g.Bt + (size_t)nxt.pn * tstep : cB;
        for (int t = 0; t < nt; t += 2) {
            const bool last = (t == nt - 2);
            const char* a1 = cA + (size_t)(t + 1) * kstep;
            const char* a2 = last ? nA : cA + (size_t)(t + 2) * kstep; const char* b2 = last ? nB : cB + (size_t)(t + 2) * kstep;
            const char* a3 = a2 + kstep; const char* b3 = b2 + kstep;
            if (last && has_next) S.a_ready(nxt);
            if constexpr (SP2) {
            PG8_LDB(B0, 0, 0); PG8_LDB(B1, 0, 1); PG8_SCHED; PG8_LDA(At, 0, 0); PG8_STAGE(PG8_SA(1, 1), a1 + hstep, voffA);
            PG8_WAIT_V(8); PG8_WAIT_L(0); PG8_BAR; PG8_MMA(0, 0, At, B0); PG8_MMA(0, 1, At, B1); PG8_BAR; PG8_SCHED;
            PG8_LDA(At, 0, 1); PG8_STAGE(PG8_SB(0, 0), b2, voffB); PG8_STAGE(PG8_SB(0, 1), b2 + hstep, voffB); PG8_STAGE(PG8_SA(0, 0), a2, voffA);
            PG8_WAIT_V(8); PG8_WAIT_L(0); PG8_BAR; PG8_MMA(1, 0, At, B0); PG8_MMA(1, 1, At, B1); PG8_BAR; PG8_SCHED;
            PG8_LDB(B0, 1, 0); PG8_LDB(B1, 1, 1); PG8_SCHED; PG8_LDA(At, 1, 0); PG8_STAGE(PG8_SA(0, 1), a2 + hstep, voffA);
            PG8_WAIT_V(8); PG8_WAIT_L(0); PG8_BAR; PG8_MMA(0, 0, At, B0); PG8_MMA(0, 1, At, B1); PG8_BAR; PG8_SCHED;
            PG8_LDA(At, 1, 1); PG8_STAGE(PG8_SB(1, 0), b3, voffB); PG8_STAGE(PG8_SB(1, 1), b3 + hstep, voffB); PG8_STAGE(PG8_SA(1, 0), a3, voffA);
            PG8_WAIT_V(8); PG8_WAIT_L(0); PG8_BAR; PG8_MMA(1, 0, At, B0); PG8_MMA(1, 1, At, B1); PG8_BAR; PG8_SCHED;
            } else {
            PG8_LDB(B0, 0, 0); PG8_SCHED; PG8_LDA(At, 0, 0); PG8_STAGE(PG8_SA(1, 1), a1 + hstep, voffA);
            PG8_WAIT_L(8); PG8_BAR; PG8_WAIT_L(0); PG8_MMA(0, 0, At, B0); PG8_BAR; PG8_SCHED;
            PG8_LDB(B1, 0, 1); PG8_STAGE(PG8_SB(0, 0), b2, voffB);
            PG8_BAR; PG8_WAIT_L(0); PG8_MMA(0, 1, At, B1); PG8_BAR;
            PG8_LDA(At, 0, 1); PG8_STAGE(PG8_SA(0, 0), a2, voffA);
            PG8_BAR; PG8_WAIT_L(0); PG8_MMA(1, 0, At, B0); PG8_BAR; PG8_SCHED;
            PG8_STAGE(PG8_SB(0, 1), b2 + hstep, voffB);
            PG8_WAIT_V(6); PG8_BAR; PG8_MMA(1, 1, At, B1); PG8_BAR;
            PG8_LDB(B0, 1, 0); PG8_SCHED; PG8_LDA(At, 1, 0); PG8_STAGE(PG8_SA(0, 1), a2 + hstep, voffA);
            PG8_WAIT_L(8); PG8_BAR; PG8_WAIT_L(0); PG8_MMA(0, 0, At, B0); PG8_BAR; PG8_SCHED;
            PG8_LDB(B1, 1, 1); PG8_STAGE(PG8_SB(1, 0), b3, voffB);
            PG8_BAR; PG8_WAIT_L(0); PG8_MMA(0, 1, At, B1); PG8_BAR;
            PG8_LDA(At, 1, 1); PG8_STAGE(PG8_SA(1, 0), a3, voffA);
            PG8_BAR; PG8_WAIT_L(0); PG8_MMA(1, 0, At, B0); PG8_BAR; PG8_SCHED;
            PG8_STAGE(PG8_SB(1, 1), b3 + hstep, voffB);
            PG8_WAIT_V(6); PG8_BAR; PG8_MMA(1, 1, At, B1); PG8_BAR;
            }
        }
        if constexpr (ALIGN_EPI) { if (wr == 0) PG8_BAR; }
        if constexpr (!Epi::AFTER_DRAIN) { E(acc, cur, wr, wc, fr, fq); S.done(cur); }
        if (!has_next) break;
#pragma unroll
        for (int a = 0; a < 2; ++a)
#pragma unroll
            for (int b = 0; b < 2; ++b)
#pragma unroll
                for (int m = 0; m < 4; ++m)
#pragma unroll
                    for (int n = 0; n < 2; ++n) acc[a][b][m][n] = (f32x4){0.f, 0.f, 0.f, 0.f};
        cur = nxt; cA = nA; cB = nB; ++ui;
        if constexpr (ALIGN_EPI) { if (wr == 1) PG8_BAR; }
    }
    PG8_WAIT_V(0);
    if constexpr (!ALIGN_EPI) { if (wr == 0) PG8_BAR; }
    PG8_BAR;
    if constexpr (Epi::AFTER_DRAIN) { E.fused(acc, cur, wr, wc, fr, fq, lds, wid, lane); S.done(cur); }
#undef PG8_SA
#undef PG8_SB
#undef PG8_STAGE
#undef PG8_LDA
#undef PG8_LDB
#undef PG8_MMA
#undef PG8_WAIT_V
#undef PG8_WAIT_L
#undef PG8_BAR
#undef PG8_SCHED
}
}

constexpr int NWAVES = 8, NTHREADS = 512;
constexpr int LDS_BYTES = 163840;
constexpr int RING_OFF = 0, RING_BYTES = 131072;
constexpr int MISC_OFF = LDS_BYTES - 256;
constexpr int PH_PRO = 0, PH_PER_LAYER = 7, PH_FINAL = 1 + PH_PER_LAYER * DEPTH, NPH = PH_FINAL + 1;
constexpr int PL_WIN = 0, PL_MIX1 = 1, PL_FFT = 2, PL_FIN = 3, PL_WOUT = 4, PL_WUP = 5, PL_WDN = 6;
constexpr int CW_BAR = 4096, N_BAR_REG = 12;

#define GAS __attribute__((address_space(1)))
#define LAS __attribute__((address_space(3)))
typedef unsigned v4u __attribute__((ext_vector_type(4)));
typedef GAS unsigned gu32;
#define RLX_AGENT __ATOMIC_RELAXED, __HIP_MEMORY_SCOPE_AGENT
#define LDS_WAIT() asm volatile("s_waitcnt lgkmcnt(0)" ::: "memory")
#define VM_WAIT() asm volatile("s_waitcnt vmcnt(0)" ::: "memory")
__device__ __forceinline__ unsigned pk2(float lo, float hi) { return f2bf(lo) | (f2bf(hi) << 16); }

#define XB_TMO      128
#define XB_XCNT(j)  (256  + 64 * (j))
#define XB_XSUB(j)  (1280 + 64 * (j))
#define XB_XGEN(j)  (2304 + 64 * (j))
#define XB_TOP      3328
#define XB_TOPGEN   3392
#define XCD_BAR_WORDS 3456
#define XB_SPIN_CAP (1u << 18)

__device__ __forceinline__ unsigned xb_ld(unsigned* p)              { return __hip_atomic_load(p, __ATOMIC_RELAXED, __HIP_MEMORY_SCOPE_AGENT); }
__device__ __forceinline__ unsigned xb_add(unsigned* p, unsigned v) { return __hip_atomic_fetch_add(p, v, __ATOMIC_RELAXED, __HIP_MEMORY_SCOPE_AGENT); }
__device__ __forceinline__ unsigned xb_xcc_id() { return (unsigned)__builtin_amdgcn_s_getreg((3 << 11) | 20) & 0xFu; }
#define XB_SPIN(cond, bar) do { unsigned _sp = 0; while (cond) { __builtin_amdgcn_s_sleep(1); \
    if ((++_sp & 255u) == 0u) { if (xb_ld(&(bar)[XB_TMO])) break; if (_sp > XB_SPIN_CAP) { atomicAdd(&(bar)[XB_TMO], 1u); break; } } } } while (0)

struct XcdBarrier {
    unsigned* bar; unsigned x;
    volatile LAS unsigned* st;
};

__device__ __forceinline__ XcdBarrier xcd_barrier_post(unsigned* bar, volatile LAS unsigned* st) {
    XcdBarrier b; b.bar = bar; b.x = xb_xcc_id(); b.st = st;
    if (threadIdx.x == 0) (void)xb_add(&bar[XB_XCNT(b.x)], 1u);
    return b;
}
__device__ __forceinline__ void xcd_barrier_complete(unsigned* bar, unsigned x, unsigned& nloc, unsigned& nx) {
    const unsigned G = gridDim.x * gridDim.y * gridDim.z;
    unsigned sum, cnt, mine, sp = 0u;
    for (;;) {
        sum = 0u; cnt = 0u; mine = 0u;
#pragma unroll
        for (unsigned j = 0; j < 16; ++j) { const unsigned c = xb_ld(&bar[XB_XCNT(j)]); sum += c; cnt += (c > 0u) ? 1u : 0u; mine = (j == x) ? c : mine; }
        if (sum == G) break;
        __builtin_amdgcn_s_sleep(1);
        if ((++sp & 255u) == 0u) { if (xb_ld(&bar[XB_TMO])) break; if (sp > XB_SPIN_CAP) { atomicAdd(&bar[XB_TMO], 1u); break; } }
    }
    nloc = mine > 0u ? mine : 1u; nx = cnt > 0u ? cnt : 1u;
}

__device__ __forceinline__ void xcd_barrier(const XcdBarrier& b) {
    asm volatile("s_waitcnt vmcnt(0)" ::: "memory");
    __syncthreads();
    if (threadIdx.x == 0) {
        unsigned* bar = b.bar;
        __builtin_amdgcn_s_waitcnt(0);
        unsigned nloc = b.st[0], nx = b.st[1];
        if (nloc == 0u) { xcd_barrier_complete(bar, b.x, nloc, nx); b.st[0] = nloc; b.st[1] = nx; }
        const unsigned old = xb_add(&bar[XB_XSUB(b.x)], 1u);
        const unsigned gen = old / nloc;
        if (old + 1u == (gen + 1u) * nloc) {
            __builtin_amdgcn_fence(__ATOMIC_RELEASE, "agent");
            asm volatile("s_waitcnt vmcnt(0)" ::: "memory");
            const unsigned og = xb_add(&bar[XB_TOP], 1u);
            const unsigned tg = og / nx;
            if (og + 1u == (tg + 1u) * nx) xb_add(&bar[XB_TOPGEN], 1u);
            else XB_SPIN(xb_ld(&bar[XB_TOPGEN]) == tg, bar);
            __builtin_amdgcn_fence(__ATOMIC_ACQUIRE, "agent");
            xb_add(&bar[XB_XGEN(b.x)], 1u);
            asm volatile("s_waitcnt vmcnt(0)" ::: "memory");
        } else {
            XB_SPIN(xb_ld(&bar[XB_XGEN(b.x)]) == gen, bar);
            __builtin_amdgcn_fence(__ATOMIC_ACQUIRE, "agent");
            asm volatile("s_waitcnt vmcnt(0)" ::: "memory");
        }
    }
    __syncthreads();
}

constexpr size_t WS_SLAB = WS_YN;
constexpr size_t WS_ZT = WS_SCR, WS_X0T = WS_SCR + 8 * MiB, WS_YCT = WS_SCR + 16 * MiB;
constexpr size_t WS_TW = WS_ROPE + 256 * 1024;
namespace hy {
typedef float cf __attribute__((ext_vector_type(2)));
__device__ __forceinline__ cf cmul(cf a, cf b) { return {a.x * b.x - a.y * b.y, a.x * b.y + a.y * b.x}; }
__device__ __forceinline__ cf cmulc(cf a, cf b) { return {a.x * b.x + a.y * b.y, a.y * b.x - a.x * b.y}; }
__device__ __forceinline__ cf cadd(cf a, cf b) { return {a.x + b.x, a.y + b.y}; }
__device__ __forceinline__ cf csub(cf a, cf b) { return {a.x - b.x, a.y - b.y}; }
__device__ __forceinline__ int pidx(int i) { return i + (i >> 5); }
constexpr int FBUF = 8192 + 256;
template <bool INV> __device__ __forceinline__ cf tw16(cf d, int K) {
    float c, s;
    switch (K) {
        case 0: return d;
        case 4: return INV ? cf{-d.y, d.x} : cf{d.y, -d.x};
        case 1: c = 0.92387953251128674f; s = 0.38268343236508977f; break;
        case 2: c = 0.70710678118654752f; s = 0.70710678118654752f; break;
        case 3: c = 0.38268343236508977f; s = 0.92387953251128674f; break;
        case 5: c = -0.38268343236508977f; s = 0.92387953251128674f; break;
        case 6: c = -0.70710678118654752f; s = 0.70710678118654752f; break;
        default: c = -0.92387953251128674f; s = 0.38268343236508977f; break;
    }
    const cf w = {c, INV ? s : -s};
    return cmul(d, w);
}
template <int H, bool INV> __device__ __forceinline__ void stage16(cf (&v)[16]) {
#pragma unroll
    for (int blk = 0; blk < 16; blk += 2 * H)
#pragma unroll
        for (int j = 0; j < H; ++j) {
            if (!INV) { const cf a = v[blk + j], b = v[blk + j + H]; v[blk + j] = cadd(a, b); v[blk + j + H] = tw16<false>(csub(a, b), j * (8 / H)); }
            else { const cf A = v[blk + j], B = tw16<true>(v[blk + j + H], j * (8 / H)); v[blk + j] = cadd(A, B); v[blk + j + H] = csub(A, B); }
        }
}
template <bool INV> __device__ __forceinline__ void dft16(cf (&v)[16]) {
    if (!INV) { stage16<8, false>(v); stage16<4, false>(v); stage16<2, false>(v); stage16<1, false>(v); }
    else { stage16<1, true>(v); stage16<2, true>(v); stage16<4, true>(v); stage16<8, true>(v); }
}
__device__ __forceinline__ constexpr int br4(int r) { return ((r & 1) << 3) | ((r & 2) << 1) | ((r & 4) >> 1) | ((r & 8) >> 3); }
template <bool INV, int LSL> __device__ __forceinline__ void pass16(LAS cf* buf, int tid, const cf* __restrict__ TW) {
    constexpr int SH = LSL - 4, st = 1 << SH;
    asm volatile("" : "+v"(tid));
    const int sub = tid >> SH, n2 = tid & (st - 1), base = (sub << LSL) + n2;
    cf v[16];
#pragma unroll
    for (int r = 0; r < 16; ++r) v[r] = buf[pidx(base + r * st)];
    cf wp[16];
    wp[1] = TW[n2 << (13 - LSL)];
    asm volatile("" : "+v"(wp[1].x), "+v"(wp[1].y));
    wp[2] = cmul(wp[1], wp[1]); wp[4] = cmul(wp[2], wp[2]); wp[8] = cmul(wp[4], wp[4]);
    wp[3] = cmul(wp[2], wp[1]); wp[5] = cmul(wp[4], wp[1]); wp[6] = cmul(wp[4], wp[2]); wp[7] = cmul(wp[4], wp[3]);
    wp[9] = cmul(wp[8], wp[1]); wp[10] = cmul(wp[8], wp[2]); wp[11] = cmul(wp[8], wp[3]); wp[12] = cmul(wp[8], wp[4]);
    wp[13] = cmul(wp[8], wp[5]); wp[14] = cmul(wp[8], wp[6]); wp[15] = cmul(wp[8], wp[7]);
    if (!INV) {
        dft16<false>(v);
#pragma unroll
        for (int r = 1; r < 16; ++r) v[r] = cmul(v[r], wp[br4(r)]);
    } else {
#pragma unroll
        for (int r = 1; r < 16; ++r) v[r] = cmulc(v[r], wp[br4(r)]);
        dft16<true>(v);
    }
#pragma unroll
    for (int r = 0; r < 16; ++r) buf[pidx(base + r * st)] = v[r];
}
template <bool MUL> __device__ __forceinline__ void mid2(LAS cf* D, const LAS cf* Hs, int tid) {
    asm volatile("" : "+v"(tid));
#pragma unroll
    for (int e = 0; e < 8; ++e) { const int i = 16 * tid + 2 * e; const cf a = D[pidx(i)], b = D[pidx(i + 1)]; cf A = cadd(a, b), B = csub(a, b);
        if (MUL) { A = cmul(A, Hs[pidx(i)]); B = cmul(B, Hs[pidx(i + 1)]); D[pidx(i)] = cadd(A, B); D[pidx(i + 1)] = csub(A, B); }
        else { D[pidx(i)] = A; D[pidx(i + 1)] = B; } }
}
#define HY_SYNC() __syncthreads()
__device__ __forceinline__ void fft_unit(LAS unsigned char* lds, int c, int tid, const float* __restrict__ HFT_l, const cf* __restrict__ TW, const bf16_t* __restrict__ ZT, const bf16_t* __restrict__ X0T,
                                         bf16_t* __restrict__ YCT, float bias) {
    asm volatile("" : "+v"(tid));
    LAS cf* D = (LAS cf*)lds; LAS cf* Hs = D + FBUF;
    const float* hsrc = HFT_l + (size_t)c * 8192;
    float hv[16]; bf16_t za[8], zb[8], xa[8], xb[8], zna[8], znb[8];
#pragma unroll
    for (int k = 0; k < 16; ++k) hv[k] = hsrc[k * 512 + tid];
    {   const size_t o0 = (size_t)c * SL, o1 = ((size_t)DC + c) * SL;
#pragma unroll
        for (int k = 0; k < 8; ++k) { za[k] = ZT[o0 + k * 512 + tid]; zb[k] = ZT[o1 + k * 512 + tid]; } }
#pragma unroll
    for (int k = 0; k < 16; ++k) Hs[pidx(k * 512 + tid)] = cf{hv[k], 0.f};
    HY_SYNC();
    pass16<false, 13>(Hs, tid, TW); HY_SYNC();
    pass16<false, 9>(Hs, tid, TW); HY_SYNC();
    pass16<false, 5>(Hs, tid, TW); HY_SYNC();
    mid2<false>(Hs, Hs, tid); HY_SYNC();
#pragma unroll
    for (int pr = 0; pr < 2; ++pr) {
        const size_t o0 = ((size_t)(2 * pr) * DC + c) * SL, o1 = ((size_t)(2 * pr + 1) * DC + c) * SL;
#pragma unroll
        for (int k = 0; k < 8; ++k) { const int i = k * 512 + tid; D[pidx(i)] = cf{bf2f(za[k]), bf2f(zb[k])}; D[pidx(i + 4096)] = cf{0.f, 0.f}; }
#pragma unroll
        for (int k = 0; k < 8; ++k) { xa[k] = X0T[o0 + k * 512 + tid]; xb[k] = X0T[o1 + k * 512 + tid]; }
        if (pr == 0) { const size_t n0 = ((size_t)2 * DC + c) * SL, n1 = ((size_t)3 * DC + c) * SL;
#pragma unroll
            for (int k = 0; k < 8; ++k) { zna[k] = ZT[n0 + k * 512 + tid]; znb[k] = ZT[n1 + k * 512 + tid]; } }
        HY_SYNC();
        pass16<false, 13>(D, tid, TW); HY_SYNC();
        pass16<false, 9>(D, tid, TW); HY_SYNC();
        pass16<false, 5>(D, tid, TW); HY_SYNC();
        mid2<true>(D, Hs, tid); HY_SYNC();
        pass16<true, 5>(D, tid, TW); HY_SYNC();
        pass16<true, 9>(D, tid, TW); HY_SYNC();
        pass16<true, 13>(D, tid, TW); HY_SYNC();
#pragma unroll
        for (int k = 0; k < 8; ++k) { const int i = k * 512 + tid; const cf y = D[pidx(i)];
            YCT[o0 + i] = (bf16_t)f2bf((y.x * (1.f / 8192.f) + bf2f(za[k]) * bias) * bf2f(xa[k])); YCT[o1 + i] = (bf16_t)f2bf((y.y * (1.f / 8192.f) + bf2f(zb[k]) * bias) * bf2f(xb[k])); }
        if (pr == 0) {
#pragma unroll
            for (int k = 0; k < 8; ++k) { za[k] = zna[k]; zb[k] = znb[k]; } }
        HY_SYNC();
    }
}
__device__ __forceinline__ float at_blo(unsigned u) { return __builtin_bit_cast(float, u << 16); }
__device__ __forceinline__ float at_bhi(unsigned u) { return __builtin_bit_cast(float, u & 0xffff0000u); }
constexpr int HP_ROWB = 1540;
__device__ __forceinline__ void hyprep_unit(LAS unsigned char* lds, int unit, int tid, const bf16_t* __restrict__ P, const bf16_t* __restrict__ SLAB, const float* __restrict__ cw, const float* __restrict__ cb,
                                            bf16_t* __restrict__ ZT, bf16_t* __restrict__ X0T) {
    asm volatile("" : "+v"(tid));
    const int b = unit >> 6, t0 = (unit & 63) * 64; const size_t m0 = (size_t)b * SL + t0;
    LAS float* CWL = (LAS float*)(lds + 101648);
    __syncthreads();
#pragma unroll
    for (int hb = 0; hb < 2; ++hb) { uint4 sv[7];
#pragma unroll
        for (int q = 0; q < 7; ++q) { const int i = tid + (hb * 7 + q) * NTHREADS, r = i / 96, ch8 = i % 96, t = t0 - 1 + r; const bool inb = (i < 66 * 96) && t >= 0 && t < SL;
            sv[q] = *(const uint4*)(P + (inb ? ((m0 + r - 1) * DINP + P_CU + ch8 * 8) : (m0 * DINP + P_CU))); if (!inb) sv[q] = make_uint4(0u, 0u, 0u, 0u); }
#pragma unroll
        for (int q = 0; q < 7; ++q) { const int i = tid + (hb * 7 + q) * NTHREADS, r = i / 96, ch8 = i % 96;
            if (i < 66 * 96 && ch8 < 80) { LAS unsigned* d = (LAS unsigned*)(lds + r * HP_ROWB + ch8 * 16); d[0] = sv[q].x; d[1] = sv[q].y; d[2] = sv[q].z; d[3] = sv[q].w; } } }
    {
        uint4 sl[3][4];
#pragma unroll
        for (int q = 0; q < 3; ++q) { const int i = tid + q * NTHREADS, r = i >> 4, c8 = i & 15, t = t0 - 1 + r; const bool inb = (i < 66 * 16) && t >= 0 && t < SL;
            const size_t ro = inb ? ((m0 + r - 1) * 128 + c8 * 8) : (m0 * 128);
#pragma unroll
            for (int k = 0; k < 4; ++k) { sl[q][k] = *(const uint4*)(SLAB + (size_t)k * MT * 128 + ro); if (!inb) sl[q][k] = make_uint4(0u, 0u, 0u, 0u); } }
#pragma unroll
        for (int q = 0; q < 3; ++q) { const int i = tid + q * NTHREADS, r = i >> 4, c8 = i & 15;
            if (i < 66 * 16) { unsigned o[4];
                const unsigned a0[4] = {sl[q][0].x, sl[q][0].y, sl[q][0].z, sl[q][0].w}, a1[4] = {sl[q][1].x, sl[q][1].y, sl[q][1].z, sl[q][1].w}, a2[4] = {sl[q][2].x, sl[q][2].y, sl[q][2].z, sl[q][2].w}, a3[4] = {sl[q][3].x, sl[q][3].y, sl[q][3].z, sl[q][3].w};
#pragma unroll
                for (int d = 0; d < 4; ++d) o[d] = pk2((at_blo(a0[d]) + at_blo(a1[d])) + (at_blo(a2[d]) + at_blo(a3[d])), (at_bhi(a0[d]) + at_bhi(a1[d])) + (at_bhi(a2[d]) + at_bhi(a3[d])));
                LAS unsigned* dd = (LAS unsigned*)(lds + r * HP_ROWB + (80 + c8) * 16); dd[0] = o[0]; dd[1] = o[1]; dd[2] = o[2]; dd[3] = o[3]; } } }
    for (int i = tid; i < 4 * 768; i += NTHREADS) CWL[i] = (i < 3 * 768) ? cw[i] : cb[i - 3 * 768];
    __syncthreads();
    const int tok = tid & 63, wv = tid >> 6;
    for (int j = 0; j < 32; ++j) { const int c = wv * 32 + j; float u[3];
#pragma unroll
        for (int part = 0; part < 3; ++part) { const int ch = part * DC + c; float a = CWL[3 * 768 + ch];
#pragma unroll
            for (int k = 0; k < 3; ++k) a += CWL[k * 768 + ch] * bf2f(*(const LAS bf16_t*)(lds + (tok + k) * HP_ROWB + ch * 2));
            u[part] = a; }
        const size_t o = ((size_t)b * DC + c) * SL + t0 + tok;
        ZT[o] = (bf16_t)f2bf(u[2] * u[1]); X0T[o] = (bf16_t)f2bf(u[0]); }
    __syncthreads();
}
__device__ __forceinline__ void filter_unit(LAS unsigned char* lds, int tb, int tid, const float* __restrict__ w1, const float* __restrict__ b1, const float* __restrict__ freq,
                                            const float* __restrict__ w2, const float* __restrict__ b2, const float* __restrict__ w3, float* __restrict__ HFT_l) {
    asm volatile("" : "+v"(tid));
    LAS float* Z = (LAS float*)lds;
    LAS float* H1T = Z + 32 * 36;
    LAS float* H2T = H1T + 64 * 32;
    const int t0 = tb * 32;
    __syncthreads();
    {   const int pos = tid >> 4, f = tid & 15, t = t0 + pos;
        const float fb = (float)(1e-4 + (double)f * ((15.0 - 1e-4) / 15.0)), w = 6.283185307179586f * (float)t * (1.0f / (float)SL);
        float sn, cs; sincosf(fb * w, &sn, &cs);
        Z[pos * 36 + 1 + f] = cs; Z[pos * 36 + 17 + f] = -sn;
        if (f == 0) Z[pos * 36] = (float)((double)t / (double)(SL - 1)); }
    __syncthreads();
    {   const int j = tid & 63; const float fj = freq[j], bj = b1[j];
#pragma unroll
        for (int q = 0; q < 4; ++q) { const int pos = (tid >> 6) + 8 * q; float a = bj;
#pragma unroll 11
            for (int i = 0; i < HY_EMB; ++i) a += Z[pos * 36 + i] * w1[i * HY_W + j];
            H1T[j * 32 + pos] = sinf(fj * a); } }
    __syncthreads();
    {   const int j = tid & 63; const float fj = freq[j], bj = b2[j];
#pragma unroll
        for (int q = 0; q < 4; ++q) { const int pos = (tid >> 6) + 8 * q; float a = bj;
#pragma unroll 16
            for (int i = 0; i < HY_W; ++i) a += H1T[i * 32 + pos] * w2[i * HY_W + j];
            H2T[j * 32 + pos] = sinf(fj * a); } }
    __syncthreads();
    {   const int o = tid, c = o & 255, dir = o >> 8;
        float acc[32];
#pragma unroll
        for (int p = 0; p < 32; ++p) acc[p] = 0.f;
#pragma unroll 16
        for (int i = 0; i < HY_W; ++i) { const float w = w3[i * 2 * DC + o];
#pragma unroll
            for (int p4 = 0; p4 < 8; ++p4) { const f32x4 h = *(const LAS f32x4*)(H2T + i * 32 + p4 * 4);
                acc[4 * p4] += h[0] * w; acc[4 * p4 + 1] += h[1] * w; acc[4 * p4 + 2] += h[2] * w; acc[4 * p4 + 3] += h[3] * w; } }
        const double mind = log(1e-2) / 1.5, maxd = log(1e-2) / 0.3;
        const float delta = fabsf((float)(mind + (maxd - mind) * (double)c / 255.0));
#pragma unroll
        for (int p = 0; p < 32; ++p) { const int t = t0 + p; const float tt = (float)((double)t / (double)(SL - 1)); acc[p] *= __builtin_amdgcn_exp2f(-1.4426950408889634f * tt * delta); }
        float* row = HFT_l + (size_t)c * 8192;
        if (dir == 0) {
#pragma unroll
            for (int p4 = 0; p4 < 8; ++p4) *(f32x4*)(row + t0 + 4 * p4) = (f32x4){acc[4 * p4], acc[4 * p4 + 1], acc[4 * p4 + 2], acc[4 * p4 + 3]};
            if (t0 == 0) row[4096] = 0.f;
        } else {
#pragma unroll
            for (int p = 0; p < 32; ++p) if (t0 + p > 0) row[8192 - t0 - p] = acc[p];
        } }
}
}

constexpr size_t WS_AO = 222 * MiB;
namespace at {
typedef short v4i16_t __attribute__((ext_vector_type(4)));
constexpr int KROW = 144, NKEY = 400, V_OFF = NKEY * KROW;
__device__ __forceinline__ float blo(unsigned u) { return __builtin_bit_cast(float, u << 16); }
__device__ __forceinline__ float bhi(unsigned u) { return __builtin_bit_cast(float, u & 0xffff0000u); }
__device__ __forceinline__ void rope16(uint4& A, uint4& B, const float* __restrict__ cs, float scale) {
    const f32x4 c0 = *(const f32x4*)cs, c1 = *(const f32x4*)(cs + 4), s0 = *(const f32x4*)(cs + 8), s1 = *(const f32x4*)(cs + 12);
    const float c[8] = {c0[0], c0[1], c0[2], c0[3], c1[0], c1[1], c1[2], c1[3]}, s[8] = {s0[0], s0[1], s0[2], s0[3], s1[0], s1[1], s1[2], s1[3]};
    unsigned a[4] = {A.x, A.y, A.z, A.w}, b[4] = {B.x, B.y, B.z, B.w};
#pragma unroll
    for (int d = 0; d < 4; ++d) {
        const float t1l = blo(a[d]), t1h = bhi(a[d]), t2l = blo(b[d]), t2h = bhi(b[d]);
        const float o1l = (t1l * c[2 * d] - t2l * s[2 * d]) * scale, o1h = (t1h * c[2 * d + 1] - t2h * s[2 * d + 1]) * scale;
        const float o2l = (t2l * c[2 * d] + t1l * s[2 * d]) * scale, o2h = (t2h * c[2 * d + 1] + t1h * s[2 * d + 1]) * scale;
        a[d] = f2bf(o1l) | (f2bf(o1h) << 16); b[d] = f2bf(o2l) | (f2bf(o2h) << 16);
    }
    A = make_uint4(a[0], a[1], a[2], a[3]); B = make_uint4(b[0], b[1], b[2], b[3]);
}
__device__ __forceinline__ void rope16s(uint4& A, uint4& B, const float (&cs)[16], float scale) {
    unsigned a[4] = {A.x, A.y, A.z, A.w}, b[4] = {B.x, B.y, B.z, B.w};
#pragma unroll
    for (int d = 0; d < 4; ++d) {
        const float t1l = blo(a[d]), t1h = bhi(a[d]), t2l = blo(b[d]), t2h = bhi(b[d]);
        const float o1l = (t1l * cs[2 * d] - t2l * cs[8 + 2 * d]) * scale, o1h = (t1h * cs[2 * d + 1] - t2h * cs[8 + 2 * d + 1]) * scale;
        const float o2l = (t2l * cs[2 * d] + t1l * cs[8 + 2 * d]) * scale, o2h = (t2h * cs[2 * d + 1] + t1h * cs[8 + 2 * d + 1]) * scale;
        a[d] = f2bf(o1l) | (f2bf(o1h) << 16); b[d] = f2bf(o2l) | (f2bf(o2h) << 16);
    }
    A = make_uint4(a[0], a[1], a[2], a[3]); B = make_uint4(b[0], b[1], b[2], b[3]);
}
__device__ __forceinline__ unsigned scale2(unsigned u, float sc) { return f2bf(blo(u) * sc) | (f2bf(bhi(u) * sc) << 16); }
__device__ __forceinline__ void attn_unit(LAS unsigned char* lds, int unit, int tid, const bf16_t* __restrict__ P, const float* __restrict__ rope, const float* __restrict__ sink_l, bf16_t* __restrict__ AO) {
    asm volatile("" : "+v"(tid));
    const int b = unit >> 6, kvh = (unit >> 5) & 1, q0 = (unit & 31) * 128, W0 = q0 - 128;
    const size_t m0 = (size_t)b * SL;
    const int lane = tid & 63, wave = __builtin_amdgcn_readfirstlane(tid >> 6), i = lane & 15, g = lane >> 4;
    __syncthreads();
    {   uint4 va[6], vb[6];
#pragma unroll
        for (int q = 0; q < 6; ++q) { const int j = tid + q * NTHREADS; const bool isV = j >= 1200; const int jj = isV ? j - 1200 : j, kk = isV ? (jj >> 2) : (jj / 3), ch = isV ? (jj & 3) : (1 + jj % 3), pos = W0 + kk;
            const bool inb = (j < 2800) && pos >= 0 && pos < SL;
            const bf16_t* src = P + (inb ? ((m0 + pos) * DINP + (isV ? P_V : P_K) + kvh * HD + ch * 16) : (m0 * DINP + P_K));
            va[q] = *(const uint4*)src; vb[q] = *(const uint4*)(src + 8); if (!inb) { va[q] = make_uint4(0u, 0u, 0u, 0u); vb[q] = va[q]; } }
        uint4 ra = make_uint4(0u, 0u, 0u, 0u), rb = ra; f32x4 rc[4];
        {   const int pos = W0 + tid; const bool inb = (tid < NKEY) && pos >= 0 && pos < SL; const int pc = inb ? pos : 0;
            const bf16_t* src = P + (m0 + pc) * DINP + P_K + kvh * HD; ra = *(const uint4*)src; rb = *(const uint4*)(src + 8);
#pragma unroll
            for (int q = 0; q < 4; ++q) rc[q] = *(const f32x4*)(rope + pc * 16 + 4 * q);
            float cs[16];
#pragma unroll
            for (int q = 0; q < 16; ++q) cs[q] = rc[q >> 2][q & 3];
            rope16s(ra, rb, cs, 1.0f);
            if (!inb) { ra = make_uint4(0u, 0u, 0u, 0u); rb = ra; } }
#pragma unroll
        for (int q = 0; q < 6; ++q) { const int j = tid + q * NTHREADS; const bool isV = j >= 1200; const int jj = isV ? j - 1200 : j, kk = isV ? (jj >> 2) : (jj / 3), ch = isV ? (jj & 3) : (1 + jj % 3);
            if (j < 2800) { LAS unsigned char* dst = lds + (isV ? V_OFF : 0) + kk * KROW + ch * 32;
                *(LAS v4u*)dst = (v4u){va[q].x, va[q].y, va[q].z, va[q].w}; *(LAS v4u*)(dst + 16) = (v4u){vb[q].x, vb[q].y, vb[q].z, vb[q].w}; } }
        if (tid < NKEY) { LAS unsigned char* dst = lds + tid * KROW; *(LAS v4u*)dst = (v4u){ra.x, ra.y, ra.z, ra.w}; *(LAS v4u*)(dst + 16) = (v4u){rb.x, rb.y, rb.z, rb.w}; }
    }
    __syncthreads();
    const bool edge = (q0 == 0) || (q0 == SL - 128);
#pragma unroll 1
    for (int gi = 0; gi < 3; ++gi) {
        const int grp = wave * 3 + gi, hl = grp >> 3, qsub = grp & 7, head = kvh * 3 + hl;
        const int tok = q0 + 16 * qsub + i;
        bf16x8 qf[2];
        {   const bf16_t* qp = P + (m0 + tok) * DINP + P_Q + head * HD + g * 8;
            uint4 own = *(const uint4*)qp, hi2 = *(const uint4*)(qp + 32);
            uint4 oth; oth.x = __shfl_xor(own.x, 16); oth.y = __shfl_xor(own.y, 16); oth.z = __shfl_xor(own.z, 16); oth.w = __shfl_xor(own.w, 16);
            uint4 t1 = (g == 0) ? own : oth, t2 = (g == 0) ? oth : own;
            rope16(t1, t2, rope + tok * 16, 0.125f);
            uint4 r0;
            if (g == 0) r0 = t1; else if (g == 1) r0 = t2; else r0 = make_uint4(scale2(own.x, 0.125f), scale2(own.y, 0.125f), scale2(own.z, 0.125f), scale2(own.w, 0.125f));
            hi2 = make_uint4(scale2(hi2.x, 0.125f), scale2(hi2.y, 0.125f), scale2(hi2.z, 0.125f), scale2(hi2.w, 0.125f));
            qf[0] = __builtin_bit_cast(bf16x8, r0); qf[1] = __builtin_bit_cast(bf16x8, hi2); }
        f32x4 st[17];
        const LAS unsigned char* kb = lds + (16 * qsub + i) * KROW + g * 16;
#pragma unroll
        for (int tt = 0; tt < 17; ++tt) {
            const bf16x8 k0 = *(const LAS bf16x8*)(kb + tt * 16 * KROW), k1 = *(const LAS bf16x8*)(kb + tt * 16 * KROW + 64);
            f32x4 acc = __builtin_amdgcn_mfma_f32_16x16x32_bf16(k0, qf[0], (f32x4){0.f, 0.f, 0.f, 0.f}, 0, 0, 0);
            st[tt] = __builtin_amdgcn_mfma_f32_16x16x32_bf16(k1, qf[1], acc, 0, 0, 0);
        }
        const float NEGF = -1e30f;
#pragma unroll
        for (int r = 0; r < 4; ++r) { if (4 * g + r < i) st[0][r] = NEGF; if (4 * g + r > i) st[16][r] = NEGF; }
        if (edge) {
#pragma unroll
            for (int tt = 0; tt < 17; ++tt)
#pragma unroll
                for (int r = 0; r < 4; ++r) { const int pos = W0 + 16 * (qsub + tt) + 4 * g + r; if (pos < 0 || pos >= SL) st[tt][r] = NEGF; }
        }
        const float sk = sink_l[head];
        float mx = sk;
#pragma unroll
        for (int tt = 0; tt < 17; ++tt) mx = fmaxf(fmaxf(mx, fmaxf(st[tt][0], st[tt][1])), fmaxf(st[tt][2], st[tt][3]));
        mx = fmaxf(mx, __shfl_xor(mx, 16)); mx = fmaxf(mx, __shfl_xor(mx, 32));
        const float L2E = 1.4426950408889634f, mb = mx * L2E;
        float lsum = 0.f;
        bf16x8 pf[9];
#pragma unroll
        for (int s = 0; s < 9; ++s) {
            float p[8];
#pragma unroll
            for (int r = 0; r < 4; ++r) { p[r] = __builtin_amdgcn_exp2f(st[2 * s][r] * L2E - mb); p[4 + r] = (2 * s + 1 < 17) ? __builtin_amdgcn_exp2f(st[(2 * s + 1 < 17) ? 2 * s + 1 : 16][r] * L2E - mb) : 0.f; }
#pragma unroll
            for (int r = 0; r < 8; ++r) lsum += p[r];
            uint4 w; w.x = f2bf(p[0]) | (f2bf(p[1]) << 16); w.y = f2bf(p[2]) | (f2bf(p[3]) << 16); w.z = f2bf(p[4]) | (f2bf(p[5]) << 16); w.w = f2bf(p[6]) | (f2bf(p[7]) << 16);
            pf[s] = __builtin_bit_cast(bf16x8, w);
        }
        lsum += __shfl_xor(lsum, 16); lsum += __shfl_xor(lsum, 32);
        lsum += __builtin_amdgcn_exp2f(sk * L2E - mb);
        const float rl = 1.0f / lsum;
        const LAS unsigned char* vb = lds + V_OFF + (16 * qsub + 4 * g + (i >> 2)) * KROW + (i & 3) * 8;
        bf16_t* op = AO + (m0 + tok) * DBB + head * HD + 4 * g;
#pragma unroll
        for (int dt = 0; dt < 4; ++dt) {
            f32x4 o = (f32x4){0.f, 0.f, 0.f, 0.f};
#pragma unroll
            for (int s = 0; s < 9; ++s) {
                const v4i16_t lo = __builtin_amdgcn_ds_read_tr16_b64_v4i16((LAS v4i16_t*)(vb + (32 * s) * KROW + dt * 32));
                const v4i16_t hi = __builtin_amdgcn_ds_read_tr16_b64_v4i16((LAS v4i16_t*)(vb + (32 * s + 16) * KROW + dt * 32));
                const bf16x8 vf = (bf16x8){lo[0], lo[1], lo[2], lo[3], hi[0], hi[1], hi[2], hi[3]};
                o = __builtin_amdgcn_mfma_f32_16x16x32_bf16(vf, pf[s], o, 0, 0, 0);
            }
            uint2 w; w.x = f2bf(o[0] * rl) | (f2bf(o[1] * rl) << 16); w.y = f2bf(o[2] * rl) | (f2bf(o[3] * rl) << 16);
            *(uint2*)(op + dt * 16) = w;
        }
    }
}
}

constexpr size_t WS_AGG = 234 * MiB;
constexpr size_t WS_LS = WS_XG, WS_LPF = WS_XG + 12 * MiB, WS_LPB = 236 * MiB;
constexpr size_t WS_LW = WS_ROPE + 512 * 1024;
namespace lru {
constexpr int AXROW = 784, XCROW = 784, XC_OFF = 67 * AXROW, CARRY_OFF = XC_OFF + 64 * XCROW, SSQ_OFF = CARRY_OFF + 2 * DA * 4, RSTD_OFF = SSQ_OFF + 64 * 24 * 4;
__device__ __forceinline__ float fsig(float x) { return __builtin_amdgcn_rcpf(1.0f + __builtin_amdgcn_exp2f(-1.4426950408889634f * x)); }
__device__ __forceinline__ float fgelu(float x) { const float u = 0.7978845608028654f * (x + 0.044715f * x * x * x); const float e = __builtin_amdgcn_exp2f(2.8853900817779268f * u);
    const float th = 1.0f - 2.0f * __builtin_amdgcn_rcpf(1.0f + e); return 0.5f * x * (1.0f + th); }
template <int CTRL> __device__ __forceinline__ float dppf(float v) { return __builtin_bit_cast(float, __builtin_amdgcn_update_dpp(0, __builtin_bit_cast(int, v), CTRL, 0xf, 0xf, true)); }
__device__ __forceinline__ float row16_sum(float v) { v += dppf<0xB1>(v); v += dppf<0x4E>(v); v += dppf<0x141>(v); v += dppf<0x140>(v); return v; }
__device__ __forceinline__ void lru_unit(LAS unsigned char* lds, int unit, int tid, const bf16_t* __restrict__ P, const float* __restrict__ cw, const float* __restrict__ cb, const bf16_t* __restrict__ LW_l,
                                         const float* __restrict__ ba, const float* __restrict__ bx, const float* __restrict__ lam, float* __restrict__ AGG, bf16_t* __restrict__ LS, bf16_t* __restrict__ LPF, bf16_t* __restrict__ LPB) {
    asm volatile("" : "+v"(tid));
    const int b = unit >> 6, kc = unit & 63, t0 = kc * 64; const size_t m0 = (size_t)b * SL + t0;
    const int lane = tid & 63, wave = __builtin_amdgcn_readfirstlane(tid >> 6), li_ = lane & 15, g_ = lane >> 4;
    LAS unsigned char* AX = lds; LAS unsigned char* XC = lds + XC_OFF;
    __syncthreads();
    {   uint4 sv[7];
#pragma unroll
        for (int q = 0; q < 7; ++q) { const int it = tid + q * NTHREADS, r = it / 48, c8 = it % 48, t = t0 - 2 + r; const bool inb = (it < 67 * 48) && t >= 0 && t < SL;
            sv[q] = *(const uint4*)(P + (inb ? ((m0 + r - 2) * DINP + P_AX + c8 * 8) : (m0 * DINP + P_AX))); if (!inb) sv[q] = make_uint4(0u, 0u, 0u, 0u); }
#pragma unroll
        for (int q = 0; q < 7; ++q) { const int it = tid + q * NTHREADS, r = it / 48, c8 = it % 48;
            if (it < 67 * 48) *(LAS v4u*)(AX + r * AXROW + c8 * 16) = (v4u){sv[q].x, sv[q].y, sv[q].z, sv[q].w}; } }
    __syncthreads();
    if (tid < 384) { const int c8 = tid % 48, tg = tid / 48, ch0 = c8 * 8;
        float w[4][8], bb[8];
#pragma unroll
        for (int e = 0; e < 8; ++e) { bb[e] = cb[ch0 + e];
#pragma unroll
            for (int k = 0; k < 4; ++k) w[k][e] = cw[k * DA + ch0 + e]; }
        for (int q = 0; q < 8; ++q) { const int tok = tg * 8 + q; float acc[8];
#pragma unroll
            for (int e = 0; e < 8; ++e) acc[e] = bb[e];
#pragma unroll
            for (int k = 0; k < 4; ++k) { const v4u v = *(const LAS v4u*)(AX + (tok + k) * AXROW + c8 * 16);
#pragma unroll
                for (int d = 0; d < 4; ++d) { acc[2 * d] += w[k][2 * d] * at::blo(v[d]); acc[2 * d + 1] += w[k][2 * d + 1] * at::bhi(v[d]); } }
            *(LAS v4u*)(XC + tok * XCROW + c8 * 16) = (v4u){pk2(acc[0], acc[1]), pk2(acc[2], acc[3]), pk2(acc[4], acc[5]), pk2(acc[6], acc[7])}; }
    }
    __syncthreads();
#pragma unroll
    for (int rd = 0; rd < 3; ++rd) {
        asm volatile("" ::: "memory"); __builtin_amdgcn_sched_barrier(0);
        int li = li_, g = g_; asm volatile("" : "+v"(li), "+v"(g));
        const int h = 2 * rd + (wave >> 2), ct = wave & 3, ch = 64 * h + 16 * ct + li;
        f32x4 acc[4][4];
        {   bf16x8 af[4][2], bfr[4][2];
#pragma unroll
            for (int mt = 0; mt < 4; ++mt)
#pragma unroll
                for (int ks = 0; ks < 2; ++ks) af[mt][ks] = *(const LAS bf16x8*)(XC + (16 * mt + li) * XCROW + (64 * h + 32 * ks + 8 * g) * 2);
#pragma unroll
            for (int mat = 0; mat < 4; ++mat)
#pragma unroll
                for (int ks = 0; ks < 2; ++ks) bfr[mat][ks] = *(const bf16x8*)(LW_l + ((size_t)((h * 4 + mat) * 64 + 16 * ct + li)) * 64 + 32 * ks + 8 * g);
#pragma unroll
            for (int mat = 0; mat < 4; ++mat)
#pragma unroll
                for (int mt = 0; mt < 4; ++mt) { f32x4 c = __builtin_amdgcn_mfma_f32_16x16x32_bf16(af[mt][0], bfr[mat][0], (f32x4){0.f, 0.f, 0.f, 0.f}, 0, 0, 0);
                    acc[mat][mt] = __builtin_amdgcn_mfma_f32_16x16x32_bf16(af[mt][1], bfr[mat][1], c, 0, 0, 0); } }
        {   const float cw0 = cw[ch], cw1 = cw[DA + ch], cw2 = cw[2 * DA + ch], cw3 = cw[3 * DA + ch], cbv = cb[ch];
            float ban[2] = {ba[ch], ba[DA + ch]}, bxn[2] = {bx[ch], bx[DA + ch]}, spn[2];
#pragma unroll
            for (int n = 0; n < 2; ++n) { const float l = lam[n * DA + ch]; spn[n] = -8.0f * 1.4426950408889634f * ((-l > 20.f) ? -l : log1pf(expf(-l))); }
#pragma unroll
            for (int mt = 0; mt < 4; ++mt)
#pragma unroll
                for (int r = 0; r < 4; ++r) { const int tok = 16 * mt + 4 * g + r; const LAS unsigned char* ap = AX + tok * AXROW + ch * 2;
                    const float xcv = cbv + cw0 * bf2f(*(const LAS bf16_t*)ap) + cw1 * bf2f(*(const LAS bf16_t*)(ap + AXROW)) + cw2 * bf2f(*(const LAS bf16_t*)(ap + 2 * AXROW)) + cw3 * bf2f(*(const LAS bf16_t*)(ap + 3 * AXROW));
#pragma unroll
                    for (int n = 0; n < 2; ++n) { const float rg = fsig(acc[2 * n][mt][r] + ban[n]), ig = fsig(acc[2 * n + 1][mt][r] + bxn[n]);
                        const float av = __builtin_amdgcn_exp2f(rg * spn[n]);
                        acc[2 * n][mt][r] = av; acc[2 * n + 1][mt][r] = __builtin_amdgcn_sqrtf(1.0f - av * av) * (ig * xcv); } } }
        f32x4 hs[4];
        {   float Af[4], Bf[4], Ab[4], Bb[4];
#pragma unroll
            for (int mt = 0; mt < 4; ++mt) { const f32x4 a = acc[0][mt], bb = acc[1][mt], c = acc[2][mt], d = acc[3][mt];
                Af[mt] = (a[0] * a[1]) * (a[2] * a[3]); Bf[mt] = ((bb[0] * a[1] + bb[1]) * a[2] + bb[2]) * a[3] + bb[3];
                Ab[mt] = (c[0] * c[1]) * (c[2] * c[3]); Bb[mt] = ((d[3] * c[2] + d[2]) * c[1] + d[1]) * c[0] + d[0]; }
            {   float t0[4], t1[4], t2[4], t3[4];
#pragma unroll
                for (int mt = 0; mt < 4; ++mt) { t0[mt] = __shfl_up(Af[mt], 16); t1[mt] = __shfl_up(Bf[mt], 16); t2[mt] = __shfl_down(Ab[mt], 16); t3[mt] = __shfl_down(Bb[mt], 16); }
#pragma unroll
                for (int mt = 0; mt < 4; ++mt) { if (g >= 1) { Bf[mt] = t1[mt] * Af[mt] + Bf[mt]; Af[mt] = t0[mt] * Af[mt]; } if (g <= 2) { Bb[mt] = t3[mt] * Ab[mt] + Bb[mt]; Ab[mt] = t2[mt] * Ab[mt]; } }
#pragma unroll
                for (int mt = 0; mt < 4; ++mt) { t0[mt] = __shfl_up(Af[mt], 32); t1[mt] = __shfl_up(Bf[mt], 32); t2[mt] = __shfl_down(Ab[mt], 32); t3[mt] = __shfl_down(Bb[mt], 32); }
#pragma unroll
                for (int mt = 0; mt < 4; ++mt) { if (g >= 2) { Bf[mt] = t1[mt] * Af[mt] + Bf[mt]; Af[mt] = t0[mt] * Af[mt]; } if (g <= 1) { Bb[mt] = t3[mt] * Ab[mt] + Bb[mt]; Ab[mt] = t2[mt] * Ab[mt]; } } }
            float Aef[4], Bef[4], Aeb[4], Beb[4], Atf[4], Btf[4], Atb[4], Btb[4];
#pragma unroll
            for (int mt = 0; mt < 4; ++mt) { Aef[mt] = __shfl_up(Af[mt], 16); Bef[mt] = __shfl_up(Bf[mt], 16); Aeb[mt] = __shfl_down(Ab[mt], 16); Beb[mt] = __shfl_down(Bb[mt], 16);
                Atf[mt] = __shfl(Af[mt], li + 48); Btf[mt] = __shfl(Bf[mt], li + 48); Atb[mt] = __shfl(Ab[mt], li); Btb[mt] = __shfl(Bb[mt], li); }
#pragma unroll
            for (int mt = 0; mt < 4; ++mt) { if (g == 0) { Aef[mt] = 1.f; Bef[mt] = 0.f; } if (g == 3) { Aeb[mt] = 1.f; Beb[mt] = 0.f; } }
            f32x4 pf[4], pb[4];
            {   float hin = 0.f, atot = 1.f;
#pragma unroll
                for (int mt = 0; mt < 4; ++mt) { const f32x4 a = acc[0][mt], bb = acc[1][mt]; float hh = Aef[mt] * hin + Bef[mt], pp = Aef[mt] * atot;
#pragma unroll
                    for (int r = 0; r < 4; ++r) { hh = a[r] * hh + bb[r]; hs[mt][r] = hh; pp *= a[r]; pf[mt][r] = pp; }
                    hin = Atf[mt] * hin + Btf[mt]; atot *= Atf[mt]; }
                if (g == 0) { float* ag = AGG + ((size_t)(b * 64 + kc) * 4) * DA + ch; ag[0] = atot; ag[DA] = hin; } }
            {   float hin = 0.f, atot = 1.f;
#pragma unroll
                for (int mt = 3; mt >= 0; --mt) { const f32x4 a = acc[2][mt], bb = acc[3][mt]; float hh = Aeb[mt] * hin + Beb[mt], pp = Aeb[mt] * atot;
#pragma unroll
                    for (int r = 3; r >= 0; --r) { hh = a[r] * hh + bb[r]; hs[mt][r] += hh; pp *= a[r]; pb[mt][r] = pp; }
                    hin = Atb[mt] * hin + Btb[mt]; atot *= Atb[mt]; }
                if (g == 0) { float* ag = AGG + ((size_t)(b * 64 + kc) * 4) * DA + ch; ag[2 * DA] = atot; ag[3 * DA] = hin; } }
#pragma unroll
            for (int mt = 0; mt < 4; ++mt)
#pragma unroll
                for (int r = 0; r < 4; ++r) { const size_t o = (m0 + 16 * mt + 4 * g + r) * DA + ch;
                    LS[o] = (bf16_t)f2bf(hs[mt][r]); LPF[o] = (bf16_t)f2bf(pf[mt][r]); LPB[o] = (bf16_t)f2bf(pb[mt][r]); } }
    }
}
constexpr size_t WS_CIN = 248 * MiB;
__device__ __forceinline__ void carry_scan_seq(int seq, int lane, const float* __restrict__ AGG, float* __restrict__ CIN) {
    const int ch = seq % DA, dir = (seq / DA) & 1, b = seq / (2 * DA);
    const float* ag = AGG + ((size_t)(b * 64 + lane) * 4 + 2 * dir) * DA + ch;
    float A = ag[0], B = ag[DA];
    if (dir == 0) {
#pragma unroll
        for (int d = 1; d < 64; d <<= 1) { const float A1 = __shfl_up(A, d), B1 = __shfl_up(B, d); if (lane >= d) { B = B1 * A + B; A = A1 * A; } }
        float c = __shfl_up(B, 1); if (lane == 0) c = 0.f;
        CIN[((size_t)(b * 64 + lane) * 2 + 0) * DA + ch] = c;
    } else {
#pragma unroll
        for (int d = 1; d < 64; d <<= 1) { const float A1 = __shfl_down(A, d), B1 = __shfl_down(B, d); if (lane + d < 64) { B = B1 * A + B; A = A1 * A; } }
        float c = __shfl_down(B, 1); if (lane == 63) c = 0.f;
        CIN[((size_t)(b * 64 + lane) * 2 + 1) * DA + ch] = c;
    }
}
__device__ __forceinline__ void lru_fin_unit(LAS unsigned char* lds, int unit, int tid, const bf16_t* __restrict__ P, const float* __restrict__ AGG, const bf16_t* __restrict__ LS, const bf16_t* __restrict__ LPF,
                                             const bf16_t* __restrict__ LPB, const float* __restrict__ gn, bf16_t* __restrict__ YN) {
    asm volatile("" : "+v"(tid));
    const int b = unit >> 6, kc = unit & 63, t0 = kc * 64; const size_t m0 = (size_t)b * SL + t0;
    const int lane = tid & 63, wave = __builtin_amdgcn_readfirstlane(tid >> 6);
    float cf[6], cbk[6], gv[6];
#pragma unroll
    for (int j = 0; j < 3; ++j) { const int c0 = 2 * (lane + 64 * j); const float* ci = AGG + ((size_t)(b * 64 + kc) * 2) * DA + c0;
        cf[2 * j] = ci[0]; cf[2 * j + 1] = ci[1]; cbk[2 * j] = ci[DA]; cbk[2 * j + 1] = ci[DA + 1]; gv[2 * j] = gn[c0]; gv[2 * j + 1] = gn[c0 + 1]; }
#pragma unroll 2
    for (int q = 0; q < 8; ++q) { const int tok = wave * 8 + q; const size_t ro = (m0 + tok) * DA;
        const unsigned* sS = (const unsigned*)(LS + ro); const unsigned* sF = (const unsigned*)(LPF + ro); const unsigned* sB = (const unsigned*)(LPB + ro); const unsigned* sG = (const unsigned*)(P + (m0 + tok) * DINP + P_AG);
        unsigned wS[3], wF[3], wB[3], wG[3];
#pragma unroll
        for (int j = 0; j < 3; ++j) { wS[j] = sS[lane + 64 * j]; wF[j] = sF[lane + 64 * j]; wB[j] = sB[lane + 64 * j]; wG[j] = sG[lane + 64 * j]; }
        float y[6]; float ss = 0.f;
#pragma unroll
        for (int j = 0; j < 3; ++j) {
            y[2 * j] = (at::blo(wS[j]) + at::blo(wF[j]) * cf[2 * j] + at::blo(wB[j]) * cbk[2 * j]) * fgelu(at::blo(wG[j]));
            y[2 * j + 1] = (at::bhi(wS[j]) + at::bhi(wF[j]) * cf[2 * j + 1] + at::bhi(wB[j]) * cbk[2 * j + 1]) * fgelu(at::bhi(wG[j]));
            ss += y[2 * j] * y[2 * j] + y[2 * j + 1] * y[2 * j + 1]; }
#pragma unroll
        for (int o = 1; o < 64; o <<= 1) ss += __shfl_xor(ss, o);
        const float r = 1.0f / sqrtf(ss * (1.0f / DA) + EPS);
        unsigned* dst = (unsigned*)(YN + (m0 + tok) * DM);
#pragma unroll
        for (int j = 0; j < 3; ++j) dst[lane + 64 * j] = pk2(y[2 * j] * r * gv[2 * j], y[2 * j + 1] * r * gv[2 * j + 1]); }
}
}

namespace fin {
constexpr int TROW = 528;
__device__ __forceinline__ float wsum(float v) {
#pragma unroll
    for (int o = 1; o < 64; o <<= 1) v += __shfl_xor(v, o);
    return v;
}
__device__ __forceinline__ void norm_bc_unit(LAS unsigned char* lds, int unit, int tid, const bf16_t* __restrict__ AO, const bf16_t* __restrict__ YCT, const float* __restrict__ gnb, const float* __restrict__ gnc, bf16_t* __restrict__ YN) {
    asm volatile("" : "+v"(tid));
    const int b = unit >> 6, t0 = (unit & 63) * 64; const size_t m0 = (size_t)b * SL + t0;
    const int lane = tid & 63, wave = __builtin_amdgcn_readfirstlane(tid >> 6);
    __syncthreads();
    {   const int c = tid >> 1, hf = tid & 1; const bf16_t* src = YCT + ((size_t)b * DC + c) * SL + t0 + hf * 32;
#pragma unroll
        for (int q = 0; q < 4; ++q) { const uint4 v = *(const uint4*)(src + q * 8); const unsigned w[4] = {v.x, v.y, v.z, v.w};
#pragma unroll
            for (int d = 0; d < 4; ++d) { const int tok = hf * 32 + q * 8 + 2 * d;
                *(LAS bf16_t*)(lds + tok * TROW + c * 2) = (bf16_t)(w[d] & 0xffffu); *(LAS bf16_t*)(lds + (tok + 1) * TROW + c * 2) = (bf16_t)(w[d] >> 16); } } }
    for (int q = 0; q < 8; ++q) { const int tok = wave * 8 + q; const unsigned* src = (const unsigned*)(AO + (m0 + tok) * DBB);
        float v[6]; float s = 0.f;
#pragma unroll
        for (int j = 0; j < 3; ++j) { const unsigned w = src[lane + 64 * j]; v[2 * j] = at::blo(w); v[2 * j + 1] = at::bhi(w); s += v[2 * j] * v[2 * j] + v[2 * j + 1] * v[2 * j + 1]; }
        const float r = 1.0f / sqrtf(wsum(s) * (1.0f / DBB) + EPS);
        unsigned* dst = (unsigned*)(YN + (m0 + tok) * DM + DA);
#pragma unroll
        for (int j = 0; j < 3; ++j) { const int c0 = 2 * (lane + 64 * j); dst[lane + 64 * j] = pk2(v[2 * j] * r * gnb[c0], v[2 * j + 1] * r * gnb[c0 + 1]); } }
    __syncthreads();
    for (int q = 0; q < 8; ++q) { const int tok = wave * 8 + q; typedef unsigned u32x2v __attribute__((ext_vector_type(2))); const u32x2v w = *(const LAS u32x2v*)(lds + tok * TROW + lane * 8);
        const float v0 = at::blo(w.x), v1 = at::bhi(w.x), v2 = at::blo(w.y), v3 = at::bhi(w.y);
        const float r = 1.0f / sqrtf(wsum(v0 * v0 + v1 * v1 + v2 * v2 + v3 * v3) * (1.0f / DC) + EPS);
        const f32x4 gg = *(const f32x4*)(gnc + lane * 4);
        uint2 o; o.x = pk2(v0 * r * gg[0], v1 * r * gg[1]); o.y = pk2(v2 * r * gg[2], v3 * r * gg[3]);
        *(uint2*)(YN + (m0 + tok) * DM + DA + DBB + lane * 4) = o; }
}
}

__device__ __forceinline__ int fresh_tid() { int t = threadIdx.x; asm volatile("" : "+v"(t)); return t; }
#define FTID fresh_tid()
#define FLANE (fresh_tid() & 63)
struct Frame {
    LAS unsigned char* lds;
    volatile LAS unsigned* MISC;
    int wave, vcu, G;
};
__device__ __forceinline__ void p0_transpose_item(const float* W, int K, int N, bf16_t* WT, LAS float* scr, int item, int lane) {
    const int nblk = N / 32, kb = item / nblk, nb = item % nblk, k0 = 64 * kb, n0 = 32 * nb;
    float tv[32];
#pragma unroll
    for (int i = 0; i < 32; ++i) { const int kk = 2 * i + (lane >> 5); tv[i] = W[(size_t)(k0 + kk) * N + n0 + (lane & 31)]; }
#pragma unroll
    for (int i = 0; i < 32; ++i) { const int kk = 2 * i + (lane >> 5); scr[kk * 33 + (lane & 31)] = tv[i]; }
    LDS_WAIT(); asm volatile("" ::: "memory");
    const int c = lane & 7;
#pragma unroll
    for (int j = 0; j < 4; ++j) { const int n = (lane >> 3) + 8 * j; const LAS float* s = scr + (8 * c) * 33 + n;
        v4u o; o.x = pk2(s[0 * 33], s[1 * 33]); o.y = pk2(s[2 * 33], s[3 * 33]); o.z = pk2(s[4 * 33], s[5 * 33]); o.w = pk2(s[6 * 33], s[7 * 33]);
        *(GAS v4u*)(WT + (size_t)(n0 + n) * K + k0 + 8 * c) = o; }
    LDS_WAIT(); asm volatile("" ::: "memory");
}
__device__ __forceinline__ void xg_row(const float* xrow, const float* g, bf16_t* orow, float* ssrow, int lane) {
    const GAS f32x4* xr = (const GAS f32x4*)xrow + lane; const GAS f32x4* gr = (const GAS f32x4*)g + lane;
    f32x4 v[4]; float s = 0.f;
#pragma unroll
    for (int j = 0; j < 4; ++j) { v[j] = xr[64 * j]; s += (v[j][0] * v[j][0] + v[j][1] * v[j][1]) + (v[j][2] * v[j][2] + v[j][3] * v[j][3]); }
    s += __shfl_xor(s, 1); s += __shfl_xor(s, 2);
    if ((lane & 3) == 0) ssrow[lane >> 2] = s;
    GAS unsigned long long* o8 = (GAS unsigned long long*)orow + lane;
#pragma unroll
    for (int j = 0; j < 4; ++j) { const f32x4 gg = gr[64 * j]; o8[64 * j] = (unsigned long long)pk2(v[j][0] * gg[0], v[j][1] * gg[1]) | ((unsigned long long)pk2(v[j][2] * gg[2], v[j][3] * gg[3]) << 32); }
}
__device__ __forceinline__ void xg_rows4(const float* x, const float* g, bf16_t* XGp, float* SSp, int m, int stride, int lane) {
    f32x4 v[4][4];
#pragma unroll
    for (int q = 0; q < 4; ++q) { const int row = m + q * stride; const int rc = row < MT ? row : m; const GAS f32x4* xr = (const GAS f32x4*)(x + (size_t)rc * DM) + lane;
#pragma unroll
        for (int j = 0; j < 4; ++j) v[q][j] = xr[64 * j]; }
    const GAS f32x4* gr = (const GAS f32x4*)g + lane; f32x4 gg[4];
#pragma unroll
    for (int j = 0; j < 4; ++j) gg[j] = gr[64 * j];
#pragma unroll
    for (int q = 0; q < 4; ++q) { const int row = m + q * stride; if (row < MT) { float s = 0.f;
#pragma unroll
        for (int j = 0; j < 4; ++j) s += (v[q][j][0] * v[q][j][0] + v[q][j][1] * v[q][j][1]) + (v[q][j][2] * v[q][j][2] + v[q][j][3] * v[q][j][3]);
        s += __shfl_xor(s, 1); s += __shfl_xor(s, 2);
        if ((lane & 3) == 0) SSp[(size_t)row * 16 + (lane >> 2)] = s;
        GAS unsigned long long* o8 = (GAS unsigned long long*)(XGp + (size_t)row * DM) + lane;
#pragma unroll
        for (int j = 0; j < 4; ++j) o8[64 * j] = (unsigned long long)pk2(v[q][j][0] * gg[j][0], v[q][j][1] * gg[j][1]) | ((unsigned long long)pk2(v[q][j][2] * gg[j][2], v[q][j][3] * gg[j][3]) << 32); } }
}
__device__ __forceinline__ void final_row(const float* xrow, const float* g, const float* SS, int row, float* orow, int lane) {
    const GAS f32x4* xr = (const GAS f32x4*)xrow + lane; const GAS f32x4* gr = (const GAS f32x4*)g + lane; GAS f32x4* o = (GAS f32x4*)orow + lane;
    const float r = pg8::rstd16(SS, row);
#pragma unroll
    for (int j = 0; j < 4; ++j) { const f32x4 v = xr[64 * j], gg = gr[64 * j]; o[64 * j] = v * gg * r; }
}

template <int I> __device__ __forceinline__ const float* in_ptr() {
    unsigned long long v;
    asm volatile("s_load_dwordx2 %0, %1, %2\n\ts_waitcnt lgkmcnt(0)" : "=s"(v) : "s"(__builtin_amdgcn_kernarg_segment_ptr()), "n"(I * 8) : "memory");
    return (const float*)v;
}
#define INP(i) in_ptr<i>()
__device__ __forceinline__ void final_rows4(float* X, const float* g, const float* SS, int m, int stride, int lane) {
    f32x4 v[4][4]; float r[4];
#pragma unroll
    for (int q = 0; q < 4; ++q) { const int row = m + q * stride; const int rc = row < MT ? row : m; const GAS f32x4* xr = (const GAS f32x4*)(X + (size_t)rc * DM) + lane;
#pragma unroll
        for (int j = 0; j < 4; ++j) v[q][j] = xr[64 * j];
        r[q] = pg8::rstd16(SS, rc); }
    const GAS f32x4* gr = (const GAS f32x4*)g + lane; f32x4 gg[4];
#pragma unroll
    for (int j = 0; j < 4; ++j) gg[j] = gr[64 * j];
#pragma unroll
    for (int q = 0; q < 4; ++q) { const int row = m + q * stride; if (row < MT) { GAS f32x4* o = (GAS f32x4*)(X + (size_t)row * DM) + lane;
#pragma unroll
        for (int j = 0; j < 4; ++j) o[64 * j] = v[q][j] * gg[j] * r[q]; } }
}
struct Args { const float* in[28]; float* out; unsigned char* ws; int ph_lo, ph_hi, li, pad; };

#define ws ((unsigned char*)in_ptr<29>())
#define XR ((float*)in_ptr<28>())
#define XRB ((bf16_t*)in_ptr<28>())
#define Win_t ((bf16_t*)(ws + WS_WIN))
#define Wout_t ((bf16_t*)(ws + WS_WOUT))
#define Wup_t ((bf16_t*)(ws + WS_WUP))
#define Wdn_t ((bf16_t*)(ws + WS_WDN))
#define XG ((bf16_t*)(ws + WS_XG))
#define P ((bf16_t*)(ws + WS_P))
#define YN ((bf16_t*)(ws + WS_YN))
#define HB ((bf16_t*)(ws + WS_H))
#define SS ((float*)(ws + WS_SS))
__global__ void __launch_bounds__(NTHREADS, 2) mega(Args args) {
    extern __shared__ __attribute__((aligned(16))) unsigned char lds[];
    Frame F;
    F.lds = (LAS unsigned char*)lds; F.MISC = (volatile LAS unsigned*)(F.lds + MISC_OFF);
    F.wave = __builtin_amdgcn_readfirstlane((int)threadIdx.x >> 6);
    F.G = gridDim.x; { const int bx = blockIdx.x; F.vcu = (F.G % 8 == 0) ? (bx % 8) * (F.G / 8) + bx / 8 : bx; }
    gu32* ctl = (gu32*)(ws + WS_CTL);
    for (int u = threadIdx.x; u < (LDS_BYTES - MISC_OFF) / 4; u += NTHREADS) ((LAS unsigned*)(F.lds + MISC_OFF))[u] = 0u;
    __syncthreads();
    const int lo = args.ph_lo, hi = args.ph_hi;
    XcdBarrier bar; bar.bar = (unsigned*)(ctl + CW_BAR) + args.li * XCD_BAR_WORDS; bar.x = 0; bar.st = nullptr;
    if (hi - lo > 1) bar = xcd_barrier_post((unsigned*)(ctl + CW_BAR) + args.li * XCD_BAR_WORDS, F.MISC + 8);

    const int gw = F.vcu * NWAVES + F.wave, NGW = F.G * NWAVES;

#define IN(k) (lo <= (k) && (k) < hi)
#ifdef TPROBE
#define TSTAMP(i) do { if (blockIdx.x == 0 && threadIdx.x == 0) ((unsigned long long*)(ws + WS_CTL + 512 * 1024))[i] = __builtin_amdgcn_s_memrealtime(); } while (0)
#else
#define TSTAMP(i)
#endif
#define SEAM(k) do { if (IN(k) && IN((k) + 1)) { xcd_barrier(bar); DUP_BAR(xcd_barrier(bar);) TSTAMP((k) + 1); } } while (0)
    TSTAMP(0);
#ifndef DUP_PRO
#define DUP_PRO(...)
#endif
    if (IN(PH_PRO)) {
        auto jobT = [&]() __attribute__((always_inline)) {
        LAS float* scr = (LAS float*)(F.lds + RING_OFF + F.wave * 16384);
        constexpr int I_IN = (DM / 64) * (DIN / 32), I_OUT = (DM / 64) * (DM / 32), I_UP = (DM / 64) * (DFF / 32), I_DN = (DFF / 64) * (DM / 32), I_L = I_IN + I_OUT + I_UP + I_DN;
        for (int it = gw; it < DEPTH * I_L; it += NGW) {
            const int l = it / I_L; int r = it % I_L;
            if (r < I_IN) { p0_transpose_item(INP(2) + (size_t)l * DM * DIN, DM, DIN, Win_t + (size_t)l * DINP * DM, scr, r, FLANE); continue; } r -= I_IN;
            if (r < I_OUT) { p0_transpose_item(INP(23) + (size_t)l * DM * DM, DM, DM, Wout_t + (size_t)l * DM * DM, scr, r, FLANE); continue; } r -= I_OUT;
            if (r < I_UP) { p0_transpose_item(INP(25) + (size_t)l * DM * DFF, DM, DFF, Wup_t + (size_t)l * DFF * DM, scr, r, FLANE); continue; } r -= I_UP;
            p0_transpose_item(INP(26) + (size_t)l * DFF * DM, DFF, DM, Wdn_t + (size_t)l * DM * DFF, scr, r, FLANE);
        }
        for (int i = blockIdx.x * NTHREADS + FTID; i < DEPTH * 16384; i += F.G * NTHREADS) { const int l = i >> 14, r = i & 16383;
            *(GAS v4u*)((GAS unsigned char*)(Win_t + (size_t)l * DINP * DM + (size_t)DIN * DM) + (size_t)r * 16) = (v4u){0u, 0u, 0u, 0u}; }
        {
            float* TWf = (float*)(ws + WS_TW); float* rope = (float*)(ws + WS_ROPE);
            for (int i = blockIdx.x * NTHREADS + FTID; i < 8192; i += F.G * NTHREADS) { const double a = 6.283185307179586476925286766559 * (double)i / 8192.0; TWf[2 * i] = (float)cos(a); TWf[2 * i + 1] = (float)(-sin(a)); }
            for (int i = blockIdx.x * NTHREADS + FTID; i < SL * 8; i += F.G * NTHREADS) { const int pos = i >> 3, j = i & 7; const double ang = (double)pos * pow(500000.0, -(double)j / 8.0);
                rope[pos * 16 + j] = (float)cos(ang); rope[pos * 16 + 8 + j] = (float)sin(ang); }
        }
        {
            bf16_t* LW = (bf16_t*)(ws + WS_LW); const float* wa = INP(5); const float* wx = INP(7);
            for (int o = blockIdx.x * NTHREADS + FTID; o < DEPTH * LRU_BLK * 4 * 64 * 64; o += F.G * NTHREADS) {
                const int i = o & 63, j = (o >> 6) & 63, mat = (o >> 12) & 3, lh = o >> 14, h = lh % LRU_BLK, l = lh / LRU_BLK, n = mat >> 1;
                const float* src = (mat & 1) ? wx : wa;
                LW[o] = (bf16_t)f2bf(src[((((size_t)l * 2 + n) * LRU_BLK + h) * 64 + i) * 64 + j]); }
        }
        };
        auto jobF = [&]() __attribute__((always_inline)) {
        {
            const float* w1 = INP(13); const float* b1 = INP(14); const float* fq = INP(15); const float* w2 = INP(16); const float* b2 = INP(17); const float* w3 = INP(18);
            for (int u = F.vcu; u < DEPTH * 128; u += F.G) { const int l = u >> 7;
                hy::filter_unit(F.lds, u & 127, FTID, w1 + (size_t)l * HY_EMB * HY_W, b1 + l * HY_W, fq + l * HY_W, w2 + (size_t)l * HY_W * HY_W, b2 + l * HY_W, w3 + (size_t)l * HY_W * 2 * DC,
                                (float*)(ws + WS_HF) + (size_t)l * DC * 8192); }
            __syncthreads();
        }
        };
        auto jobX = [&]() __attribute__((always_inline)) {
        { const float* x0 = INP(0); const float* g0 = INP(1);
          for (int m = gw; m < MT; m += 4 * NGW) xg_rows4(x0, g0, XG, SS, m, NGW, FLANE); }
        };
        if (blockIdx.x & 1) { jobF(); jobT(); jobX(); } else { jobT(); jobX(); jobF(); }
    }
    SEAM(PH_PRO);
#ifndef DUP_MIX1
#define DUP_MIX1(...)
#endif
#ifndef DUP_FFT
#define DUP_FFT(...)
#endif
#ifndef DUP_FIN
#define DUP_FIN(...)
#endif
#ifndef DUP_WIN
#define DUP_WIN(...)
#endif
#ifndef DUP_WUP
#define DUP_WUP(...)
#endif
#ifndef DUP_HYP
#define DUP_HYP(...)
#endif
#ifndef DUP_AGG
#define DUP_AGG(...)
#endif
#ifndef DUP_ATT
#define DUP_ATT(...)
#endif
#ifndef DUP_WOUT
#define DUP_WOUT(...)
#endif
#ifndef DUP_LRUFIN
#define DUP_LRUFIN(...)
#endif
#ifndef DUP_NBC
#define DUP_NBC(...)
#endif
#ifndef DUP_BAR
#define DUP_BAR(...)
#endif
#ifndef DUP_WDN
#define DUP_WDN(...)
#endif
#define WIN_BODY(l) { \
        pg8::Gemm g{XG, Win_t + (size_t)(l) * DINP * DM, MT, 2048, DM, DM}; pg8::StaticOrder S; S.init(MT, 2048, F.G, (int)blockIdx.x); \
        pg8::EpiScaleBf16<0> E{P, DINP, SS}; \
        pg8::gemm_phase<pg8::EpiScaleBf16<0>, pg8::StaticOrder, true, true>(F.lds + RING_OFF, g, S, E); \
          \
        { const int c = (int)blockIdx.x, q = c & 3; \
          pg8::Gemm g2{XG + q * 256, Win_t + (size_t)(l) * DINP * DM + (size_t)2048 * DM + q * 256, MT, 256, 256, DM}; \
          pg8::QuarterOrder S2{c >> 2, F.G}; pg8::EpiSlab E2{(bf16_t*)(ws + WS_SLAB) + (size_t)q * MT * 128, SS}; \
          pg8::gemm_phase<pg8::EpiSlab, pg8::QuarterOrder, false, true>(F.lds + RING_OFF, g2, S2, E2); } }
#define MIX1_HYP(l) { const float* cw = INP(11) + (l) * 9 * DC; const float* cb = INP(12) + (l) * 3 * DC; \
        for (int u = F.vcu; u < 256; u += F.G) hy::hyprep_unit(F.lds, u, FTID, P, (const bf16_t*)(ws + WS_SLAB), cw, cb, (bf16_t*)(ws + WS_ZT), (bf16_t*)(ws + WS_X0T)); }
#define MIX1_LRU(l) { const float* cwa = INP(3) + (l) * 4 * DA; const float* cba = INP(4) + (l) * DA; const float* ba = INP(6) + (l) * 2 * DA; const float* bx = INP(8) + (l) * 2 * DA; const float* lam = INP(9) + (l) * 2 * DA; \
          for (int u = F.vcu; u < 256; u += F.G) lru::lru_unit(F.lds, u, FTID, P, cwa, cba, (const bf16_t*)(ws + WS_LW) + (size_t)(l) * LRU_BLK * 4 * 4096, ba, bx, lam, (float*)(ws + WS_AGG), (bf16_t*)(ws + WS_LS), (bf16_t*)(ws + WS_LPF), (bf16_t*)(ws + WS_LPB)); }
#define MIX1_ATT(l) { const float* sk = INP(10) + (l) * NQH; \
          for (int u = F.vcu; u < 256; u += F.G) at::attn_unit(F.lds, u, FTID, P, (const float*)(ws + WS_ROPE), sk, (bf16_t*)(ws + WS_AO)); }
#define MIX1_BODY(l) { const int rot = (int)(blockIdx.x >> 3) % 3; \
        if (rot == 0) { MIX1_HYP(l) MIX1_LRU(l) MIX1_ATT(l) } else if (rot == 1) { MIX1_LRU(l) MIX1_ATT(l) MIX1_HYP(l) } else { MIX1_ATT(l) MIX1_HYP(l) MIX1_LRU(l) } }
#define FFT_BODY(l) { const float* hb = INP(19) + (l) * DC; \
        for (int sq = gw; sq < NB * 2 * DA; sq += NGW) lru::carry_scan_seq(sq, FLANE, (const float*)(ws + WS_AGG), (float*)(ws + lru::WS_CIN)); \
        for (int u = F.vcu; u < DC; u += F.G) hy::fft_unit(F.lds, u, FTID, (const float*)(ws + WS_HF) + (size_t)(l) * DC * 8192, (const hy::cf*)(ws + WS_TW), (const bf16_t*)(ws + WS_ZT), (const bf16_t*)(ws + WS_X0T), \
                                                           (bf16_t*)(ws + WS_YCT), hb[u]); }
#define FIN_LRU(l) { const float* gna = INP(20) + (l) * DA; \
          for (int u = F.vcu; u < 256; u += F.G) lru::lru_fin_unit(F.lds, u, FTID, P, (const float*)(ws + lru::WS_CIN), (const bf16_t*)(ws + WS_LS), (const bf16_t*)(ws + WS_LPF), (const bf16_t*)(ws + WS_LPB), gna, YN); }
#define FIN_NBC(l) { const float* gnb = INP(21) + (l) * DBB; const float* gnc = INP(22) + (l) * DC; \
          for (int u = F.vcu; u < 256; u += F.G) fin::norm_bc_unit(F.lds, u, FTID, (const bf16_t*)(ws + WS_AO), (const bf16_t*)(ws + WS_YCT), gnb, gnc, YN); }
#define FIN_BODY(l) { if ((blockIdx.x >> 3) & 1) { FIN_NBC(l) FIN_LRU(l) } else { FIN_LRU(l) FIN_NBC(l) } }
#define WUP_BODY(l) { \
        pg8::Gemm g{XG, Wup_t + (size_t)(l) * DFF * DM, MT, DFF, DM, DM}; pg8::StaticOrder S; S.init(MT, DFF, F.G, (int)blockIdx.x); \
        pg8::EpiScaleBf16<1> E{HB, DFF, SS}; \
        pg8::gemm_phase<pg8::EpiScaleBf16<1>, pg8::StaticOrder, true, true>(F.lds + RING_OFF, g, S, E); }
#define LAYER(l) do { constexpr int pb = 1 + PH_PER_LAYER * (l); \
    if (IN(pb + PL_WIN)) { WIN_BODY(l) DUP_WIN(xcd_barrier(bar); WIN_BODY(l)) } \
    SEAM(pb + PL_WIN); \
    if (IN(pb + PL_MIX1)) { MIX1_BODY(l) DUP_MIX1(xcd_barrier(bar); MIX1_BODY(l)) } \
    SEAM(pb + PL_MIX1); \
    if (IN(pb + PL_FFT)) { FFT_BODY(l) DUP_FFT(xcd_barrier(bar); FFT_BODY(l)) } \
    SEAM(pb + PL_FFT); \
    if (IN(pb + PL_FIN)) { FIN_BODY(l) DUP_FIN(xcd_barrier(bar); FIN_BODY(l)) } \
    SEAM(pb + PL_FIN); \
    if (IN(pb + PL_WOUT)) { \
        pg8::Gemm g{YN, Wout_t + (size_t)(l) * DM * DM, MT, DM, DM, DM}; pg8::StaticOrder S; S.init(MT, DM, F.G, (int)blockIdx.x); \
        if ((l) == 0) { pg8::EpiResB<true> E{(const void*)INP(0), XRB, XG, INP(24) + (l) * DM, SS}; \
            pg8::gemm_phase<pg8::EpiResB<true>, pg8::StaticOrder, true, true>(F.lds + RING_OFF, g, S, E); } \
        else { pg8::EpiResB<false> E{(const void*)XRB, XRB, XG, INP(24) + (l) * DM, SS}; \
            pg8::gemm_phase<pg8::EpiResB<false>, pg8::StaticOrder, true, true>(F.lds + RING_OFF, g, S, E); } } \
    SEAM(pb + PL_WOUT); \
    if (IN(pb + PL_WUP)) { WUP_BODY(l) DUP_WUP(xcd_barrier(bar); WUP_BODY(l)) } \
    SEAM(pb + PL_WUP); \
    if (IN(pb + PL_WDN)) { \
        pg8::Gemm g{HB, Wdn_t + (size_t)(l) * DM * DFF, MT, DM, DFF, DFF}; pg8::StaticOrder S; S.init(MT, DM, F.G, (int)blockIdx.x); \
        pg8::EpiResB<false> E{(const void*)XRB, ((l) + 1 < DEPTH) ? XRB : XG  , ((l) + 1 < DEPTH) ? XG : (bf16_t*)nullptr, INP(1) + (((l) + 1 < DEPTH) ? ((l) + 1) * DM : 0), SS}; \
        pg8::gemm_phase<pg8::EpiResB<false>, pg8::StaticOrder, true, true>(F.lds + RING_OFF, g, S, E); } \
    SEAM(pb + PL_WDN); } while (0)
    LAYER(0);
    LAYER(1);
    if (IN(PH_FINAL)) { const float* gf = INP(27);
        const GAS f32x4* gr = (const GAS f32x4*)gf; const int ln = FLANE;
        f32x4 gg[4];
#pragma unroll
        for (int j = 0; j < 2; ++j) { gg[2 * j] = gr[2 * ln + 128 * j]; gg[2 * j + 1] = gr[2 * ln + 128 * j + 1]; }
        for (int m = gw; m < MT; m += 4 * NGW) { v4u xv[4][2]; float rr[4];
#pragma unroll
            for (int q = 0; q < 4; ++q) { const int row = m + q * NGW; const int rc = row < MT ? row : m; const v4u* src = (const v4u*)(XG + (size_t)rc * DM) + ln;
                xv[q][0] = src[0]; xv[q][1] = src[64]; rr[q] = pg8::rstd16(SS, rc); }
#pragma unroll
            for (int q = 0; q < 4; ++q) { const int row = m + q * NGW; if (row < MT) { GAS f32x4* o = (GAS f32x4*)(XR + (size_t)row * DM);
#pragma unroll
                for (int j = 0; j < 2; ++j) { const v4u w = xv[q][j];
                    const f32x4 a = (f32x4){pg8::bflo(w.x), pg8::bfhi(w.x), pg8::bflo(w.y), pg8::bfhi(w.y)}, c = (f32x4){pg8::bflo(w.z), pg8::bfhi(w.z), pg8::bflo(w.w), pg8::bfhi(w.w)};
                    o[2 * ln + 128 * j] = a * gg[2 * j] * rr[q]; o[2 * ln + 128 * j + 1] = c * gg[2 * j + 1] * rr[q]; } } } }
#ifdef TPROBE
        {   const unsigned long long* T = (const unsigned long long*)(ws + WS_CTL + 512 * 1024);
            const float d2 = (TPROBE == 102) ? ((float)(T[15] - T[0]) * 0.01f - 1000.f) * 0.002f : (TPROBE == 101) ? (float)(__builtin_amdgcn_s_memrealtime() - T[15]) * 0.0001f : (TPROBE >= 100) ? (float)(T[15] - T[0]) * 0.00001f : (float)(T[(TPROBE % 100) + 1] - T[TPROBE % 100]) * 0.0001f;
            asm volatile("s_waitcnt vmcnt(0)" ::: "memory");
            if (gw == 0 && FLANE == 0) XR[0] += d2; }
#endif
    }
#undef IN
#undef SEAM
#undef LAYER
}

#undef ws
#undef XR
#undef Win_t
#undef Wout_t
#undef Wup_t
#undef Wdn_t
#undef XG
#undef P
#undef YN
#undef HB
#undef SS
static int g_grid = 0, g_li = 0;
static void launch_mega(Args a, int lo, int hi, hipStream_t stream) {
    a.ph_lo = lo; a.ph_hi = hi; a.li = (hi - lo > 1) ? g_li++ : 0;
    void* kargs[] = {&a};
    hipLaunchCooperativeKernel((const void*)mega, dim3(g_grid), dim3(NTHREADS), kargs, LDS_BYTES, stream);
}
extern "C" void kernel_launch(void* const* d_in, const int* in_sizes, int n_in, void* d_out, int out_size, void* d_ws, size_t ws_size, hipStream_t stream) {
    if (n_in != 28 || ws_size < WS_END) return;
    if (g_grid == 0) {
        int dev = 0, cus = 0, per_cu = 0;
        hipGetDevice(&dev); hipDeviceGetAttribute(&cus, hipDeviceAttributeMultiprocessorCount, dev);
        hipFuncSetAttribute((const void*)mega, hipFuncAttributeMaxDynamicSharedMemorySize, LDS_BYTES);
        hipOccupancyMaxActiveBlocksPerMultiprocessor(&per_cu, (const void*)mega, NTHREADS, LDS_BYTES);
        (void)hipGetLastError();
        if (per_cu < 1) per_cu = 1;
        if (per_cu > 1) per_cu = 1;
        g_grid = cus * per_cu;
    }
    g_li = 0;
    unsigned char* ws = (unsigned char*)d_ws;
    auto F = [&](int i) { return (const float*)d_in[i]; };
    hipMemsetAsync(ws + WS_CTL, 0, 64 * 1024, stream);
    Args a{};
    for (int i = 0; i < 28; ++i) a.in[i] = (const float*)d_in[i];
    a.out = (float*)d_out; a.ws = ws;
    float* rope = (float*)(ws + WS_ROPE); float* HF = (float*)(ws + WS_HF);
    bf16_t* P = (bf16_t*)(ws + WS_P); bf16_t* YN = (bf16_t*)(ws + WS_YN);
    float* nA = (float*)(ws + NV_A); float* nB = (float*)(ws + NV_B); float* nHS = (float*)(ws + NV_HS); float* nZ = (float*)(ws + NV_Z); float* nX0 = (float*)(ws + NV_X0); float* nYC = (float*)(ws + NV_YC);

    launch_mega(a, 0, NPH, stream);
}
```

```cpp
#include <hip/hip_runtime.h>
#include <stdint.h>
#include <math.h>

typedef unsigned short bf16_t;
typedef short bf16x8 __attribute__((ext_vector_type(8)));
typedef float f32x4 __attribute__((ext_vector_type(4)));

constexpr int NB = 4, SL = 4096, DM = 1024, MT = NB * SL, DEPTH = 2;
constexpr int DA = 384, DBB = 384, DC = 256, HD = 64, NQH = 6, NKVH = 2, DIN = 2176, DINP = 2304, DFF = 4096;
constexpr int P_AX = 0, P_AG = 384, P_Q = 768, P_K = 1152, P_V = 1280, P_CU = 1408;
constexpr int LRU_BLK = 6, LRU_BW = 64, WIN = 128, HY_EMB = 33, HY_W = 64;
constexpr float EPS = 1e-6f;

constexpr size_t MiB = 1u << 20;
constexpr size_t WS_WIN = 0;
constexpr size_t WS_WOUT = 9 * MiB;
constexpr size_t WS_WUP = 13 * MiB;
constexpr size_t WS_WDN = 29 * MiB;
constexpr size_t WS_ROPE = 45 * MiB;
constexpr size_t WS_HF = 46 * MiB;
constexpr size_t WS_XG = 62 * MiB;
constexpr size_t WS_BIG = 94 * MiB;
constexpr size_t WS_H = WS_BIG;
constexpr size_t WS_P = WS_BIG;
constexpr size_t WS_YN = WS_BIG + 72 * MiB;
constexpr size_t WS_SCR = WS_BIG + 104 * MiB;
constexpr size_t WS_CTL = 254 * MiB;
constexpr size_t WS_SS = 255 * MiB;
constexpr size_t WS_END = 256 * MiB;

__device__ __forceinline__ unsigned f2bf(float f) { unsigned u = __builtin_bit_cast(unsigned, f); return (u + 0x7fffu + ((u >> 16) & 1u)) >> 16; }
__device__ __forceinline__ float bf2f(bf16_t h) { return __builtin_bit_cast(float, (unsigned)h << 16); }
namespace pg8 {
#define PG8_LAS __attribute__((address_space(3)))
typedef unsigned short bf16_t;
typedef short bf16x8 __attribute__((ext_vector_type(8)));
typedef float f32x4 __attribute__((ext_vector_type(4)));
typedef unsigned u32x4 __attribute__((ext_vector_type(4)));
constexpr int BM = 256, BK = 64, HALF = 128, HTB = HALF * BK * 2  , STAGE_BYTES = 8 * HTB, NXCD = 8, WGM = 8;

__host__ __device__ __forceinline__ int lds_byte(int r, int c) { const int st = (r >> 4) * 2 + (c >> 5), rr = r & 15, cc = c & 31, ob = rr * 64 + cc * 2; return st * 1024 + (ob ^ (((ob >> 9) & 1) << 5)); }
__host__ __device__ __forceinline__ void stage_rc(int b, int& R, int& C) { const int st = b / 1024, sb = b % 1024, swz = sb ^ (((sb >> 9) & 1) << 5); R = (st >> 1) * 16 + swz / 64; C = (st & 1) * 32 + (swz % 64) / 2; }
__host__ __device__ __forceinline__ int perm32(int rho) { const int n = rho >> 4, i = rho & 15; return 8 * (i >> 2) + 4 * n + (i & 3); }

struct Unit { int pm, pn; };
struct Gemm { const bf16_t* A; const bf16_t* Bt; int M, N, K, ld; };

struct StaticOrder {
    int nM, nN, nwg, G, c;
    __host__ __device__ void init(int M, int N, int G_, int c_) { nM = M / BM; nN = N / BM; nwg = nM * nN; G = G_; c = c_; }
    __host__ __device__ bool next(int i, Unit& u) const {
        const long L = (long)i * G + c; if (L >= nwg) return false;
        int wgid = (int)L; { const int q = nwg / NXCD, r = nwg % NXCD, xcd = wgid % NXCD, off = wgid / NXCD; wgid = (xcd < r ? xcd * (q + 1) : r * (q + 1) + (xcd - r) * q) + off; }
        const int nig = WGM * nN, gid = wgid / nig, fm = gid * WGM, gsz = (nM - fm) < WGM ? (nM - fm) : WGM;
        u.pm = fm + ((wgid % nig) % gsz); u.pn = (wgid % nig) / gsz; return true;
    }
    __device__ __forceinline__ void a_ready(const Unit&) const {}
    __device__ __forceinline__ void done(const Unit&) const {}
};

__device__ __forceinline__ unsigned cvt_pk_bf16(float lo, float hi) { unsigned r; asm volatile("v_cvt_pk_bf16_f32 %0, %1, %2" : "=v"(r) : "v"(lo), "v"(hi)); return r; }

constexpr int E_DM = 1024, E_DINP = 2304, E_DFF = 4096; constexpr float E_EPS = 1e-6f;
__device__ __forceinline__ float rstd16(const float* SS, int row) {
    const f32x4* p = (const f32x4*)(SS + (size_t)row * 16); const f32x4 a = (p[0] + p[1]) + (p[2] + p[3]);
    return 1.0f / sqrtf(((a[0] + a[1]) + (a[2] + a[3])) * (1.0f / E_DM) + E_EPS);
}
template <int ACT> struct EpiScaleBf16 {
    static constexpr bool PERM = true, AFTER_DRAIN = false;
    bf16_t* O; int ldc; const float* SS;
    __device__ __forceinline__ void operator()(const f32x4 (&acc)[2][2][4][2], const Unit& u, int wr, int wc, int fr, int fq) const {
        const int row0 = u.pm * BM + wr * 64 + fr, col0 = u.pn * BM + wc * 32 + 8 * fq;
        float rs[2][4];
        {   f32x4 p[2][4];
#pragma unroll
            for (int ai = 0; ai < 2; ++ai) { const f32x4* src = (const f32x4*)(SS + (size_t)(row0 + ai * HALF + fq * 16) * 16);
#pragma unroll
                for (int q = 0; q < 4; ++q) p[ai][q] = src[q]; }
            float mine[2];
#pragma unroll
            for (int ai = 0; ai < 2; ++ai) { const f32x4 a = (p[ai][0] + p[ai][1]) + (p[ai][2] + p[ai][3]); mine[ai] = 1.0f / sqrtf(((a[0] + a[1]) + (a[2] + a[3])) * (1.0f / E_DM) + E_EPS); }
#pragma unroll
            for (int ai = 0; ai < 2; ++ai)
#pragma unroll
                for (int m = 0; m < 4; ++m) rs[ai][m] = __shfl(mine[ai], fr + 16 * m); }
#pragma unroll
        for (int ai = 0; ai < 2; ++ai)
#pragma unroll
            for (int m = 0; m < 4; ++m) { const int row = row0 + ai * HALF + m * 16; const float r = rs[ai][m]; bf16_t* rowp = O + (size_t)row * ldc + col0;
#pragma unroll
                for (int bj = 0; bj < 2; ++bj) { f32x4 v0 = acc[ai][bj][m][0] * r, v1 = acc[ai][bj][m][1] * r;
                    if (ACT == 1) {
#pragma unroll
                        for (int i = 0; i < 4; ++i) { const float a = fmaxf(v0[i], 0.f), b = fmaxf(v1[i], 0.f); v0[i] = a * a; v1[i] = b * b; } }
                    u32x4 w; w.x = cvt_pk_bf16(v0[0], v0[1]); w.y = cvt_pk_bf16(v0[2], v0[3]); w.z = cvt_pk_bf16(v1[0], v1[1]); w.w = cvt_pk_bf16(v1[2], v1[3]);
                    *(u32x4*)(rowp + bj * HALF) = w; } }
    }
};
struct QuarterOrder { int pm0, G;
    __device__ __forceinline__ bool next(int i, Unit& u) const { const int pm = pm0 + i * (G >> 2); if (pm >= 64) return false; u.pm = pm; u.pn = 0; return true; }
    __device__ __forceinline__ void a_ready(const Unit&) const {}
    __device__ __forceinline__ void done(const Unit&) const {} };
struct EpiSlab {
    static constexpr bool PERM = true, AFTER_DRAIN = false;
    bf16_t* S; const float* SS;
    __device__ __forceinline__ void operator()(const f32x4 (&acc)[2][2][4][2], const Unit& u, int wr, int wc, int fr, int fq) const {
        const int row0 = u.pm * BM + wr * 64 + fr, col0 = wc * 32 + 8 * fq;
        float rs[2][4];
        {   f32x4 p[2][4];
#pragma unroll
            for (int ai = 0; ai < 2; ++ai) { const f32x4* src = (const f32x4*)(SS + (size_t)(row0 + ai * HALF + fq * 16) * 16);
#pragma unroll
                for (int q = 0; q < 4; ++q) p[ai][q] = src[q]; }
            float mine[2];
#pragma unroll
            for (int ai = 0; ai < 2; ++ai) { const f32x4 a = (p[ai][0] + p[ai][1]) + (p[ai][2] + p[ai][3]); mine[ai] = 1.0f / sqrtf(((a[0] + a[1]) + (a[2] + a[3])) * (1.0f / E_DM) + E_EPS); }
#pragma unroll
            for (int ai = 0; ai < 2; ++ai)
#pragma unroll
                for (int m = 0; m < 4; ++m) rs[ai][m] = __shfl(mine[ai], fr + 16 * m); }
#pragma unroll
        for (int ai = 0; ai < 2; ++ai)
#pragma unroll
            for (int m = 0; m < 4; ++m) { const int row = row0 + ai * HALF + m * 16; const float r = rs[ai][m];
                const f32x4 v0 = acc[ai][0][m][0] * r, v1 = acc[ai][0][m][1] * r;
                u32x4 w; w.x = cvt_pk_bf16(v0[0], v0[1]); w.y = cvt_pk_bf16(v0[2], v0[3]); w.z = cvt_pk_bf16(v1[0], v1[1]); w.w = cvt_pk_bf16(v1[2], v1[3]);
                *(u32x4*)(S + (size_t)row * 128 + col0) = w; }
    }
};
__device__ __forceinline__ float bflo(unsigned u) { return __builtin_bit_cast(float, u << 16); }
__device__ __forceinline__ float bfhi(unsigned u) { return __builtin_bit_cast(float, u & 0xffff0000u); }
template <bool BASEF32> struct EpiResB {
    static constexpr bool PERM = true, AFTER_DRAIN = false;
    const void* base; bf16_t* out; bf16_t* XG; const float* g; float* SS;
    __device__ __forceinline__ void operator()(const f32x4 (&acc)[2][2][4][2], const Unit& u, int wr, int wc, int fr, int fq) const {
        const int row0 = u.pm * BM + wr * 64 + fr, col0 = u.pn * BM + wc * 32 + 8 * fq;
        f32x4 gv[2][2];
#pragma unroll
        for (int bj = 0; bj < 2; ++bj)
#pragma unroll
            for (int n = 0; n < 2; ++n) gv[bj][n] = XG ? *(const f32x4*)(g + col0 + bj * HALF + 4 * n) : (f32x4){0.f, 0.f, 0.f, 0.f};
        if (!BASEF32) {
            u32x4 bw[2][4][2];
#pragma unroll
            for (int ai = 0; ai < 2; ++ai)
#pragma unroll
                for (int m = 0; m < 4; ++m)
#pragma unroll
                    for (int bj = 0; bj < 2; ++bj) bw[ai][m][bj] = *(const u32x4*)((const bf16_t*)base + (size_t)(row0 + ai * HALF + m * 16) * E_DM + col0 + bj * HALF);
#pragma unroll
            for (int ai = 0; ai < 2; ++ai)
#pragma unroll
                for (int m = 0; m < 4; ++m) { const int row = row0 + ai * HALF + m * 16; const size_t off = (size_t)row * E_DM + col0; float s = 0.f;
#pragma unroll
                    for (int bj = 0; bj < 2; ++bj) { const u32x4 w = bw[ai][m][bj];
                        const f32x4 v0 = (f32x4){bflo(w.x), bfhi(w.x), bflo(w.y), bfhi(w.y)} + acc[ai][bj][m][0], v1 = (f32x4){bflo(w.z), bfhi(w.z), bflo(w.w), bfhi(w.w)} + acc[ai][bj][m][1];
                        u32x4 o; o.x = cvt_pk_bf16(v0[0], v0[1]); o.y = cvt_pk_bf16(v0[2], v0[3]); o.z = cvt_pk_bf16(v1[0], v1[1]); o.w = cvt_pk_bf16(v1[2], v1[3]);
                        *(u32x4*)(out + off + bj * HALF) = o;
                        s += ((v0[0] * v0[0] + v0[1] * v0[1]) + (v0[2] * v0[2] + v0[3] * v0[3])) + ((v1[0] * v1[0] + v1[1] * v1[1]) + (v1[2] * v1[2] + v1[3] * v1[3]));
                        if (XG) { const f32x4 x0 = v0 * gv[bj][0], x1 = v1 * gv[bj][1]; u32x4 q; q.x = cvt_pk_bf16(x0[0], x0[1]); q.y = cvt_pk_bf16(x0[2], x0[3]); q.z = cvt_pk_bf16(x1[0], x1[1]); q.w = cvt_pk_bf16(x1[2], x1[3]);
                            *(u32x4*)(XG + off + bj * HALF) = q; } }
                    s += __shfl_xor(s, 16); s += __shfl_xor(s, 32);
                    if (fq == 0) SS[(size_t)row * 16 + u.pn * 4 + wc] = s; }
        } else {
#pragma unroll
            for (int ai = 0; ai < 2; ++ai)
#pragma unroll
                for (int m = 0; m < 4; ++m) { const int row = row0 + ai * HALF + m * 16; const size_t off = (size_t)row * E_DM + col0; float s = 0.f;
#pragma unroll
                    for (int bj = 0; bj < 2; ++bj) { const f32x4 b0 = *(const f32x4*)((const float*)base + off + bj * HALF), b1 = *(const f32x4*)((const float*)base + off + bj * HALF + 4);
                        const f32x4 v0 = b0 + acc[ai][bj][m][0], v1 = b1 + acc[ai][bj][m][1];
                        u32x4 o; o.x = cvt_pk_bf16(v0[0], v0[1]); o.y = cvt_pk_bf16(v0[2], v0[3]); o.z = cvt_pk_bf16(v1[0], v1[1]); o.w = cvt_pk_bf16(v1[2], v1[3]);
                        *(u32x4*)(out + off + bj * HALF) = o;
                        s += ((v0[0] * v0[0] + v0[1] * v0[1]) + (v0[2] * v0[2] + v0[3] * v0[3])) + ((v1[0] * v1[0] + v1[1] * v1[1]) + (v1[2] * v1[2] + v1[3] * v1[3]));
                        if (XG) { const f32x4 x0 = v0 * gv[bj][0], x1 = v1 * gv[bj][1]; u32x4 q; q.x = cvt_pk_bf16(x0[0], x0[1]); q.y = cvt_pk_bf16(x0[2], x0[3]); q.z = cvt_pk_bf16(x1[0], x1[1]); q.w = cvt_pk_bf16(x1[2], x1[3]);
                            *(u32x4*)(XG + off + bj * HALF) = q; } }
                    s += __shfl_xor(s, 16); s += __shfl_xor(s, 32);
                    if (fq == 0) SS[(size_t)row * 16 + u.pn * 4 + wc] = s;
                    if (m & 1) asm volatile("" ::: "memory"); }
        }
    }
};

template <class Epi, class Sched, bool ALIGN_EPI = false, bool SP2 = false>
__device__ __forceinline__ void gemm_phase(PG8_LAS unsigned char* lds, const Gemm g, const Sched& S, const Epi& E) {
    const int tid = threadIdx.x, wid = __builtin_amdgcn_readfirstlane(tid >> 6), lane = tid & 63, wr = wid >> 2, wc = wid & 3, fr = lane & 15, fq = lane >> 4;
    const int K = g.ld, nt = g.K / BK;
    unsigned voffA[2], voffB[2];
#pragma unroll
    for (int i = 0; i < 2; ++i) { int R, C; stage_rc(tid * 16 + i * 8192, R, C); const int Rb = Epi::PERM ? ((R & ~31) + perm32(R & 31)) : R;
        voffA[i] = (unsigned)(R * K + C) * 2u; voffB[i] = (unsigned)(Rb * K + C) * 2u; }
    const size_t kstep = (size_t)(BK * 2);
    const size_t hstep = (size_t)HALF * K * 2;
    const size_t tstep = 2 * hstep;
    const unsigned ldsw = (unsigned)wid * 1024u;
    const int aoff = lds_byte(wr * 64 + fr, fq * 8), boff = lds_byte(wc * 32 + fr, fq * 8);
#define PG8_SA(b, h) (((b) * 2 + (h)) * HTB)
#define PG8_SB(b, h) ((4 + (b) * 2 + (h)) * HTB)
#define PG8_STAGE(bufoff, gbase, voff) do { _Pragma("unroll") for (int _i = 0; _i < 2; ++_i) \
        __builtin_amdgcn_global_load_lds((const unsigned*)((const char*)(gbase) + (voff)[_i]), (PG8_LAS unsigned*)(lds + (bufoff) + ldsw + _i * 8192), 16, 0, 0); } while (0)
#define PG8_LDA(dst, b, h) do { _Pragma("unroll") for (int m = 0; m < 4; ++m) _Pragma("unroll") for (int k = 0; k < 2; ++k) dst[m][k] = *(const PG8_LAS bf16x8*)(lds + PG8_SA(b, h) + aoff + m * 2048 + k * 1024); } while (0)
#define PG8_LDB(dst, b, h) do { _Pragma("unroll") for (int n = 0; n < 2; ++n) _Pragma("unroll") for (int k = 0; k < 2; ++k) dst[n][k] = *(const PG8_LAS bf16x8*)(lds + PG8_SB(b, h) + boff + n * 2048 + k * 1024); } while (0)
#define PG8_MMA(ai, bj, At, Bt) do { __builtin_amdgcn_s_setprio(1); _Pragma("unroll") for (int m = 0; m < 4; ++m) _Pragma("unroll") for (int n = 0; n < 2; ++n) _Pragma("unroll") for (int k = 0; k < 2; ++k) \
        acc[ai][bj][m][n] = __builtin_amdgcn_mfma_f32_16x16x32_bf16(Bt[n][k], At[m][k], acc[ai][bj][m][n], 0, 0, 0); __builtin_amdgcn_s_setprio(0); } while (0)
#define PG8_WAIT_V(n) asm volatile("s_waitcnt vmcnt(" #n ")" ::: "memory")
#define PG8_WAIT_L(n) asm volatile("s_waitcnt lgkmcnt(" #n ")" ::: "memory")
#define PG8_BAR __builtin_amdgcn_s_barrier()
#define PG8_SCHED __builtin_amdgcn_sched_barrier(0)
    Unit cur, nxt; int ui = 0;
    if (!S.next(0, cur)) return;
    f32x4 acc[2][2][4][2];
#pragma unroll
    for (int a = 0; a < 2; ++a)
#pragma unroll
        for (int b = 0; b < 2; ++b)
#pragma unroll
            for (int m = 0; m < 4; ++m)
#pragma unroll
                for (int n = 0; n < 2; ++n) acc[a][b][m][n] = (f32x4){0.f, 0.f, 0.f, 0.f};
    bf16x8 At[4][2], B0[2][2], B1[2][2];
    const char* cA = (const char*)g.A + (size_t)cur.pm * tstep; const char* cB = (const char*)g.Bt + (size_t)cur.pn * tstep;
    S.a_ready(cur);
    if constexpr (SP2) {
        PG8_STAGE(PG8_SB(0, 0), cB, voffB); PG8_STAGE(PG8_SB(0, 1), cB + hstep, voffB); PG8_STAGE(PG8_SA(0, 0), cA, voffA); PG8_STAGE(PG8_SA(0, 1), cA + hstep, voffA);
        if (wr == 1) PG8_BAR;
        PG8_WAIT_V(2); PG8_BAR;
        PG8_STAGE(PG8_SB(1, 0), cB + kstep, voffB); PG8_STAGE(PG8_SA(1, 0), cA + kstep, voffA); PG8_STAGE(PG8_SB(1, 1), cB + hstep + kstep, voffB);
        PG8_WAIT_V(6); PG8_BAR;
    } else {
        PG8_STAGE(PG8_SB(0, 0), cB, voffB); PG8_STAGE(PG8_SA(0, 0), cA, voffA); PG8_STAGE(PG8_SB(0, 1), cB + hstep, voffB); PG8_STAGE(PG8_SA(0, 1), cA + hstep, voffA);
        if (wr == 1) PG8_BAR;
        PG8_WAIT_V(4); PG8_BAR;
        PG8_STAGE(PG8_SB(1, 0), cB + kstep, voffB); PG8_STAGE(PG8_SA(1, 0), cA + kstep, voffA); PG8_STAGE(PG8_SB(1, 1), cB + hstep + kstep, voffB);
        PG8_WAIT_V(6); PG8_BAR;
    }
    for (;;) {
        const bool has_next = S.next(ui + 1, nxt);
        const char* nA = has_next ? (const char*)g.A + (size_t)nxt.pm * tstep : cA; const char* nB = has_next ? (const char*)g.Bt + (size_t)nxt.pn * tstep : cB;
        for (int t = 0; t < nt; t += 2) {
            const bool last = (t == nt - 2);
            const char* a1 = cA + (size_t)(t + 1) * kstep;
            const char* a2 = last ? nA : cA + (size_t)(t + 2) * kstep; const char* b2 = last ? nB : cB + (size_t)(t + 2) * kstep;
            const char* a3 = a2 + kstep; const char* b3 = b2 + kstep;
            if (last && has_next) S.a_ready(nxt);
            if constexpr (SP2) {
            PG8_LDB(B0, 0, 0); PG8_LDB(B1, 0, 1); PG8_SCHED; PG8_LDA(At, 0, 0); PG8_STAGE(PG8_SA(1, 1), a1 + hstep, voffA);
            PG8_WAIT_V(8); PG8_WAIT_L(0); PG8_BAR; PG8_MMA(0, 0, At, B0); PG8_MMA(0, 1, At, B1); PG8_BAR; PG8_SCHED;
            PG8_LDA(At, 0, 1); PG8_STAGE(PG8_SB(0, 0), b2, voffB); PG8_STAGE(PG8_SB(0, 1), b2 + hstep, voffB); PG8_STAGE(PG8_SA(0, 0), a2, voffA);
            PG8_WAIT_V(8); PG8_WAIT_L(0); PG8_BAR; PG8_MMA(1, 0, At, B0); PG8_MMA(1, 1, At, B1); PG8_BAR; PG8_SCHED;
            PG8_LDB(B0, 1, 0); PG8_LDB(B1, 1, 1); PG8_SCHED; PG8_LDA(At, 1, 0); PG8_STAGE(PG8_SA(0, 1), a2 + hstep, voffA);
            PG8_WAIT_V(8); PG8_WAIT_L(0); PG8_BAR; PG8_MMA(0, 0, At, B0); PG8_MMA(0, 1, At, B1); PG8_BAR; PG8_SCHED;
            PG8_LDA(At, 1, 1); PG8_STAGE(PG8_SB(1, 0), b3, voffB); PG8_STAGE(PG8_SB(1, 1), b3 + hstep, voffB); PG8_STAGE(PG8_SA(1, 0), a3, voffA);
            PG8_WAIT_V(8); PG8_WAIT_L(0); PG8_BAR; PG8_MMA(1, 0, At, B0); PG8_MMA(1, 1, At, B1); PG8_BAR; PG8_SCHED;
            } else {
            PG8_LDB(B0, 0, 0); PG8_SCHED; PG8_LDA(At, 0, 0); PG8_STAGE(PG8_SA(1, 1), a1 + hstep, voffA);
            PG8_WAIT_L(8); PG8_BAR; PG8_WAIT_L(0); PG8_MMA(0, 0, At, B0); PG8_BAR; PG8_SCHED;
            PG8_LDB(B1, 0, 1); PG8_STAGE(PG8_SB(0, 0), b2, voffB);
            PG8_BAR; PG8_WAIT_L(0); PG8_MMA(0, 1, At, B1); PG8_BAR;
            PG8_LDA(At, 0, 1); PG8_STAGE(PG8_SA(0, 0), a2, voffA);
            PG8_BAR; PG8_WAIT_L(0); PG8_MMA(1, 0, At, B0); PG8_BAR; PG8_SCHED;
            PG8_STAGE(PG8_SB(0, 1), b2 + hstep, voffB);
            PG8_WAIT_V(6); PG8_BAR; PG8_MMA(1, 1, At, B1); PG8_BAR;
            PG8_LDB(B0, 1, 0); PG8_SCHED; PG8_LDA(At, 1, 0); PG8_STAGE(PG8_SA(0, 1), a2 + hstep, voffA);
            PG8_WAIT_L(8); PG8_BAR; PG8_WAIT_L(0); PG8_MMA(0, 0, At, B0); PG8_BAR; PG8_SCHED;
            PG8_LDB(B1, 1, 1); PG8_STAGE(PG8_SB(1, 0), b3, voffB);
            PG8_BAR; PG8_WAIT_L(0); PG8_MMA(0, 1, At, B1); PG8_BAR;
            PG8_LDA(At, 1, 1); PG8_STAGE(PG8_SA(1, 0), a3, voffA);
            PG8_BAR; PG8_WAIT_L(0); PG8_MMA(1, 0, At, B0); PG8_BAR; PG8_SCHED;
            PG8_STAGE(PG8_SB(1, 1), b3 + hstep, voffB);
            PG8_WAIT_V(6); PG8_BAR; PG8_MMA(1, 1, At, B1); PG8_BAR;
            }
        }
        if constexpr (ALIGN_EPI) { if (wr == 0) PG8_BAR; }
        if constexpr (!Epi::AFTER_DRAIN) { E(acc, cur, wr, wc, fr, fq); S.done(cur); }
        if (!has_next) break;
#pragma unroll
        for (int a = 0; a < 2; ++a)
#pragma unroll
            for (int b = 0; b < 2; ++b)
#pragma unroll
                for (int m = 0; m < 4; ++m)
#pragma unroll
                    for (int n = 0; n < 2; ++n) acc[a][b][m][n] = (f32x4){0.f, 0.f, 0.f, 0.f};
        cur = nxt; cA = nA; cB = nB; ++ui;
        if constexpr (ALIGN_EPI) { if (wr == 1) PG8_BAR; }
    }
    PG8_WAIT_V(0);
    if constexpr (!ALIGN_EPI) { if (wr == 0) PG8_BAR; }
    PG8_BAR;
    if constexpr (Epi::AFTER_DRAIN) { E.fused(acc, cur, wr, wc, fr, fq, lds, wid, lane); S.done(cur); }
#undef PG8_SA
#undef PG8_SB
#undef PG8_STAGE
#undef PG8_LDA
#undef PG8_LDB
#undef PG8_MMA
#undef PG8_WAIT_V
#undef PG8_WAIT_L
#undef PG8_BAR
#undef PG8_SCHED
}
}

constexpr int NWAVES = 8, NTHREADS = 512;
constexpr int LDS_BYTES = 163840;
constexpr int RING_OFF = 0, RING_BYTES = 131072;
constexpr int MISC_OFF = LDS_BYTES - 256;
constexpr int PH_PRO = 0, PH_PER_LAYER = 7, PH_FINAL = 1 + PH_PER_LAYER * DEPTH, NPH = PH_FINAL + 1;
constexpr int PL_WIN = 0, PL_MIX1 = 1, PL_FFT = 2, PL_FIN = 3, PL_WOUT = 4, PL_WUP = 5, PL_WDN = 6;
constexpr int CW_BAR = 4096, N_BAR_REG = 12;

#define GAS __attribute__((address_space(1)))
#define LAS __attribute__((address_space(3)))
typedef unsigned v4u __attribute__((ext_vector_type(4)));
typedef GAS unsigned gu32;
#define RLX_AGENT __ATOMIC_RELAXED, __HIP_MEMORY_SCOPE_AGENT
#define LDS_WAIT() asm volatile("s_waitcnt lgkmcnt(0)" ::: "memory")
#define VM_WAIT() asm volatile("s_waitcnt vmcnt(0)" ::: "memory")
__device__ __forceinline__ unsigned pk2(float lo, float hi) { return f2bf(lo) | (f2bf(hi) << 16); }

#define XB_TMO      128
#define XB_XCNT(j)  (256  + 64 * (j))
#define XB_XSUB(j)  (1280 + 64 * (j))
#define XB_XGEN(j)  (2304 + 64 * (j))
#define XB_TOP      3328
#define XB_TOPGEN   3392
#define XCD_BAR_WORDS 3456
#define XB_SPIN_CAP (1u << 18)

__device__ __forceinline__ unsigned xb_ld(unsigned* p)              { return __hip_atomic_load(p, __ATOMIC_RELAXED, __HIP_MEMORY_SCOPE_AGENT); }
__device__ __forceinline__ unsigned xb_add(unsigned* p, unsigned v) { return __hip_atomic_fetch_add(p, v, __ATOMIC_RELAXED, __HIP_MEMORY_SCOPE_AGENT); }
__device__ __forceinline__ unsigned xb_xcc_id() { return (unsigned)__builtin_amdgcn_s_getreg((3 << 11) | 20) & 0xFu; }
#define XB_SPIN(cond, bar) do { unsigned _sp = 0; while (cond) { __builtin_amdgcn_s_sleep(1); \
    if ((++_sp & 255u) == 0u) { if (xb_ld(&(bar)[XB_TMO])) break; if (_sp > XB_SPIN_CAP) { atomicAdd(&(bar)[XB_TMO], 1u); break; } } } } while (0)

struct XcdBarrier {
    unsigned* bar; unsigned x;
    volatile LAS unsigned* st;
};

__device__ __forceinline__ XcdBarrier xcd_barrier_post(unsigned* bar, volatile LAS unsigned* st) {
    XcdBarrier b; b.bar = bar; b.x = xb_xcc_id(); b.st = st;
    if (threadIdx.x == 0) (void)xb_add(&bar[XB_XCNT(b.x)], 1u);
    return b;
}
__device__ __forceinline__ void xcd_barrier_complete(unsigned* bar, unsigned x, unsigned& nloc, unsigned& nx) {
    const unsigned G = gridDim.x * gridDim.y * gridDim.z;
    unsigned sum, cnt, mine, sp = 0u;
    for (;;) {
        sum = 0u; cnt = 0u; mine = 0u;
#pragma unroll
        for (unsigned j = 0; j < 16; ++j) { const unsigned c = xb_ld(&bar[XB_XCNT(j)]); sum += c; cnt += (c > 0u) ? 1u : 0u; mine = (j == x) ? c : mine; }
        if (sum == G) break;
        __builtin_amdgcn_s_sleep(1);
        if ((++sp & 255u) == 0u) { if (xb_ld(&bar[XB_TMO])) break; if (sp > XB_SPIN_CAP) { atomicAdd(&bar[XB_TMO], 1u); break; } }
    }
    nloc = mine > 0u ? mine : 1u; nx = cnt > 0u ? cnt : 1u;
}

__device__ __forceinline__ void xcd_barrier(const XcdBarrier& b) {
    asm volatile("s_waitcnt vmcnt(0)" ::: "memory");
    __syncthreads();
    if (threadIdx.x == 0) {
        unsigned* bar = b.bar;
        __builtin_amdgcn_s_waitcnt(0);
        unsigned nloc = b.st[0], nx = b.st[1];
        if (nloc == 0u) { xcd_barrier_complete(bar, b.x, nloc, nx); b.st[0] = nloc; b.st[1] = nx; }
        const unsigned old = xb_add(&bar[XB_XSUB(b.x)], 1u);
        const unsigned gen = old / nloc;
        if (old + 1u == (gen + 1u) * nloc) {
            __builtin_amdgcn_fence(__ATOMIC_RELEASE, "agent");
            asm volatile("s_waitcnt vmcnt(0)" ::: "memory");
            const unsigned og = xb_add(&bar[XB_TOP], 1u);
            const unsigned tg = og / nx;
            if (og + 1u == (tg + 1u) * nx) xb_add(&bar[XB_TOPGEN], 1u);
            else XB_SPIN(xb_ld(&bar[XB_TOPGEN]) == tg, bar);
            __builtin_amdgcn_fence(__ATOMIC_ACQUIRE, "agent");
            xb_add(&bar[XB_XGEN(b.x)], 1u);
            asm volatile("s_waitcnt vmcnt(0)" ::: "memory");
        } else {
            XB_SPIN(xb_ld(&bar[XB_XGEN(b.x)]) == gen, bar);
            __builtin_amdgcn_fence(__ATOMIC_ACQUIRE, "agent");
            asm volatile("s_waitcnt vmcnt(0)" ::: "memory");
        }
    }
    __syncthreads();
}

constexpr size_t WS_SLAB = WS_YN;
constexpr size_t WS_ZT = WS_SCR, WS_X0T = WS_SCR + 8 * MiB, WS_YCT = WS_SCR + 16 * MiB;
constexpr size_t WS_TW = WS_ROPE + 256 * 1024;
namespace hy {
typedef float cf __attribute__((ext_vector_type(2)));
__device__ __forceinline__ cf cmul(cf a, cf b) { return {a.x * b.x - a.y * b.y, a.x * b.y + a.y * b.x}; }
__device__ __forceinline__ cf cmulc(cf a, cf b) { return {a.x * b.x + a.y * b.y, a.y * b.x - a.x * b.y}; }
__device__ __forceinline__ cf cadd(cf a, cf b) { return {a.x + b.x, a.y + b.y}; }
__device__ __forceinline__ cf csub(cf a, cf b) { return {a.x - b.x, a.y - b.y}; }
__device__ __forceinline__ int pidx(int i) { return i + (i >> 5); }
constexpr int FBUF = 8192 + 256;
template <bool INV> __device__ __forceinline__ cf tw16(cf d, int K) {
    float c, s;
    switch (K) {
        case 0: return d;
        case 4: return INV ? cf{-d.y, d.x} : cf{d.y, -d.x};
        case 1: c = 0.92387953251128674f; s = 0.38268343236508977f; break;
        case 2: c = 0.70710678118654752f; s = 0.70710678118654752f; break;
        case 3: c = 0.38268343236508977f; s = 0.92387953251128674f; break;
        case 5: c = -0.38268343236508977f; s = 0.92387953251128674f; break;
        case 6: c = -0.70710678118654752f; s = 0.70710678118654752f; break;
        default: c = -0.92387953251128674f; s = 0.38268343236508977f; break;
    }
    const cf w = {c, INV ? s : -s};
    return cmul(d, w);
}
template <int H, bool INV> __device__ __forceinline__ void stage16(cf (&v)[16]) {
#pragma unroll
    for (int blk = 0; blk < 16; blk += 2 * H)
#pragma unroll
        for (int j = 0; j < H; ++j) {
            if (!INV) { const cf a = v[blk + j], b = v[blk + j + H]; v[blk + j] = cadd(a, b); v[blk + j + H] = tw16<false>(csub(a, b), j * (8 / H)); }
            else { const cf A = v[blk + j], B = tw16<true>(v[blk + j + H], j * (8 / H)); v[blk + j] = cadd(A, B); v[blk + j + H] = csub(A, B); }
        }
}
template <bool INV> __device__ __forceinline__ void dft16(cf (&v)[16]) {
    if (!INV) { stage16<8, false>(v); stage16<4, false>(v); stage16<2, false>(v); stage16<1, false>(v); }
    else { stage16<1, true>(v); stage16<2, true>(v); stage16<4, true>(v); stage16<8, true>(v); }
}
__device__ __forceinline__ constexpr int br4(int r) { return ((r & 1) << 3) | ((r & 2) << 1) | ((r & 4) >> 1) | ((r & 8) >> 3); }
template <bool INV, int LSL> __device__ __forceinline__ void pass16(LAS cf* buf, int tid, cf wbase) {
    constexpr int SH = LSL - 4, st = 1 << SH;
    asm volatile("" : "+v"(tid));
    const int sub = tid >> SH, n2 = tid & (st - 1), base = (sub << LSL) + n2;
    cf v[16];
#pragma unroll
    for (int r = 0; r < 16; ++r) v[r] = buf[pidx(base + r * st)];
    cf wp[16];
    wp[1] = wbase;
    asm volatile("" : "+v"(wp[1].x), "+v"(wp[1].y));
    wp[2] = cmul(wp[1], wp[1]); wp[4] = cmul(wp[2], wp[2]); wp[8] = cmul(wp[4], wp[4]);
    wp[3] = cmul(wp[2], wp[1]); wp[5] = cmul(wp[4], wp[1]); wp[6] = cmul(wp[4], wp[2]); wp[7] = cmul(wp[4], wp[3]);
    wp[9] = cmul(wp[8], wp[1]); wp[10] = cmul(wp[8], wp[2]); wp[11] = cmul(wp[8], wp[3]); wp[12] = cmul(wp[8], wp[4]);
    wp[13] = cmul(wp[8], wp[5]); wp[14] = cmul(wp[8], wp[6]); wp[15] = cmul(wp[8], wp[7]);
    if (!INV) {
        dft16<false>(v);
#pragma unroll
        for (int r = 1; r < 16; ++r) v[r] = cmul(v[r], wp[br4(r)]);
    } else {
#pragma unroll
        for (int r = 1; r < 16; ++r) v[r] = cmulc(v[r], wp[br4(r)]);
        dft16<true>(v);
    }
#pragma unroll
    for (int r = 0; r < 16; ++r) buf[pidx(base + r * st)] = v[r];
}
template <bool MUL> __device__ __forceinline__ void mid2(LAS cf* D, const LAS cf* Hs, int tid) {
    asm volatile("" : "+v"(tid));
#pragma unroll
    for (int e = 0; e < 8; ++e) { const int i = 16 * tid + 2 * e; const cf a = D[pidx(i)], b = D[pidx(i + 1)]; cf A = cadd(a, b), B = csub(a, b);
        if (MUL) { A = cmul(A, Hs[pidx(i)]); B = cmul(B, Hs[pidx(i + 1)]); D[pidx(i)] = cadd(A, B); D[pidx(i + 1)] = csub(A, B); }
        else { D[pidx(i)] = A; D[pidx(i + 1)] = B; } }
}
#define HY_SYNC() __syncthreads()
__device__ __forceinline__ void fft_unit(LAS unsigned char* lds, int c, int tid, const float* __restrict__ HFT_l, const cf* __restrict__ TW, const bf16_t* __restrict__ ZT, const bf16_t* __restrict__ X0T,
                                         bf16_t* __restrict__ YCT, float bias) {
    asm volatile("" : "+v"(tid));
    LAS cf* D = (LAS cf*)lds; LAS cf* Hs = D + FBUF;
    const float* hsrc = HFT_l + (size_t)c * 8192;
    const cf w13 = TW[tid & 511], w9 = TW[(tid & 31) << 4], w5 = TW[(tid & 1) << 8];
    float hv[16]; bf16_t za[8], zb[8], xa[8], xb[8], zna[8], znb[8];
#pragma unroll
    for (int k = 0; k < 16; ++k) hv[k] = hsrc[k * 512 + tid];
    {   const size_t o0 = (size_t)c * SL, o1 = ((size_t)DC + c) * SL;
#pragma unroll
        for (int k = 0; k < 8; ++k) { za[k] = ZT[o0 + k * 512 + tid]; zb[k] = ZT[o1 + k * 512 + tid]; } }
#pragma unroll
    for (int k = 0; k < 16; ++k) Hs[pidx(k * 512 + tid)] = cf{hv[k], 0.f};
    HY_SYNC();
    pass16<false, 13>(Hs, tid, w13); HY_SYNC();
    pass16<false, 9>(Hs, tid, w9); HY_SYNC();
    pass16<false, 5>(Hs, tid, w5); HY_SYNC();
    mid2<false>(Hs, Hs, tid); HY_SYNC();
#pragma unroll
    for (int pr = 0; pr < 2; ++pr) {
        const size_t o0 = ((size_t)(2 * pr) * DC + c) * SL, o1 = ((size_t)(2 * pr + 1) * DC + c) * SL;
#pragma unroll
        for (int k = 0; k < 8; ++k) { const int i = k * 512 + tid; D[pidx(i)] = cf{bf2f(za[k]), bf2f(zb[k])}; D[pidx(i + 4096)] = cf{0.f, 0.f}; }
#pragma unroll
        for (int k = 0; k < 8; ++k) { xa[k] = X0T[o0 + k * 512 + tid]; xb[k] = X0T[o1 + k * 512 + tid]; }
        if (pr == 0) { const size_t n0 = ((size_t)2 * DC + c) * SL, n1 = ((size_t)3 * DC + c) * SL;
#pragma unroll
            for (int k = 0; k < 8; ++k) { zna[k] = ZT[n0 + k * 512 + tid]; znb[k] = ZT[n1 + k * 512 + tid]; } }
        HY_SYNC();
        pass16<false, 13>(D, tid, w13); HY_SYNC();
        pass16<false, 9>(D, tid, w9); HY_SYNC();
        pass16<false, 5>(D, tid, w5); HY_SYNC();
        mid2<true>(D, Hs, tid); HY_SYNC();
        pass16<true, 5>(D, tid, w5); HY_SYNC();
        pass16<true, 9>(D, tid, w9); HY_SYNC();
        pass16<true, 13>(D, tid, w13); HY_SYNC();
#pragma unroll
        for (int k = 0; k < 8; ++k) { const int i = k * 512 + tid; const cf y = D[pidx(i)];
            YCT[o0 + i] = (bf16_t)f2bf((y.x * (1.f / 8192.f) + bf2f(za[k]) * bias) * bf2f(xa[k])); YCT[o1 + i] = (bf16_t)f2bf((y.y * (1.f / 8192.f) + bf2f(zb[k]) * bias) * bf2f(xb[k])); }
        if (pr == 0) {
#pragma unroll
            for (int k = 0; k < 8; ++k) { za[k] = zna[k]; zb[k] = znb[k]; } }
        HY_SYNC();
    }
}
__device__ __forceinline__ float at_blo(unsigned u) { return __builtin_bit_cast(float, u << 16); }
__device__ __forceinline__ float at_bhi(unsigned u) { return __builtin_bit_cast(float, u & 0xffff0000u); }
constexpr int HP_ROWB = 1540;
__device__ __forceinline__ void hyprep_unit(LAS unsigned char* lds, int unit, int tid, const bf16_t* __restrict__ P, const bf16_t* __restrict__ SLAB, const float* __restrict__ cw, const float* __restrict__ cb,
                                            bf16_t* __restrict__ ZT, bf16_t* __restrict__ X0T) {
    asm volatile("" : "+v"(tid));
    const int b = unit >> 6, t0 = (unit & 63) * 64; const size_t m0 = (size_t)b * SL + t0;
    LAS float* CWL = (LAS float*)(lds + 101648);
    __syncthreads();
#pragma unroll
    for (int hb = 0; hb < 2; ++hb) { uint4 sv[7];
#pragma unroll
        for (int q = 0; q < 7; ++q) { const int i = tid + (hb * 7 + q) * NTHREADS, r = i / 96, ch8 = i % 96, t = t0 - 1 + r; const bool inb = (i < 66 * 96) && t >= 0 && t < SL;
            sv[q] = *(const uint4*)(P + (inb ? ((m0 + r - 1) * DINP + P_CU + ch8 * 8) : (m0 * DINP + P_CU))); if (!inb) sv[q] = make_uint4(0u, 0u, 0u, 0u); }
#pragma unroll
        for (int q = 0; q < 7; ++q) { const int i = tid + (hb * 7 + q) * NTHREADS, r = i / 96, ch8 = i % 96;
            if (i < 66 * 96 && ch8 < 80) { LAS unsigned* d = (LAS unsigned*)(lds + r * HP_ROWB + ch8 * 16); d[0] = sv[q].x; d[1] = sv[q].y; d[2] = sv[q].z; d[3] = sv[q].w; } } }
    {
        uint4 sl[3][4];
#pragma unroll
        for (int q = 0; q < 3; ++q) { const int i = tid + q * NTHREADS, r = i >> 4, c8 = i & 15, t = t0 - 1 + r; const bool inb = (i < 66 * 16) && t >= 0 && t < SL;
            const size_t ro = inb ? ((m0 + r - 1) * 128 + c8 * 8) : (m0 * 128);
#pragma unroll
            for (int k = 0; k < 4; ++k) { sl[q][k] = *(const uint4*)(SLAB + (size_t)k * MT * 128 + ro); if (!inb) sl[q][k] = make_uint4(0u, 0u, 0u, 0u); } }
#pragma unroll
        for (int q = 0; q < 3; ++q) { const int i = tid + q * NTHREADS, r = i >> 4, c8 = i & 15;
            if (i < 66 * 16) { unsigned o[4];
                const unsigned a0[4] = {sl[q][0].x, sl[q][0].y, sl[q][0].z, sl[q][0].w}, a1[4] = {sl[q][1].x, sl[q][1].y, sl[q][1].z, sl[q][1].w}, a2[4] = {sl[q][2].x, sl[q][2].y, sl[q][2].z, sl[q][2].w}, a3[4] = {sl[q][3].x, sl[q][3].y, sl[q][3].z, sl[q][3].w};
#pragma unroll
                for (int d = 0; d < 4; ++d) o[d] = pk2((at_blo(a0[d]) + at_blo(a1[d])) + (at_blo(a2[d]) + at_blo(a3[d])), (at_bhi(a0[d]) + at_bhi(a1[d])) + (at_bhi(a2[d]) + at_bhi(a3[d])));
                LAS unsigned* dd = (LAS unsigned*)(lds + r * HP_ROWB + (80 + c8) * 16); dd[0] = o[0]; dd[1] = o[1]; dd[2] = o[2]; dd[3] = o[3]; } } }
    {   float cv[6];
#pragma unroll
        for (int q = 0; q < 6; ++q) { const int i = tid + q * NTHREADS; cv[q] = (i < 3 * 768) ? cw[i] : cb[i - 3 * 768]; }
#pragma unroll
        for (int q = 0; q < 6; ++q) CWL[tid + q * NTHREADS] = cv[q]; }
    __syncthreads();
    const int tok = tid & 63, wv = tid >> 6;
    for (int j = 0; j < 32; ++j) { const int c = wv * 32 + j; float u[3];
#pragma unroll
        for (int part = 0; part < 3; ++part) { const int ch = part * DC + c; float a = CWL[3 * 768 + ch];
#pragma unroll
            for (int k = 0; k < 3; ++k) a += CWL[k * 768 + ch] * bf2f(*(const LAS bf16_t*)(lds + (tok + k) * HP_ROWB + ch * 2));
            u[part] = a; }
        const size_t o = ((size_t)b * DC + c) * SL + t0 + tok;
        ZT[o] = (bf16_t)f2bf(u[2] * u[1]); X0T[o] = (bf16_t)f2bf(u[0]); }
    __syncthreads();
}
__device__ __forceinline__ void filter_unit(LAS unsigned char* lds, int tb, int tid, const float* __restrict__ w1, const float* __restrict__ b1, const float* __restrict__ freq,
                                            const float* __restrict__ w2, const float* __restrict__ b2, const float* __restrict__ w3, float* __restrict__ HFT_l) {
    asm volatile("" : "+v"(tid));
    LAS float* Z = (LAS float*)lds;
    LAS float* H1T = Z + 32 * 36;
    LAS float* H2T = H1T + 64 * 32;
    const int t0 = tb * 32;
    __syncthreads();
    {   const int pos = tid >> 4, f = tid & 15, t = t0 + pos;
        const float fb = (float)(1e-4 + (double)f * ((15.0 - 1e-4) / 15.0)), w = 6.283185307179586f * (float)t * (1.0f / (float)SL);
        float sn, cs; sincosf(fb * w, &sn, &cs);
        Z[pos * 36 + 1 + f] = cs; Z[pos * 36 + 17 + f] = -sn;
        if (f == 0) Z[pos * 36] = (float)((double)t / (double)(SL - 1)); }
    __syncthreads();
    {   const int j = tid & 63; const float fj = freq[j], bj = b1[j];
#pragma unroll
        for (int q = 0; q < 4; ++q) { const int pos = (tid >> 6) + 8 * q; float a = bj;
#pragma unroll 11
            for (int i = 0; i < HY_EMB; ++i) a += Z[pos * 36 + i] * w1[i * HY_W + j];
            H1T[j * 32 + pos] = sinf(fj * a); } }
    __syncthreads();
    {   const int j = tid & 63; const float fj = freq[j], bj = b2[j];
#pragma unroll
        for (int q = 0; q < 4; ++q) { const int pos = (tid >> 6) + 8 * q; float a = bj;
#pragma unroll 16
            for (int i = 0; i < HY_W; ++i) a += H1T[i * 32 + pos] * w2[i * HY_W + j];
            H2T[j * 32 + pos] = sinf(fj * a); } }
    __syncthreads();
    {   const int o = tid, c = o & 255, dir = o >> 8;
        float acc[32];
#pragma unroll
        for (int p = 0; p < 32; ++p) acc[p] = 0.f;
#pragma unroll 16
        for (int i = 0; i < HY_W; ++i) { const float w = w3[i * 2 * DC + o];
#pragma unroll
            for (int p4 = 0; p4 < 8; ++p4) { const f32x4 h = *(const LAS f32x4*)(H2T + i * 32 + p4 * 4);
                acc[4 * p4] += h[0] * w; acc[4 * p4 + 1] += h[1] * w; acc[4 * p4 + 2] += h[2] * w; acc[4 * p4 + 3] += h[3] * w; } }
        const double mind = log(1e-2) / 1.5, maxd = log(1e-2) / 0.3;
        const float delta = fabsf((float)(mind + (maxd - mind) * (double)c / 255.0));
#pragma unroll
        for (int p = 0; p < 32; ++p) { const int t = t0 + p; const float tt = (float)((double)t / (double)(SL - 1)); acc[p] *= __builtin_amdgcn_exp2f(-1.4426950408889634f * tt * delta); }
        float* row = HFT_l + (size_t)c * 8192;
        if (dir == 0) {
#pragma unroll
            for (int p4 = 0; p4 < 8; ++p4) *(f32x4*)(row + t0 + 4 * p4) = (f32x4){acc[4 * p4], acc[4 * p4 + 1], acc[4 * p4 + 2], acc[4 * p4 + 3]};
            if (t0 == 0) row[4096] = 0.f;
        } else {
#pragma unroll
            for (int p = 0; p < 32; ++p) if (t0 + p > 0) row[8192 - t0 - p] = acc[p];
        } }
}
}

constexpr size_t WS_AO = 222 * MiB;
namespace at {
typedef short v4i16_t __attribute__((ext_vector_type(4)));
constexpr int KROW = 144, NKEY = 400, V_OFF = NKEY * KROW;
__device__ __forceinline__ float blo(unsigned u) { return __builtin_bit_cast(float, u << 16); }
__device__ __forceinline__ float bhi(unsigned u) { return __builtin_bit_cast(float, u & 0xffff0000u); }
__device__ __forceinline__ void rope16(uint4& A, uint4& B, const float* __restrict__ cs, float scale) {
    const f32x4 c0 = *(const f32x4*)cs, c1 = *(const f32x4*)(cs + 4), s0 = *(const f32x4*)(cs + 8), s1 = *(const f32x4*)(cs + 12);
    const float c[8] = {c0[0], c0[1], c0[2], c0[3], c1[0], c1[1], c1[2], c1[3]}, s[8] = {s0[0], s0[1], s0[2], s0[3], s1[0], s1[1], s1[2], s1[3]};
    unsigned a[4] = {A.x, A.y, A.z, A.w}, b[4] = {B.x, B.y, B.z, B.w};
#pragma unroll
    for (int d = 0; d < 4; ++d) {
        const float t1l = blo(a[d]), t1h = bhi(a[d]), t2l = blo(b[d]), t2h = bhi(b[d]);
        const float o1l = (t1l * c[2 * d] - t2l * s[2 * d]) * scale, o1h = (t1h * c[2 * d + 1] - t2h * s[2 * d + 1]) * scale;
        const float o2l = (t2l * c[2 * d] + t1l * s[2 * d]) * scale, o2h = (t2h * c[2 * d + 1] + t1h * s[2 * d + 1]) * scale;
        a[d] = f2bf(o1l) | (f2bf(o1h) << 16); b[d] = f2bf(o2l) | (f2bf(o2h) << 16);
    }
    A = make_uint4(a[0], a[1], a[2], a[3]); B = make_uint4(b[0], b[1], b[2], b[3]);
}
__device__ __forceinline__ void rope16s(uint4& A, uint4& B, const float (&cs)[16], float scale) {
    unsigned a[4] = {A.x, A.y, A.z, A.w}, b[4] = {B.x, B.y, B.z, B.w};
#pragma unroll
    for (int d = 0; d < 4; ++d) {
        const float t1l = blo(a[d]), t1h = bhi(a[d]), t2l = blo(b[d]), t2h = bhi(b[d]);
        const float o1l = (t1l * cs[2 * d] - t2l * cs[8 + 2 * d]) * scale, o1h = (t1h * cs[2 * d + 1] - t2h * cs[8 + 2 * d + 1]) * scale;
        const float o2l = (t2l * cs[2 * d] + t1l * cs[8 + 2 * d]) * scale, o2h = (t2h * cs[2 * d + 1] + t1h * cs[8 + 2 * d + 1]) * scale;
        a[d] = f2bf(o1l) | (f2bf(o1h) << 16); b[d] = f2bf(o2l) | (f2bf(o2h) << 16);
    }
    A = make_uint4(a[0], a[1], a[2], a[3]); B = make_uint4(b[0], b[1], b[2], b[3]);
}
__device__ __forceinline__ unsigned scale2(unsigned u, float sc) { return f2bf(blo(u) * sc) | (f2bf(bhi(u) * sc) << 16); }
__device__ __forceinline__ void attn_unit(LAS unsigned char* lds, int unit, int tid, const bf16_t* __restrict__ P, const float* __restrict__ rope, const float* __restrict__ sink_l, bf16_t* __restrict__ AO) {
    asm volatile("" : "+v"(tid));
    const int b = unit >> 6, kvh = (unit >> 5) & 1, q0 = (unit & 31) * 128, W0 = q0 - 128;
    const size_t m0 = (size_t)b * SL;
    const int lane = tid & 63, wave = __builtin_amdgcn_readfirstlane(tid >> 6), i = lane & 15, g = lane >> 4;
    __syncthreads();
    {   uint4 va[6], vb[6];
#pragma unroll
        for (int q = 0; q < 6; ++q) { const int j = tid + q * NTHREADS; const bool isV = j >= 1200; const int jj = isV ? j - 1200 : j, kk = isV ? (jj >> 2) : (jj / 3), ch = isV ? (jj & 3) : (1 + jj % 3), pos = W0 + kk;
            const bool inb = (j < 2800) && pos >= 0 && pos < SL;
            const bf16_t* src = P + (inb ? ((m0 + pos) * DINP + (isV ? P_V : P_K) + kvh * HD + ch * 16) : (m0 * DINP + P_K));
            va[q] = *(const uint4*)src; vb[q] = *(const uint4*)(src + 8); if (!inb) { va[q] = make_uint4(0u, 0u, 0u, 0u); vb[q] = va[q]; } }
        uint4 ra = make_uint4(0u, 0u, 0u, 0u), rb = ra; f32x4 rc[4];
        {   const int pos = W0 + tid; const bool inb = (tid < NKEY) && pos >= 0 && pos < SL; const int pc = inb ? pos : 0;
            const bf16_t* src = P + (m0 + pc) * DINP + P_K + kvh * HD; ra = *(const uint4*)src; rb = *(const uint4*)(src + 8);
#pragma unroll
            for (int q = 0; q < 4; ++q) rc[q] = *(const f32x4*)(rope + pc * 16 + 4 * q);
            float cs[16];
#pragma unroll
            for (int q = 0; q < 16; ++q) cs[q] = rc[q >> 2][q & 3];
            rope16s(ra, rb, cs, 1.0f);
            if (!inb) { ra = make_uint4(0u, 0u, 0u, 0u); rb = ra; } }
#pragma unroll
        for (int q = 0; q < 6; ++q) { const int j = tid + q * NTHREADS; const bool isV = j >= 1200; const int jj = isV ? j - 1200 : j, kk = isV ? (jj >> 2) : (jj / 3), ch = isV ? (jj & 3) : (1 + jj % 3);
            if (j < 2800) { LAS unsigned char* dst = lds + (isV ? V_OFF : 0) + kk * KROW + ch * 32;
                *(LAS v4u*)dst = (v4u){va[q].x, va[q].y, va[q].z, va[q].w}; *(LAS v4u*)(dst + 16) = (v4u){vb[q].x, vb[q].y, vb[q].z, vb[q].w}; } }
        if (tid < NKEY) { LAS unsigned char* dst = lds + tid * KROW; *(LAS v4u*)dst = (v4u){ra.x, ra.y, ra.z, ra.w}; *(LAS v4u*)(dst + 16) = (v4u){rb.x, rb.y, rb.z, rb.w}; }
    }
    __syncthreads();
    const bool edge = (q0 == 0) || (q0 == SL - 128);
#pragma unroll 1
    for (int gi = 0; gi < 3; ++gi) {
        const int grp = wave * 3 + gi, hl = grp >> 3, qsub = grp & 7, head = kvh * 3 + hl;
        const int tok = q0 + 16 * qsub + i;
        bf16x8 qf[2];
        {   const bf16_t* qp = P + (m0 + tok) * DINP + P_Q + head * HD + g * 8;
            uint4 own = *(const uint4*)qp, hi2 = *(const uint4*)(qp + 32);
            uint4 oth; oth.x = __shfl_xor(own.x, 16); oth.y = __shfl_xor(own.y, 16); oth.z = __shfl_xor(own.z, 16); oth.w = __shfl_xor(own.w, 16);
            uint4 t1 = (g == 0) ? own : oth, t2 = (g == 0) ? oth : own;
            rope16(t1, t2, rope + tok * 16, 0.125f);
            uint4 r0;
            if (g == 0) r0 = t1; else if (g == 1) r0 = t2; else r0 = make_uint4(scale2(own.x, 0.125f), scale2(own.y, 0.125f), scale2(own.z, 0.125f), scale2(own.w, 0.125f));
            hi2 = make_uint4(scale2(hi2.x, 0.125f), scale2(hi2.y, 0.125f), scale2(hi2.z, 0.125f), scale2(hi2.w, 0.125f));
            qf[0] = __builtin_bit_cast(bf16x8, r0); qf[1] = __builtin_bit_cast(bf16x8, hi2); }
        f32x4 st[17];
        const LAS unsigned char* kb = lds + (16 * qsub + i) * KROW + g * 16;
#pragma unroll
        for (int tt = 0; tt < 17; ++tt) {
            const bf16x8 k0 = *(const LAS bf16x8*)(kb + tt * 16 * KROW), k1 = *(const LAS bf16x8*)(kb + tt * 16 * KROW + 64);
            f32x4 acc = __builtin_amdgcn_mfma_f32_16x16x32_bf16(k0, qf[0], (f32x4){0.f, 0.f, 0.f, 0.f}, 0, 0, 0);
            st[tt] = __builtin_amdgcn_mfma_f32_16x16x32_bf16(k1, qf[1], acc, 0, 0, 0);
        }
        const float NEGF = -1e30f;
#pragma unroll
        for (int r = 0; r < 4; ++r) { if (4 * g + r < i) st[0][r] = NEGF; if (4 * g + r > i) st[16][r] = NEGF; }
        if (edge) {
#pragma unroll
            for (int tt = 0; tt < 17; ++tt)
#pragma unroll
                for (int r = 0; r < 4; ++r) { const int pos = W0 + 16 * (qsub + tt) + 4 * g + r; if (pos < 0 || pos >= SL) st[tt][r] = NEGF; }
        }
        const float sk = sink_l[head];
        float mx = sk;
#pragma unroll
        for (int tt = 0; tt < 17; ++tt) mx = fmaxf(fmaxf(mx, fmaxf(st[tt][0], st[tt][1])), fmaxf(st[tt][2], st[tt][3]));
        mx = fmaxf(mx, __shfl_xor(mx, 16)); mx = fmaxf(mx, __shfl_xor(mx, 32));
        const float L2E = 1.4426950408889634f, mb = mx * L2E;
        float lsum = 0.f;
        bf16x8 pf[9];
#pragma unroll
        for (int s = 0; s < 9; ++s) {
            float p[8];
#pragma unroll
            for (int r = 0; r < 4; ++r) { p[r] = __builtin_amdgcn_exp2f(st[2 * s][r] * L2E - mb); p[4 + r] = (2 * s + 1 < 17) ? __builtin_amdgcn_exp2f(st[(2 * s + 1 < 17) ? 2 * s + 1 : 16][r] * L2E - mb) : 0.f; }
#pragma unroll
            for (int r = 0; r < 8; ++r) lsum += p[r];
            uint4 w; w.x = pg8::cvt_pk_bf16(p[0], p[1]); w.y = pg8::cvt_pk_bf16(p[2], p[3]); w.z = pg8::cvt_pk_bf16(p[4], p[5]); w.w = pg8::cvt_pk_bf16(p[6], p[7]);
            pf[s] = __builtin_bit_cast(bf16x8, w);
        }
        lsum += __shfl_xor(lsum, 16); lsum += __shfl_xor(lsum, 32);
        lsum += __builtin_amdgcn_exp2f(sk * L2E - mb);
        const float rl = 1.0f / lsum;
        const LAS unsigned char* vb = lds + V_OFF + (16 * qsub + 4 * g + (i >> 2)) * KROW + (i & 3) * 8;
        bf16_t* op = AO + (m0 + tok) * DBB + head * HD + 4 * g;
        f32x4 o[4];
#pragma unroll
        for (int dt = 0; dt < 4; ++dt) o[dt] = (f32x4){0.f, 0.f, 0.f, 0.f};
#pragma unroll
        for (int s = 0; s < 9; ++s)
#pragma unroll
            for (int dt = 0; dt < 4; ++dt) {
                const v4i16_t lo = __builtin_amdgcn_ds_read_tr16_b64_v4i16((LAS v4i16_t*)(vb + (32 * s) * KROW + dt * 32));
                const v4i16_t hi = __builtin_amdgcn_ds_read_tr16_b64_v4i16((LAS v4i16_t*)(vb + (32 * s + 16) * KROW + dt * 32));
                const bf16x8 vf = (bf16x8){lo[0], lo[1], lo[2], lo[3], hi[0], hi[1], hi[2], hi[3]};
                o[dt] = __builtin_amdgcn_mfma_f32_16x16x32_bf16(vf, pf[s], o[dt], 0, 0, 0);
            }
#pragma unroll
        for (int dt = 0; dt < 4; ++dt) { uint2 w; w.x = pg8::cvt_pk_bf16(o[dt][0] * rl, o[dt][1] * rl); w.y = pg8::cvt_pk_bf16(o[dt][2] * rl, o[dt][3] * rl);
            *(uint2*)(op + dt * 16) = w; }
    }
}
}

constexpr size_t WS_AGG = 234 * MiB;
constexpr size_t WS_LS = WS_XG, WS_LPF = WS_XG + 12 * MiB, WS_LPB = 236 * MiB;
constexpr size_t WS_LW = WS_ROPE + 512 * 1024;
namespace lru {
constexpr int AXROW = 784, XCROW = 784, XC_OFF = 67 * AXROW, CARRY_OFF = XC_OFF + 64 * XCROW, SSQ_OFF = CARRY_OFF + 2 * DA * 4, RSTD_OFF = SSQ_OFF + 64 * 24 * 4;
__device__ __forceinline__ float fsig(float x) { return __builtin_amdgcn_rcpf(1.0f + __builtin_amdgcn_exp2f(-1.4426950408889634f * x)); }
__device__ __forceinline__ float fgelu(float x) { const float u = 0.7978845608028654f * (x + 0.044715f * x * x * x); const float e = __builtin_amdgcn_exp2f(2.8853900817779268f * u);
    const float th = 1.0f - 2.0f * __builtin_amdgcn_rcpf(1.0f + e); return 0.5f * x * (1.0f + th); }
template <int CTRL> __device__ __forceinline__ float dppf(float v) { return __builtin_bit_cast(float, __builtin_amdgcn_update_dpp(0, __builtin_bit_cast(int, v), CTRL, 0xf, 0xf, true)); }
__device__ __forceinline__ float row16_sum(float v) { v += dppf<0xB1>(v); v += dppf<0x4E>(v); v += dppf<0x141>(v); v += dppf<0x140>(v); return v; }
__device__ __forceinline__ void lru_unit(LAS unsigned char* lds, int unit, int tid, const bf16_t* __restrict__ P, const float* __restrict__ cw, const float* __restrict__ cb, const bf16_t* __restrict__ LW_l,
                                         const float* __restrict__ ba, const float* __restrict__ bx, const float* __restrict__ lam, float* __restrict__ AGG, bf16_t* __restrict__ LS, bf16_t* __restrict__ LPF, bf16_t* __restrict__ LPB) {
    asm volatile("" : "+v"(tid));
    const int b = unit >> 6, kc = unit & 63, t0 = kc * 64; const size_t m0 = (size_t)b * SL + t0;
    const int lane = tid & 63, wave = __builtin_amdgcn_readfirstlane(tid >> 6), li_ = lane & 15, g_ = lane >> 4;
    LAS unsigned char* AX = lds; LAS unsigned char* XC = lds + XC_OFF;
    __syncthreads();
    float prm[3][6];
#pragma unroll
    for (int rd = 0; rd < 3; ++rd) { const int chq = 64 * (2 * rd + (wave >> 2)) + 16 * (wave & 3) + li_;
        prm[rd][0] = ba[chq]; prm[rd][1] = ba[DA + chq]; prm[rd][2] = bx[chq]; prm[rd][3] = bx[DA + chq]; prm[rd][4] = lam[chq]; prm[rd][5] = lam[DA + chq]; }
    bf16x8 bfa[4][2], bfb[4][2];
#pragma unroll
    for (int mat = 0; mat < 4; ++mat)
#pragma unroll
        for (int ks = 0; ks < 2; ++ks) bfa[mat][ks] = *(const bf16x8*)(LW_l + ((size_t)(((wave >> 2) * 4 + mat) * 64 + 16 * (wave & 3) + li_)) * 64 + 32 * ks + 8 * g_);
    float w[4][8], bb[8];
    {   const int ch0 = (tid % 48) * 8;
#pragma unroll
        for (int e = 0; e < 8; ++e) { bb[e] = cb[ch0 + e];
#pragma unroll
            for (int k = 0; k < 4; ++k) w[k][e] = cw[k * DA + ch0 + e]; } }
    {   uint4 sv[7];
#pragma unroll
        for (int q = 0; q < 7; ++q) { const int it = tid + q * NTHREADS, r = it / 48, c8 = it % 48, t = t0 - 2 + r; const bool inb = (it < 67 * 48) && t >= 0 && t < SL;
            sv[q] = *(const uint4*)(P + (inb ? ((m0 + r - 2) * DINP + P_AX + c8 * 8) : (m0 * DINP + P_AX))); if (!inb) sv[q] = make_uint4(0u, 0u, 0u, 0u); }
#pragma unroll
        for (int q = 0; q < 7; ++q) { const int it = tid + q * NTHREADS, r = it / 48, c8 = it % 48;
            if (it < 67 * 48) *(LAS v4u*)(AX + r * AXROW + c8 * 16) = (v4u){sv[q].x, sv[q].y, sv[q].z, sv[q].w}; } }
    __syncthreads();
    if (tid < 384) { const int c8 = tid % 48, tg = tid / 48;
        for (int q = 0; q < 8; ++q) { const int tok = tg * 8 + q; float acc[8];
#pragma unroll
            for (int e = 0; e < 8; ++e) acc[e] = bb[e];
#pragma unroll
            for (int k = 0; k < 4; ++k) { const v4u v = *(const LAS v4u*)(AX + (tok + k) * AXROW + c8 * 16);
#pragma unroll
                for (int d = 0; d < 4; ++d) { acc[2 * d] += w[k][2 * d] * at::blo(v[d]); acc[2 * d + 1] += w[k][2 * d + 1] * at::bhi(v[d]); } }
            *(LAS v4u*)(XC + tok * XCROW + c8 * 16) = (v4u){pk2(acc[0], acc[1]), pk2(acc[2], acc[3]), pk2(acc[4], acc[5]), pk2(acc[6], acc[7])}; }
    }
    __syncthreads();
#pragma unroll
    for (int rd = 0; rd < 3; ++rd) {
        asm volatile("" ::: "memory"); __builtin_amdgcn_sched_barrier(0);
        int li = li_, g = g_; asm volatile("" : "+v"(li), "+v"(g));
        const int h = 2 * rd + (wave >> 2), ct = wave & 3, ch = 64 * h + 16 * ct + li;
        bf16x8 (&bfr)[4][2] = (rd & 1) ? bfb : bfa; bf16x8 (&bfn)[4][2] = (rd & 1) ? bfa : bfb;
        if (rd < 2) {
#pragma unroll
            for (int mat = 0; mat < 4; ++mat)
#pragma unroll
                for (int ks = 0; ks < 2; ++ks) bfn[mat][ks] = *(const bf16x8*)(LW_l + ((size_t)(((h + 2) * 4 + mat) * 64 + 16 * ct + li)) * 64 + 32 * ks + 8 * g); }
        f32x4 acc[4][4];
        {   bf16x8 af[4][2];
#pragma unroll
            for (int mt = 0; mt < 4; ++mt)
#pragma unroll
                for (int ks = 0; ks < 2; ++ks) af[mt][ks] = *(const LAS bf16x8*)(XC + (16 * mt + li) * XCROW + (64 * h + 32 * ks + 8 * g) * 2);
#pragma unroll
            for (int mat = 0; mat < 4; ++mat)
#pragma unroll
                for (int mt = 0; mt < 4; ++mt) { f32x4 c = __builtin_amdgcn_mfma_f32_16x16x32_bf16(af[mt][0], bfr[mat][0], (f32x4){0.f, 0.f, 0.f, 0.f}, 0, 0, 0);
                    acc[mat][mt] = __builtin_amdgcn_mfma_f32_16x16x32_bf16(af[mt][1], bfr[mat][1], c, 0, 0, 0); } }
        {
            float ban[2] = {prm[rd][0], prm[rd][1]}, bxn[2] = {prm[rd][2], prm[rd][3]}, spn[2];
#pragma unroll
            for (int n = 0; n < 2; ++n) { const float l = prm[rd][4 + n]; spn[n] = -8.0f * 1.4426950408889634f * ((-l > 20.f) ? -l : log1pf(expf(-l))); }
#pragma unroll
            for (int mt = 0; mt < 4; ++mt)
#pragma unroll
                for (int r = 0; r < 4; ++r) { const int tok = 16 * mt + 4 * g + r;
                    const float xcv = bf2f(*(const LAS bf16_t*)(XC + tok * XCROW + ch * 2));
#pragma unroll
                    for (int n = 0; n < 2; ++n) { const float rg = fsig(acc[2 * n][mt][r] + ban[n]), ig = fsig(acc[2 * n + 1][mt][r] + bxn[n]);
                        const float av = __builtin_amdgcn_exp2f(rg * spn[n]);
                        acc[2 * n][mt][r] = av; acc[2 * n + 1][mt][r] = __builtin_amdgcn_sqrtf(1.0f - av * av) * (ig * xcv); } } }
        f32x4 hs[4];
        {   float Af[4], Bf[4], Ab[4], Bb[4];
#pragma unroll
            for (int mt = 0; mt < 4; ++mt) { const f32x4 a = acc[0][mt], bb = acc[1][mt], c = acc[2][mt], d = acc[3][mt];
                Af[mt] = (a[0] * a[1]) * (a[2] * a[3]); Bf[mt] = ((bb[0] * a[1] + bb[1]) * a[2] + bb[2]) * a[3] + bb[3];
                Ab[mt] = (c[0] * c[1]) * (c[2] * c[3]); Bb[mt] = ((d[3] * c[2] + d[2]) * c[1] + d[1]) * c[0] + d[0]; }
            {   float t0[4], t1[4], t2[4], t3[4];
#pragma unroll
                for (int mt = 0; mt < 4; ++mt) { t0[mt] = __shfl_up(Af[mt], 16); t1[mt] = __shfl_up(Bf[mt], 16); t2[mt] = __shfl_down(Ab[mt], 16); t3[mt] = __shfl_down(Bb[mt], 16); }
#pragma unroll
                for (int mt = 0; mt < 4; ++mt) { if (g >= 1) { Bf[mt] = t1[mt] * Af[mt] + Bf[mt]; Af[mt] = t0[mt] * Af[mt]; } if (g <= 2) { Bb[mt] = t3[mt] * Ab[mt] + Bb[mt]; Ab[mt] = t2[mt] * Ab[mt]; } }
#pragma unroll
                for (int mt = 0; mt < 4; ++mt) { t0[mt] = __shfl_up(Af[mt], 32); t1[mt] = __shfl_up(Bf[mt], 32); t2[mt] = __shfl_down(Ab[mt], 32); t3[mt] = __shfl_down(Bb[mt], 32); }
#pragma unroll
                for (int mt = 0; mt < 4; ++mt) { if (g >= 2) { Bf[mt] = t1[mt] * Af[mt] + Bf[mt]; Af[mt] = t0[mt] * Af[mt]; } if (g <= 1) { Bb[mt] = t3[mt] * Ab[mt] + Bb[mt]; Ab[mt] = t2[mt] * Ab[mt]; } } }
            float Aef[4], Bef[4], Aeb[4], Beb[4], Atf[4], Btf[4], Atb[4], Btb[4];
#pragma unroll
            for (int mt = 0; mt < 4; ++mt) { Aef[mt] = __shfl_up(Af[mt], 16); Bef[mt] = __shfl_up(Bf[mt], 16); Aeb[mt] = __shfl_down(Ab[mt], 16); Beb[mt] = __shfl_down(Bb[mt], 16);
                Atf[mt] = __shfl(Af[mt], li + 48); Btf[mt] = __shfl(Bf[mt], li + 48); Atb[mt] = __shfl(Ab[mt], li); Btb[mt] = __shfl(Bb[mt], li); }
#pragma unroll
            for (int mt = 0; mt < 4; ++mt) { if (g == 0) { Aef[mt] = 1.f; Bef[mt] = 0.f; } if (g == 3) { Aeb[mt] = 1.f; Beb[mt] = 0.f; } }
            f32x4 pf[4], pb[4];
            {   float hin = 0.f, atot = 1.f;
#pragma unroll
                for (int mt = 0; mt < 4; ++mt) { const f32x4 a = acc[0][mt], bb = acc[1][mt]; float hh = Aef[mt] * hin + Bef[mt], pp = Aef[mt] * atot;
#pragma unroll
                    for (int r = 0; r < 4; ++r) { hh = a[r] * hh + bb[r]; hs[mt][r] = hh; pp *= a[r]; pf[mt][r] = pp; }
                    hin = Atf[mt] * hin + Btf[mt]; atot *= Atf[mt]; }
                if (g == 0) { float* ag = AGG + ((size_t)(b * 64 + kc) * 4) * DA + ch; ag[0] = atot; ag[DA] = hin; } }
            {   float hin = 0.f, atot = 1.f;
#pragma unroll
                for (int mt = 3; mt >= 0; --mt) { const f32x4 a = acc[2][mt], bb = acc[3][mt]; float hh = Aeb[mt] * hin + Beb[mt], pp = Aeb[mt] * atot;
#pragma unroll
                    for (int r = 3; r >= 0; --r) { hh = a[r] * hh + bb[r]; hs[mt][r] += hh; pp *= a[r]; pb[mt][r] = pp; }
                    hin = Atb[mt] * hin + Btb[mt]; atot *= Atb[mt]; }
                if (g == 0) { float* ag = AGG + ((size_t)(b * 64 + kc) * 4) * DA + ch; ag[2 * DA] = atot; ag[3 * DA] = hin; } }
#pragma unroll
            for (int mt = 0; mt < 4; ++mt)
#pragma unroll
                for (int r = 0; r < 4; ++r) { const size_t o = (m0 + 16 * mt + 4 * g + r) * DA + ch;
                    const unsigned w0 = pg8::cvt_pk_bf16(hs[mt][r], pf[mt][r]), w1 = pg8::cvt_pk_bf16(pb[mt][r], 0.f);
                    LS[o] = (bf16_t)(w0 & 0xffffu); LPF[o] = (bf16_t)(w0 >> 16); LPB[o] = (bf16_t)(w1 & 0xffffu); } }
    }
}
constexpr size_t WS_CIN = 248 * MiB;
__device__ __forceinline__ void carry_scan_seq(int seq, int lane, const float* __restrict__ AGG, float* __restrict__ CIN) {
    const int ch = seq % DA, dir = (seq / DA) & 1, b = seq / (2 * DA);
    const float* ag = AGG + ((size_t)(b * 64 + lane) * 4 + 2 * dir) * DA + ch;
    float A = ag[0], B = ag[DA];
    if (dir == 0) {
#pragma unroll
        for (int d = 1; d < 64; d <<= 1) { const float A1 = __shfl_up(A, d), B1 = __shfl_up(B, d); if (lane >= d) { B = B1 * A + B; A = A1 * A; } }
        float c = __shfl_up(B, 1); if (lane == 0) c = 0.f;
        CIN[((size_t)(b * 64 + lane) * 2 + 0) * DA + ch] = c;
    } else {
#pragma unroll
        for (int d = 1; d < 64; d <<= 1) { const float A1 = __shfl_down(A, d), B1 = __shfl_down(B, d); if (lane + d < 64) { B = B1 * A + B; A = A1 * A; } }
        float c = __shfl_down(B, 1); if (lane == 63) c = 0.f;
        CIN[((size_t)(b * 64 + lane) * 2 + 1) * DA + ch] = c;
    }
}
__device__ __forceinline__ void lru_fin_unit(LAS unsigned char* lds, int unit, int tid, const bf16_t* __restrict__ P, const float* __restrict__ AGG, const bf16_t* __restrict__ LS, const bf16_t* __restrict__ LPF,
                                             const bf16_t* __restrict__ LPB, const float* __restrict__ gn, bf16_t* __restrict__ YN) {
    asm volatile("" : "+v"(tid));
    const int b = unit >> 6, kc = unit & 63, t0 = kc * 64; const size_t m0 = (size_t)b * SL + t0;
    const int lane = tid & 63, wave = __builtin_amdgcn_readfirstlane(tid >> 6);
    float cf[6], cbk[6], gv[6];
#pragma unroll
    for (int j = 0; j < 3; ++j) { const int c0 = 2 * (lane + 64 * j); const float* ci = AGG + ((size_t)(b * 64 + kc) * 2) * DA + c0;
        cf[2 * j] = ci[0]; cf[2 * j + 1] = ci[1]; cbk[2 * j] = ci[DA]; cbk[2 * j + 1] = ci[DA + 1]; gv[2 * j] = gn[c0]; gv[2 * j + 1] = gn[c0 + 1]; }
#pragma unroll 4
    for (int q = 0; q < 8; ++q) { const int tok = wave * 8 + q; const size_t ro = (m0 + tok) * DA;
        const unsigned* sS = (const unsigned*)(LS + ro); const unsigned* sF = (const unsigned*)(LPF + ro); const unsigned* sB = (const unsigned*)(LPB + ro); const unsigned* sG = (const unsigned*)(P + (m0 + tok) * DINP + P_AG);
        unsigned wS[3], wF[3], wB[3], wG[3];
#pragma unroll
        for (int j = 0; j < 3; ++j) { wS[j] = sS[lane + 64 * j]; wF[j] = sF[lane + 64 * j]; wB[j] = sB[lane + 64 * j]; wG[j] = sG[lane + 64 * j]; }
        float y[6]; float ss = 0.f;
#pragma unroll
        for (int j = 0; j < 3; ++j) {
            y[2 * j] = (at::blo(wS[j]) + at::blo(wF[j]) * cf[2 * j] + at::blo(wB[j]) * cbk[2 * j]) * fgelu(at::blo(wG[j]));
            y[2 * j + 1] = (at::bhi(wS[j]) + at::bhi(wF[j]) * cf[2 * j + 1] + at::bhi(wB[j]) * cbk[2 * j + 1]) * fgelu(at::bhi(wG[j]));
            ss += y[2 * j] * y[2 * j] + y[2 * j + 1] * y[2 * j + 1]; }
#pragma unroll
        for (int o = 1; o < 64; o <<= 1) ss += __shfl_xor(ss, o);
        const float r = 1.0f / sqrtf(ss * (1.0f / DA) + EPS);
        unsigned* dst = (unsigned*)(YN + (m0 + tok) * DM);
#pragma unroll
        for (int j = 0; j < 3; ++j) dst[lane + 64 * j] = pk2(y[2 * j] * r * gv[2 * j], y[2 * j + 1] * r * gv[2 * j + 1]); }
}
}

namespace fin {
constexpr int TROW = 528;
__device__ __forceinline__ float wsum(float v) {
#pragma unroll
    for (int o = 1; o < 64; o <<= 1) v += __shfl_xor(v, o);
    return v;
}
__device__ __forceinline__ void norm_bc_unit(LAS unsigned char* lds, int unit, int tid, const bf16_t* __restrict__ AO, const bf16_t* __restrict__ YCT, const float* __restrict__ gnb, const float* __restrict__ gnc, bf16_t* __restrict__ YN) {
    asm volatile("" : "+v"(tid));
    const int b = unit >> 6, t0 = (unit & 63) * 64; const size_t m0 = (size_t)b * SL + t0;
    const int lane = tid & 63, wave = __builtin_amdgcn_readfirstlane(tid >> 6);
    __syncthreads();
    {   const int c = tid >> 1, hf = tid & 1; const bf16_t* src = YCT + ((size_t)b * DC + c) * SL + t0 + hf * 32;
#pragma unroll
        for (int q = 0; q < 4; ++q) { const uint4 v = *(const uint4*)(src + q * 8); const unsigned w[4] = {v.x, v.y, v.z, v.w};
#pragma unroll
            for (int d = 0; d < 4; ++d) { const int tok = hf * 32 + q * 8 + 2 * d;
                *(LAS bf16_t*)(lds + tok * TROW + c * 2) = (bf16_t)(w[d] & 0xffffu); *(LAS bf16_t*)(lds + (tok + 1) * TROW + c * 2) = (bf16_t)(w[d] >> 16); } } }
    {   unsigned wv[8][3];
#pragma unroll
        for (int q = 0; q < 8; ++q) { const unsigned* src = (const unsigned*)(AO + (m0 + wave * 8 + q) * DBB);
#pragma unroll
            for (int j = 0; j < 3; ++j) wv[q][j] = src[lane + 64 * j]; }
        float gb[6];
#pragma unroll
        for (int j = 0; j < 3; ++j) { const int c0 = 2 * (lane + 64 * j); gb[2 * j] = gnb[c0]; gb[2 * j + 1] = gnb[c0 + 1]; }
#pragma unroll
        for (int q = 0; q < 8; ++q) { const int tok = wave * 8 + q; float v[6]; float s = 0.f;
#pragma unroll
            for (int j = 0; j < 3; ++j) { v[2 * j] = at::blo(wv[q][j]); v[2 * j + 1] = at::bhi(wv[q][j]); s += v[2 * j] * v[2 * j] + v[2 * j + 1] * v[2 * j + 1]; }
            const float r = 1.0f / sqrtf(wsum(s) * (1.0f / DBB) + EPS);
            unsigned* dst = (unsigned*)(YN + (m0 + tok) * DM + DA);
#pragma unroll
            for (int j = 0; j < 3; ++j) dst[lane + 64 * j] = pk2(v[2 * j] * r * gb[2 * j], v[2 * j + 1] * r * gb[2 * j + 1]); } }
    __syncthreads();
    for (int q = 0; q < 8; ++q) { const int tok = wave * 8 + q; typedef unsigned u32x2v __attribute__((ext_vector_type(2))); const u32x2v w = *(const LAS u32x2v*)(lds + tok * TROW + lane * 8);
        const float v0 = at::blo(w.x), v1 = at::bhi(w.x), v2 = at::blo(w.y), v3 = at::bhi(w.y);
        const float r = 1.0f / sqrtf(wsum(v0 * v0 + v1 * v1 + v2 * v2 + v3 * v3) * (1.0f / DC) + EPS);
        const f32x4 gg = *(const f32x4*)(gnc + lane * 4);
        uint2 o; o.x = pk2(v0 * r * gg[0], v1 * r * gg[1]); o.y = pk2(v2 * r * gg[2], v3 * r * gg[3]);
        *(uint2*)(YN + (m0 + tok) * DM + DA + DBB + lane * 4) = o; }
}
}

__device__ __forceinline__ int fresh_tid() { int t = threadIdx.x; asm volatile("" : "+v"(t)); return t; }
#define FTID fresh_tid()
#define FLANE (fresh_tid() & 63)
struct Frame {
    LAS unsigned char* lds;
    volatile LAS unsigned* MISC;
    int wave, vcu, G;
};
__device__ __forceinline__ void p0_transpose_item(const float* W, int K, int N, bf16_t* WT, LAS float* scr, int item, int lane) {
    const int nblk = N / 32, kb = item / nblk, nb = item % nblk, k0 = 64 * kb, n0 = 32 * nb;
    float tv[32];
#pragma unroll
    for (int i = 0; i < 32; ++i) { const int kk = 2 * i + (lane >> 5); tv[i] = W[(size_t)(k0 + kk) * N + n0 + (lane & 31)]; }
#pragma unroll
    for (int i = 0; i < 32; ++i) { const int kk = 2 * i + (lane >> 5); scr[kk * 33 + (lane & 31)] = tv[i]; }
    LDS_WAIT(); asm volatile("" ::: "memory");
    const int c = lane & 7;
#pragma unroll
    for (int j = 0; j < 4; ++j) { const int n = (lane >> 3) + 8 * j; const LAS float* s = scr + (8 * c) * 33 + n;
        v4u o; o.x = pk2(s[0 * 33], s[1 * 33]); o.y = pk2(s[2 * 33], s[3 * 33]); o.z = pk2(s[4 * 33], s[5 * 33]); o.w = pk2(s[6 * 33], s[7 * 33]);
        *(GAS v4u*)(WT + (size_t)(n0 + n) * K + k0 + 8 * c) = o; }
    LDS_WAIT(); asm volatile("" ::: "memory");
}
__device__ __forceinline__ void xg_row(const float* xrow, const float* g, bf16_t* orow, float* ssrow, int lane) {
    const GAS f32x4* xr = (const GAS f32x4*)xrow + lane; const GAS f32x4* gr = (const GAS f32x4*)g + lane;
    f32x4 v[4]; float s = 0.f;
#pragma unroll
    for (int j = 0; j < 4; ++j) { v[j] = xr[64 * j]; s += (v[j][0] * v[j][0] + v[j][1] * v[j][1]) + (v[j][2] * v[j][2] + v[j][3] * v[j][3]); }
    s += __shfl_xor(s, 1); s += __shfl_xor(s, 2);
    if ((lane & 3) == 0) ssrow[lane >> 2] = s;
    GAS unsigned long long* o8 = (GAS unsigned long long*)orow + lane;
#pragma unroll
    for (int j = 0; j < 4; ++j) { const f32x4 gg = gr[64 * j]; o8[64 * j] = (unsigned long long)pk2(v[j][0] * gg[0], v[j][1] * gg[1]) | ((unsigned long long)pk2(v[j][2] * gg[2], v[j][3] * gg[3]) << 32); }
}
__device__ __forceinline__ void xg_rows4(const float* x, const float* g, bf16_t* XGp, float* SSp, int m, int stride, int lane) {
    f32x4 v[4][4];
#pragma unroll
    for (int q = 0; q < 4; ++q) { const int row = m + q * stride; const int rc = row < MT ? row : m; const GAS f32x4* xr = (const GAS f32x4*)(x + (size_t)rc * DM) + lane;
#pragma unroll
        for (int j = 0; j < 4; ++j) v[q][j] = xr[64 * j]; }
    const GAS f32x4* gr = (const GAS f32x4*)g + lane; f32x4 gg[4];
#pragma unroll
    for (int j = 0; j < 4; ++j) gg[j] = gr[64 * j];
#pragma unroll
    for (int q = 0; q < 4; ++q) { const int row = m + q * stride; if (row < MT) { float s = 0.f;
#pragma unroll
        for (int j = 0; j < 4; ++j) s += (v[q][j][0] * v[q][j][0] + v[q][j][1] * v[q][j][1]) + (v[q][j][2] * v[q][j][2] + v[q][j][3] * v[q][j][3]);
        s += __shfl_xor(s, 1); s += __shfl_xor(s, 2);
        if ((lane & 3) == 0) SSp[(size_t)row * 16 + (lane >> 2)] = s;
        GAS unsigned long long* o8 = (GAS unsigned long long*)(XGp + (size_t)row * DM) + lane;
#pragma unroll
        for (int j = 0; j < 4; ++j) o8[64 * j] = (unsigned long long)pk2(v[q][j][0] * gg[j][0], v[q][j][1] * gg[j][1]) | ((unsigned long long)pk2(v[q][j][2] * gg[j][2], v[q][j][3] * gg[j][3]) << 32); } }
}
__device__ __forceinline__ void final_row(const float* xrow, const float* g, const float* SS, int row, float* orow, int lane) {
    const GAS f32x4* xr = (const GAS f32x4*)xrow + lane; const GAS f32x4* gr = (const GAS f32x4*)g + lane; GAS f32x4* o = (GAS f32x4*)orow + lane;
    const float r = pg8::rstd16(SS, row);
#pragma unroll
    for (int j = 0; j < 4; ++j) { const f32x4 v = xr[64 * j], gg = gr[64 * j]; o[64 * j] = v * gg * r; }
}

template <int I> __device__ __forceinline__ const float* in_ptr() {
    unsigned long long v;
    asm volatile("s_load_dwordx2 %0, %1, %2\n\ts_waitcnt lgkmcnt(0)" : "=s"(v) : "s"(__builtin_amdgcn_kernarg_segment_ptr()), "n"(I * 8) : "memory");
    return (const float*)v;
}
#define INP(i) in_ptr<i>()
__device__ __forceinline__ void final_rows4(float* X, const float* g, const float* SS, int m, int stride, int lane) {
    f32x4 v[4][4]; float r[4];
#pragma unroll
    for (int q = 0; q < 4; ++q) { const int row = m + q * stride; const int rc = row < MT ? row : m; const GAS f32x4* xr = (const GAS f32x4*)(X + (size_t)rc * DM) + lane;
#pragma unroll
        for (int j = 0; j < 4; ++j) v[q][j] = xr[64 * j];
        r[q] = pg8::rstd16(SS, rc); }
    const GAS f32x4* gr = (const GAS f32x4*)g + lane; f32x4 gg[4];
#pragma unroll
    for (int j = 0; j < 4; ++j) gg[j] = gr[64 * j];
#pragma unroll
    for (int q = 0; q < 4; ++q) { const int row = m + q * stride; if (row < MT) { GAS f32x4* o = (GAS f32x4*)(X + (size_t)row * DM) + lane;
#pragma unroll
        for (int j = 0; j < 4; ++j) o[64 * j] = v[q][j] * gg[j] * r[q]; } }
}
struct Args { const float* in[28]; float* out; unsigned char* ws; int ph_lo, ph_hi, li, pad; };

#define ws ((unsigned char*)in_ptr<29>())
#define XR ((float*)in_ptr<28>())
#define XRB ((bf16_t*)in_ptr<28>())
#define Win_t ((bf16_t*)(ws + WS_WIN))
#define Wout_t ((bf16_t*)(ws + WS_WOUT))
#define Wup_t ((bf16_t*)(ws + WS_WUP))
#define Wdn_t ((bf16_t*)(ws + WS_WDN))
#define XG ((bf16_t*)(ws + WS_XG))
#define P ((bf16_t*)(ws + WS_P))
#define YN ((bf16_t*)(ws + WS_YN))
#define HB ((bf16_t*)(ws + WS_H))
#define SS ((float*)(ws + WS_SS))
__global__ void __launch_bounds__(NTHREADS, 2) mega(Args args) {
    extern __shared__ __attribute__((aligned(16))) unsigned char lds[];
    Frame F;
    F.lds = (LAS unsigned char*)lds; F.MISC = (volatile LAS unsigned*)(F.lds + MISC_OFF);
    F.wave = __builtin_amdgcn_readfirstlane((int)threadIdx.x >> 6);
    F.G = gridDim.x; { const int bx = blockIdx.x; F.vcu = (F.G % 8 == 0) ? (bx % 8) * (F.G / 8) + bx / 8 : bx; }
    gu32* ctl = (gu32*)(ws + WS_CTL);
    for (int u = threadIdx.x; u < (LDS_BYTES - MISC_OFF) / 4; u += NTHREADS) ((LAS unsigned*)(F.lds + MISC_OFF))[u] = 0u;
    __syncthreads();
    const int lo = args.ph_lo, hi = args.ph_hi;
    XcdBarrier bar; bar.bar = (unsigned*)(ctl + CW_BAR) + args.li * XCD_BAR_WORDS; bar.x = 0; bar.st = nullptr;
    if (hi - lo > 1) bar = xcd_barrier_post((unsigned*)(ctl + CW_BAR) + args.li * XCD_BAR_WORDS, F.MISC + 8);

    const int gw = F.vcu * NWAVES + F.wave, NGW = F.G * NWAVES;

#define IN(k) (lo <= (k) && (k) < hi)
#ifdef TPROBE
#define TSTAMP(i) do { if (blockIdx.x == 0 && threadIdx.x == 0) ((unsigned long long*)(ws + WS_CTL + 512 * 1024))[i] = __builtin_amdgcn_s_memrealtime(); } while (0)
#else
#define TSTAMP(i)
#endif
#define SEAM(k) do { if (IN(k) && IN((k) + 1)) { xcd_barrier(bar); TSTAMP((k) + 1); } } while (0)
    TSTAMP(0);
    if (IN(PH_PRO)) {
        auto jobT = [&]() __attribute__((always_inline)) {
        LAS float* scr = (LAS float*)(F.lds + RING_OFF + F.wave * 16384);
        constexpr int I_IN = (DM / 64) * (DIN / 32), I_OUT = (DM / 64) * (DM / 32), I_UP = (DM / 64) * (DFF / 32), I_DN = (DFF / 64) * (DM / 32), I_L = I_IN + I_OUT + I_UP + I_DN;
        for (int it = gw; it < DEPTH * I_L; it += NGW) {
            const int l = it / I_L; int r = it % I_L;
            if (r < I_IN) { p0_transpose_item(INP(2) + (size_t)l * DM * DIN, DM, DIN, Win_t + (size_t)l * DINP * DM, scr, r, FLANE); continue; } r -= I_IN;
            if (r < I_OUT) { p0_transpose_item(INP(23) + (size_t)l * DM * DM, DM, DM, Wout_t + (size_t)l * DM * DM, scr, r, FLANE); continue; } r -= I_OUT;
            if (r < I_UP) { p0_transpose_item(INP(25) + (size_t)l * DM * DFF, DM, DFF, Wup_t + (size_t)l * DFF * DM, scr, r, FLANE); continue; } r -= I_UP;
            p0_transpose_item(INP(26) + (size_t)l * DFF * DM, DFF, DM, Wdn_t + (size_t)l * DM * DFF, scr, r, FLANE);
        }
        for (int i = blockIdx.x * NTHREADS + FTID; i < DEPTH * 16384; i += F.G * NTHREADS) { const int l = i >> 14, r = i & 16383;
            *(GAS v4u*)((GAS unsigned char*)(Win_t + (size_t)l * DINP * DM + (size_t)DIN * DM) + (size_t)r * 16) = (v4u){0u, 0u, 0u, 0u}; }
        {
            float* TWf = (float*)(ws + WS_TW); float* rope = (float*)(ws + WS_ROPE);
            for (int i = blockIdx.x * NTHREADS + FTID; i < 8192; i += F.G * NTHREADS) { const double a = 6.283185307179586476925286766559 * (double)i / 8192.0; TWf[2 * i] = (float)cos(a); TWf[2 * i + 1] = (float)(-sin(a)); }
            for (int i = blockIdx.x * NTHREADS + FTID; i < SL * 8; i += F.G * NTHREADS) { const int pos = i >> 3, j = i & 7; const double ang = (double)pos * pow(500000.0, -(double)j / 8.0);
                rope[pos * 16 + j] = (float)cos(ang); rope[pos * 16 + 8 + j] = (float)sin(ang); }
        }
        {
            bf16_t* LW = (bf16_t*)(ws + WS_LW); const float* wa = INP(5); const float* wx = INP(7);
            for (int o = blockIdx.x * NTHREADS + FTID; o < DEPTH * LRU_BLK * 4 * 64 * 64; o += F.G * NTHREADS) {
                const int i = o & 63, j = (o >> 6) & 63, mat = (o >> 12) & 3, lh = o >> 14, h = lh % LRU_BLK, l = lh / LRU_BLK, n = mat >> 1;
                const float* src = (mat & 1) ? wx : wa;
                LW[o] = (bf16_t)f2bf(src[((((size_t)l * 2 + n) * LRU_BLK + h) * 64 + i) * 64 + j]); }
        }
        };
        auto jobF = [&]() __attribute__((always_inline)) {
        {
            const float* w1 = INP(13); const float* b1 = INP(14); const float* fq = INP(15); const float* w2 = INP(16); const float* b2 = INP(17); const float* w3 = INP(18);
            for (int u = F.vcu; u < DEPTH * 128; u += F.G) { const int l = u >> 7;
                hy::filter_unit(F.lds, u & 127, FTID, w1 + (size_t)l * HY_EMB * HY_W, b1 + l * HY_W, fq + l * HY_W, w2 + (size_t)l * HY_W * HY_W, b2 + l * HY_W, w3 + (size_t)l * HY_W * 2 * DC,
                                (float*)(ws + WS_HF) + (size_t)l * DC * 8192); }
            __syncthreads();
        }
        };
        auto jobX = [&]() __attribute__((always_inline)) {
        { const float* x0 = INP(0); const float* g0 = INP(1);
          for (int m = gw; m < MT; m += 4 * NGW) xg_rows4(x0, g0, XG, SS, m, NGW, FLANE); }
        };
        if (blockIdx.x & 1) { jobF(); jobT(); jobX(); } else { jobT(); jobX(); jobF(); }
    }
    SEAM(PH_PRO);
#define WIN_BODY(l) { \
        pg8::Gemm g{XG, Win_t + (size_t)(l) * DINP * DM, MT, 2048, DM, DM}; pg8::StaticOrder S; S.init(MT, 2048, F.G, (int)blockIdx.x); \
        pg8::EpiScaleBf16<0> E{P, DINP, SS}; \
        pg8::gemm_phase<pg8::EpiScaleBf16<0>, pg8::StaticOrder, true, true>(F.lds + RING_OFF, g, S, E); \
          \
        { const int c = (int)blockIdx.x, q = c & 3; \
          pg8::Gemm g2{XG + q * 256, Win_t + (size_t)(l) * DINP * DM + (size_t)2048 * DM + q * 256, MT, 256, 256, DM}; \
          pg8::QuarterOrder S2{c >> 2, F.G}; pg8::EpiSlab E2{(bf16_t*)(ws + WS_SLAB) + (size_t)q * MT * 128, SS}; \
          pg8::gemm_phase<pg8::EpiSlab, pg8::QuarterOrder, false, true>(F.lds + RING_OFF, g2, S2, E2); } }
#define MIX1_HYP(l) { const float* cw = INP(11) + (l) * 9 * DC; const float* cb = INP(12) + (l) * 3 * DC; \
        for (int u = F.vcu; u < 256; u += F.G) hy::hyprep_unit(F.lds, u, FTID, P, (const bf16_t*)(ws + WS_SLAB), cw, cb, (bf16_t*)(ws + WS_ZT), (bf16_t*)(ws + WS_X0T)); }
#define MIX1_LRU(l) { const float* cwa = INP(3) + (l) * 4 * DA; const float* cba = INP(4) + (l) * DA; const float* ba = INP(6) + (l) * 2 * DA; const float* bx = INP(8) + (l) * 2 * DA; const float* lam = INP(9) + (l) * 2 * DA; \
          for (int u = F.vcu; u < 256; u += F.G) lru::lru_unit(F.lds, u, FTID, P, cwa, cba, (const bf16_t*)(ws + WS_LW) + (size_t)(l) * LRU_BLK * 4 * 4096, ba, bx, lam, (float*)(ws + WS_AGG), (bf16_t*)(ws + WS_LS), (bf16_t*)(ws + WS_LPF), (bf16_t*)(ws + WS_LPB)); }
#define MIX1_ATT(l) { const float* sk = INP(10) + (l) * NQH; \
          for (int u = F.vcu; u < 256; u += F.G) at::attn_unit(F.lds, u, FTID, P, (const float*)(ws + WS_ROPE), sk, (bf16_t*)(ws + WS_AO)); }
#define MIX1_BODY(l) { const int rot = (int)(blockIdx.x >> 3) % 3; \
        if (rot == 0) { MIX1_HYP(l) MIX1_LRU(l) MIX1_ATT(l) } else if (rot == 1) { MIX1_LRU(l) MIX1_ATT(l) MIX1_HYP(l) } else { MIX1_ATT(l) MIX1_HYP(l) MIX1_LRU(l) } }
#define FFT_BODY(l) { const float* hb = INP(19) + (l) * DC; \
        for (int sq = gw; sq < NB * 2 * DA; sq += NGW) lru::carry_scan_seq(sq, FLANE, (const float*)(ws + WS_AGG), (float*)(ws + lru::WS_CIN)); \
        for (int u = F.vcu; u < DC; u += F.G) hy::fft_unit(F.lds, u, FTID, (const float*)(ws + WS_HF) + (size_t)(l) * DC * 8192, (const hy::cf*)(ws + WS_TW), (const bf16_t*)(ws + WS_ZT), (const bf16_t*)(ws + WS_X0T), \
                                                           (bf16_t*)(ws + WS_YCT), hb[u]); }
#define FIN_LRU(l) { const float* gna = INP(20) + (l) * DA; \
          for (int u = F.vcu; u < 256; u += F.G) lru::lru_fin_unit(F.lds, u, FTID, P, (const float*)(ws + lru::WS_CIN), (const bf16_t*)(ws + WS_LS), (const bf16_t*)(ws + WS_LPF), (const bf16_t*)(ws + WS_LPB), gna, YN); }
#define FIN_NBC(l) { const float* gnb = INP(21) + (l) * DBB; const float* gnc = INP(22) + (l) * DC; \
          for (int u = F.vcu; u < 256; u += F.G) fin::norm_bc_unit(F.lds, u, FTID, (const bf16_t*)(ws + WS_AO), (const bf16_t*)(ws + WS_YCT), gnb, gnc, YN); }
#define FIN_BODY(l) { if ((blockIdx.x >> 3) & 1) { FIN_NBC(l) FIN_LRU(l) } else { FIN_LRU(l) FIN_NBC(l) } }
#define WUP_BODY(l) { \
        pg8::Gemm g{XG, Wup_t + (size_t)(l) * DFF * DM, MT, DFF, DM, DM}; pg8::StaticOrder S; S.init(MT, DFF, F.G, (int)blockIdx.x); \
        pg8::EpiScaleBf16<1> E{HB, DFF, SS}; \
        pg8::gemm_phase<pg8::EpiScaleBf16<1>, pg8::StaticOrder, true, true>(F.lds + RING_OFF, g, S, E); }
#define LAYER(l) do { constexpr int pb = 1 + PH_PER_LAYER * (l); \
    if (IN(pb + PL_WIN)) { WIN_BODY(l) } \
    SEAM(pb + PL_WIN); \
    if (IN(pb + PL_MIX1)) { MIX1_BODY(l) } \
    SEAM(pb + PL_MIX1); \
    if (IN(pb + PL_FFT)) { FFT_BODY(l) } \
    SEAM(pb + PL_FFT); \
    if (IN(pb + PL_FIN)) { FIN_BODY(l) } \
    SEAM(pb + PL_FIN); \
    if (IN(pb + PL_WOUT)) { \
        pg8::Gemm g{YN, Wout_t + (size_t)(l) * DM * DM, MT, DM, DM, DM}; pg8::StaticOrder S; S.init(MT, DM, F.G, (int)blockIdx.x); \
        if ((l) == 0) { pg8::EpiResB<true> E{(const void*)INP(0), XRB, XG, INP(24) + (l) * DM, SS}; \
            pg8::gemm_phase<pg8::EpiResB<true>, pg8::StaticOrder, true, true>(F.lds + RING_OFF, g, S, E); } \
        else { pg8::EpiResB<false> E{(const void*)XRB, XRB, XG, INP(24) + (l) * DM, SS}; \
            pg8::gemm_phase<pg8::EpiResB<false>, pg8::StaticOrder, true, true>(F.lds + RING_OFF, g, S, E); } } \
    SEAM(pb + PL_WOUT); \
    if (IN(pb + PL_WUP)) { WUP_BODY(l) } \
    SEAM(pb + PL_WUP); \
    if (IN(pb + PL_WDN)) { \
        pg8::Gemm g{HB, Wdn_t + (size_t)(l) * DM * DFF, MT, DM, DFF, DFF}; pg8::StaticOrder S; S.init(MT, DM, F.G, (int)blockIdx.x); \
        pg8::EpiResB<false> E{(const void*)XRB, ((l) + 1 < DEPTH) ? XRB : XG  , ((l) + 1 < DEPTH) ? XG : (bf16_t*)nullptr, INP(1) + (((l) + 1 < DEPTH) ? ((l) + 1) * DM : 0), SS}; \
        pg8::gemm_phase<pg8::EpiResB<false>, pg8::StaticOrder, true, true>(F.lds + RING_OFF, g, S, E); } \
    SEAM(pb + PL_WDN); } while (0)
    LAYER(0);
    LAYER(1);
    if (IN(PH_FINAL)) { const float* gf = INP(27);
        const GAS f32x4* gr = (const GAS f32x4*)gf; const int ln = FLANE;
        f32x4 gg[4];
#pragma unroll
        for (int j = 0; j < 2; ++j) { gg[2 * j] = gr[2 * ln + 128 * j]; gg[2 * j + 1] = gr[2 * ln + 128 * j + 1]; }
        for (int m = gw; m < MT; m += 4 * NGW) { v4u xv[4][2]; float rr[4];
#pragma unroll
            for (int q = 0; q < 4; ++q) { const int row = m + q * NGW; const int rc = row < MT ? row : m; const v4u* src = (const v4u*)(XG + (size_t)rc * DM) + ln;
                xv[q][0] = src[0]; xv[q][1] = src[64]; rr[q] = pg8::rstd16(SS, rc); }
#pragma unroll
            for (int q = 0; q < 4; ++q) { const int row = m + q * NGW; if (row < MT) { GAS f32x4* o = (GAS f32x4*)(XR + (size_t)row * DM);
#pragma unroll
                for (int j = 0; j < 2; ++j) { const v4u w = xv[q][j];
                    const f32x4 a = (f32x4){pg8::bflo(w.x), pg8::bfhi(w.x), pg8::bflo(w.y), pg8::bfhi(w.y)}, c = (f32x4){pg8::bflo(w.z), pg8::bfhi(w.z), pg8::bflo(w.w), pg8::bfhi(w.w)};
                    o[2 * ln + 128 * j] = a * gg[2 * j] * rr[q]; o[2 * ln + 128 * j + 1] = c * gg[2 * j + 1] * rr[q]; } } } }
#ifdef TPROBE
        {   const unsigned long long* T = (const unsigned long long*)(ws + WS_CTL + 512 * 1024);
            const float d2 = (TPROBE == 102) ? ((float)(T[15] - T[0]) * 0.01f - 1000.f) * 0.002f : (TPROBE == 101) ? (float)(__builtin_amdgcn_s_memrealtime() - T[15]) * 0.0001f : (TPROBE >= 100) ? (float)(T[15] - T[0]) * 0.00001f : (float)(T[(TPROBE % 100) + 1] - T[TPROBE % 100]) * 0.0001f;
            asm volatile("s_waitcnt vmcnt(0)" ::: "memory");
            if (gw == 0 && FLANE == 0) XR[0] += d2; }
#endif
    }
#undef IN
#undef SEAM
#undef LAYER
}

#undef ws
#undef XR
#undef Win_t
#undef Wout_t
#undef Wup_t
#undef Wdn_t
#undef XG
#undef P
#undef YN
#undef HB
#undef SS
static int g_grid = 0, g_li = 0;
static void launch_mega(Args a, int lo, int hi, hipStream_t stream) {
    a.ph_lo = lo; a.ph_hi = hi; a.li = (hi - lo > 1) ? g_li++ : 0;
    void* kargs[] = {&a};
    hipLaunchCooperativeKernel((const void*)mega, dim3(g_grid), dim3(NTHREADS), kargs, LDS_BYTES, stream);
}
extern "C" void kernel_launch(void* const* d_in, const int* in_sizes, int n_in, void* d_out, int out_size, void* d_ws, size_t ws_size, hipStream_t stream) {
    if (n_in != 28 || ws_size < WS_END) return;
    if (g_grid == 0) {
        int dev = 0, cus = 0, per_cu = 0;
        hipGetDevice(&dev); hipDeviceGetAttribute(&cus, hipDeviceAttributeMultiprocessorCount, dev);
        hipFuncSetAttribute((const void*)mega, hipFuncAttributeMaxDynamicSharedMemorySize, LDS_BYTES);
        hipOccupancyMaxActiveBlocksPerMultiprocessor(&per_cu, (const void*)mega, NTHREADS, LDS_BYTES);
        (void)hipGetLastError();
        if (per_cu < 1) per_cu = 1;
        if (per_cu > 1) per_cu = 1;
        g_grid = cus * per_cu;
    }
    g_li = 0;
    unsigned char* ws = (unsigned char*)d_ws;
    hipMemsetAsync(ws + WS_CTL, 0, 64 * 1024, stream);
    Args a{};
    for (int i = 0; i < 28; ++i) a.in[i] = (const float*)d_in[i];
    a.out = (float*)d_out; a.ws = ws;

    launch_mega(a, 0, NPH, stream);
}
```

```cpp
#include <hip/hip_runtime.h>
#include <stdint.h>
#include <math.h>

typedef unsigned short bf16_t;
typedef short bf16x8 __attribute__((ext_vector_type(8)));
typedef float f32x4 __attribute__((ext_vector_type(4)));

constexpr int NB = 4, SL = 4096, DM = 1024, MT = NB * SL, DEPTH = 2;
constexpr int DA = 384, DBB = 384, DC = 256, HD = 64, NQH = 6, NKVH = 2, DIN = 2176, DINP = 2304, DFF = 4096;
constexpr int P_AX = 0, P_AG = 384, P_Q = 768, P_K = 1152, P_V = 1280, P_CU = 1408;
constexpr int LRU_BLK = 6, LRU_BW = 64, WIN = 128, HY_EMB = 33, HY_W = 64;
constexpr float EPS = 1e-6f;

constexpr size_t MiB = 1u << 20;
constexpr size_t WS_WIN = 0;
constexpr size_t WS_WOUT = 9 * MiB;
constexpr size_t WS_WUP = 13 * MiB;
constexpr size_t WS_WDN = 29 * MiB;
constexpr size_t WS_ROPE = 45 * MiB;
constexpr size_t WS_HF = 46 * MiB;
constexpr size_t WS_XG = 62 * MiB;
constexpr size_t WS_BIG = 94 * MiB;
constexpr size_t WS_H = WS_BIG;
constexpr size_t WS_P = WS_BIG;
constexpr size_t WS_YN = WS_BIG + 72 * MiB;
constexpr size_t WS_SCR = WS_BIG + 104 * MiB;
constexpr size_t WS_CTL = 254 * MiB;
constexpr size_t WS_SS = 255 * MiB;
constexpr size_t WS_END = 256 * MiB;

__device__ __forceinline__ unsigned f2bf(float f) { unsigned u = __builtin_bit_cast(unsigned, f); return (u + 0x7fffu + ((u >> 16) & 1u)) >> 16; }
__device__ __forceinline__ float bf2f(bf16_t h) { return __builtin_bit_cast(float, (unsigned)h << 16); }
namespace pg8 {
#define PG8_LAS __attribute__((address_space(3)))
typedef unsigned short bf16_t;
typedef short bf16x8 __attribute__((ext_vector_type(8)));
typedef float f32x4 __attribute__((ext_vector_type(4)));
typedef unsigned u32x4 __attribute__((ext_vector_type(4)));
constexpr int BM = 256, BK = 64, HALF = 128, HTB = HALF * BK * 2  , STAGE_BYTES = 8 * HTB, NXCD = 8, WGM = 8;

__host__ __device__ __forceinline__ int lds_byte(int r, int c) { const int st = (r >> 4) * 2 + (c >> 5), rr = r & 15, cc = c & 31, ob = rr * 64 + cc * 2; return st * 1024 + (ob ^ (((ob >> 9) & 1) << 5)); }
__host__ __device__ __forceinline__ void stage_rc(int b, int& R, int& C) { const int st = b / 1024, sb = b % 1024, swz = sb ^ (((sb >> 9) & 1) << 5); R = (st >> 1) * 16 + swz / 64; C = (st & 1) * 32 + (swz % 64) / 2; }
__host__ __device__ __forceinline__ int perm32(int rho) { const int n = rho >> 4, i = rho & 15; return 8 * (i >> 2) + 4 * n + (i & 3); }

struct Unit { int pm, pn; };
struct Gemm { const bf16_t* A; const bf16_t* Bt; int M, N, K, ld; };

struct StaticOrder {
    int nM, nN, nwg, G, c, wgm;
    __host__ __device__ void init(int M, int N, int G_, int c_, int wgm_ = 8) { nM = M / BM; nN = N / BM; nwg = nM * nN; G = G_; c = c_; wgm = wgm_; }
    __host__ __device__ bool next(int i, Unit& u) const {
        const long L = (long)i * G + c; if (L >= nwg) return false;
        int wgid = (int)L; { const int q = nwg / NXCD, r = nwg % NXCD, xcd = wgid % NXCD, off = wgid / NXCD; wgid = (xcd < r ? xcd * (q + 1) : r * (q + 1) + (xcd - r) * q) + off; }
        const int nig = wgm * nN, gid = wgid / nig, fm = gid * wgm, gsz = (nM - fm) < wgm ? (nM - fm) : wgm;
        u.pm = fm + ((wgid % nig) % gsz); u.pn = (wgid % nig) / gsz; return true;
    }
    __device__ __forceinline__ void a_ready(const Unit&) const {}
    __device__ __forceinline__ void done(const Unit&) const {}
};

__device__ __forceinline__ unsigned cvt_pk_bf16(float lo, float hi) { unsigned r; asm volatile("v_cvt_pk_bf16_f32 %0, %1, %2" : "=v"(r) : "v"(lo), "v"(hi)); return r; }

constexpr int E_DM = 1024, E_DINP = 2304, E_DFF = 4096; constexpr float E_EPS = 1e-6f;
__device__ __forceinline__ float rstd16(const float* SS, int row) {
    const f32x4* p = (const f32x4*)(SS + (size_t)row * 16); const f32x4 a = (p[0] + p[1]) + (p[2] + p[3]);
    return 1.0f / sqrtf(((a[0] + a[1]) + (a[2] + a[3])) * (1.0f / E_DM) + E_EPS);
}
template <int ACT> struct EpiScaleBf16 {
    static constexpr bool PERM = true, AFTER_DRAIN = false;
    bf16_t* O; int ldc; const float* SS;
    __device__ __forceinline__ void operator()(const f32x4 (&acc)[2][2][4][2], const Unit& u, int wr, int wc, int fr, int fq) const {
        const int row0 = u.pm * BM + wr * 64 + fr, col0 = u.pn * BM + wc * 32 + 8 * fq;
        float rs[2][4];
        {   f32x4 p[2][4];
#pragma unroll
            for (int ai = 0; ai < 2; ++ai) { const f32x4* src = (const f32x4*)(SS + (size_t)(row0 + ai * HALF + fq * 16) * 16);
#pragma unroll
                for (int q = 0; q < 4; ++q) p[ai][q] = src[q]; }
            float mine[2];
#pragma unroll
            for (int ai = 0; ai < 2; ++ai) { const f32x4 a = (p[ai][0] + p[ai][1]) + (p[ai][2] + p[ai][3]); mine[ai] = 1.0f / sqrtf(((a[0] + a[1]) + (a[2] + a[3])) * (1.0f / E_DM) + E_EPS); }
#pragma unroll
            for (int ai = 0; ai < 2; ++ai)
#pragma unroll
                for (int m = 0; m < 4; ++m) rs[ai][m] = __shfl(mine[ai], fr + 16 * m); }
#pragma unroll
        for (int ai = 0; ai < 2; ++ai)
#pragma unroll
            for (int m = 0; m < 4; ++m) { const int row = row0 + ai * HALF + m * 16; const float r = rs[ai][m]; bf16_t* rowp = O + (size_t)row * ldc + col0;
#pragma unroll
                for (int bj = 0; bj < 2; ++bj) { f32x4 v0 = acc[ai][bj][m][0] * r, v1 = acc[ai][bj][m][1] * r;
                    if (ACT == 1) {
#pragma unroll
                        for (int i = 0; i < 4; ++i) { const float a = fmaxf(v0[i], 0.f), b = fmaxf(v1[i], 0.f); v0[i] = a * a; v1[i] = b * b; } }
                    u32x4 w; w.x = cvt_pk_bf16(v0[0], v0[1]); w.y = cvt_pk_bf16(v0[2], v0[3]); w.z = cvt_pk_bf16(v1[0], v1[1]); w.w = cvt_pk_bf16(v1[2], v1[3]);
                    *(u32x4*)(rowp + bj * HALF) = w; } }
    }
};
struct QuarterOrder { int pm0, G;
    __device__ __forceinline__ bool next(int i, Unit& u) const { const int pm = pm0 + i * (G >> 2); if (pm >= 64) return false; u.pm = pm; u.pn = 0; return true; }
    __device__ __forceinline__ void a_ready(const Unit&) const {}
    __device__ __forceinline__ void done(const Unit&) const {} };
struct EpiSlab {
    static constexpr bool PERM = true, AFTER_DRAIN = false;
    bf16_t* S; const float* SS;
    __device__ __forceinline__ void operator()(const f32x4 (&acc)[2][2][4][2], const Unit& u, int wr, int wc, int fr, int fq) const {
        const int row0 = u.pm * BM + wr * 64 + fr, col0 = wc * 32 + 8 * fq;
        float rs[2][4];
        {   f32x4 p[2][4];
#pragma unroll
            for (int ai = 0; ai < 2; ++ai) { const f32x4* src = (const f32x4*)(SS + (size_t)(row0 + ai * HALF + fq * 16) * 16);
#pragma unroll
                for (int q = 0; q < 4; ++q) p[ai][q] = src[q]; }
            float mine[2];
#pragma unroll
            for (int ai = 0; ai < 2; ++ai) { const f32x4 a = (p[ai][0] + p[ai][1]) + (p[ai][2] + p[ai][3]); mine[ai] = 1.0f / sqrtf(((a[0] + a[1]) + (a[2] + a[3])) * (1.0f / E_DM) + E_EPS); }
#pragma unroll
            for (int ai = 0; ai < 2; ++ai)
#pragma unroll
                for (int m = 0; m < 4; ++m) rs[ai][m] = __shfl(mine[ai], fr + 16 * m); }
#pragma unroll
        for (int ai = 0; ai < 2; ++ai)
#pragma unroll
            for (int m = 0; m < 4; ++m) { const int row = row0 + ai * HALF + m * 16; const float r = rs[ai][m];
                const f32x4 v0 = acc[ai][0][m][0] * r, v1 = acc[ai][0][m][1] * r;
                u32x4 w; w.x = cvt_pk_bf16(v0[0], v0[1]); w.y = cvt_pk_bf16(v0[2], v0[3]); w.z = cvt_pk_bf16(v1[0], v1[1]); w.w = cvt_pk_bf16(v1[2], v1[3]);
                *(u32x4*)(S + (size_t)row * 128 + col0) = w; }
    }
};
__device__ __forceinline__ float bflo(unsigned u) { return __builtin_bit_cast(float, u << 16); }
__device__ __forceinline__ float bfhi(unsigned u) { return __builtin_bit_cast(float, u & 0xffff0000u); }
template <bool BASEF32> struct EpiResB {
    static constexpr bool PERM = true, AFTER_DRAIN = false;
    const void* base; bf16_t* out; bf16_t* XG; const float* g; float* SS;
    __device__ __forceinline__ void operator()(const f32x4 (&acc)[2][2][4][2], const Unit& u, int wr, int wc, int fr, int fq) const {
        const int row0 = u.pm * BM + wr * 64 + fr, col0 = u.pn * BM + wc * 32 + 8 * fq;
        f32x4 gv[2][2];
#pragma unroll
        for (int bj = 0; bj < 2; ++bj)
#pragma unroll
            for (int n = 0; n < 2; ++n) gv[bj][n] = XG ? *(const f32x4*)(g + col0 + bj * HALF + 4 * n) : (f32x4){0.f, 0.f, 0.f, 0.f};
        if (!BASEF32) {
            u32x4 bw[2][4][2];
#pragma unroll
            for (int ai = 0; ai < 2; ++ai)
#pragma unroll
                for (int m = 0; m < 4; ++m)
#pragma unroll
                    for (int bj = 0; bj < 2; ++bj) bw[ai][m][bj] = *(const u32x4*)((const bf16_t*)base + (size_t)(row0 + ai * HALF + m * 16) * E_DM + col0 + bj * HALF);
#pragma unroll
            for (int ai = 0; ai < 2; ++ai)
#pragma unroll
                for (int m = 0; m < 4; ++m) { const int row = row0 + ai * HALF + m * 16; const size_t off = (size_t)row * E_DM + col0; float s = 0.f;
#pragma unroll
                    for (int bj = 0; bj < 2; ++bj) { const u32x4 w = bw[ai][m][bj];
                        const f32x4 v0 = (f32x4){bflo(w.x), bfhi(w.x), bflo(w.y), bfhi(w.y)} + acc[ai][bj][m][0], v1 = (f32x4){bflo(w.z), bfhi(w.z), bflo(w.w), bfhi(w.w)} + acc[ai][bj][m][1];
                        u32x4 o; o.x = cvt_pk_bf16(v0[0], v0[1]); o.y = cvt_pk_bf16(v0[2], v0[3]); o.z = cvt_pk_bf16(v1[0], v1[1]); o.w = cvt_pk_bf16(v1[2], v1[3]);
                        *(u32x4*)(out + off + bj * HALF) = o;
                        s += ((v0[0] * v0[0] + v0[1] * v0[1]) + (v0[2] * v0[2] + v0[3] * v0[3])) + ((v1[0] * v1[0] + v1[1] * v1[1]) + (v1[2] * v1[2] + v1[3] * v1[3]));
                        if (XG) { const f32x4 x0 = v0 * gv[bj][0], x1 = v1 * gv[bj][1]; u32x4 q; q.x = cvt_pk_bf16(x0[0], x0[1]); q.y = cvt_pk_bf16(x0[2], x0[3]); q.z = cvt_pk_bf16(x1[0], x1[1]); q.w = cvt_pk_bf16(x1[2], x1[3]);
                            *(u32x4*)(XG + off + bj * HALF) = q; } }
                    s += __shfl_xor(s, 16); s += __shfl_xor(s, 32);
                    if (fq == 0) SS[(size_t)row * 16 + u.pn * 4 + wc] = s; }
        } else {
#pragma unroll
            for (int ai = 0; ai < 2; ++ai)
#pragma unroll
                for (int m = 0; m < 4; ++m) { const int row = row0 + ai * HALF + m * 16; const size_t off = (size_t)row * E_DM + col0; float s = 0.f;
#pragma unroll
                    for (int bj = 0; bj < 2; ++bj) { const f32x4 b0 = *(const f32x4*)((const float*)base + off + bj * HALF), b1 = *(const f32x4*)((const float*)base + off + bj * HALF + 4);
                        const f32x4 v0 = b0 + acc[ai][bj][m][0], v1 = b1 + acc[ai][bj][m][1];
                        u32x4 o; o.x = cvt_pk_bf16(v0[0], v0[1]); o.y = cvt_pk_bf16(v0[2], v0[3]); o.z = cvt_pk_bf16(v1[0], v1[1]); o.w = cvt_pk_bf16(v1[2], v1[3]);
                        *(u32x4*)(out + off + bj * HALF) = o;
                        s += ((v0[0] * v0[0] + v0[1] * v0[1]) + (v0[2] * v0[2] + v0[3] * v0[3])) + ((v1[0] * v1[0] + v1[1] * v1[1]) + (v1[2] * v1[2] + v1[3] * v1[3]));
                        if (XG) { const f32x4 x0 = v0 * gv[bj][0], x1 = v1 * gv[bj][1]; u32x4 q; q.x = cvt_pk_bf16(x0[0], x0[1]); q.y = cvt_pk_bf16(x0[2], x0[3]); q.z = cvt_pk_bf16(x1[0], x1[1]); q.w = cvt_pk_bf16(x1[2], x1[3]);
                            *(u32x4*)(XG + off + bj * HALF) = q; } }
                    s += __shfl_xor(s, 16); s += __shfl_xor(s, 32);
                    if (fq == 0) SS[(size_t)row * 16 + u.pn * 4 + wc] = s;
                    if (m & 1) asm volatile("" ::: "memory"); }
        }
    }
};

template <class Epi, class Sched, bool ALIGN_EPI = false, bool SP2 = false>
__device__ __forceinline__ void gemm_phase(PG8_LAS unsigned char* lds, const Gemm g, const Sched& S, const Epi& E) {
    const int tid = threadIdx.x, wid = __builtin_amdgcn_readfirstlane(tid >> 6), lane = tid & 63, wr = wid >> 2, wc = wid & 3, fr = lane & 15, fq = lane >> 4;
    const int K = g.ld, nt = g.K / BK;
    unsigned voffA[2], voffB[2];
#pragma unroll
    for (int i = 0; i < 2; ++i) { int R, C; stage_rc(tid * 16 + i * 8192, R, C); const int Rb = Epi::PERM ? ((R & ~31) + perm32(R & 31)) : R;
        voffA[i] = (unsigned)(R * K + C) * 2u; voffB[i] = (unsigned)(Rb * K + C) * 2u; }
    const size_t kstep = (size_t)(BK * 2);
    const size_t hstep = (size_t)HALF * K * 2;
    const size_t tstep = 2 * hstep;
    const unsigned ldsw = (unsigned)wid * 1024u;
    const int aoff = lds_byte(wr * 64 + fr, fq * 8), boff = lds_byte(wc * 32 + fr, fq * 8);
#define PG8_SA(b, h) (((b) * 2 + (h)) * HTB)
#define PG8_SB(b, h) ((4 + (b) * 2 + (h)) * HTB)
#define PG8_STAGE(bufoff, gbase, voff) do { _Pragma("unroll") for (int _i = 0; _i < 2; ++_i) \
        __builtin_amdgcn_global_load_lds((const unsigned*)((const char*)(gbase) + (voff)[_i]), (PG8_LAS unsigned*)(lds + (bufoff) + ldsw + _i * 8192), 16, 0, 0); } while (0)
#define PG8_LDA(dst, b, h) do { _Pragma("unroll") for (int m = 0; m < 4; ++m) _Pragma("unroll") for (int k = 0; k < 2; ++k) dst[m][k] = *(const PG8_LAS bf16x8*)(lds + PG8_SA(b, h) + aoff + m * 2048 + k * 1024); } while (0)
#define PG8_LDB(dst, b, h) do { _Pragma("unroll") for (int n = 0; n < 2; ++n) _Pragma("unroll") for (int k = 0; k < 2; ++k) dst[n][k] = *(const PG8_LAS bf16x8*)(lds + PG8_SB(b, h) + boff + n * 2048 + k * 1024); } while (0)
#define PG8_MMA(ai, bj, At, Bt) do { __builtin_amdgcn_s_setprio(1); _Pragma("unroll") for (int m = 0; m < 4; ++m) _Pragma("unroll") for (int n = 0; n < 2; ++n) _Pragma("unroll") for (int k = 0; k < 2; ++k) \
        acc[ai][bj][m][n] = __builtin_amdgcn_mfma_f32_16x16x32_bf16(Bt[n][k], At[m][k], acc[ai][bj][m][n], 0, 0, 0); __builtin_amdgcn_s_setprio(0); } while (0)
#define PG8_WAIT_V(n) asm volatile("s_waitcnt vmcnt(" #n ")" ::: "memory")
#define PG8_WAIT_L(n) asm volatile("s_waitcnt lgkmcnt(" #n ")" ::: "memory")
#define PG8_BAR __builtin_amdgcn_s_barrier()
#define PG8_SCHED __builtin_amdgcn_sched_barrier(0)
    Unit cur, nxt; int ui = 0;
    if (!S.next(0, cur)) return;
    f32x4 acc[2][2][4][2];
#pragma unroll
    for (int a = 0; a < 2; ++a)
#pragma unroll
        for (int b = 0; b < 2; ++b)
#pragma unroll
            for (int m = 0; m < 4; ++m)
#pragma unroll
                for (int n = 0; n < 2; ++n) acc[a][b][m][n] = (f32x4){0.f, 0.f, 0.f, 0.f};
    bf16x8 At[4][2], B0[2][2], B1[2][2];
    const char* cA = (const char*)g.A + (size_t)cur.pm * tstep; const char* cB = (const char*)g.Bt + (size_t)cur.pn * tstep;
    S.a_ready(cur);
    if constexpr (SP2) {
        PG8_STAGE(PG8_SB(0, 0), cB, voffB); PG8_STAGE(PG8_SB(0, 1), cB + hstep, voffB); PG8_STAGE(PG8_SA(0, 0), cA, voffA); PG8_STAGE(PG8_SA(0, 1), cA + hstep, voffA);
        if (wr == 1) PG8_BAR;
        PG8_WAIT_V(2); PG8_BAR;
        PG8_STAGE(PG8_SB(1, 0), cB + kstep, voffB); PG8_STAGE(PG8_SA(1, 0), cA + kstep, voffA); PG8_STAGE(PG8_SB(1, 1), cB + hstep + kstep, voffB);
        PG8_WAIT_V(6); PG8_BAR;
    } else {
        PG8_STAGE(PG8_SB(0, 0), cB, voffB); PG8_STAGE(PG8_SA(0, 0), cA, voffA); PG8_STAGE(PG8_SB(0, 1), cB + hstep, voffB); PG8_STAGE(PG8_SA(0, 1), cA + hstep, voffA);
        if (wr == 1) PG8_BAR;
        PG8_WAIT_V(4); PG8_BAR;
        PG8_STAGE(PG8_SB(1, 0), cB + kstep, voffB); PG8_STAGE(PG8_SA(1, 0), cA + kstep, voffA); PG8_STAGE(PG8_SB(1, 1), cB + hstep + kstep, voffB);
        PG8_WAIT_V(6); PG8_BAR;
    }
    for (;;) {
        const bool has_next = S.next(ui + 1, nxt);
        const char* nA = has_next ? (const char*)g.A + (size_t)nxt.pm * tstep : cA; const char* nB = has_next ? (const char*)g.Bt + (size_t)nxt.pn * tstep : cB;
        for (int t = 0; t < nt; t += 2) {
            const bool last = (t == nt - 2);
            const char* a1 = cA + (size_t)(t + 1) * kstep;
            const char* a2 = last ? nA : cA + (size_t)(t + 2) * kstep; const char* b2 = last ? nB : cB + (size_t)(t + 2) * kstep;
            const char* a3 = a2 + kstep; const char* b3 = b2 + kstep;
            if (last && has_next) S.a_ready(nxt);
            if constexpr (SP2) {
            PG8_LDB(B0, 0, 0); PG8_LDB(B1, 0, 1); PG8_SCHED; PG8_LDA(At, 0, 0); PG8_STAGE(PG8_SA(1, 1), a1 + hstep, voffA);
            PG8_WAIT_V(8); PG8_WAIT_L(0); PG8_BAR; PG8_MMA(0, 0, At, B0); PG8_MMA(0, 1, At, B1); PG8_BAR; PG8_SCHED;
            PG8_LDA(At, 0, 1); PG8_STAGE(PG8_SB(0, 0), b2, voffB); PG8_STAGE(PG8_SB(0, 1), b2 + hstep, voffB); PG8_STAGE(PG8_SA(0, 0), a2, voffA);
            PG8_WAIT_V(8); PG8_WAIT_L(0); PG8_BAR; PG8_MMA(1, 0, At, B0); PG8_MMA(1, 1, At, B1); PG8_BAR; PG8_SCHED;
            PG8_LDB(B0, 1, 0); PG8_LDB(B1, 1, 1); PG8_SCHED; PG8_LDA(At, 1, 0); PG8_STAGE(PG8_SA(0, 1), a2 + hstep, voffA);
            PG8_WAIT_V(8); PG8_WAIT_L(0); PG8_BAR; PG8_MMA(0, 0, At, B0); PG8_MMA(0, 1, At, B1); PG8_BAR; PG8_SCHED;
            PG8_LDA(At, 1, 1); PG8_STAGE(PG8_SB(1, 0), b3, voffB); PG8_STAGE(PG8_SB(1, 1), b3 + hstep, voffB); PG8_STAGE(PG8_SA(1, 0), a3, voffA);
            PG8_WAIT_V(8); PG8_WAIT_L(0); PG8_BAR; PG8_MMA(1, 0, At, B0); PG8_MMA(1, 1, At, B1); PG8_BAR; PG8_SCHED;
            } else {
            PG8_LDB(B0, 0, 0); PG8_SCHED; PG8_LDA(At, 0, 0); PG8_STAGE(PG8_SA(1, 1), a1 + hstep, voffA);
            PG8_WAIT_L(8); PG8_BAR; PG8_WAIT_L(0); PG8_MMA(0, 0, At, B0); PG8_BAR; PG8_SCHED;
            PG8_LDB(B1, 0, 1); PG8_STAGE(PG8_SB(0, 0), b2, voffB);
            PG8_BAR; PG8_WAIT_L(0); PG8_MMA(0, 1, At, B1); PG8_BAR;
            PG8_LDA(At, 0, 1); PG8_STAGE(PG8_SA(0, 0), a2, voffA);
            PG8_BAR; PG8_WAIT_L(0); PG8_MMA(1, 0, At, B0); PG8_BAR; PG8_SCHED;
            PG8_STAGE(PG8_SB(0, 1), b2 + hstep, voffB);
            PG8_WAIT_V(6); PG8_BAR; PG8_MMA(1, 1, At, B1); PG8_BAR;
            PG8_LDB(B0, 1, 0); PG8_SCHED; PG8_LDA(At, 1, 0); PG8_STAGE(PG8_SA(0, 1), a2 + hstep, voffA);
            PG8_WAIT_L(8); PG8_BAR; PG8_WAIT_L(0); PG8_MMA(0, 0, At, B0); PG8_BAR; PG8_SCHED;
            PG8_LDB(B1, 1, 1); PG8_STAGE(PG8_SB(1, 0), b3, voffB);
            PG8_BAR; PG8_WAIT_L(0); PG8_MMA(0, 1, At, B1); PG8_BAR;
            PG8_LDA(At, 1, 1); PG8_STAGE(PG8_SA(1, 0), a3, voffA);
            PG8_BAR; PG8_WAIT_L(0); PG8_MMA(1, 0, At, B0); PG8_BAR; PG8_SCHED;
            PG8_STAGE(PG8_SB(1, 1), b3 + hstep, voffB);
            PG8_WAIT_V(6); PG8_BAR; PG8_MMA(1, 1, At, B1); PG8_BAR;
            }
        }
        if constexpr (ALIGN_EPI) { if (wr == 0) PG8_BAR; }
        if constexpr (!Epi::AFTER_DRAIN) { E(acc, cur, wr, wc, fr, fq); S.done(cur); }
        if (!has_next) break;
#pragma unroll
        for (int a = 0; a < 2; ++a)
#pragma unroll
            for (int b = 0; b < 2; ++b)
#pragma unroll
                for (int m = 0; m < 4; ++m)
#pragma unroll
                    for (int n = 0; n < 2; ++n) acc[a][b][m][n] = (f32x4){0.f, 0.f, 0.f, 0.f};
        cur = nxt; cA = nA; cB = nB; ++ui;
        if constexpr (ALIGN_EPI) { if (wr == 1) PG8_BAR; }
    }
    PG8_WAIT_V(0);
    if constexpr (!ALIGN_EPI) { if (wr == 0) PG8_BAR; }
    PG8_BAR;
    if constexpr (Epi::AFTER_DRAIN) { E.fused(acc, cur, wr, wc, fr, fq, lds, wid, lane); S.done(cur); }
#undef PG8_SA
#undef PG8_SB
#undef PG8_STAGE
#undef PG8_LDA
#undef PG8_LDB
#undef PG8_MMA
#undef PG8_WAIT_V
#undef PG8_WAIT_L
#undef PG8_BAR
#undef PG8_SCHED
}
}

#ifndef WGM_IN
#define WGM_IN 8
#endif
#ifndef WGM_OUT
#define WGM_OUT 8
#endif
#ifndef WGM_UP
#define WGM_UP 4
#endif
#ifndef WGM_DN
#define WGM_DN 4
#endif
constexpr int NWAVES = 8, NTHREADS = 512;
constexpr int LDS_BYTES = 163840;
constexpr int RING_OFF = 0, RING_BYTES = 131072;
constexpr int MISC_OFF = LDS_BYTES - 256;
constexpr int PH_PRO = 0, PH_PER_LAYER = 7, PH_FINAL = 1 + PH_PER_LAYER * DEPTH, NPH = PH_FINAL + 1;
constexpr int PL_WIN = 0, PL_MIX1 = 1, PL_FFT = 2, PL_FIN = 3, PL_WOUT = 4, PL_WUP = 5, PL_WDN = 6;
constexpr int CW_BAR = 4096, N_BAR_REG = 12;

#define GAS __attribute__((address_space(1)))
#define LAS __attribute__((address_space(3)))
typedef unsigned v4u __attribute__((ext_vector_type(4)));
typedef GAS unsigned gu32;
#define RLX_AGENT __ATOMIC_RELAXED, __HIP_MEMORY_SCOPE_AGENT
#define LDS_WAIT() asm volatile("s_waitcnt lgkmcnt(0)" ::: "memory")
#define VM_WAIT() asm volatile("s_waitcnt vmcnt(0)" ::: "memory")
__device__ __forceinline__ unsigned pk2(float lo, float hi) { return f2bf(lo) | (f2bf(hi) << 16); }

#define XB_TMO      128
#define XB_XCNT(j)  (256  + 64 * (j))
#define XB_XSUB(j)  (1280 + 64 * (j))
#define XB_XGEN(j)  (2304 + 64 * (j))
#define XB_TOP      3328
#define XB_TOPGEN   3392
#define XCD_BAR_WORDS 3456
#define XB_SPIN_CAP (1u << 18)

__device__ __forceinline__ unsigned xb_ld(unsigned* p)              { return __hip_atomic_load(p, __ATOMIC_RELAXED, __HIP_MEMORY_SCOPE_AGENT); }
__device__ __forceinline__ unsigned xb_add(unsigned* p, unsigned v) { return __hip_atomic_fetch_add(p, v, __ATOMIC_RELAXED, __HIP_MEMORY_SCOPE_AGENT); }
__device__ __forceinline__ unsigned xb_xcc_id() { return (unsigned)__builtin_amdgcn_s_getreg((3 << 11) | 20) & 0xFu; }
#define XB_SPIN(cond, bar) do { unsigned _sp = 0; while (cond) { __builtin_amdgcn_s_sleep(1); \
    if ((++_sp & 255u) == 0u) { if (xb_ld(&(bar)[XB_TMO])) break; if (_sp > XB_SPIN_CAP) { atomicAdd(&(bar)[XB_TMO], 1u); break; } } } } while (0)

struct XcdBarrier {
    unsigned* bar; unsigned x;
    volatile LAS unsigned* st;
};

__device__ __forceinline__ XcdBarrier xcd_barrier_post(unsigned* bar, volatile LAS unsigned* st) {
    XcdBarrier b; b.bar = bar; b.x = xb_xcc_id(); b.st = st;
    if (threadIdx.x == 0) (void)xb_add(&bar[XB_XCNT(b.x)], 1u);
    return b;
}
__device__ __forceinline__ void xcd_barrier_complete(unsigned* bar, unsigned x, unsigned& nloc, unsigned& nx) {
    const unsigned G = gridDim.x * gridDim.y * gridDim.z;
    unsigned sum, cnt, mine, sp = 0u;
    for (;;) {
        sum = 0u; cnt = 0u; mine = 0u;
#pragma unroll
        for (unsigned j = 0; j < 16; ++j) { const unsigned c = xb_ld(&bar[XB_XCNT(j)]); sum += c; cnt += (c > 0u) ? 1u : 0u; mine = (j == x) ? c : mine; }
        if (sum == G) break;
        __builtin_amdgcn_s_sleep(1);
        if ((++sp & 255u) == 0u) { if (xb_ld(&bar[XB_TMO])) break; if (sp > XB_SPIN_CAP) { atomicAdd(&bar[XB_TMO], 1u); break; } }
    }
    nloc = mine > 0u ? mine : 1u; nx = cnt > 0u ? cnt : 1u;
}

__device__ __forceinline__ void xcd_barrier(const XcdBarrier& b) {
    asm volatile("s_waitcnt vmcnt(0)" ::: "memory");
    __syncthreads();
    if (threadIdx.x == 0) {
        unsigned* bar = b.bar;
        __builtin_amdgcn_s_waitcnt(0);
        unsigned nloc = b.st[0], nx = b.st[1];
        if (nloc == 0u) { xcd_barrier_complete(bar, b.x, nloc, nx); b.st[0] = nloc; b.st[1] = nx; }
        const unsigned old = xb_add(&bar[XB_XSUB(b.x)], 1u);
        const unsigned gen = old / nloc;
        if (old + 1u == (gen + 1u) * nloc) {
            __builtin_amdgcn_fence(__ATOMIC_RELEASE, "agent");
            asm volatile("s_waitcnt vmcnt(0)" ::: "memory");
            const unsigned og = xb_add(&bar[XB_TOP], 1u);
            const unsigned tg = og / nx;
            if (og + 1u == (tg + 1u) * nx) xb_add(&bar[XB_TOPGEN], 1u);
            else XB_SPIN(xb_ld(&bar[XB_TOPGEN]) == tg, bar);
            __builtin_amdgcn_fence(__ATOMIC_ACQUIRE, "agent");
            xb_add(&bar[XB_XGEN(b.x)], 1u);
            asm volatile("s_waitcnt vmcnt(0)" ::: "memory");
        } else {
            XB_SPIN(xb_ld(&bar[XB_XGEN(b.x)]) == gen, bar);
            __builtin_amdgcn_fence(__ATOMIC_ACQUIRE, "agent");
            asm volatile("s_waitcnt vmcnt(0)" ::: "memory");
        }
    }
    __syncthreads();
}

constexpr size_t WS_SLAB = WS_YN;
constexpr size_t WS_ZT = WS_SCR, WS_X0T = WS_SCR + 8 * MiB, WS_YCT = WS_SCR + 16 * MiB;
constexpr size_t WS_TW = WS_ROPE + 256 * 1024;
namespace hy {
typedef float cf __attribute__((ext_vector_type(2)));
__device__ __forceinline__ cf cmul(cf a, cf b) { return {a.x * b.x - a.y * b.y, a.x * b.y + a.y * b.x}; }
__device__ __forceinline__ cf cmulc(cf a, cf b) { return {a.x * b.x + a.y * b.y, a.y * b.x - a.x * b.y}; }
__device__ __forceinline__ cf cadd(cf a, cf b) { return {a.x + b.x, a.y + b.y}; }
__device__ __forceinline__ cf csub(cf a, cf b) { return {a.x - b.x, a.y - b.y}; }
__device__ __forceinline__ int pidx(int i) { return i + (i >> 5); }
constexpr int FBUF = 8192 + 256;
template <bool INV> __device__ __forceinline__ cf tw16(cf d, int K) {
    float c, s;
    switch (K) {
        case 0: return d;
        case 4: return INV ? cf{-d.y, d.x} : cf{d.y, -d.x};
        case 1: c = 0.92387953251128674f; s = 0.38268343236508977f; break;
        case 2: c = 0.70710678118654752f; s = 0.70710678118654752f; break;
        case 3: c = 0.38268343236508977f; s = 0.92387953251128674f; break;
        case 5: c = -0.38268343236508977f; s = 0.92387953251128674f; break;
        case 6: c = -0.70710678118654752f; s = 0.70710678118654752f; break;
        default: c = -0.92387953251128674f; s = 0.38268343236508977f; break;
    }
    const cf w = {c, INV ? s : -s};
    return cmul(d, w);
}
template <int H, bool INV> __device__ __forceinline__ void stage16(cf (&v)[16]) {
#pragma unroll
    for (int blk = 0; blk < 16; blk += 2 * H)
#pragma unroll
        for (int j = 0; j < H; ++j) {
            if (!INV) { const cf a = v[blk + j], b = v[blk + j + H]; v[blk + j] = cadd(a, b); v[blk + j + H] = tw16<false>(csub(a, b), j * (8 / H)); }
            else { const cf A = v[blk + j], B = tw16<true>(v[blk + j + H], j * (8 / H)); v[blk + j] = cadd(A, B); v[blk + j + H] = csub(A, B); }
        }
}
template <bool INV> __device__ __forceinline__ void dft16(cf (&v)[16]) {
    if (!INV) { stage16<8, false>(v); stage16<4, false>(v); stage16<2, false>(v); stage16<1, false>(v); }
    else { stage16<1, true>(v); stage16<2, true>(v); stage16<4, true>(v); stage16<8, true>(v); }
}
__device__ __forceinline__ constexpr int br4(int r) { return ((r & 1) << 3) | ((r & 2) << 1) | ((r & 4) >> 1) | ((r & 8) >> 3); }
template <bool INV, int LSL> __device__ __forceinline__ void pass16(LAS cf* buf, int tid, cf wbase) {
    constexpr int SH = LSL - 4, st = 1 << SH;
    asm volatile("" : "+v"(tid));
    const int sub = tid >> SH, n2 = tid & (st - 1), base = (sub << LSL) + n2;
    cf v[16];
#pragma unroll
    for (int r = 0; r < 16; ++r) v[r] = buf[pidx(base + r * st)];
    cf wp[16];
    wp[1] = wbase;
    asm volatile("" : "+v"(wp[1].x), "+v"(wp[1].y));
    wp[2] = cmul(wp[1], wp[1]); wp[4] = cmul(wp[2], wp[2]); wp[8] = cmul(wp[4], wp[4]);
    wp[3] = cmul(wp[2], wp[1]); wp[5] = cmul(wp[4], wp[1]); wp[6] = cmul(wp[4], wp[2]); wp[7] = cmul(wp[4], wp[3]);
    wp[9] = cmul(wp[8], wp[1]); wp[10] = cmul(wp[8], wp[2]); wp[11] = cmul(wp[8], wp[3]); wp[12] = cmul(wp[8], wp[4]);
    wp[13] = cmul(wp[8], wp[5]); wp[14] = cmul(wp[8], wp[6]); wp[15] = cmul(wp[8], wp[7]);
    if (!INV) {
        dft16<false>(v);
#pragma unroll
        for (int r = 1; r < 16; ++r) v[r] = cmul(v[r], wp[br4(r)]);
    } else {
#pragma unroll
        for (int r = 1; r < 16; ++r) v[r] = cmulc(v[r], wp[br4(r)]);
        dft16<true>(v);
    }
#pragma unroll
    for (int r = 0; r < 16; ++r) buf[pidx(base + r * st)] = v[r];
}
template <bool MUL> __device__ __forceinline__ void mid2(LAS cf* D, const LAS cf* Hs, int tid) {
    asm volatile("" : "+v"(tid));
#pragma unroll
    for (int e = 0; e < 8; ++e) { const int i = 16 * tid + 2 * e; const cf a = D[pidx(i)], b = D[pidx(i + 1)]; cf A = cadd(a, b), B = csub(a, b);
        if (MUL) { A = cmul(A, Hs[pidx(i)]); B = cmul(B, Hs[pidx(i + 1)]); D[pidx(i)] = cadd(A, B); D[pidx(i + 1)] = csub(A, B); }
        else { D[pidx(i)] = A; D[pidx(i + 1)] = B; } }
}
#define HY_SYNC() __syncthreads()
__device__ __forceinline__ void fft_unit(LAS unsigned char* lds, int c, int tid, const float* __restrict__ HFT_l, const cf* __restrict__ TW, const bf16_t* __restrict__ ZT, const bf16_t* __restrict__ X0T,
                                         bf16_t* __restrict__ YCT, float bias) {
    asm volatile("" : "+v"(tid));
    LAS cf* D = (LAS cf*)lds; LAS cf* Hs = D + FBUF;
    const float* hsrc = HFT_l + (size_t)c * 8192;
    const cf w13 = TW[tid & 511], w9 = TW[(tid & 31) << 4], w5 = TW[(tid & 1) << 8];
    float hv[16]; bf16_t za[8], zb[8], xa[8], xb[8], zna[8], znb[8];
#pragma unroll
    for (int k = 0; k < 16; ++k) hv[k] = hsrc[k * 512 + tid];
    {   const size_t o0 = (size_t)c * SL, o1 = ((size_t)DC + c) * SL;
#pragma unroll
        for (int k = 0; k < 8; ++k) { za[k] = ZT[o0 + k * 512 + tid]; zb[k] = ZT[o1 + k * 512 + tid]; } }
#pragma unroll
    for (int k = 0; k < 16; ++k) Hs[pidx(k * 512 + tid)] = cf{hv[k], 0.f};
    HY_SYNC();
    pass16<false, 13>(Hs, tid, w13); HY_SYNC();
    pass16<false, 9>(Hs, tid, w9); HY_SYNC();
    pass16<false, 5>(Hs, tid, w5); HY_SYNC();
    mid2<false>(Hs, Hs, tid); HY_SYNC();
#pragma unroll
    for (int pr = 0; pr < 2; ++pr) {
        const size_t o0 = ((size_t)(2 * pr) * DC + c) * SL, o1 = ((size_t)(2 * pr + 1) * DC + c) * SL;
#pragma unroll
        for (int k = 0; k < 8; ++k) { const int i = k * 512 + tid; D[pidx(i)] = cf{bf2f(za[k]), bf2f(zb[k])}; D[pidx(i + 4096)] = cf{0.f, 0.f}; }
#pragma unroll
        for (int k = 0; k < 8; ++k) { xa[k] = X0T[o0 + k * 512 + tid]; xb[k] = X0T[o1 + k * 512 + tid]; }
        if (pr == 0) { const size_t n0 = ((size_t)2 * DC + c) * SL, n1 = ((size_t)3 * DC + c) * SL;
#pragma unroll
            for (int k = 0; k < 8; ++k) { zna[k] = ZT[n0 + k * 512 + tid]; znb[k] = ZT[n1 + k * 512 + tid]; } }
        HY_SYNC();
        pass16<false, 13>(D, tid, w13); HY_SYNC();
        pass16<false, 9>(D, tid, w9); HY_SYNC();
        pass16<false, 5>(D, tid, w5); HY_SYNC();
        mid2<true>(D, Hs, tid); HY_SYNC();
        pass16<true, 5>(D, tid, w5); HY_SYNC();
        pass16<true, 9>(D, tid, w9); HY_SYNC();
        pass16<true, 13>(D, tid, w13); HY_SYNC();
#pragma unroll
        for (int k = 0; k < 8; ++k) { const int i = k * 512 + tid; const cf y = D[pidx(i)];
            YCT[o0 + i] = (bf16_t)f2bf((y.x * (1.f / 8192.f) + bf2f(za[k]) * bias) * bf2f(xa[k])); YCT[o1 + i] = (bf16_t)f2bf((y.y * (1.f / 8192.f) + bf2f(zb[k]) * bias) * bf2f(xb[k])); }
        if (pr == 0) {
#pragma unroll
            for (int k = 0; k < 8; ++k) { za[k] = zna[k]; zb[k] = znb[k]; } }
        HY_SYNC();
    }
}
__device__ __forceinline__ float at_blo(unsigned u) { return __builtin_bit_cast(float, u << 16); }
__device__ __forceinline__ float at_bhi(unsigned u) { return __builtin_bit_cast(float, u & 0xffff0000u); }
constexpr int HP_ROWB = 1540;
__device__ __forceinline__ void hyprep_unit(LAS unsigned char* lds, int unit, int tid, const bf16_t* __restrict__ P, const bf16_t* __restrict__ SLAB, const float* __restrict__ cw, const float* __restrict__ cb,
                                            bf16_t* __restrict__ ZT, bf16_t* __restrict__ X0T) {
    asm volatile("" : "+v"(tid));
    const int b = unit >> 6, t0 = (unit & 63) * 64; const size_t m0 = (size_t)b * SL + t0;
    LAS float* CWL = (LAS float*)(lds + 101648);
    __syncthreads();
#pragma unroll
    for (int hb = 0; hb < 2; ++hb) { uint4 sv[7];
#pragma unroll
        for (int q = 0; q < 7; ++q) { const int i = tid + (hb * 7 + q) * NTHREADS, r = i / 96, ch8 = i % 96, t = t0 - 1 + r; const bool inb = (i < 66 * 96) && t >= 0 && t < SL;
            sv[q] = *(const uint4*)(P + (inb ? ((m0 + r - 1) * DINP + P_CU + ch8 * 8) : (m0 * DINP + P_CU))); if (!inb) sv[q] = make_uint4(0u, 0u, 0u, 0u); }
#pragma unroll
        for (int q = 0; q < 7; ++q) { const int i = tid + (hb * 7 + q) * NTHREADS, r = i / 96, ch8 = i % 96;
            if (i < 66 * 96 && ch8 < 80) { LAS unsigned* d = (LAS unsigned*)(lds + r * HP_ROWB + ch8 * 16); d[0] = sv[q].x; d[1] = sv[q].y; d[2] = sv[q].z; d[3] = sv[q].w; } } }
    {
        uint4 sl[3][4];
#pragma unroll
        for (int q = 0; q < 3; ++q) { const int i = tid + q * NTHREADS, r = i >> 4, c8 = i & 15, t = t0 - 1 + r; const bool inb = (i < 66 * 16) && t >= 0 && t < SL;
            const size_t ro = inb ? ((m0 + r - 1) * 128 + c8 * 8) : (m0 * 128);
#pragma unroll
            for (int k = 0; k < 4; ++k) { sl[q][k] = *(const uint4*)(SLAB + (size_t)k * MT * 128 + ro); if (!inb) sl[q][k] = make_uint4(0u, 0u, 0u, 0u); } }
#pragma unroll
        for (int q = 0; q < 3; ++q) { const int i = tid + q * NTHREADS, r = i >> 4, c8 = i & 15;
            if (i < 66 * 16) { unsigned o[4];
                const unsigned a0[4] = {sl[q][0].x, sl[q][0].y, sl[q][0].z, sl[q][0].w}, a1[4] = {sl[q][1].x, sl[q][1].y, sl[q][1].z, sl[q][1].w}, a2[4] = {sl[q][2].x, sl[q][2].y, sl[q][2].z, sl[q][2].w}, a3[4] = {sl[q][3].x, sl[q][3].y, sl[q][3].z, sl[q][3].w};
#pragma unroll
                for (int d = 0; d < 4; ++d) o[d] = pk2((at_blo(a0[d]) + at_blo(a1[d])) + (at_blo(a2[d]) + at_blo(a3[d])), (at_bhi(a0[d]) + at_bhi(a1[d])) + (at_bhi(a2[d]) + at_bhi(a3[d])));
                LAS unsigned* dd = (LAS unsigned*)(lds + r * HP_ROWB + (80 + c8) * 16); dd[0] = o[0]; dd[1] = o[1]; dd[2] = o[2]; dd[3] = o[3]; } } }
    {   float cv[6];
#pragma unroll
        for (int q = 0; q < 6; ++q) { const int i = tid + q * NTHREADS; cv[q] = (i < 3 * 768) ? cw[i] : cb[i - 3 * 768]; }
#pragma unroll
        for (int q = 0; q < 6; ++q) CWL[tid + q * NTHREADS] = cv[q]; }
    __syncthreads();
    const int tok = tid & 63, wv = tid >> 6;
    for (int j = 0; j < 32; ++j) { const int c = wv * 32 + j; float u[3];
#pragma unroll
        for (int part = 0; part < 3; ++part) { const int ch = part * DC + c; float a = CWL[3 * 768 + ch];
#pragma unroll
            for (int k = 0; k < 3; ++k) a += CWL[k * 768 + ch] * bf2f(*(const LAS bf16_t*)(lds + (tok + k) * HP_ROWB + ch * 2));
            u[part] = a; }
        const size_t o = ((size_t)b * DC + c) * SL + t0 + tok;
        ZT[o] = (bf16_t)f2bf(u[2] * u[1]); X0T[o] = (bf16_t)f2bf(u[0]); }
    __syncthreads();
}
__device__ __forceinline__ void filter_unit(LAS unsigned char* lds, int tb, int tid, const float* __restrict__ w1, const float* __restrict__ b1, const float* __restrict__ freq,
                                            const float* __restrict__ w2, const float* __restrict__ b2, const float* __restrict__ w3, float* __restrict__ HFT_l) {
    asm volatile("" : "+v"(tid));
    LAS float* Z = (LAS float*)lds;
    LAS float* H1T = Z + 32 * 36;
    LAS float* H2T = H1T + 64 * 32;
    const int t0 = tb * 32;
    __syncthreads();
    {   const int pos = tid >> 4, f = tid & 15, t = t0 + pos;
        const float fb = (float)(1e-4 + (double)f * ((15.0 - 1e-4) / 15.0)), w = 6.283185307179586f * (float)t * (1.0f / (float)SL);
        float sn, cs; sincosf(fb * w, &sn, &cs);
        Z[pos * 36 + 1 + f] = cs; Z[pos * 36 + 17 + f] = -sn;
        if (f == 0) Z[pos * 36] = (float)((double)t / (double)(SL - 1)); }
    __syncthreads();
    {   const int j = tid & 63; const float fj = freq[j], bj = b1[j];
#pragma unroll
        for (int q = 0; q < 4; ++q) { const int pos = (tid >> 6) + 8 * q; float a = bj;
#pragma unroll 11
            for (int i = 0; i < HY_EMB; ++i) a += Z[pos * 36 + i] * w1[i * HY_W + j];
            H1T[j * 32 + pos] = sinf(fj * a); } }
    __syncthreads();
    {   const int j = tid & 63; const float fj = freq[j], bj = b2[j];
#pragma unroll
        for (int q = 0; q < 4; ++q) { const int pos = (tid >> 6) + 8 * q; float a = bj;
#pragma unroll 16
            for (int i = 0; i < HY_W; ++i) a += H1T[i * 32 + pos] * w2[i * HY_W + j];
            H2T[j * 32 + pos] = sinf(fj * a); } }
    __syncthreads();
    {   const int o = tid, c = o & 255, dir = o >> 8;
        float acc[32];
#pragma unroll
        for (int p = 0; p < 32; ++p) acc[p] = 0.f;
#pragma unroll 16
        for (int i = 0; i < HY_W; ++i) { const float w = w3[i * 2 * DC + o];
#pragma unroll
            for (int p4 = 0; p4 < 8; ++p4) { const f32x4 h = *(const LAS f32x4*)(H2T + i * 32 + p4 * 4);
                acc[4 * p4] += h[0] * w; acc[4 * p4 + 1] += h[1] * w; acc[4 * p4 + 2] += h[2] * w; acc[4 * p4 + 3] += h[3] * w; } }
        const double mind = log(1e-2) / 1.5, maxd = log(1e-2) / 0.3;
        const float delta = fabsf((float)(mind + (maxd - mind) * (double)c / 255.0));
#pragma unroll
        for (int p = 0; p < 32; ++p) { const int t = t0 + p; const float tt = (float)((double)t / (double)(SL - 1)); acc[p] *= __builtin_amdgcn_exp2f(-1.4426950408889634f * tt * delta); }
        float* row = HFT_l + (size_t)c * 8192;
        if (dir == 0) {
#pragma unroll
            for (int p4 = 0; p4 < 8; ++p4) *(f32x4*)(row + t0 + 4 * p4) = (f32x4){acc[4 * p4], acc[4 * p4 + 1], acc[4 * p4 + 2], acc[4 * p4 + 3]};
            if (t0 == 0) row[4096] = 0.f;
        } else {
#pragma unroll
            for (int p = 0; p < 32; ++p) if (t0 + p > 0) row[8192 - t0 - p] = acc[p];
        } }
}
}

constexpr size_t WS_AO = 222 * MiB;
namespace at {
typedef short v4i16_t __attribute__((ext_vector_type(4)));
constexpr int KROW = 144, NKEY = 400, V_OFF = NKEY * KROW;
__device__ __forceinline__ float blo(unsigned u) { return __builtin_bit_cast(float, u << 16); }
__device__ __forceinline__ float bhi(unsigned u) { return __builtin_bit_cast(float, u & 0xffff0000u); }
__device__ __forceinline__ void rope16(uint4& A, uint4& B, const float* __restrict__ cs, float scale) {
    const f32x4 c0 = *(const f32x4*)cs, c1 = *(const f32x4*)(cs + 4), s0 = *(const f32x4*)(cs + 8), s1 = *(const f32x4*)(cs + 12);
    const float c[8] = {c0[0], c0[1], c0[2], c0[3], c1[0], c1[1], c1[2], c1[3]}, s[8] = {s0[0], s0[1], s0[2], s0[3], s1[0], s1[1], s1[2], s1[3]};
    unsigned a[4] = {A.x, A.y, A.z, A.w}, b[4] = {B.x, B.y, B.z, B.w};
#pragma unroll
    for (int d = 0; d < 4; ++d) {
        const float t1l = blo(a[d]), t1h = bhi(a[d]), t2l = blo(b[d]), t2h = bhi(b[d]);
        const float o1l = (t1l * c[2 * d] - t2l * s[2 * d]) * scale, o1h = (t1h * c[2 * d + 1] - t2h * s[2 * d + 1]) * scale;
        const float o2l = (t2l * c[2 * d] + t1l * s[2 * d]) * scale, o2h = (t2h * c[2 * d + 1] + t1h * s[2 * d + 1]) * scale;
        a[d] = f2bf(o1l) | (f2bf(o1h) << 16); b[d] = f2bf(o2l) | (f2bf(o2h) << 16);
    }
    A = make_uint4(a[0], a[1], a[2], a[3]); B = make_uint4(b[0], b[1], b[2], b[3]);
}
__device__ __forceinline__ void rope16s(uint4& A, uint4& B, const float (&cs)[16], float scale) {
    unsigned a[4] = {A.x, A.y, A.z, A.w}, b[4] = {B.x, B.y, B.z, B.w};
#pragma unroll
    for (int d = 0; d < 4; ++d) {
        const float t1l = blo(a[d]), t1h = bhi(a[d]), t2l = blo(b[d]), t2h = bhi(b[d]);
        const float o1l = (t1l * cs[2 * d] - t2l * cs[8 + 2 * d]) * scale, o1h = (t1h * cs[2 * d + 1] - t2h * cs[8 + 2 * d + 1]) * scale;
        const float o2l = (t2l * cs[2 * d] + t1l * cs[8 + 2 * d]) * scale, o2h = (t2h * cs[2 * d + 1] + t1h * cs[8 + 2 * d + 1]) * scale;
        a[d] = f2bf(o1l) | (f2bf(o1h) << 16); b[d] = f2bf(o2l) | (f2bf(o2h) << 16);
    }
    A = make_uint4(a[0], a[1], a[2], a[3]); B = make_uint4(b[0], b[1], b[2], b[3]);
}
__device__ __forceinline__ unsigned scale2(unsigned u, float sc) { return f2bf(blo(u) * sc) | (f2bf(bhi(u) * sc) << 16); }
__device__ __forceinline__ void attn_unit(LAS unsigned char* lds, int unit, int tid, const bf16_t* __restrict__ P, const float* __restrict__ rope, const float* __restrict__ sink_l, bf16_t* __restrict__ AO) {
    asm volatile("" : "+v"(tid));
    const int b = unit >> 6, kvh = (unit >> 5) & 1, q0 = (unit & 31) * 128, W0 = q0 - 128;
    const size_t m0 = (size_t)b * SL;
    const int lane = tid & 63, wave = __builtin_amdgcn_readfirstlane(tid >> 6), i = lane & 15, g = lane >> 4;
    __syncthreads();
    {   uint4 va[6], vb[6];
#pragma unroll
        for (int q = 0; q < 6; ++q) { const int j = tid + q * NTHREADS; const bool isV = j >= 1200; const int jj = isV ? j - 1200 : j, kk = isV ? (jj >> 2) : (jj / 3), ch = isV ? (jj & 3) : (1 + jj % 3), pos = W0 + kk;
            const bool inb = (j < 2800) && pos >= 0 && pos < SL;
            const bf16_t* src = P + (inb ? ((m0 + pos) * DINP + (isV ? P_V : P_K) + kvh * HD + ch * 16) : (m0 * DINP + P_K));
            va[q] = *(const uint4*)src; vb[q] = *(const uint4*)(src + 8); if (!inb) { va[q] = make_uint4(0u, 0u, 0u, 0u); vb[q] = va[q]; } }
        uint4 ra = make_uint4(0u, 0u, 0u, 0u), rb = ra; f32x4 rc[4];
        {   const int pos = W0 + tid; const bool inb = (tid < NKEY) && pos >= 0 && pos < SL; const int pc = inb ? pos : 0;
            const bf16_t* src = P + (m0 + pc) * DINP + P_K + kvh * HD; ra = *(const uint4*)src; rb = *(const uint4*)(src + 8);
#pragma unroll
            for (int q = 0; q < 4; ++q) rc[q] = *(const f32x4*)(rope + pc * 16 + 4 * q);
            float cs[16];
#pragma unroll
            for (int q = 0; q < 16; ++q) cs[q] = rc[q >> 2][q & 3];
            rope16s(ra, rb, cs, 1.0f);
            if (!inb) { ra = make_uint4(0u, 0u, 0u, 0u); rb = ra; } }
#pragma unroll
        for (int q = 0; q < 6; ++q) { const int j = tid + q * NTHREADS; const bool isV = j >= 1200; const int jj = isV ? j - 1200 : j, kk = isV ? (jj >> 2) : (jj / 3), ch = isV ? (jj & 3) : (1 + jj % 3);
            if (j < 2800) { LAS unsigned char* dst = lds + (isV ? V_OFF : 0) + kk * KROW + ch * 32;
                *(LAS v4u*)dst = (v4u){va[q].x, va[q].y, va[q].z, va[q].w}; *(LAS v4u*)(dst + 16) = (v4u){vb[q].x, vb[q].y, vb[q].z, vb[q].w}; } }
        if (tid < NKEY) { LAS unsigned char* dst = lds + tid * KROW; *(LAS v4u*)dst = (v4u){ra.x, ra.y, ra.z, ra.w}; *(LAS v4u*)(dst + 16) = (v4u){rb.x, rb.y, rb.z, rb.w}; }
    }
    __syncthreads();
    const bool edge = (q0 == 0) || (q0 == SL - 128);
#pragma unroll 1
    for (int gi = 0; gi < 3; ++gi) {
        const int grp = wave * 3 + gi, hl = grp >> 3, qsub = grp & 7, head = kvh * 3 + hl;
        const int tok = q0 + 16 * qsub + i;
        bf16x8 qf[2];
        {   const bf16_t* qp = P + (m0 + tok) * DINP + P_Q + head * HD + g * 8;
            uint4 own = *(const uint4*)qp, hi2 = *(const uint4*)(qp + 32);
            uint4 oth; oth.x = __shfl_xor(own.x, 16); oth.y = __shfl_xor(own.y, 16); oth.z = __shfl_xor(own.z, 16); oth.w = __shfl_xor(own.w, 16);
            uint4 t1 = (g == 0) ? own : oth, t2 = (g == 0) ? oth : own;
            rope16(t1, t2, rope + tok * 16, 0.125f);
            uint4 r0;
            if (g == 0) r0 = t1; else if (g == 1) r0 = t2; else r0 = make_uint4(scale2(own.x, 0.125f), scale2(own.y, 0.125f), scale2(own.z, 0.125f), scale2(own.w, 0.125f));
            hi2 = make_uint4(scale2(hi2.x, 0.125f), scale2(hi2.y, 0.125f), scale2(hi2.z, 0.125f), scale2(hi2.w, 0.125f));
            qf[0] = __builtin_bit_cast(bf16x8, r0); qf[1] = __builtin_bit_cast(bf16x8, hi2); }
        f32x4 st[17];
        const LAS unsigned char* kb = lds + (16 * qsub + i) * KROW + g * 16;
#pragma unroll
        for (int tt = 0; tt < 17; ++tt) {
            const bf16x8 k0 = *(const LAS bf16x8*)(kb + tt * 16 * KROW), k1 = *(const LAS bf16x8*)(kb + tt * 16 * KROW + 64);
            f32x4 acc = __builtin_amdgcn_mfma_f32_16x16x32_bf16(k0, qf[0], (f32x4){0.f, 0.f, 0.f, 0.f}, 0, 0, 0);
            st[tt] = __builtin_amdgcn_mfma_f32_16x16x32_bf16(k1, qf[1], acc, 0, 0, 0);
        }
        const float NEGF = -1e30f;
#pragma unroll
        for (int r = 0; r < 4; ++r) { if (4 * g + r < i) st[0][r] = NEGF; if (4 * g + r > i) st[16][r] = NEGF; }
        if (edge) {
#pragma unroll
            for (int tt = 0; tt < 17; ++tt)
#pragma unroll
                for (int r = 0; r < 4; ++r) { const int pos = W0 + 16 * (qsub + tt) + 4 * g + r; if (pos < 0 || pos >= SL) st[tt][r] = NEGF; }
        }
        const float sk = sink_l[head];
        float mx = sk;
#pragma unroll
        for (int tt = 0; tt < 17; ++tt) mx = fmaxf(fmaxf(mx, fmaxf(st[tt][0], st[tt][1])), fmaxf(st[tt][2], st[tt][3]));
        mx = fmaxf(mx, __shfl_xor(mx, 16)); mx = fmaxf(mx, __shfl_xor(mx, 32));
        const float L2E = 1.4426950408889634f, mb = mx * L2E;
        float lsum = 0.f;
        bf16x8 pf[9];
#pragma unroll
        for (int s = 0; s < 9; ++s) {
            float p[8];
#pragma unroll
            for (int r = 0; r < 4; ++r) { p[r] = __builtin_amdgcn_exp2f(st[2 * s][r] * L2E - mb); p[4 + r] = (2 * s + 1 < 17) ? __builtin_amdgcn_exp2f(st[(2 * s + 1 < 17) ? 2 * s + 1 : 16][r] * L2E - mb) : 0.f; }
#pragma unroll
            for (int r = 0; r < 8; ++r) lsum += p[r];
            uint4 w; w.x = pg8::cvt_pk_bf16(p[0], p[1]); w.y = pg8::cvt_pk_bf16(p[2], p[3]); w.z = pg8::cvt_pk_bf16(p[4], p[5]); w.w = pg8::cvt_pk_bf16(p[6], p[7]);
            pf[s] = __builtin_bit_cast(bf16x8, w);
        }
        lsum += __shfl_xor(lsum, 16); lsum += __shfl_xor(lsum, 32);
        lsum += __builtin_amdgcn_exp2f(sk * L2E - mb);
        const float rl = 1.0f / lsum;
        const LAS unsigned char* vb = lds + V_OFF + (16 * qsub + 4 * g + (i >> 2)) * KROW + (i & 3) * 8;
        bf16_t* op = AO + (m0 + tok) * DBB + head * HD + 4 * g;
        f32x4 o[4];
#pragma unroll
        for (int dt = 0; dt < 4; ++dt) o[dt] = (f32x4){0.f, 0.f, 0.f, 0.f};
#pragma unroll
        for (int s = 0; s < 9; ++s)
#pragma unroll
            for (int dt = 0; dt < 4; ++dt) {
                const v4i16_t lo = __builtin_amdgcn_ds_read_tr16_b64_v4i16((LAS v4i16_t*)(vb + (32 * s) * KROW + dt * 32));
                const v4i16_t hi = __builtin_amdgcn_ds_read_tr16_b64_v4i16((LAS v4i16_t*)(vb + (32 * s + 16) * KROW + dt * 32));
                const bf16x8 vf = (bf16x8){lo[0], lo[1], lo[2], lo[3], hi[0], hi[1], hi[2], hi[3]};
                o[dt] = __builtin_amdgcn_mfma_f32_16x16x32_bf16(vf, pf[s], o[dt], 0, 0, 0);
            }
#pragma unroll
        for (int dt = 0; dt < 4; ++dt) { uint2 w; w.x = pg8::cvt_pk_bf16(o[dt][0] * rl, o[dt][1] * rl); w.y = pg8::cvt_pk_bf16(o[dt][2] * rl, o[dt][3] * rl);
            *(uint2*)(op + dt * 16) = w; }
    }
}
}

constexpr size_t WS_AGG = 234 * MiB;
constexpr size_t WS_LS = WS_XG, WS_LPF = WS_XG + 12 * MiB, WS_LPB = 236 * MiB;
constexpr size_t WS_LW = WS_ROPE + 512 * 1024;
namespace lru {
constexpr int AXROW = 784, XCROW = 784, XC_OFF = 67 * AXROW, CARRY_OFF = XC_OFF + 64 * XCROW, SSQ_OFF = CARRY_OFF + 2 * DA * 4, RSTD_OFF = SSQ_OFF + 64 * 24 * 4;
__device__ __forceinline__ float fsig(float x) { return __builtin_amdgcn_rcpf(1.0f + __builtin_amdgcn_exp2f(-1.4426950408889634f * x)); }
__device__ __forceinline__ float fgelu(float x) { const float u = 0.7978845608028654f * (x + 0.044715f * x * x * x); const float e = __builtin_amdgcn_exp2f(2.8853900817779268f * u);
    const float th = 1.0f - 2.0f * __builtin_amdgcn_rcpf(1.0f + e); return 0.5f * x * (1.0f + th); }
template <int CTRL> __device__ __forceinline__ float dppf(float v) { return __builtin_bit_cast(float, __builtin_amdgcn_update_dpp(0, __builtin_bit_cast(int, v), CTRL, 0xf, 0xf, true)); }
__device__ __forceinline__ float row16_sum(float v) { v += dppf<0xB1>(v); v += dppf<0x4E>(v); v += dppf<0x141>(v); v += dppf<0x140>(v); return v; }
__device__ __forceinline__ void lru_unit(LAS unsigned char* lds, int unit, int tid, const bf16_t* __restrict__ P, const float* __restrict__ cw, const float* __restrict__ cb, const bf16_t* __restrict__ LW_l,
                                         const float* __restrict__ ba, const float* __restrict__ bx, const float* __restrict__ lam, float* __restrict__ AGG, bf16_t* __restrict__ LS, bf16_t* __restrict__ LPF, bf16_t* __restrict__ LPB) {
    asm volatile("" : "+v"(tid));
    const int b = unit >> 6, kc = unit & 63, t0 = kc * 64; const size_t m0 = (size_t)b * SL + t0;
    const int lane = tid & 63, wave = __builtin_amdgcn_readfirstlane(tid >> 6), li_ = lane & 15, g_ = lane >> 4;
    LAS unsigned char* AX = lds; LAS unsigned char* XC = lds + XC_OFF;
    __syncthreads();
    float prm[3][6];
#pragma unroll
    for (int rd = 0; rd < 3; ++rd) { const int chq = 64 * (2 * rd + (wave >> 2)) + 16 * (wave & 3) + li_;
        prm[rd][0] = ba[chq]; prm[rd][1] = ba[DA + chq]; prm[rd][2] = bx[chq]; prm[rd][3] = bx[DA + chq]; prm[rd][4] = lam[chq]; prm[rd][5] = lam[DA + chq]; }
    bf16x8 bfa[4][2], bfb[4][2];
#pragma unroll
    for (int mat = 0; mat < 4; ++mat)
#pragma unroll
        for (int ks = 0; ks < 2; ++ks) bfa[mat][ks] = *(const bf16x8*)(LW_l + ((size_t)(((wave >> 2) * 4 + mat) * 64 + 16 * (wave & 3) + li_)) * 64 + 32 * ks + 8 * g_);
    float w[4][8], bb[8];
    {   const int ch0 = (tid % 48) * 8;
#pragma unroll
        for (int e = 0; e < 8; ++e) { bb[e] = cb[ch0 + e];
#pragma unroll
            for (int k = 0; k < 4; ++k) w[k][e] = cw[k * DA + ch0 + e]; } }
    {   uint4 sv[7];
#pragma unroll
        for (int q = 0; q < 7; ++q) { const int it = tid + q * NTHREADS, r = it / 48, c8 = it % 48, t = t0 - 2 + r; const bool inb = (it < 67 * 48) && t >= 0 && t < SL;
            sv[q] = *(const uint4*)(P + (inb ? ((m0 + r - 2) * DINP + P_AX + c8 * 8) : (m0 * DINP + P_AX))); if (!inb) sv[q] = make_uint4(0u, 0u, 0u, 0u); }
#pragma unroll
        for (int q = 0; q < 7; ++q) { const int it = tid + q * NTHREADS, r = it / 48, c8 = it % 48;
            if (it < 67 * 48) *(LAS v4u*)(AX + r * AXROW + c8 * 16) = (v4u){sv[q].x, sv[q].y, sv[q].z, sv[q].w}; } }
    __syncthreads();
    if (tid < 384) { const int c8 = tid % 48, tg = tid / 48;
        for (int q = 0; q < 8; ++q) { const int tok = tg * 8 + q; float acc[8];
#pragma unroll
            for (int e = 0; e < 8; ++e) acc[e] = bb[e];
#pragma unroll
            for (int k = 0; k < 4; ++k) { const v4u v = *(const LAS v4u*)(AX + (tok + k) * AXROW + c8 * 16);
#pragma unroll
                for (int d = 0; d < 4; ++d) { acc[2 * d] += w[k][2 * d] * at::blo(v[d]); acc[2 * d + 1] += w[k][2 * d + 1] * at::bhi(v[d]); } }
            *(LAS v4u*)(XC + tok * XCROW + c8 * 16) = (v4u){pk2(acc[0], acc[1]), pk2(acc[2], acc[3]), pk2(acc[4], acc[5]), pk2(acc[6], acc[7])}; }
    }
    __syncthreads();
#pragma unroll
    for (int rd = 0; rd < 3; ++rd) {
        asm volatile("" ::: "memory"); __builtin_amdgcn_sched_barrier(0);
        int li = li_, g = g_; asm volatile("" : "+v"(li), "+v"(g));
        const int h = 2 * rd + (wave >> 2), ct = wave & 3, ch = 64 * h + 16 * ct + li;
        bf16x8 (&bfr)[4][2] = (rd & 1) ? bfb : bfa; bf16x8 (&bfn)[4][2] = (rd & 1) ? bfa : bfb;
        if (rd < 2) {
#pragma unroll
            for (int mat = 0; mat < 4; ++mat)
#pragma unroll
                for (int ks = 0; ks < 2; ++ks) bfn[mat][ks] = *(const bf16x8*)(LW_l + ((size_t)(((h + 2) * 4 + mat) * 64 + 16 * ct + li)) * 64 + 32 * ks + 8 * g); }
        f32x4 acc[4][4];
        {   bf16x8 af[4][2];
#pragma unroll
            for (int mt = 0; mt < 4; ++mt)
#pragma unroll
                for (int ks = 0; ks < 2; ++ks) af[mt][ks] = *(const LAS bf16x8*)(XC + (16 * mt + li) * XCROW + (64 * h + 32 * ks + 8 * g) * 2);
#pragma unroll
            for (int mat = 0; mat < 4; ++mat)
#pragma unroll
                for (int mt = 0; mt < 4; ++mt) { f32x4 c = __builtin_amdgcn_mfma_f32_16x16x32_bf16(af[mt][0], bfr[mat][0], (f32x4){0.f, 0.f, 0.f, 0.f}, 0, 0, 0);
                    acc[mat][mt] = __builtin_amdgcn_mfma_f32_16x16x32_bf16(af[mt][1], bfr[mat][1], c, 0, 0, 0); } }
        {
            float ban[2] = {prm[rd][0], prm[rd][1]}, bxn[2] = {prm[rd][2], prm[rd][3]}, spn[2];
#pragma unroll
            for (int n = 0; n < 2; ++n) { const float l = prm[rd][4 + n]; spn[n] = -8.0f * 1.4426950408889634f * ((-l > 20.f) ? -l : log1pf(expf(-l))); }
#pragma unroll
            for (int mt = 0; mt < 4; ++mt)
#pragma unroll
                for (int r = 0; r < 4; ++r) { const int tok = 16 * mt + 4 * g + r;
                    const float xcv = bf2f(*(const LAS bf16_t*)(XC + tok * XCROW + ch * 2));
#pragma unroll
                    for (int n = 0; n < 2; ++n) { const float rg = fsig(acc[2 * n][mt][r] + ban[n]), ig = fsig(acc[2 * n + 1][mt][r] + bxn[n]);
                        const float av = __builtin_amdgcn_exp2f(rg * spn[n]);
                        acc[2 * n][mt][r] = av; acc[2 * n + 1][mt][r] = __builtin_amdgcn_sqrtf(1.0f - av * av) * (ig * xcv); } } }
        f32x4 hs[4];
        {   float Af[4], Bf[4], Ab[4], Bb[4];
#pragma unroll
            for (int mt = 0; mt < 4; ++mt) { const f32x4 a = acc[0][mt], bb = acc[1][mt], c = acc[2][mt], d = acc[3][mt];
                Af[mt] = (a[0] * a[1]) * (a[2] * a[3]); Bf[mt] = ((bb[0] * a[1] + bb[1]) * a[2] + bb[2]) * a[3] + bb[3];
                Ab[mt] = (c[0] * c[1]) * (c[2] * c[3]); Bb[mt] = ((d[3] * c[2] + d[2]) * c[1] + d[1]) * c[0] + d[0]; }
            {   float t0[4], t1[4], t2[4], t3[4];
#pragma unroll
                for (int mt = 0; mt < 4; ++mt) { t0[mt] = __shfl_up(Af[mt], 16); t1[mt] = __shfl_up(Bf[mt], 16); t2[mt] = __shfl_down(Ab[mt], 16); t3[mt] = __shfl_down(Bb[mt], 16); }
#pragma unroll
                for (int mt = 0; mt < 4; ++mt) { if (g >= 1) { Bf[mt] = t1[mt] * Af[mt] + Bf[mt]; Af[mt] = t0[mt] * Af[mt]; } if (g <= 2) { Bb[mt] = t3[mt] * Ab[mt] + Bb[mt]; Ab[mt] = t2[mt] * Ab[mt]; } }
#pragma unroll
                for (int mt = 0; mt < 4; ++mt) { t0[mt] = __shfl_up(Af[mt], 32); t1[mt] = __shfl_up(Bf[mt], 32); t2[mt] = __shfl_down(Ab[mt], 32); t3[mt] = __shfl_down(Bb[mt], 32); }
#pragma unroll
                for (int mt = 0; mt < 4; ++mt) { if (g >= 2) { Bf[mt] = t1[mt] * Af[mt] + Bf[mt]; Af[mt] = t0[mt] * Af[mt]; } if (g <= 1) { Bb[mt] = t3[mt] * Ab[mt] + Bb[mt]; Ab[mt] = t2[mt] * Ab[mt]; } } }
            float Aef[4], Bef[4], Aeb[4], Beb[4], Atf[4], Btf[4], Atb[4], Btb[4];
#pragma unroll
            for (int mt = 0; mt < 4; ++mt) { Aef[mt] = __shfl_up(Af[mt], 16); Bef[mt] = __shfl_up(Bf[mt], 16); Aeb[mt] = __shfl_down(Ab[mt], 16); Beb[mt] = __shfl_down(Bb[mt], 16);
                Atf[mt] = __shfl(Af[mt], li + 48); Btf[mt] = __shfl(Bf[mt], li + 48); Atb[mt] = __shfl(Ab[mt], li); Btb[mt] = __shfl(Bb[mt], li); }
#pragma unroll
            for (int mt = 0; mt < 4; ++mt) { if (g == 0) { Aef[mt] = 1.f; Bef[mt] = 0.f; } if (g == 3) { Aeb[mt] = 1.f; Beb[mt] = 0.f; } }
            f32x4 pf[4], pb[4];
            {   float hin = 0.f, atot = 1.f;
#pragma unroll
                for (int mt = 0; mt < 4; ++mt) { const f32x4 a = acc[0][mt], bb = acc[1][mt]; float hh = Aef[mt] * hin + Bef[mt], pp = Aef[mt] * atot;
#pragma unroll
                    for (int r = 0; r < 4; ++r) { hh = a[r] * hh + bb[r]; hs[mt][r] = hh; pp *= a[r]; pf[mt][r] = pp; }
                    hin = Atf[mt] * hin + Btf[mt]; atot *= Atf[mt]; }
                if (g == 0) { float* ag = AGG + ((size_t)(b * 64 + kc) * 4) * DA + ch; ag[0] = atot; ag[DA] = hin; } }
            {   float hin = 0.f, atot = 1.f;
#pragma unroll
                for (int mt = 3; mt >= 0; --mt) { const f32x4 a = acc[2][mt], bb = acc[3][mt]; float hh = Aeb[mt] * hin + Beb[mt], pp = Aeb[mt] * atot;
#pragma unroll
                    for (int r = 3; r >= 0; --r) { hh = a[r] * hh + bb[r]; hs[mt][r] += hh; pp *= a[r]; pb[mt][r] = pp; }
                    hin = Atb[mt] * hin + Btb[mt]; atot *= Atb[mt]; }
                if (g == 0) { float* ag = AGG + ((size_t)(b * 64 + kc) * 4) * DA + ch; ag[2 * DA] = atot; ag[3 * DA] = hin; } }
#pragma unroll
            for (int mt = 0; mt < 4; ++mt)
#pragma unroll
                for (int r = 0; r < 4; ++r) { const size_t o = (m0 + 16 * mt + 4 * g + r) * DA + ch;
                    const unsigned w0 = pg8::cvt_pk_bf16(hs[mt][r], pf[mt][r]), w1 = pg8::cvt_pk_bf16(pb[mt][r], 0.f);
                    LS[o] = (bf16_t)(w0 & 0xffffu); LPF[o] = (bf16_t)(w0 >> 16); LPB[o] = (bf16_t)(w1 & 0xffffu); } }
    }
}
constexpr size_t WS_CIN = 248 * MiB;
__device__ __forceinline__ void carry_scan_seq(int seq, int lane, const float* __restrict__ AGG, float* __restrict__ CIN) {
    const int ch = seq % DA, dir = (seq / DA) & 1, b = seq / (2 * DA);
    const float* ag = AGG + ((size_t)(b * 64 + lane) * 4 + 2 * dir) * DA + ch;
    float A = ag[0], B = ag[DA];
    if (dir == 0) {
#pragma unroll
        for (int d = 1; d < 64; d <<= 1) { const float A1 = __shfl_up(A, d), B1 = __shfl_up(B, d); if (lane >= d) { B = B1 * A + B; A = A1 * A; } }
        float c = __shfl_up(B, 1); if (lane == 0) c = 0.f;
        CIN[((size_t)(b * 64 + lane) * 2 + 0) * DA + ch] = c;
    } else {
#pragma unroll
        for (int d = 1; d < 64; d <<= 1) { const float A1 = __shfl_down(A, d), B1 = __shfl_down(B, d); if (lane + d < 64) { B = B1 * A + B; A = A1 * A; } }
        float c = __shfl_down(B, 1); if (lane == 63) c = 0.f;
        CIN[((size_t)(b * 64 + lane) * 2 + 1) * DA + ch] = c;
    }
}
__device__ __forceinline__ void lru_fin_unit(LAS unsigned char* lds, int unit, int tid, const bf16_t* __restrict__ P, const float* __restrict__ AGG, const bf16_t* __restrict__ LS, const bf16_t* __restrict__ LPF,
                                             const bf16_t* __restrict__ LPB, const float* __restrict__ gn, bf16_t* __restrict__ YN) {
    asm volatile("" : "+v"(tid));
    const int b = unit >> 6, kc = unit & 63, t0 = kc * 64; const size_t m0 = (size_t)b * SL + t0;
    const int lane = tid & 63, wave = __builtin_amdgcn_readfirstlane(tid >> 6);
    float cf[6], cbk[6], gv[6];
#pragma unroll
    for (int j = 0; j < 3; ++j) { const int c0 = 2 * (lane + 64 * j); const float* ci = AGG + ((size_t)(b * 64 + kc) * 2) * DA + c0;
        cf[2 * j] = ci[0]; cf[2 * j + 1] = ci[1]; cbk[2 * j] = ci[DA]; cbk[2 * j + 1] = ci[DA + 1]; gv[2 * j] = gn[c0]; gv[2 * j + 1] = gn[c0 + 1]; }
#pragma unroll 4
    for (int q = 0; q < 8; ++q) { const int tok = wave * 8 + q; const size_t ro = (m0 + tok) * DA;
        const unsigned* sS = (const unsigned*)(LS + ro); const unsigned* sF = (const unsigned*)(LPF + ro); const unsigned* sB = (const unsigned*)(LPB + ro); const unsigned* sG = (const unsigned*)(P + (m0 + tok) * DINP + P_AG);
        unsigned wS[3], wF[3], wB[3], wG[3];
#pragma unroll
        for (int j = 0; j < 3; ++j) { wS[j] = sS[lane + 64 * j]; wF[j] = sF[lane + 64 * j]; wB[j] = sB[lane + 64 * j]; wG[j] = sG[lane + 64 * j]; }
        float y[6]; float ss = 0.f;
#pragma unroll
        for (int j = 0; j < 3; ++j) {
            y[2 * j] = (at::blo(wS[j]) + at::blo(wF[j]) * cf[2 * j] + at::blo(wB[j]) * cbk[2 * j]) * fgelu(at::blo(wG[j]));
            y[2 * j + 1] = (at::bhi(wS[j]) + at::bhi(wF[j]) * cf[2 * j + 1] + at::bhi(wB[j]) * cbk[2 * j + 1]) * fgelu(at::bhi(wG[j]));
            ss += y[2 * j] * y[2 * j] + y[2 * j + 1] * y[2 * j + 1]; }
#pragma unroll
        for (int o = 1; o < 64; o <<= 1) ss += __shfl_xor(ss, o);
        const float r = 1.0f / sqrtf(ss * (1.0f / DA) + EPS);
        unsigned* dst = (unsigned*)(YN + (m0 + tok) * DM);
#pragma unroll
        for (int j = 0; j < 3; ++j) dst[lane + 64 * j] = pk2(y[2 * j] * r * gv[2 * j], y[2 * j + 1] * r * gv[2 * j + 1]); }
}
}

namespace fin {
constexpr int TROW = 528;
__device__ __forceinline__ float wsum(float v) {
#pragma unroll
    for (int o = 1; o < 64; o <<= 1) v += __shfl_xor(v, o);
    return v;
}
__device__ __forceinline__ void norm_bc_unit(LAS unsigned char* lds, int unit, int tid, const bf16_t* __restrict__ AO, const bf16_t* __restrict__ YCT, const float* __restrict__ gnb, const float* __restrict__ gnc, bf16_t* __restrict__ YN) {
    asm volatile("" : "+v"(tid));
    const int b = unit >> 6, t0 = (unit & 63) * 64; const size_t m0 = (size_t)b * SL + t0;
    const int lane = tid & 63, wave = __builtin_amdgcn_readfirstlane(tid >> 6);
    __syncthreads();
    {   const int c = tid >> 1, hf = tid & 1; const bf16_t* src = YCT + ((size_t)b * DC + c) * SL + t0 + hf * 32;
#pragma unroll
        for (int q = 0; q < 4; ++q) { const uint4 v = *(const uint4*)(src + q * 8); const unsigned w[4] = {v.x, v.y, v.z, v.w};
#pragma unroll
            for (int d = 0; d < 4; ++d) { const int tok = hf * 32 + q * 8 + 2 * d;
                *(LAS bf16_t*)(lds + tok * TROW + c * 2) = (bf16_t)(w[d] & 0xffffu); *(LAS bf16_t*)(lds + (tok + 1) * TROW + c * 2) = (bf16_t)(w[d] >> 16); } } }
    {   unsigned wv[8][3];
#pragma unroll
        for (int q = 0; q < 8; ++q) { const unsigned* src = (const unsigned*)(AO + (m0 + wave * 8 + q) * DBB);
#pragma unroll
            for (int j = 0; j < 3; ++j) wv[q][j] = src[lane + 64 * j]; }
        float gb[6];
#pragma unroll
        for (int j = 0; j < 3; ++j) { const int c0 = 2 * (lane + 64 * j); gb[2 * j] = gnb[c0]; gb[2 * j + 1] = gnb[c0 + 1]; }
#pragma unroll
        for (int q = 0; q < 8; ++q) { const int tok = wave * 8 + q; float v[6]; float s = 0.f;
#pragma unroll
            for (int j = 0; j < 3; ++j) { v[2 * j] = at::blo(wv[q][j]); v[2 * j + 1] = at::bhi(wv[q][j]); s += v[2 * j] * v[2 * j] + v[2 * j + 1] * v[2 * j + 1]; }
            const float r = 1.0f / sqrtf(wsum(s) * (1.0f / DBB) + EPS);
            unsigned* dst = (unsigned*)(YN + (m0 + tok) * DM + DA);
#pragma unroll
            for (int j = 0; j < 3; ++j) dst[lane + 64 * j] = pk2(v[2 * j] * r * gb[2 * j], v[2 * j + 1] * r * gb[2 * j + 1]); } }
    __syncthreads();
    for (int q = 0; q < 8; ++q) { const int tok = wave * 8 + q; typedef unsigned u32x2v __attribute__((ext_vector_type(2))); const u32x2v w = *(const LAS u32x2v*)(lds + tok * TROW + lane * 8);
        const float v0 = at::blo(w.x), v1 = at::bhi(w.x), v2 = at::blo(w.y), v3 = at::bhi(w.y);
        const float r = 1.0f / sqrtf(wsum(v0 * v0 + v1 * v1 + v2 * v2 + v3 * v3) * (1.0f / DC) + EPS);
        const f32x4 gg = *(const f32x4*)(gnc + lane * 4);
        uint2 o; o.x = pk2(v0 * r * gg[0], v1 * r * gg[1]); o.y = pk2(v2 * r * gg[2], v3 * r * gg[3]);
        *(uint2*)(YN + (m0 + tok) * DM + DA + DBB + lane * 4) = o; }
}
}

__device__ __forceinline__ int fresh_tid() { int t = threadIdx.x; asm volatile("" : "+v"(t)); return t; }
#define FTID fresh_tid()
#define FLANE (fresh_tid() & 63)
struct Frame {
    LAS unsigned char* lds;
    volatile LAS unsigned* MISC;
    int wave, vcu, G;
};
__device__ __forceinline__ void p0_transpose_item(const float* W, int K, int N, bf16_t* WT, LAS float* scr, int item, int lane) {
    const int nblk = N / 32, kb = item / nblk, nb = item % nblk, k0 = 64 * kb, n0 = 32 * nb;
    float tv[32];
#pragma unroll
    for (int i = 0; i < 32; ++i) { const int kk = 2 * i + (lane >> 5); tv[i] = W[(size_t)(k0 + kk) * N + n0 + (lane & 31)]; }
#pragma unroll
    for (int i = 0; i < 32; ++i) { const int kk = 2 * i + (lane >> 5); scr[kk * 33 + (lane & 31)] = tv[i]; }
    LDS_WAIT(); asm volatile("" ::: "memory");
    const int c = lane & 7;
#pragma unroll
    for (int j = 0; j < 4; ++j) { const int n = (lane >> 3) + 8 * j; const LAS float* s = scr + (8 * c) * 33 + n;
        v4u o; o.x = pk2(s[0 * 33], s[1 * 33]); o.y = pk2(s[2 * 33], s[3 * 33]); o.z = pk2(s[4 * 33], s[5 * 33]); o.w = pk2(s[6 * 33], s[7 * 33]);
        *(GAS v4u*)(WT + (size_t)(n0 + n) * K + k0 + 8 * c) = o; }
    LDS_WAIT(); asm volatile("" ::: "memory");
}
__device__ __forceinline__ void xg_row(const float* xrow, const float* g, bf16_t* orow, float* ssrow, int lane) {
    const GAS f32x4* xr = (const GAS f32x4*)xrow + lane; const GAS f32x4* gr = (const GAS f32x4*)g + lane;
    f32x4 v[4]; float s = 0.f;
#pragma unroll
    for (int j = 0; j < 4; ++j) { v[j] = xr[64 * j]; s += (v[j][0] * v[j][0] + v[j][1] * v[j][1]) + (v[j][2] * v[j][2] + v[j][3] * v[j][3]); }
    s += __shfl_xor(s, 1); s += __shfl_xor(s, 2);
    if ((lane & 3) == 0) ssrow[lane >> 2] = s;
    GAS unsigned long long* o8 = (GAS unsigned long long*)orow + lane;
#pragma unroll
    for (int j = 0; j < 4; ++j) { const f32x4 gg = gr[64 * j]; o8[64 * j] = (unsigned long long)pk2(v[j][0] * gg[0], v[j][1] * gg[1]) | ((unsigned long long)pk2(v[j][2] * gg[2], v[j][3] * gg[3]) << 32); }
}
__device__ __forceinline__ void xg_rows4(const float* x, const float* g, bf16_t* XGp, float* SSp, int m, int stride, int lane) {
    f32x4 v[4][4];
#pragma unroll
    for (int q = 0; q < 4; ++q) { const int row = m + q * stride; const int rc = row < MT ? row : m; const GAS f32x4* xr = (const GAS f32x4*)(x + (size_t)rc * DM) + lane;
#pragma unroll
        for (int j = 0; j < 4; ++j) v[q][j] = xr[64 * j]; }
    const GAS f32x4* gr = (const GAS f32x4*)g + lane; f32x4 gg[4];
#pragma unroll
    for (int j = 0; j < 4; ++j) gg[j] = gr[64 * j];
#pragma unroll
    for (int q = 0; q < 4; ++q) { const int row = m + q * stride; if (row < MT) { float s = 0.f;
#pragma unroll
        for (int j = 0; j < 4; ++j) s += (v[q][j][0] * v[q][j][0] + v[q][j][1] * v[q][j][1]) + (v[q][j][2] * v[q][j][2] + v[q][j][3] * v[q][j][3]);
        s += __shfl_xor(s, 1); s += __shfl_xor(s, 2);
        if ((lane & 3) == 0) SSp[(size_t)row * 16 + (lane >> 2)] = s;
        GAS unsigned long long* o8 = (GAS unsigned long long*)(XGp + (size_t)row * DM) + lane;
#pragma unroll
        for (int j = 0; j < 4; ++j) o8[64 * j] = (unsigned long long)pk2(v[q][j][0] * gg[j][0], v[q][j][1] * gg[j][1]) | ((unsigned long long)pk2(v[q][j][2] * gg[j][2], v[q][j][3] * gg[j][3]) << 32); } }
}
__device__ __forceinline__ void final_row(const float* xrow, const float* g, const float* SS, int row, float* orow, int lane) {
    const GAS f32x4* xr = (const GAS f32x4*)xrow + lane; const GAS f32x4* gr = (const GAS f32x4*)g + lane; GAS f32x4* o = (GAS f32x4*)orow + lane;
    const float r = pg8::rstd16(SS, row);
#pragma unroll
    for (int j = 0; j < 4; ++j) { const f32x4 v = xr[64 * j], gg = gr[64 * j]; o[64 * j] = v * gg * r; }
}

template <int I> __device__ __forceinline__ const float* in_ptr() {
    unsigned long long v;
    asm volatile("s_load_dwordx2 %0, %1, %2\n\ts_waitcnt lgkmcnt(0)" : "=s"(v) : "s"(__builtin_amdgcn_kernarg_segment_ptr()), "n"(I * 8) : "memory");
    return (const float*)v;
}
#define INP(i) in_ptr<i>()
__device__ __forceinline__ void final_rows4(float* X, const float* g, const float* SS, int m, int stride, int lane) {
    f32x4 v[4][4]; float r[4];
#pragma unroll
    for (int q = 0; q < 4; ++q) { const int row = m + q * stride; const int rc = row < MT ? row : m; const GAS f32x4* xr = (const GAS f32x4*)(X + (size_t)rc * DM) + lane;
#pragma unroll
        for (int j = 0; j < 4; ++j) v[q][j] = xr[64 * j];
        r[q] = pg8::rstd16(SS, rc); }
    const GAS f32x4* gr = (const GAS f32x4*)g + lane; f32x4 gg[4];
#pragma unroll
    for (int j = 0; j < 4; ++j) gg[j] = gr[64 * j];
#pragma unroll
    for (int q = 0; q < 4; ++q) { const int row = m + q * stride; if (row < MT) { GAS f32x4* o = (GAS f32x4*)(X + (size_t)row * DM) + lane;
#pragma unroll
        for (int j = 0; j < 4; ++j) o[64 * j] = v[q][j] * gg[j] * r[q]; } }
}
struct Args { const float* in[28]; float* out; unsigned char* ws; int ph_lo, ph_hi, li, pad; };

#define ws ((unsigned char*)in_ptr<29>())
#define XR ((float*)in_ptr<28>())
#define XRB ((bf16_t*)in_ptr<28>())
#define Win_t ((bf16_t*)(ws + WS_WIN))
#define Wout_t ((bf16_t*)(ws + WS_WOUT))
#define Wup_t ((bf16_t*)(ws + WS_WUP))
#define Wdn_t ((bf16_t*)(ws + WS_WDN))
#define XG ((bf16_t*)(ws + WS_XG))
#define P ((bf16_t*)(ws + WS_P))
#define YN ((bf16_t*)(ws + WS_YN))
#define HB ((bf16_t*)(ws + WS_H))
#define SS ((float*)(ws + WS_SS))
__global__ void __launch_bounds__(NTHREADS, 2) mega(Args args) {
    extern __shared__ __attribute__((aligned(16))) unsigned char lds[];
    Frame F;
    F.lds = (LAS unsigned char*)lds; F.MISC = (volatile LAS unsigned*)(F.lds + MISC_OFF);
    F.wave = __builtin_amdgcn_readfirstlane((int)threadIdx.x >> 6);
    F.G = gridDim.x; { const int bx = blockIdx.x; F.vcu = (F.G % 8 == 0) ? (bx % 8) * (F.G / 8) + bx / 8 : bx; }
    gu32* ctl = (gu32*)(ws + WS_CTL);
    for (int u = threadIdx.x; u < (LDS_BYTES - MISC_OFF) / 4; u += NTHREADS) ((LAS unsigned*)(F.lds + MISC_OFF))[u] = 0u;
    __syncthreads();
    const int lo = args.ph_lo, hi = args.ph_hi;
    XcdBarrier bar; bar.bar = (unsigned*)(ctl + CW_BAR) + args.li * XCD_BAR_WORDS; bar.x = 0; bar.st = nullptr;
    if (hi - lo > 1) bar = xcd_barrier_post((unsigned*)(ctl + CW_BAR) + args.li * XCD_BAR_WORDS, F.MISC + 8);

    const int gw = F.vcu * NWAVES + F.wave, NGW = F.G * NWAVES;

#define IN(k) (lo <= (k) && (k) < hi)
#ifdef TPROBE
#define TSTAMP(i) do { if (blockIdx.x == 0 && threadIdx.x == 0) ((unsigned long long*)(ws + WS_CTL + 512 * 1024))[i] = __builtin_amdgcn_s_memrealtime(); } while (0)
#else
#define TSTAMP(i)
#endif
#define SEAM(k) do { if (IN(k) && IN((k) + 1)) { xcd_barrier(bar); TSTAMP((k) + 1); } } while (0)
    TSTAMP(0);
    if (IN(PH_PRO)) {
        auto jobT = [&]() __attribute__((always_inline)) {
        LAS float* scr = (LAS float*)(F.lds + RING_OFF + F.wave * 16384);
        constexpr int I_IN = (DM / 64) * (DIN / 32), I_OUT = (DM / 64) * (DM / 32), I_UP = (DM / 64) * (DFF / 32), I_DN = (DFF / 64) * (DM / 32), I_L = I_IN + I_OUT + I_UP + I_DN;
        for (int it = gw; it < DEPTH * I_L; it += NGW) {
            const int l = it / I_L; int r = it % I_L;
            if (r < I_IN) { p0_transpose_item(INP(2) + (size_t)l * DM * DIN, DM, DIN, Win_t + (size_t)l * DINP * DM, scr, r, FLANE); continue; } r -= I_IN;
            if (r < I_OUT) { p0_transpose_item(INP(23) + (size_t)l * DM * DM, DM, DM, Wout_t + (size_t)l * DM * DM, scr, r, FLANE); continue; } r -= I_OUT;
            if (r < I_UP) { p0_transpose_item(INP(25) + (size_t)l * DM * DFF, DM, DFF, Wup_t + (size_t)l * DFF * DM, scr, r, FLANE); continue; } r -= I_UP;
            p0_transpose_item(INP(26) + (size_t)l * DFF * DM, DFF, DM, Wdn_t + (size_t)l * DM * DFF, scr, r, FLANE);
        }
        for (int i = blockIdx.x * NTHREADS + FTID; i < DEPTH * 16384; i += F.G * NTHREADS) { const int l = i >> 14, r = i & 16383;
            *(GAS v4u*)((GAS unsigned char*)(Win_t + (size_t)l * DINP * DM + (size_t)DIN * DM) + (size_t)r * 16) = (v4u){0u, 0u, 0u, 0u}; }
        {
            float* TWf = (float*)(ws + WS_TW); float* rope = (float*)(ws + WS_ROPE);
            for (int i = blockIdx.x * NTHREADS + FTID; i < 8192; i += F.G * NTHREADS) { const double a = 6.283185307179586476925286766559 * (double)i / 8192.0; TWf[2 * i] = (float)cos(a); TWf[2 * i + 1] = (float)(-sin(a)); }
            for (int i = blockIdx.x * NTHREADS + FTID; i < SL * 8; i += F.G * NTHREADS) { const int pos = i >> 3, j = i & 7; const double ang = (double)pos * pow(500000.0, -(double)j / 8.0);
                rope[pos * 16 + j] = (float)cos(ang); rope[pos * 16 + 8 + j] = (float)sin(ang); }
        }
        {
            bf16_t* LW = (bf16_t*)(ws + WS_LW); const float* wa = INP(5); const float* wx = INP(7);
            for (int o = blockIdx.x * NTHREADS + FTID; o < DEPTH * LRU_BLK * 4 * 64 * 64; o += F.G * NTHREADS) {
                const int i = o & 63, j = (o >> 6) & 63, mat = (o >> 12) & 3, lh = o >> 14, h = lh % LRU_BLK, l = lh / LRU_BLK, n = mat >> 1;
                const float* src = (mat & 1) ? wx : wa;
                LW[o] = (bf16_t)f2bf(src[((((size_t)l * 2 + n) * LRU_BLK + h) * 64 + i) * 64 + j]); }
        }
        };
        auto jobF = [&]() __attribute__((always_inline)) {
        {
            const float* w1 = INP(13); const float* b1 = INP(14); const float* fq = INP(15); const float* w2 = INP(16); const float* b2 = INP(17); const float* w3 = INP(18);
            for (int u = F.vcu; u < DEPTH * 128; u += F.G) { const int l = u >> 7;
                hy::filter_unit(F.lds, u & 127, FTID, w1 + (size_t)l * HY_EMB * HY_W, b1 + l * HY_W, fq + l * HY_W, w2 + (size_t)l * HY_W * HY_W, b2 + l * HY_W, w3 + (size_t)l * HY_W * 2 * DC,
                                (float*)(ws + WS_HF) + (size_t)l * DC * 8192); }
            __syncthreads();
        }
        };
        auto jobX = [&]() __attribute__((always_inline)) {
        { const float* x0 = INP(0); const float* g0 = INP(1);
          for (int m = gw; m < MT; m += 4 * NGW) xg_rows4(x0, g0, XG, SS, m, NGW, FLANE); }
        };
        if (blockIdx.x & 1) { jobF(); jobT(); jobX(); } else { jobT(); jobX(); jobF(); }
    }
    SEAM(PH_PRO);
#define WIN_BODY(l) { \
        pg8::Gemm g{XG, Win_t + (size_t)(l) * DINP * DM, MT, 2048, DM, DM}; pg8::StaticOrder S; S.init(MT, 2048, F.G, (int)blockIdx.x, WGM_IN); \
        pg8::EpiScaleBf16<0> E{P, DINP, SS}; \
        pg8::gemm_phase<pg8::EpiScaleBf16<0>, pg8::StaticOrder, true, true>(F.lds + RING_OFF, g, S, E); \
          \
        { const int c = (int)blockIdx.x, q = c & 3; \
          pg8::Gemm g2{XG + q * 256, Win_t + (size_t)(l) * DINP * DM + (size_t)2048 * DM + q * 256, MT, 256, 256, DM}; \
          pg8::QuarterOrder S2{c >> 2, F.G}; pg8::EpiSlab E2{(bf16_t*)(ws + WS_SLAB) + (size_t)q * MT * 128, SS}; \
          pg8::gemm_phase<pg8::EpiSlab, pg8::QuarterOrder, false, true>(F.lds + RING_OFF, g2, S2, E2); } }
#define MIX1_HYP(l) { const float* cw = INP(11) + (l) * 9 * DC; const float* cb = INP(12) + (l) * 3 * DC; \
        for (int u = F.vcu; u < 256; u += F.G) hy::hyprep_unit(F.lds, u, FTID, P, (const bf16_t*)(ws + WS_SLAB), cw, cb, (bf16_t*)(ws + WS_ZT), (bf16_t*)(ws + WS_X0T)); }
#define MIX1_LRU(l) { const float* cwa = INP(3) + (l) * 4 * DA; const float* cba = INP(4) + (l) * DA; const float* ba = INP(6) + (l) * 2 * DA; const float* bx = INP(8) + (l) * 2 * DA; const float* lam = INP(9) + (l) * 2 * DA; \
          for (int u = F.vcu; u < 256; u += F.G) lru::lru_unit(F.lds, u, FTID, P, cwa, cba, (const bf16_t*)(ws + WS_LW) + (size_t)(l) * LRU_BLK * 4 * 4096, ba, bx, lam, (float*)(ws + WS_AGG), (bf16_t*)(ws + WS_LS), (bf16_t*)(ws + WS_LPF), (bf16_t*)(ws + WS_LPB)); }
#define MIX1_ATT(l) { const float* sk = INP(10) + (l) * NQH; \
          for (int u = F.vcu; u < 256; u += F.G) at::attn_unit(F.lds, u, FTID, P, (const float*)(ws + WS_ROPE), sk, (bf16_t*)(ws + WS_AO)); }
#define MIX1_BODY(l) { const int rot = (int)(blockIdx.x >> 3) % 3; \
        if (rot == 0) { MIX1_HYP(l) MIX1_LRU(l) MIX1_ATT(l) } else if (rot == 1) { MIX1_LRU(l) MIX1_ATT(l) MIX1_HYP(l) } else { MIX1_ATT(l) MIX1_HYP(l) MIX1_LRU(l) } }
#define FFT_BODY(l) { const float* hb = INP(19) + (l) * DC; \
        for (int sq = gw; sq < NB * 2 * DA; sq += NGW) lru::carry_scan_seq(sq, FLANE, (const float*)(ws + WS_AGG), (float*)(ws + lru::WS_CIN)); \
        for (int u = F.vcu; u < DC; u += F.G) hy::fft_unit(F.lds, u, FTID, (const float*)(ws + WS_HF) + (size_t)(l) * DC * 8192, (const hy::cf*)(ws + WS_TW), (const bf16_t*)(ws + WS_ZT), (const bf16_t*)(ws + WS_X0T), \
                                                           (bf16_t*)(ws + WS_YCT), hb[u]); }
#define FIN_LRU(l) { const float* gna = INP(20) + (l) * DA; \
          for (int u = F.vcu; u < 256; u += F.G) lru::lru_fin_unit(F.lds, u, FTID, P, (const float*)(ws + lru::WS_CIN), (const bf16_t*)(ws + WS_LS), (const bf16_t*)(ws + WS_LPF), (const bf16_t*)(ws + WS_LPB), gna, YN); }
#define FIN_NBC(l) { const float* gnb = INP(21) + (l) * DBB; const float* gnc = INP(22) + (l) * DC; \
          for (int u = F.vcu; u < 256; u += F.G) fin::norm_bc_unit(F.lds, u, FTID, (const bf16_t*)(ws + WS_AO), (const bf16_t*)(ws + WS_YCT), gnb, gnc, YN); }
#define FIN_BODY(l) { if ((blockIdx.x >> 3) & 1) { FIN_NBC(l) FIN_LRU(l) } else { FIN_LRU(l) FIN_NBC(l) } }
#define WUP_BODY(l) { \
        pg8::Gemm g{XG, Wup_t + (size_t)(l) * DFF * DM, MT, DFF, DM, DM}; pg8::StaticOrder S; S.init(MT, DFF, F.G, (int)blockIdx.x, WGM_UP); \
        pg8::EpiScaleBf16<1> E{HB, DFF, SS}; \
        pg8::gemm_phase<pg8::EpiScaleBf16<1>, pg8::StaticOrder, true, true>(F.lds + RING_OFF, g, S, E); }
#define LAYER(l) do { constexpr int pb = 1 + PH_PER_LAYER * (l); \
    if (IN(pb + PL_WIN)) { WIN_BODY(l) } \
    SEAM(pb + PL_WIN); \
    if (IN(pb + PL_MIX1)) { MIX1_BODY(l) } \
    SEAM(pb + PL_MIX1); \
    if (IN(pb + PL_FFT)) { FFT_BODY(l) } \
    SEAM(pb + PL_FFT); \
    if (IN(pb + PL_FIN)) { FIN_BODY(l) } \
    SEAM(pb + PL_FIN); \
    if (IN(pb + PL_WOUT)) { \
        pg8::Gemm g{YN, Wout_t + (size_t)(l) * DM * DM, MT, DM, DM, DM}; pg8::StaticOrder S; S.init(MT, DM, F.G, (int)blockIdx.x, WGM_OUT); \
        if ((l) == 0) { pg8::EpiResB<true> E{(const void*)INP(0), XRB, XG, INP(24) + (l) * DM, SS}; \
            pg8::gemm_phase<pg8::EpiResB<true>, pg8::StaticOrder, true, true>(F.lds + RING_OFF, g, S, E); } \
        else { pg8::EpiResB<false> E{(const void*)XRB, XRB, XG, INP(24) + (l) * DM, SS}; \
            pg8::gemm_phase<pg8::EpiResB<false>, pg8::StaticOrder, true, true>(F.lds + RING_OFF, g, S, E); } } \
    SEAM(pb + PL_WOUT); \
    if (IN(pb + PL_WUP)) { WUP_BODY(l) } \
    SEAM(pb + PL_WUP); \
    if (IN(pb + PL_WDN)) { \
        pg8::Gemm g{HB, Wdn_t + (size_t)(l) * DM * DFF, MT, DM, DFF, DFF}; pg8::StaticOrder S; S.init(MT, DM, F.G, (int)blockIdx.x, WGM_DN); \
        pg8::EpiResB<false> E{(const void*)XRB, ((l) + 1 < DEPTH) ? XRB : XG  , ((l) + 1 < DEPTH) ? XG : (bf16_t*)nullptr, INP(1) + (((l) + 1 < DEPTH) ? ((l) + 1) * DM : 0), SS}; \
        pg8::gemm_phase<pg8::EpiResB<false>, pg8::StaticOrder, true, true>(F.lds + RING_OFF, g, S, E); } \
    SEAM(pb + PL_WDN); } while (0)
    LAYER(0);
    LAYER(1);
    if (IN(PH_FINAL)) { const float* gf = INP(27);
        const GAS f32x4* gr = (const GAS f32x4*)gf; const int ln = FLANE;
        f32x4 gg[4];
#pragma unroll
        for (int j = 0; j < 2; ++j) { gg[2 * j] = gr[2 * ln + 128 * j]; gg[2 * j + 1] = gr[2 * ln + 128 * j + 1]; }
        for (int m = gw; m < MT; m += 4 * NGW) { v4u xv[4][2]; float rr[4];
#pragma unroll
            for (int q = 0; q < 4; ++q) { const int row = m + q * NGW; const int rc = row < MT ? row : m; const v4u* src = (const v4u*)(XG + (size_t)rc * DM) + ln;
                xv[q][0] = src[0]; xv[q][1] = src[64]; rr[q] = pg8::rstd16(SS, rc); }
#pragma unroll
            for (int q = 0; q < 4; ++q) { const int row = m + q * NGW; if (row < MT) { GAS f32x4* o = (GAS f32x4*)(XR + (size_t)row * DM);
#pragma unroll
                for (int j = 0; j < 2; ++j) { const v4u w = xv[q][j];
                    const f32x4 a = (f32x4){pg8::bflo(w.x), pg8::bfhi(w.x), pg8::bflo(w.y), pg8::bfhi(w.y)}, c = (f32x4){pg8::bflo(w.z), pg8::bfhi(w.z), pg8::bflo(w.w), pg8::bfhi(w.w)};
                    o[2 * ln + 128 * j] = a * gg[2 * j] * rr[q]; o[2 * ln + 128 * j + 1] = c * gg[2 * j + 1] * rr[q]; } } } }
#ifdef TPROBE
        {   const unsigned long long* T = (const unsigned long long*)(ws + WS_CTL + 512 * 1024);
            const float d2 = (TPROBE == 102) ? ((float)(T[15] - T[0]) * 0.01f - 1000.f) * 0.002f : (TPROBE == 101) ? (float)(__builtin_amdgcn_s_memrealtime() - T[15]) * 0.0001f : (TPROBE >= 100) ? (float)(T[15] - T[0]) * 0.00001f : (float)(T[(TPROBE % 100) + 1] - T[TPROBE % 100]) * 0.0001f;
            asm volatile("s_waitcnt vmcnt(0)" ::: "memory");
            if (gw == 0 && FLANE == 0) XR[0] += d2; }
#endif
    }
#undef IN
#undef SEAM
#undef LAYER
}

#undef ws
#undef XR
#undef Win_t
#undef Wout_t
#undef Wup_t
#undef Wdn_t
#undef XG
#undef P
#undef YN
#undef HB
#undef SS
static int g_grid = 0, g_li = 0;
static void launch_mega(Args a, int lo, int hi, hipStream_t stream) {
    a.ph_lo = lo; a.ph_hi = hi; a.li = (hi - lo > 1) ? g_li++ : 0;
    void* kargs[] = {&a};
    hipLaunchCooperativeKernel((const void*)mega, dim3(g_grid), dim3(NTHREADS), kargs, LDS_BYTES, stream);
}
extern "C" void kernel_launch(void* const* d_in, const int* in_sizes, int n_in, void* d_out, int out_size, void* d_ws, size_t ws_size, hipStream_t stream) {
    if (n_in != 28 || ws_size < WS_END) return;
    if (g_grid == 0) {
        int dev = 0, cus = 0, per_cu = 0;
        hipGetDevice(&dev); hipDeviceGetAttribute(&cus, hipDeviceAttributeMultiprocessorCount, dev);
        hipFuncSetAttribute((const void*)mega, hipFuncAttributeMaxDynamicSharedMemorySize, LDS_BYTES);
        hipOccupancyMaxActiveBlocksPerMultiprocessor(&per_cu, (const void*)mega, NTHREADS, LDS_BYTES);
        (void)hipGetLastError();
        if (per_cu < 1) per_cu = 1;
        if (per_cu > 1) per_cu = 1;
        g_grid = cus * per_cu;
    }
    g_li = 0;
    unsigned char* ws = (unsigned char*)d_ws;
    hipMemsetAsync(ws + WS_CTL, 0, 64 * 1024, stream);
    Args a{};
    for (int i = 0; i < 28; ++i) a.in[i] = (const float*)d_in[i];
    a.out = (float*)d_out; a.ws = ws;

    launch_mega(a, 0, NPH, stream);
}
```
